# Optimizing an MI355X kernel written in HIP

```python
import math
import jax, jax.numpy as jnp
from jax import lax
import numpy as np

D_MODEL = 1024
BATCH = 8
SEQ = 2048
DEPTH = 2

HEAD_DIM = 64
SWA_Q_HEADS = 8
SWA_KV_HEADS = 2
WINDOW = 128
BLOCK = 128
DIFF_HEADS = 4
DIFF_QK_DIM = 64
DIFF_V_DIM = 2 * DIFF_QK_DIM
D_FF = ((8 * D_MODEL // 3 + 127) // 128) * 128
CONV_WIDTH = 3
ROPE_THETA = 10000.0
EPS = 1e-6
NEG = -1e30

SWA_Q = SWA_Q_HEADS * HEAD_DIM
SWA_KV = SWA_KV_HEADS * HEAD_DIM
DIFF_Q = DIFF_HEADS * 2 * DIFF_QK_DIM
DIFF_V = DIFF_HEADS * DIFF_V_DIM
IN_COLS = SWA_Q + 2 * SWA_KV + 2 * DIFF_Q + DIFF_V
MIX_WIDTH = SWA_Q + DIFF_V

kernel_name = "hybrid_swa_sink_diffattn_convglu"


def rmsnorm(x, g):
    xf = x.astype(jnp.float32)
    y = xf * lax.rsqrt(jnp.mean(xf * xf, axis=-1, keepdims=True) + EPS)
    return (y * g.astype(jnp.float32)).astype(x.dtype)


def rope_tables(seq, dim):
    inv = 1.0 / (ROPE_THETA ** (jnp.arange(0, dim, 2, dtype=jnp.float32) / dim))
    ang = jnp.arange(seq, dtype=jnp.float32)[:, None] * inv[None, :]
    return jnp.cos(ang), jnp.sin(ang)


def apply_rope(x, cos, sin):
    x1, x2 = jnp.split(x.astype(jnp.float32), 2, axis=-1)
    c = cos[None, :, None, :]
    s = sin[None, :, None, :]
    return jnp.concatenate([x1 * c - x2 * s, x2 * c + x1 * s], axis=-1).astype(x.dtype)


def windowed_gqa_sink(q, k, v, sink):
    B, S, Hq, D = q.shape
    Hkv = k.shape[2]
    G = Hq // Hkv
    nb = S // BLOCK
    qb = q.reshape(B, nb, BLOCK, Hkv, G, D)

    def band(t):
        tp = jnp.pad(t, ((0, 0), (BLOCK, BLOCK), (0, 0), (0, 0)))
        tb = tp.reshape(B, nb + 2, BLOCK, Hkv, D)
        return jnp.concatenate([tb[:, :-2], tb[:, 1:-1], tb[:, 2:]], axis=2)

    kb, vb = band(k), band(v)
    scores = jnp.einsum('bnqhgd,bnkhd->bnhgqk', qb, kb,
                        preferred_element_type=jnp.float32) * (D ** -0.5)
    qpos = jnp.arange(nb)[:, None] * BLOCK + jnp.arange(BLOCK)[None, :]
    kpos = (jnp.arange(nb)[:, None] - 1) * BLOCK + jnp.arange(3 * BLOCK)[None, :]
    rel = kpos[:, None, :] - qpos[:, :, None]
    valid = (jnp.abs(rel) <= WINDOW) & (kpos[:, None, :] >= 0) & (kpos[:, None, :] < S)
    scores = jnp.where(valid[None, :, None, None], scores, NEG)
    sink_l = sink.astype(jnp.float32).reshape(Hkv, G)[None, None, :, :, None, None]
    m = jnp.maximum(jnp.max(scores, axis=-1, keepdims=True), sink_l)
    p = jnp.exp(scores - m)
    p = p / (jnp.sum(p, axis=-1, keepdims=True) + jnp.exp(sink_l - m))
    out = jnp.einsum('bnhgqk,bnkhd->bnqhgd', p.astype(v.dtype), vb)
    return out.reshape(B, S, Hq, D)


def diff_attention(q, k, v, lam):
    B, S, H, _, Dk = q.shape
    nb = S // BLOCK
    qb = jnp.moveaxis(q.reshape(B, nb, BLOCK, H, 2, Dk), 1, 0)
    scale = Dk ** -0.5

    def one_block(qi):
        s = jnp.einsum('bqhcd,bkhcd->bhcqk', qi, k,
                       preferred_element_type=jnp.float32) * scale
        p = jax.nn.softmax(s, axis=-1)
        w = p[:, :, 0] - lam * p[:, :, 1]
        return jnp.einsum('bhqk,bkhd->bqhd', w.astype(v.dtype), v)

    out = lax.map(one_block, qb)
    return jnp.moveaxis(out, 0, 1).reshape(B, S, H, v.shape[-1])


def centred_dwconv(x, w, b):
    S = x.shape[1]
    half = CONV_WIDTH // 2
    xp = jnp.pad(x, ((0, 0), (half, half), (0, 0)))
    out = b
    for j in range(CONV_WIDTH):
        out = out + xp[:, j:j + S, :] * w[j]
    return out


def setup_inputs(seed: int = 0) -> dict:
    key = jax.random.key(seed)
    ks = jax.random.split(key, 20)
    f32 = jnp.float32
    nrm = lambda k, shp, sc: jax.random.normal(k, shp, f32) * sc
    L = DEPTH
    return {
        "x": nrm(ks[0], (BATCH, SEQ, D_MODEL), 1.0),
        "g_attn": 1.0 + nrm(ks[1], (L, D_MODEL), 0.02),
        "w_in": nrm(ks[2], (L, D_MODEL, IN_COLS), D_MODEL ** -0.5),
        "qn_a": 1.0 + nrm(ks[3], (L, HEAD_DIM), 0.02),
        "kn_a": 1.0 + nrm(ks[4], (L, HEAD_DIM), 0.02),
        "sink": nrm(ks[5], (L, SWA_Q_HEADS), 0.5),
        "qn_b": 1.0 + nrm(ks[6], (L, DIFF_QK_DIM), 0.02),
        "kn_b": 1.0 + nrm(ks[7], (L, DIFF_QK_DIM), 0.02),
        "lq1": nrm(ks[8], (L, DIFF_QK_DIM), 0.1),
        "lk1": nrm(ks[9], (L, DIFF_QK_DIM), 0.1),
        "lq2": nrm(ks[10], (L, DIFF_QK_DIM), 0.1),
        "lk2": nrm(ks[11], (L, DIFF_QK_DIM), 0.1),
        "subln": 1.0 + nrm(ks[12], (L, DIFF_V_DIM), 0.02),
        "w_out": nrm(ks[13], (L, MIX_WIDTH, D_MODEL), MIX_WIDTH ** -0.5),
        "g_ffn": 1.0 + nrm(ks[14], (L, D_MODEL), 0.02),
        "w_up": nrm(ks[15], (L, D_MODEL, 2 * D_FF), D_MODEL ** -0.5),
        "conv_w": nrm(ks[16], (L, CONV_WIDTH, D_FF), CONV_WIDTH ** -0.5),
        "conv_b": nrm(ks[17], (L, D_FF), 0.02),
        "w_down": nrm(ks[18], (L, D_FF, D_MODEL), D_FF ** -0.5),
    }


def reference(x, g_attn, w_in, qn_a, kn_a, sink, qn_b, kn_b, lq1, lk1, lq2, lk2,
              subln, w_out, g_ffn, w_up, conv_w, conv_b, w_down):
    B, S, _ = x.shape
    cos_a, sin_a = rope_tables(S, HEAD_DIM)
    cos_b, sin_b = rope_tables(S, DIFF_QK_DIM)
    offs = np.cumsum([SWA_Q, SWA_KV, SWA_KV, DIFF_Q, DIFF_Q]).tolist()
    for l in range(DEPTH):
        lambda_init = 0.8 - 0.6 * math.exp(-0.3 * l)
        h = rmsnorm(x, g_attn[l])
        proj = jnp.einsum('bsd,dc->bsc', h, w_in[l])
        qa, ka, va, qb, kb, vb = jnp.split(proj, offs, axis=-1)
        qa = apply_rope(rmsnorm(qa.reshape(B, S, SWA_Q_HEADS, HEAD_DIM), qn_a[l]), cos_a, sin_a)
        ka = apply_rope(rmsnorm(ka.reshape(B, S, SWA_KV_HEADS, HEAD_DIM), kn_a[l]), cos_a, sin_a)
        va = va.reshape(B, S, SWA_KV_HEADS, HEAD_DIM)
        ya = windowed_gqa_sink(qa, ka, va, sink[l])
        qb = apply_rope(rmsnorm(qb.reshape(B, S, 2 * DIFF_HEADS, DIFF_QK_DIM), qn_b[l]), cos_b, sin_b)
        kb = apply_rope(rmsnorm(kb.reshape(B, S, 2 * DIFF_HEADS, DIFF_QK_DIM), kn_b[l]), cos_b, sin_b)
        qb = qb.reshape(B, S, DIFF_HEADS, 2, DIFF_QK_DIM)
        kb = kb.reshape(B, S, DIFF_HEADS, 2, DIFF_QK_DIM)
        vb = vb.reshape(B, S, DIFF_HEADS, DIFF_V_DIM)
        lam = (jnp.exp(jnp.sum(lq1[l].astype(jnp.float32) * lk1[l].astype(jnp.float32)))
               - jnp.exp(jnp.sum(lq2[l].astype(jnp.float32) * lk2[l].astype(jnp.float32)))
               + lambda_init)
        yb = diff_attention(qb, kb, vb, lam)
        yb = rmsnorm(yb, subln[l]) * (1.0 - lambda_init)
        y = jnp.concatenate([ya.reshape(B, S, SWA_Q), yb.reshape(B, S, DIFF_V)], axis=-1)
        x = x + jnp.einsum('bsm,md->bsd', y, w_out[l])
        h = rmsnorm(x, g_ffn[l])
        gate, val = jnp.split(jnp.einsum('bsd,df->bsf', h, w_up[l]), 2, axis=-1)
        gate = centred_dwconv(gate, conv_w[l], conv_b[l])
        x = x + jnp.einsum('bsf,fd->bsd', jax.nn.silu(gate) * val, w_down[l])
    return x
```

```cpp
#include <hip/hip_runtime.h>
#include <hip/hip_cooperative_groups.h>
#include <cstdio>
#include <cstdint>
namespace cg = cooperative_groups;
namespace pg8 {
#define PG8_LAS __attribute__((address_space(3)))
typedef unsigned short bf16_t;
typedef short bf16x8 __attribute__((ext_vector_type(8)));
typedef float f32x4 __attribute__((ext_vector_type(4)));
typedef unsigned u32x4 __attribute__((ext_vector_type(4)));
constexpr int BM = 256, BK = 64, HALF = 128, HTB = HALF * BK * 2  , STAGE_BYTES = 8 * HTB, NXCD = 8, WGM = 8;

__host__ __device__ __forceinline__ int lds_byte(int r, int c) { const int st = (r >> 4) * 2 + (c >> 5), rr = r & 15, cc = c & 31, ob = rr * 64 + cc * 2; return st * 1024 + (ob ^ (((ob >> 9) & 1) << 5)); }
__host__ __device__ __forceinline__ void stage_rc(int b, int& R, int& C) { const int st = b / 1024, sb = b % 1024, swz = sb ^ (((sb >> 9) & 1) << 5); R = (st >> 1) * 16 + swz / 64; C = (st & 1) * 32 + (swz % 64) / 2; }
__host__ __device__ __forceinline__ int perm32(int rho) { const int n = rho >> 4, i = rho & 15; return 8 * (i >> 2) + 4 * n + (i & 3); }

struct Unit { int pm, pn; };
struct Gemm { const bf16_t* A; const bf16_t* Bt; int M, N, K; };

struct StaticOrder {
    int nM, nN, nwg, G, c;
    __host__ __device__ void init(int M, int N, int G_, int c_) { nM = M / BM; nN = N / BM; nwg = nM * nN; G = G_; c = c_; }
    __host__ __device__ bool next(int i, Unit& u) const {
        const long L = (long)i * G + c; if (L >= nwg) return false;
        int wgid = (int)L; { const int q = nwg / NXCD, r = nwg % NXCD, xcd = wgid % NXCD, off = wgid / NXCD; wgid = (xcd < r ? xcd * (q + 1) : r * (q + 1) + (xcd - r) * q) + off; }
        const int nig = WGM * nN, gid = wgid / nig, fm = gid * WGM, gsz = (nM - fm) < WGM ? (nM - fm) : WGM;
        u.pm = fm + ((wgid % nig) % gsz); u.pn = (wgid % nig) / gsz; return true;
    }
    __device__ __forceinline__ void a_ready(const Unit&) const {}
    __device__ __forceinline__ void done(const Unit&) const {}
};

__device__ __forceinline__ unsigned cvt_pk_bf16(float lo, float hi) { unsigned r; asm volatile("v_cvt_pk_bf16_f32 %0, %1, %2" : "=v"(r) : "v"(lo), "v"(hi)); return r; }
template <class Epi, class Sched, bool ALIGN_EPI = false, bool SP2 = false>
__device__ __forceinline__ void gemm_phase(PG8_LAS unsigned char* lds, const Gemm g, const Sched& S, const Epi& E) {
    int tid = threadIdx.x; asm volatile("" : "+v"(tid)); const int wid = __builtin_amdgcn_readfirstlane(tid >> 6), lane = tid & 63, wr = wid >> 2, wc = wid & 3, fr = lane & 15, fq = lane >> 4;
    const int K = g.K, nt = K / BK;
    unsigned voffA[2], voffB[2];
#pragma unroll
    for (int i = 0; i < 2; ++i) { int R, C; stage_rc(tid * 16 + i * 8192, R, C); const int Rb = Epi::PERM ? ((R & ~31) + perm32(R & 31)) : R;
        voffA[i] = (unsigned)(R * K + C) * 2u; voffB[i] = (unsigned)(Rb * K + C) * 2u; }
    const size_t kstep = (size_t)(BK * 2);
    const size_t hstep = (size_t)HALF * K * 2;
    const size_t tstep = 2 * hstep;
    const unsigned ldsw = (unsigned)wid * 1024u;
    const int aoff = lds_byte(wr * 64 + fr, fq * 8), boff = lds_byte(wc * 32 + fr, fq * 8);
#define PG8_SA(b, h) (((b) * 2 + (h)) * HTB)
#define PG8_SB(b, h) ((4 + (b) * 2 + (h)) * HTB)
#define PG8_STAGE(bufoff, gbase, voff) do { _Pragma("unroll") for (int _i = 0; _i < 2; ++_i) \
        __builtin_amdgcn_global_load_lds((const unsigned*)((const char*)(gbase) + (voff)[_i]), (PG8_LAS unsigned*)(lds + (bufoff) + ldsw + _i * 8192), 16, 0, 0); } while (0)
#define PG8_LDA(dst, b, h) do { _Pragma("unroll") for (int m = 0; m < 4; ++m) _Pragma("unroll") for (int k = 0; k < 2; ++k) dst[m][k] = *(const PG8_LAS bf16x8*)(lds + PG8_SA(b, h) + aoff + m * 2048 + k * 1024); } while (0)
#define PG8_LDB(dst, b, h) do { _Pragma("unroll") for (int n = 0; n < 2; ++n) _Pragma("unroll") for (int k = 0; k < 2; ++k) dst[n][k] = *(const PG8_LAS bf16x8*)(lds + PG8_SB(b, h) + boff + n * 2048 + k * 1024); } while (0)
#define PG8_MMA(ai, bj, At, Bt) do { __builtin_amdgcn_s_setprio(1); _Pragma("unroll") for (int m = 0; m < 4; ++m) _Pragma("unroll") for (int n = 0; n < 2; ++n) _Pragma("unroll") for (int k = 0; k < 2; ++k) \
        acc[ai][bj][m][n] = __builtin_amdgcn_mfma_f32_16x16x32_bf16(Bt[n][k], At[m][k], acc[ai][bj][m][n], 0, 0, 0); __builtin_amdgcn_s_setprio(0); } while (0)
#define PG8_WAIT_V(n) asm volatile("s_waitcnt vmcnt(" #n ")" ::: "memory")
#define PG8_WAIT_L(n) asm volatile("s_waitcnt lgkmcnt(" #n ")" ::: "memory")
#define PG8_BAR __builtin_amdgcn_s_barrier()
#define PG8_SCHED __builtin_amdgcn_sched_barrier(0)
    Unit cur, nxt; int ui = 0;
    if (!S.next(0, cur)) return;
    f32x4 acc[2][2][4][2];
#pragma unroll
    for (int a = 0; a < 2; ++a)
#pragma unroll
        for (int b = 0; b < 2; ++b)
#pragma unroll
            for (int m = 0; m < 4; ++m)
#pragma unroll
                for (int n = 0; n < 2; ++n) acc[a][b][m][n] = (f32x4){0.f, 0.f, 0.f, 0.f};
    bf16x8 At[4][2], B0[2][2], B1[2][2];
    const char* cA = (const char*)g.A + (size_t)cur.pm * tstep; const char* cB = (const char*)g.Bt + (size_t)cur.pn * tstep;
    S.a_ready(cur);
    if constexpr (SP2) {
        PG8_STAGE(PG8_SB(0, 0), cB, voffB); PG8_STAGE(PG8_SB(0, 1), cB + hstep, voffB); PG8_STAGE(PG8_SA(0, 0), cA, voffA); PG8_STAGE(PG8_SA(0, 1), cA + hstep, voffA);
        if (wr == 1) PG8_BAR;
        PG8_WAIT_V(2); PG8_BAR;
        PG8_STAGE(PG8_SB(1, 0), cB + kstep, voffB); PG8_STAGE(PG8_SA(1, 0), cA + kstep, voffA); PG8_STAGE(PG8_SB(1, 1), cB + hstep + kstep, voffB);
        PG8_WAIT_V(6); PG8_BAR;
    } else {
        PG8_STAGE(PG8_SB(0, 0), cB, voffB); PG8_STAGE(PG8_SA(0, 0), cA, voffA); PG8_STAGE(PG8_SB(0, 1), cB + hstep, voffB); PG8_STAGE(PG8_SA(0, 1), cA + hstep, voffA);
        if (wr == 1) PG8_BAR;
        PG8_WAIT_V(4); PG8_BAR;
        PG8_STAGE(PG8_SB(1, 0), cB + kstep, voffB); PG8_STAGE(PG8_SA(1, 0), cA + kstep, voffA); PG8_STAGE(PG8_SB(1, 1), cB + hstep + kstep, voffB);
        PG8_WAIT_V(6); PG8_BAR;
    }
    for (;;) {
        const bool has_next = S.next(ui + 1, nxt);
        const char* nA = has_next ? (const char*)g.A + (size_t)nxt.pm * tstep : cA; const char* nB = has_next ? (const char*)g.Bt + (size_t)nxt.pn * tstep : cB;
        for (int t = 0; t < nt; t += 2) {
            const bool last = (t == nt - 2);
            const char* a1 = cA + (size_t)(t + 1) * kstep;
            const char* a2 = last ? nA : cA + (size_t)(t + 2) * kstep; const char* b2 = last ? nB : cB + (size_t)(t + 2) * kstep;
            const char* a3 = a2 + kstep; const char* b3 = b2 + kstep;
            if (last && has_next) S.a_ready(nxt);
            if constexpr (SP2) {
            PG8_LDB(B0, 0, 0); PG8_LDB(B1, 0, 1); PG8_SCHED; PG8_LDA(At, 0, 0); PG8_STAGE(PG8_SA(1, 1), a1 + hstep, voffA);
            PG8_WAIT_V(8); PG8_WAIT_L(0); PG8_BAR; PG8_MMA(0, 0, At, B0); PG8_MMA(0, 1, At, B1); PG8_BAR; PG8_SCHED;
            PG8_LDA(At, 0, 1); PG8_STAGE(PG8_SB(0, 0), b2, voffB); PG8_STAGE(PG8_SB(0, 1), b2 + hstep, voffB); PG8_STAGE(PG8_SA(0, 0), a2, voffA);
            PG8_WAIT_V(8); PG8_WAIT_L(0); PG8_BAR; PG8_MMA(1, 0, At, B0); PG8_MMA(1, 1, At, B1); PG8_BAR; PG8_SCHED;
            PG8_LDB(B0, 1, 0); PG8_LDB(B1, 1, 1); PG8_SCHED; PG8_LDA(At, 1, 0); PG8_STAGE(PG8_SA(0, 1), a2 + hstep, voffA);
            PG8_WAIT_V(8); PG8_WAIT_L(0); PG8_BAR; PG8_MMA(0, 0, At, B0); PG8_MMA(0, 1, At, B1); PG8_BAR; PG8_SCHED;
            PG8_LDA(At, 1, 1); PG8_STAGE(PG8_SB(1, 0), b3, voffB); PG8_STAGE(PG8_SB(1, 1), b3 + hstep, voffB); PG8_STAGE(PG8_SA(1, 0), a3, voffA);
            PG8_WAIT_V(8); PG8_WAIT_L(0); PG8_BAR; PG8_MMA(1, 0, At, B0); PG8_MMA(1, 1, At, B1); PG8_BAR; PG8_SCHED;
            } else {
            PG8_LDB(B0, 0, 0); PG8_SCHED; PG8_LDA(At, 0, 0); PG8_STAGE(PG8_SA(1, 1), a1 + hstep, voffA);
            PG8_WAIT_L(8); PG8_BAR; PG8_WAIT_L(0); PG8_MMA(0, 0, At, B0); PG8_BAR; PG8_SCHED;
            PG8_LDB(B1, 0, 1); PG8_STAGE(PG8_SB(0, 0), b2, voffB);
            PG8_BAR; PG8_WAIT_L(0); PG8_MMA(0, 1, At, B1); PG8_BAR;
            PG8_LDA(At, 0, 1); PG8_STAGE(PG8_SA(0, 0), a2, voffA);
            PG8_BAR; PG8_WAIT_L(0); PG8_MMA(1, 0, At, B0); PG8_BAR; PG8_SCHED;
            PG8_STAGE(PG8_SB(0, 1), b2 + hstep, voffB);
            PG8_WAIT_V(6); PG8_BAR; PG8_MMA(1, 1, At, B1); PG8_BAR;
            PG8_LDB(B0, 1, 0); PG8_SCHED; PG8_LDA(At, 1, 0); PG8_STAGE(PG8_SA(0, 1), a2 + hstep, voffA);
            PG8_WAIT_L(8); PG8_BAR; PG8_WAIT_L(0); PG8_MMA(0, 0, At, B0); PG8_BAR; PG8_SCHED;
            PG8_LDB(B1, 1, 1); PG8_STAGE(PG8_SB(1, 0), b3, voffB);
            PG8_BAR; PG8_WAIT_L(0); PG8_MMA(0, 1, At, B1); PG8_BAR;
            PG8_LDA(At, 1, 1); PG8_STAGE(PG8_SA(1, 0), a3, voffA);
            PG8_BAR; PG8_WAIT_L(0); PG8_MMA(1, 0, At, B0); PG8_BAR; PG8_SCHED;
            PG8_STAGE(PG8_SB(1, 1), b3 + hstep, voffB);
            PG8_WAIT_V(6); PG8_BAR; PG8_MMA(1, 1, At, B1); PG8_BAR;
            }
        }
        if constexpr (ALIGN_EPI) { if (wr == 0) PG8_BAR; }
        if constexpr (!Epi::AFTER_DRAIN) { E(acc, cur, wr, wc, fr, fq); S.done(cur); }
        if (!has_next) break;
#pragma unroll
        for (int a = 0; a < 2; ++a)
#pragma unroll
            for (int b = 0; b < 2; ++b)
#pragma unroll
                for (int m = 0; m < 4; ++m)
#pragma unroll
                    for (int n = 0; n < 2; ++n) acc[a][b][m][n] = (f32x4){0.f, 0.f, 0.f, 0.f};
        cur = nxt; cA = nA; cB = nB; ++ui;
        if constexpr (ALIGN_EPI) { if (wr == 1) PG8_BAR; }
    }
    PG8_WAIT_V(0);
    if constexpr (!ALIGN_EPI) { if (wr == 0) PG8_BAR; }
    PG8_BAR;
    if constexpr (Epi::AFTER_DRAIN) { E.fused(acc, cur, wr, wc, fr, fq, lds, wid, lane); S.done(cur); }
#undef PG8_SA
#undef PG8_SB
#undef PG8_STAGE
#undef PG8_LDA
#undef PG8_LDB
#undef PG8_MMA
#undef PG8_WAIT_V
#undef PG8_WAIT_L
#undef PG8_BAR
#undef PG8_SCHED
}
}
#define LAS __attribute__((address_space(3)))
typedef unsigned short bf16;
using pg8::f32x4; using pg8::u32x4; using pg8::Unit; using pg8::cvt_pk_bf16; using pg8::bf16x8;
typedef unsigned u32x2 __attribute__((ext_vector_type(2)));

constexpr int NB = 8, S = 2048, D = 1024, M = NB * S, NIN = 2304, FF = 2816, NUP = 2 * FF, DEPTH = 2;
constexpr float EPS = 1e-6f;
constexpr float LOG2E = 1.4426950408889634f;
constexpr float QSCALE = 0.125f * LOG2E;
constexpr int XL_OFF = 131072;
constexpr int LDS_BYTES = 131072 + 8192;

__device__ __forceinline__ float dot4(f32x4 a) { return (a[0] * a[0] + a[1] * a[1]) + (a[2] * a[2] + a[3] * a[3]); }
__device__ __forceinline__ float silu_f(float v) { return v * __builtin_amdgcn_rcpf(1.f + __expf(-v)); }

struct EpiInProj {
    static constexpr bool PERM = true, AFTER_DRAIN = false;
    bf16* O; const float* qn_a; const float* kn_a; const float* qn_b; const float* kn_b; const float* cosT; const float* sinT;
    __device__ __forceinline__ void operator()(const f32x4 (&acc)[2][2][4][2], const Unit& u, int wr, int wc, int fr, int fq) const {
        asm volatile("" : "+v"(fr), "+v"(fq));
        const int pn = u.pn;
        const float* g = nullptr; float sc = 1.f;
        if (pn < 2) { g = qn_a; sc = QSCALE; }
        else if (pn == 2) { if (wc < 2) g = kn_a; }
        else if (pn < 5) { g = qn_b; sc = QSCALE; }
        else if (pn < 7) { g = kn_b; }
        const int colb = pn * 256 + wc * 64 + 8 * fq;
        const int row0 = u.pm * 256 + wr * 64 + fr;
        if (g) {
            f32x4 g1[2], g2[2];
#pragma unroll
            for (int n = 0; n < 2; ++n) { g1[n] = *(const f32x4*)(g + 8 * fq + 4 * n); g2[n] = *(const f32x4*)(g + 32 + 8 * fq + 4 * n); }
#pragma unroll
            for (int ai = 0; ai < 2; ++ai)
#pragma unroll
                for (int m = 0; m < 4; ++m) {
                    const int row = row0 + ai * 128 + m * 16;
                    const f32x4 a0 = acc[ai][0][m][0], a1 = acc[ai][0][m][1], b0 = acc[ai][1][m][0], b1 = acc[ai][1][m][1];
                    float ss = (dot4(a0) + dot4(a1)) + (dot4(b0) + dot4(b1));
                    ss += __shfl_xor(ss, 16); ss += __shfl_xor(ss, 32);
                    const float rs = rsqrtf(ss * (1.f / 64.f) + EPS) * sc;
                    const size_t ro = (size_t)(row & (S - 1)) * 32 + 8 * fq;
                    const f32x4 c0 = *(const f32x4*)(cosT + ro), c1 = *(const f32x4*)(cosT + ro + 4), s0 = *(const f32x4*)(sinT + ro), s1 = *(const f32x4*)(sinT + ro + 4);
                    const f32x4 y10 = a0 * rs * g1[0], y11 = a1 * rs * g1[1], y20 = b0 * rs * g2[0], y21 = b1 * rs * g2[1];
                    const f32x4 o10 = y10 * c0 - y20 * s0, o11 = y11 * c1 - y21 * s1, o20 = y20 * c0 + y10 * s0, o21 = y21 * c1 + y11 * s1;
                    u32x4 w1, w2;
                    w1.x = cvt_pk_bf16(o10[0], o10[1]); w1.y = cvt_pk_bf16(o10[2], o10[3]); w1.z = cvt_pk_bf16(o11[0], o11[1]); w1.w = cvt_pk_bf16(o11[2], o11[3]);
                    w2.x = cvt_pk_bf16(o20[0], o20[1]); w2.y = cvt_pk_bf16(o20[2], o20[3]); w2.z = cvt_pk_bf16(o21[0], o21[1]); w2.w = cvt_pk_bf16(o21[2], o21[3]);
                    bf16* op = O + (size_t)row * NIN + colb;
                    *(u32x4*)op = w1; *(u32x4*)(op + 32) = w2;
                }
        } else {
#pragma unroll
            for (int ai = 0; ai < 2; ++ai)
#pragma unroll
                for (int m = 0; m < 4; ++m) {
                    const int row = row0 + ai * 128 + m * 16;
                    bf16* op = O + (size_t)row * NIN + colb;
#pragma unroll
                    for (int bj = 0; bj < 2; ++bj) { const f32x4 v0 = acc[ai][bj][m][0], v1 = acc[ai][bj][m][1]; u32x4 w;
                        w.x = cvt_pk_bf16(v0[0], v0[1]); w.y = cvt_pk_bf16(v0[2], v0[3]); w.z = cvt_pk_bf16(v1[0], v1[1]); w.w = cvt_pk_bf16(v1[2], v1[3]);
                        *(u32x4*)(op + 32 * bj) = w; }
                }
        }
    }
};

struct EpiResid {
    static constexpr bool PERM = true, AFTER_DRAIN = false;
    const float* base; float* out;
    __device__ __forceinline__ void operator()(const f32x4 (&acc)[2][2][4][2], const Unit& u, int wr, int wc, int fr, int fq) const {
        asm volatile("" : "+v"(fr), "+v"(fq));
        const int col0 = u.pn * 256 + wc * 32 + 8 * fq, row0 = u.pm * 256 + wr * 64 + fr;
#pragma unroll
        for (int ai = 0; ai < 2; ++ai)
#pragma unroll
            for (int m = 0; m < 4; ++m) {
                const size_t off = (size_t)(row0 + ai * 128 + m * 16) * D + col0;
#pragma unroll
                for (int bj = 0; bj < 2; ++bj) {
                    const f32x4 x0 = *(const f32x4*)(base + off + bj * 128), x1 = *(const f32x4*)(base + off + bj * 128 + 4);
                    *(f32x4*)(out + off + bj * 128) = x0 + acc[ai][bj][m][0]; *(f32x4*)(out + off + bj * 128 + 4) = x1 + acc[ai][bj][m][1];
                }
            }
    }
};

struct EpiUpConv {
    static constexpr bool PERM = true, AFTER_DRAIN = false;
    bf16* ACT; const float* cw; const float* cb; float* edge; float* part; LAS float* xl;
    __device__ __forceinline__ void operator()(const f32x4 (&acc)[2][2][4][2], const Unit& u, int wr, int wc, int fr, int fq) const {
        asm volatile("" : "+v"(fr), "+v"(fq));
        const int lane = 16 * fq + fr;
        const int cl0 = 32 * wc + 8 * fq, ch0 = 128 * u.pn + cl0;
#pragma unroll
        for (int ai = 0; ai < 2; ++ai) {
            const int chunk = 2 * ai + wr;
            if (fr == 0) { *(LAS f32x4*)(xl + (chunk * 2 + 0) * 128 + cl0) = acc[ai][0][0][0]; *(LAS f32x4*)(xl + (chunk * 2 + 0) * 128 + cl0 + 4) = acc[ai][0][0][1]; }
            if (fr == 15) { *(LAS f32x4*)(xl + (chunk * 2 + 1) * 128 + cl0) = acc[ai][0][3][0]; *(LAS f32x4*)(xl + (chunk * 2 + 1) * 128 + cl0 + 4) = acc[ai][0][3][1]; }
        }
        asm volatile("s_waitcnt lgkmcnt(0)" ::: "memory"); __builtin_amdgcn_s_barrier(); asm volatile("" ::: "memory");
        const int lup = (lane & ~15) | ((fr + 15) & 15), ldn = (lane & ~15) | ((fr + 1) & 15);
        const bool seq_first = (u.pm & 7) == 0, seq_last = (u.pm & 7) == 7;
#pragma unroll
        for (int ai = 0; ai < 2; ++ai) {
            const int chunk = 2 * ai + wr;
#pragma unroll
            for (int n = 0; n < 2; ++n) {
                const int ch = ch0 + 4 * n;
                const f32x4 w0 = *(const f32x4*)(cw + ch), w1 = *(const f32x4*)(cw + FF + ch), w2 = *(const f32x4*)(cw + 2 * FF + ch), bb = *(const f32x4*)(cb + ch);
                const f32x4 above = (chunk > 0) ? *(const LAS f32x4*)(xl + ((chunk - 1) * 2 + 1) * 128 + cl0 + 4 * n) : (f32x4){0.f, 0.f, 0.f, 0.f};
                const f32x4 below = (chunk < 3) ? *(const LAS f32x4*)(xl + ((chunk + 1) * 2 + 0) * 128 + cl0 + 4 * n) : (f32x4){0.f, 0.f, 0.f, 0.f};
                f32x4 Rprev = above, Lcur;
#pragma unroll
                for (int e = 0; e < 4; ++e) Lcur[e] = __shfl(acc[ai][0][0][n][e], ldn);
#pragma unroll
                for (int m = 0; m < 4; ++m) {
                    const int rt = ai * 128 + wr * 64 + m * 16 + fr;
                    const size_t row = (size_t)u.pm * 256 + rt;
                    const f32x4 cur = acc[ai][0][m][n], val = acc[ai][1][m][n];
                    f32x4 Rm, Lnext = below;
#pragma unroll
                    for (int e = 0; e < 4; ++e) { Rm[e] = __shfl(cur[e], lup); if (m < 3) Lnext[e] = __shfl(acc[ai][0][m < 3 ? m + 1 : 3][n][e], ldn); }
                    const f32x4 up = (fr == 0) ? Rprev : Rm, dn = (fr == 15) ? Lnext : Lcur;
                    Rprev = Rm; Lcur = Lnext;
                    const f32x4 pre = bb + w0 * up + w1 * cur + w2 * dn;
                    f32x4 res;
#pragma unroll
                    for (int e = 0; e < 4; ++e) res[e] = silu_f(pre[e]) * val[e];
                    if (rt == 0) {
                        *(f32x4*)(edge + ((size_t)u.pm * 2 + 0) * FF + ch) = cur;
                        if (!seq_first) { float* pp = part + (((size_t)u.pm * 2 + 0) * FF + ch) * 2;
                            *(f32x4*)pp = (f32x4){pre[0], val[0], pre[1], val[1]}; *(f32x4*)(pp + 4) = (f32x4){pre[2], val[2], pre[3], val[3]}; }
                    }
                    if (rt == 255) {
                        *(f32x4*)(edge + ((size_t)u.pm * 2 + 1) * FF + ch) = cur;
                        if (!seq_last) { float* pp = part + (((size_t)u.pm * 2 + 1) * FF + ch) * 2;
                            *(f32x4*)pp = (f32x4){pre[0], val[0], pre[1], val[1]}; *(f32x4*)(pp + 4) = (f32x4){pre[2], val[2], pre[3], val[3]}; }
                    }
                    u32x2 w; w.x = cvt_pk_bf16(res[0], res[1]); w.y = cvt_pk_bf16(res[2], res[3]);
                    *(u32x2*)(ACT + row * FF + ch) = w;
                }
            }
        }
    }
};
namespace att {
typedef __attribute__((ext_vector_type(16))) float f32x16;
typedef __attribute__((ext_vector_type(4))) short s16x4;
typedef short v4i16_t __attribute__((ext_vector_type(4)));
typedef LAS const char* lptr;
__device__ __forceinline__ s16x4 vtr(lptr p) { return __builtin_bit_cast(s16x4, __builtin_amdgcn_ds_read_tr16_b64_v4i16((LAS v4i16_t*)p)); }
__device__ __forceinline__ bf16x8 pack8(const f32x16& s, int b) {
    u32x4 w; w.x = cvt_pk_bf16(s[b], s[b + 1]); w.y = cvt_pk_bf16(s[b + 2], s[b + 3]); w.z = cvt_pk_bf16(s[b + 4], s[b + 5]); w.w = cvt_pk_bf16(s[b + 6], s[b + 7]);
    return __builtin_bit_cast(bf16x8, w);
}
#define MFMA32(a, b, c) __builtin_amdgcn_mfma_f32_32x32x16_bf16((a), (b), (c), 0, 0, 0)
constexpr int KROW = 144, VROWD = 320, VROWA = 192;
constexpr int DSTG = 2 * 64 * KROW + 64 * VROWD;
constexpr int ASTG = 64 * KROW + 64 * VROWA;

__device__ __forceinline__ void diff_unit(LAS char* lds, const bf16* __restrict__ QKV, bf16* __restrict__ Y, int b, int h, int qb, float Mb, float lam, const float* __restrict__ subln, float outscale) {
    int tid = threadIdx.x; asm volatile("" : "+v"(tid)); const int lane = tid & 63, w = __builtin_amdgcn_readfirstlane(tid >> 6), q = lane & 31, hi = lane >> 5;
    const int rg = w >> 1, c = w & 1;
    const size_t rowQ = (size_t)b * S + qb * 128 + rg * 32 + q;
    const bf16* qp = QKV + rowQ * NIN + 768 + (2 * h + c) * 64 + hi * 8;
    bf16x8 qf[4];
#pragma unroll
    for (int ds = 0; ds < 4; ++ds) qf[ds] = *(const bf16x8*)(qp + ds * 16);
    const int lrow = tid >> 4, lcc = tid & 15;
    const bf16* kg = QKV + ((size_t)b * S + lrow) * NIN + 1280 + 128 * h + lcc * 8;
    const bf16* vg = QKV + ((size_t)b * S + lrow) * NIN + 1792 + 128 * h + lcc * 8;
    const int kdst = (lcc >> 3) * (64 * KROW) + lrow * KROW + (lcc & 7) * 16;
    const int vdst = 2 * 64 * KROW + lrow * VROWD + lcc * 16;
    u32x4 st0, st1, st2, st3;
#define DLOAD(t) do { const size_t o_ = (size_t)(t) * 64 * NIN; st0 = *(const u32x4*)(kg + o_); st1 = *(const u32x4*)(kg + o_ + 32 * NIN); st2 = *(const u32x4*)(vg + o_); st3 = *(const u32x4*)(vg + o_ + 32 * NIN); } while (0)
#define DSTORE(bo) do { *(LAS u32x4*)(lds + (bo) + kdst) = st0; *(LAS u32x4*)(lds + (bo) + kdst + 32 * KROW) = st1; *(LAS u32x4*)(lds + (bo) + vdst) = st2; *(LAS u32x4*)(lds + (bo) + vdst + 32 * VROWD) = st3; } while (0)
    f32x16 o[4];
#pragma unroll
    for (int i = 0; i < 4; ++i) o[i] = (f32x16){0.f};
    float l = 0.f;
    DLOAD(0); DSTORE(0); __syncthreads();
    const int koff = c * (64 * KROW) + q * KROW + hi * 16;
    const int voff = 2 * 64 * KROW + (4 * hi + ((lane & 15) >> 2)) * VROWD + ((lane >> 4) & 1) * 32 + (lane & 3) * 8;
    for (int t = 0; t < S / 64; ++t) {
        const int cur = (t & 1) * DSTG, nxt = DSTG - cur;
        if (t + 1 < S / 64) DLOAD(t + 1);
        lptr kb = (lptr)(lds + cur + koff);
        f32x16 s0 = (f32x16){0.f}, s1 = (f32x16){0.f};
#pragma unroll
        for (int ds = 0; ds < 4; ++ds) {
            const bf16x8 k0 = *(const LAS bf16x8*)(kb + ds * 32), k1 = *(const LAS bf16x8*)(kb + 32 * KROW + ds * 32);
            s0 = MFMA32(k0, qf[ds], s0); s1 = MFMA32(k1, qf[ds], s1);
        }
        float ls = 0.f;
#pragma unroll
        for (int r = 0; r < 16; ++r) { s0[r] = __builtin_amdgcn_exp2f(s0[r] - Mb); s1[r] = __builtin_amdgcn_exp2f(s1[r] - Mb); ls += s0[r] + s1[r]; }
        l += ls;
        bf16x8 pf[4]; pf[0] = pack8(s0, 0); pf[1] = pack8(s0, 8); pf[2] = pack8(s1, 0); pf[3] = pack8(s1, 8);
        lptr vb = (lptr)(lds + cur + voff);
#pragma unroll
        for (int ks = 0; ks < 4; ++ks)
#pragma unroll
            for (int db = 0; db < 4; ++db) {
                const s16x4 lo = vtr(vb + ks * 16 * VROWD + db * 64), hh = vtr(vb + ks * 16 * VROWD + 8 * VROWD + db * 64);
                const bf16x8 vf = (bf16x8){lo[0], lo[1], lo[2], lo[3], hh[0], hh[1], hh[2], hh[3]};
                o[db] = MFMA32(vf, pf[ks], o[db]);
            }
        if (t + 1 < S / 64) DSTORE(nxt);
        __syncthreads();
    }
#undef DLOAD
#undef DSTORE
    l += __shfl_xor(l, 32);
    const float inv = 1.f / l;
    LAS f32x4* xb = (LAS f32x4*)lds + rg * (16 * 64) + lane;
    if (c == 1) {
#pragma unroll
        for (int db = 0; db < 4; ++db)
#pragma unroll
            for (int r4 = 0; r4 < 4; ++r4) xb[(db * 4 + r4) * 64] = (f32x4){o[db][4 * r4], o[db][4 * r4 + 1], o[db][4 * r4 + 2], o[db][4 * r4 + 3]} * inv;
    }
    __syncthreads();
    if (c == 0) {
        float ss = 0.f;
#pragma unroll
        for (int db = 0; db < 4; ++db)
#pragma unroll
            for (int r4 = 0; r4 < 4; ++r4) { const f32x4 ot = xb[(db * 4 + r4) * 64];
#pragma unroll
                for (int e = 0; e < 4; ++e) { const float d = o[db][4 * r4 + e] * inv - lam * ot[e]; o[db][4 * r4 + e] = d; ss += d * d; } }
        ss += __shfl_xor(ss, 32);
        const float rs = rsqrtf(ss * (1.f / 128.f) + EPS) * outscale;
        bf16* yp = Y + rowQ * D + 512 + 128 * h + 4 * hi;
#pragma unroll
        for (int db = 0; db < 4; ++db)
#pragma unroll
            for (int r4 = 0; r4 < 4; ++r4) { const f32x4 gw = *(const f32x4*)(subln + 32 * db + 8 * r4 + 4 * hi);
                u32x2 wv; wv.x = cvt_pk_bf16(o[db][4 * r4] * rs * gw[0], o[db][4 * r4 + 1] * rs * gw[1]); wv.y = cvt_pk_bf16(o[db][4 * r4 + 2] * rs * gw[2], o[db][4 * r4 + 3] * rs * gw[3]);
                *(u32x2*)(yp + 32 * db + 8 * r4) = wv; }
    }
    __syncthreads();
}

__device__ __forceinline__ void swa_unit(LAS char* lds, const bf16* __restrict__ QKV, bf16* __restrict__ Y, int b, int kvh, int n, float Mb, const float* __restrict__ sink) {
    int tid = threadIdx.x; asm volatile("" : "+v"(tid)); const int lane = tid & 63, w = __builtin_amdgcn_readfirstlane(tid >> 6), q = lane & 31, hi = lane >> 5;
    const int head = kvh * 4 + (w >> 1), rb = (w & 1) * 64;
    const size_t rowQ = (size_t)b * S + n * 128 + rb + q;
    bf16x8 qf[2][4];
#pragma unroll
    for (int rg = 0; rg < 2; ++rg)
#pragma unroll
        for (int ds = 0; ds < 4; ++ds) qf[rg][ds] = *(const bf16x8*)(QKV + (rowQ + 32 * rg) * NIN + head * 64 + hi * 8 + ds * 16);
    const int lrow = tid >> 3, lcc = tid & 7;
    const long kp0 = (long)b * S + (long)(n - 1) * 128 + lrow;
    const bf16* kg = QKV + kp0 * NIN + 512 + kvh * 64 + lcc * 8;
    const bf16* vg = QKV + kp0 * NIN + 640 + kvh * 64 + lcc * 8;
    const int kdst = lrow * KROW + lcc * 16, vdst = 64 * KROW + lrow * VROWA + lcc * 16;
    u32x4 st0, st1;
#define ALOAD(t) do { const long o_ = (long)(t) * 64 * NIN; st0 = *(const u32x4*)(kg + o_); st1 = *(const u32x4*)(vg + o_); } while (0)
#define ASTORE(bo) do { *(LAS u32x4*)(lds + (bo) + kdst) = st0; *(LAS u32x4*)(lds + (bo) + vdst) = st1; } while (0)
    f32x16 o[2][2];
#pragma unroll
    for (int i = 0; i < 2; ++i)
#pragma unroll
        for (int j = 0; j < 2; ++j) o[i][j] = (f32x16){0.f};
    float l[2] = {0.f, 0.f};
    const int t0 = (n == 0) ? 2 : 0, t1 = (n == S / 128 - 1) ? 4 : 6;
    ALOAD(t0); ASTORE((t0 & 1) * ASTG); __syncthreads();
    const int koff = q * KROW + hi * 16;
    const int voff = 64 * KROW + (4 * hi + ((lane & 15) >> 2)) * VROWA + ((lane >> 4) & 1) * 32 + (lane & 3) * 8;
    for (int t = t0; t < t1; ++t) {
        const int cur = (t & 1) * ASTG, nxt = ASTG - cur;
        if (t + 1 < t1) ALOAD(t + 1);
        lptr kb = (lptr)(lds + cur + koff);
        lptr vb = (lptr)(lds + cur + voff);
#pragma unroll
        for (int rg = 0; rg < 2; ++rg) {
            const int i0 = rb + 32 * rg;
            if (64 * t + 63 >= i0 && 64 * t <= i0 + 31 + 256) {
                f32x16 s0 = (f32x16){0.f}, s1 = (f32x16){0.f};
#pragma unroll
                for (int ds = 0; ds < 4; ++ds) {
                    const bf16x8 k0 = *(const LAS bf16x8*)(kb + ds * 32), k1 = *(const LAS bf16x8*)(kb + 32 * KROW + ds * 32);
                    s0 = MFMA32(k0, qf[rg][ds], s0); s1 = MFMA32(k1, qf[rg][ds], s1);
                }
                const int jb = 64 * t + 4 * hi - (i0 + q);
                float ls = 0.f;
#pragma unroll
                for (int r = 0; r < 16; ++r) {
                    const int d0 = jb + (r & 3) + 8 * (r >> 2), d1 = d0 + 32;
                    const float p0 = __builtin_amdgcn_exp2f(s0[r] - Mb), p1 = __builtin_amdgcn_exp2f(s1[r] - Mb);
                    s0[r] = ((unsigned)d0 <= 256u) ? p0 : 0.f; s1[r] = ((unsigned)d1 <= 256u) ? p1 : 0.f; ls += s0[r] + s1[r];
                }
                l[rg] += ls;
                bf16x8 pf[4]; pf[0] = pack8(s0, 0); pf[1] = pack8(s0, 8); pf[2] = pack8(s1, 0); pf[3] = pack8(s1, 8);
#pragma unroll
                for (int ks = 0; ks < 4; ++ks)
#pragma unroll
                    for (int db = 0; db < 2; ++db) {
                        const s16x4 lo = vtr(vb + ks * 16 * VROWA + db * 64), hh = vtr(vb + ks * 16 * VROWA + 8 * VROWA + db * 64);
                        const bf16x8 vf = (bf16x8){lo[0], lo[1], lo[2], lo[3], hh[0], hh[1], hh[2], hh[3]};
                        o[rg][db] = MFMA32(vf, pf[ks], o[rg][db]);
                    }
            }
        }
        if (t + 1 < t1) ASTORE(nxt);
        __syncthreads();
    }
#undef ALOAD
#undef ASTORE
    const float sk = __builtin_amdgcn_exp2f(sink[head] * LOG2E - Mb);
#pragma unroll
    for (int rg = 0; rg < 2; ++rg) {
        float lt = l[rg]; lt += __shfl_xor(lt, 32);
        const float inv = 1.f / (lt + sk);
        bf16* yp = Y + (rowQ + 32 * rg) * D + head * 64 + 4 * hi;
#pragma unroll
        for (int db = 0; db < 2; ++db)
#pragma unroll
            for (int r4 = 0; r4 < 4; ++r4) { u32x2 wv; wv.x = cvt_pk_bf16(o[rg][db][4 * r4] * inv, o[rg][db][4 * r4 + 1] * inv); wv.y = cvt_pk_bf16(o[rg][db][4 * r4 + 2] * inv, o[rg][db][4 * r4 + 3] * inv);
                *(u32x2*)(yp + 32 * db + 8 * r4) = wv; }
    }
}
}
constexpr size_t MiB = 1u << 20;
constexpr size_t WS_ROPE = 1 * MiB;
constexpr size_t WS_W = 2 * MiB, W_LAYER = 23 * MiB;
constexpr size_t W_IN = 0, W_OUT = (size_t)NIN * D * 2, W_UP = W_OUT + (size_t)D * D * 2, W_DOWN = W_UP + (size_t)NUP * D * 2;
static_assert(W_DOWN + (size_t)D * FF * 2 <= W_LAYER, "weights");
constexpr size_t WS_H = 48 * MiB;
constexpr size_t WS_QKV = 80 * MiB;
constexpr size_t WS_Y = 152 * MiB;
constexpr size_t WS_ACT = 80 * MiB;
constexpr size_t WS_EDGE = 184 * MiB;
constexpr size_t WS_PART = 186 * MiB;
constexpr size_t WS_END = 190 * MiB;
static_assert(WS_ACT + (size_t)M * FF * 2 <= WS_EDGE && WS_QKV + (size_t)M * NIN * 2 <= WS_Y && WS_Y + (size_t)M * D * 2 <= WS_EDGE, "ws map");

struct Args {
    const float *x, *g_attn, *w_in, *qn_a, *kn_a, *sink, *qn_b, *kn_b, *lq1, *lk1, *lq2, *lk2, *subln, *w_out, *g_ffn, *w_up, *conv_w, *conv_b, *w_down;
    float* out; unsigned char* ws;
};

__device__ __forceinline__ float wave_sum(float v) {
#pragma unroll
    for (int o = 1; o < 64; o <<= 1) v += __shfl_xor(v, o);
    return v;
}
__device__ __forceinline__ float wave_max(float v) {
#pragma unroll
    for (int o = 1; o < 64; o <<= 1) v = fmaxf(v, __shfl_xor(v, o));
    return v;
}
__device__ __forceinline__ unsigned f2bf(float f) { unsigned u = __builtin_bit_cast(unsigned, f); return (u + 0x7fffu + ((u >> 16) & 1u)) >> 16; }
__device__ __forceinline__ unsigned pk2(float lo, float hi) { return f2bf(lo) | (f2bf(hi) << 16); }

__device__ __forceinline__ void transpose_item(const float* __restrict__ W, int K, int N, bf16* __restrict__ WT, LAS float* scr, int kb, int nb, int dnb, int lane) {
    const int k0 = 64 * kb, n0 = 32 * nb;
#pragma unroll 8
    for (int i = 0; i < 32; ++i) { const int kk = 2 * i + (lane >> 5); scr[kk * 33 + (lane & 31)] = W[(size_t)(k0 + kk) * N + n0 + (lane & 31)]; }
    asm volatile("s_waitcnt lgkmcnt(0)" ::: "memory");
    const int c = lane & 7;
#pragma unroll
    for (int j = 0; j < 4; ++j) { const int n = (lane >> 3) + 8 * j; const LAS float* s = scr + (8 * c) * 33 + n;
        u32x4 o; o.x = pk2(s[0 * 33], s[1 * 33]); o.y = pk2(s[2 * 33], s[3 * 33]); o.z = pk2(s[4 * 33], s[5 * 33]); o.w = pk2(s[6 * 33], s[7 * 33]);
        *(u32x4*)(WT + (size_t)(32 * dnb + n) * K + k0 + 8 * c) = o; }
    asm volatile("s_waitcnt lgkmcnt(0)" ::: "memory");
}

__device__ __forceinline__ void rms_rows(const float* x, const float* __restrict__ g, bf16* __restrict__ out, int gw, int ngw, int lane) {
    f32x4 gv[4];
#pragma unroll
    for (int j = 0; j < 4; ++j) gv[j] = *(const f32x4*)(g + 4 * lane + 256 * j);
    for (int m = gw; m < M; m += ngw) {
        const f32x4* xr = (const f32x4*)(x + (size_t)m * D) + lane; f32x4 v[4]; float s = 0.f;
#pragma unroll
        for (int j = 0; j < 4; ++j) { v[j] = xr[64 * j]; s += dot4(v[j]); }
        const float rs = rsqrtf(wave_sum(s) * (1.f / D) + EPS);
        u32x2* o8 = (u32x2*)(out + (size_t)m * D) + lane;
#pragma unroll
        for (int j = 0; j < 4; ++j) { const f32x4 y = v[j] * rs * gv[j]; u32x2 wv; wv.x = pk2(y[0], y[1]); wv.y = pk2(y[2], y[3]); o8[64 * j] = wv; }
    }
}

__device__ __forceinline__ void grid_barrier(cg::grid_group& grid) {
    __threadfence();
    grid.sync();
    __builtin_amdgcn_fence(__ATOMIC_ACQUIRE, "agent");
}

__global__ void __launch_bounds__(512, 2) mega_fwd(Args a) {
    extern __shared__ __attribute__((aligned(16))) unsigned char lds_raw[];
    LAS unsigned char* lds = (LAS unsigned char*)lds_raw;
    cg::grid_group grid = cg::this_grid();
    const int tid = threadIdx.x, lane = tid & 63, wave = __builtin_amdgcn_readfirstlane(tid >> 6);
    const int G = gridDim.x, bx = blockIdx.x;
    const int vcu = (G % 8 == 0) ? (bx % 8) * (G / 8) + bx / 8 : bx;
    const int gw = vcu * 8 + wave, ngw = G * 8;
    unsigned char* ws = a.ws;
    float* cosT = (float*)(ws + WS_ROPE); float* sinT = cosT + S * 32;
    bf16* Hb = (bf16*)(ws + WS_H); bf16* QKV = (bf16*)(ws + WS_QKV); bf16* Yb = (bf16*)(ws + WS_Y); bf16* ACT = (bf16*)(ws + WS_ACT);
    float* edge = (float*)(ws + WS_EDGE); float* part = (float*)(ws + WS_PART);

    {
        LAS float* scr = (LAS float*)(lds + wave * 16384);
        constexpr int I_IN = 16 * 72, I_OUT = 16 * 32, I_UP = 16 * 176, I_DOWN = 44 * 32, I_L = I_IN + I_OUT + I_UP + I_DOWN;
        for (int it = gw; it < DEPTH * I_L; it += ngw) {
            const int l = it / I_L; int r = it % I_L;
            unsigned char* wl = ws + WS_W + (size_t)l * W_LAYER;
            if (r < I_IN) { const int kb = r / 72, nb = r % 72; const int pn = nb >> 3, wc = (nb >> 1) & 3, bj = nb & 1;
                transpose_item(a.w_in + (size_t)l * D * NIN, D, NIN, (bf16*)(wl + W_IN), scr, kb, nb, 8 * pn + 4 * bj + wc, lane); continue; }
            r -= I_IN;
            if (r < I_OUT) { const int kb = r / 32, nb = r % 32; transpose_item(a.w_out + (size_t)l * D * D, D, D, (bf16*)(wl + W_OUT), scr, kb, nb, nb, lane); continue; }
            r -= I_OUT;
            if (r < I_UP) { const int kb = r / 176, nb = r % 176; const int isv = nb >= 88, nn = isv ? nb - 88 : nb; const int dnb = 8 * (nn >> 2) + 4 * isv + (nn & 3);
                transpose_item(a.w_up + (size_t)l * D * NUP, D, NUP, (bf16*)(wl + W_UP), scr, kb, nb, dnb, lane); continue; }
            r -= I_UP;
            { const int kb = r / 32, nb = r % 32; transpose_item(a.w_down + (size_t)l * FF * D, FF, D, (bf16*)(wl + W_DOWN), scr, kb, nb, nb, lane); }
        }
        for (int i = vcu * 512 + tid; i < S * 32; i += G * 512) {
            const int pos = i >> 5, j = i & 31;
            double inv = 1.0; for (int k = 0; k < j; ++k) inv *= 0.74989420933245582730;
            const double ang = (double)pos * inv;
            const double kq = __builtin_rint(ang * 0.15915494309189533577);
            const double rr = (ang - kq * 6.283185307179586232) - kq * 2.4492935982947064e-16;
            const double r2 = rr * rr;
            double sn = 1.0, cs = 1.0;
#pragma unroll
            for (int k = 12; k >= 1; --k) { sn = 1.0 - sn * r2 / (double)((2 * k) * (2 * k + 1)); cs = 1.0 - cs * r2 / (double)((2 * k - 1) * (2 * k)); }
            cosT[i] = (float)cs; sinT[i] = (float)(sn * rr);
        }
        rms_rows(a.x, a.g_attn, Hb, gw, ngw, lane);
    }
    grid_barrier(grid);

    const float* xin = a.x;
    for (int l = 0; l < DEPTH; ++l) {
        const float lambda_init = 0.8f - 0.6f * __expf(-0.3f * (float)l);
        unsigned char* wl = ws + WS_W + (size_t)l * W_LAYER;
#ifndef SKIP_P1
        {
            pg8::Gemm g{Hb, (const bf16*)(wl + W_IN), M, NIN, D}; pg8::StaticOrder So; So.init(M, NIN, G, bx);
            EpiInProj E{QKV, a.qn_a + l * 64, a.kn_a + l * 64, a.qn_b + l * 64, a.kn_b + l * 64, cosT, sinT};
            pg8::gemm_phase<EpiInProj, pg8::StaticOrder, true, true>(lds, g, So, E);
        }
#endif
        grid_barrier(grid);
#ifndef SKIP_P2
        {
            const float mqa = wave_max(fabsf(a.qn_a[l * 64 + lane])), mka = wave_max(fabsf(a.kn_a[l * 64 + lane]));
            const float mqb = wave_max(fabsf(a.qn_b[l * 64 + lane])), mkb = wave_max(fabsf(a.kn_b[l * 64 + lane]));
            const float MbA = 8.f * mqa * mka * LOG2E * 1.02f, MbB = 8.f * mqb * mkb * LOG2E * 1.02f;
            const float s1 = wave_sum(a.lq1[l * 64 + lane] * a.lk1[l * 64 + lane]), s2 = wave_sum(a.lq2[l * 64 + lane] * a.lk2[l * 64 + lane]);
            const float lam = __expf(s1) - __expf(s2) + lambda_init;
            for (int uidx = vcu; uidx < NB * 4 * 16; uidx += G) {
                const int bh = uidx >> 4, qb = uidx & 15;
                att::diff_unit((LAS char*)lds, QKV, Yb, bh >> 2, bh & 3, qb, MbB, lam, a.subln + l * 128, 1.f - lambda_init);
            }
            for (int uidx = vcu; uidx < NB * 2 * 16; uidx += G) {
                const int bk = uidx >> 4, n = uidx & 15;
                att::swa_unit((LAS char*)lds, QKV, Yb, bk >> 1, bk & 1, n, MbA, a.sink + l * 8);
            }
        }
#endif
        grid_barrier(grid);
#ifndef SKIP_P3
        {
            pg8::Gemm g{Yb, (const bf16*)(wl + W_OUT), M, D, D}; pg8::StaticOrder So; So.init(M, D, G, bx);
            EpiResid E{xin, a.out};
            pg8::gemm_phase<EpiResid, pg8::StaticOrder, true, true>(lds, g, So, E);
        }
#endif
        grid_barrier(grid);
        rms_rows(a.out, a.g_ffn + l * D, Hb, gw, ngw, lane);
        grid_barrier(grid);
#ifndef SKIP_P4
        {
            pg8::Gemm g{Hb, (const bf16*)(wl + W_UP), M, NUP, D}; pg8::StaticOrder So; So.init(M, NUP, G, bx);
            EpiUpConv E{ACT, a.conv_w + (size_t)l * 3 * FF, a.conv_b + (size_t)l * FF, edge, part, (LAS float*)(lds + XL_OFF)};
            pg8::gemm_phase<EpiUpConv, pg8::StaticOrder, true, true>(lds, g, So, E);
        }
#endif
        grid_barrier(grid);
        {
            const float* cw = a.conv_w + (size_t)l * 3 * FF;
            for (int i = vcu * 512 + tid; i < 64 * 2 * FF; i += G * 512) {
                const int pm = i / (2 * FF), rem = i % (2 * FF), which = rem / FF, ch = rem % FF;
                if (which == 0 && (pm & 7) != 0) {
                    const float* pp = part + (((size_t)pm * 2 + 0) * FF + ch) * 2;
                    const float pre = pp[0] + cw[ch] * edge[((size_t)(pm - 1) * 2 + 1) * FF + ch];
                    ACT[(size_t)(pm * 256) * FF + ch] = (bf16)f2bf(silu_f(pre) * pp[1]);
                }
                if (which == 1 && (pm & 7) != 7) {
                    const float* pp = part + (((size_t)pm * 2 + 1) * FF + ch) * 2;
                    const float pre = pp[0] + cw[2 * FF + ch] * edge[((size_t)(pm + 1) * 2 + 0) * FF + ch];
                    ACT[(size_t)(pm * 256 + 255) * FF + ch] = (bf16)f2bf(silu_f(pre) * pp[1]);
                }
            }
        }
        grid_barrier(grid);
#ifndef SKIP_P5
        {
            pg8::Gemm g{ACT, (const bf16*)(wl + W_DOWN), M, D, FF}; pg8::StaticOrder So; So.init(M, D, G, bx);
            EpiResid E{a.out, a.out};
            pg8::gemm_phase<EpiResid, pg8::StaticOrder, true, true>(lds, g, So, E);
        }
#endif
        if (l + 1 < DEPTH) {
            grid_barrier(grid);
            rms_rows(a.out, a.g_attn + (l + 1) * D, Hb, gw, ngw, lane);
            grid_barrier(grid);
        }
        xin = a.out;
    }
}

extern "C" void kernel_launch(void* const* d_in, const int* in_sizes, int n_in, void* d_out, int out_size, void* d_ws, size_t ws_size, hipStream_t stream) {
    static int grid = 0;
    if (grid == 0) {
        if (n_in != 19 || ws_size < WS_END) { fprintf(stderr, "kernel_launch: unexpected inputs (n_in %d, ws %zu)\n", n_in, ws_size); grid = -1; return; }
        int dev = 0, cus = 0, per_cu = 0;
        hipGetDevice(&dev);
        hipDeviceGetAttribute(&cus, hipDeviceAttributeMultiprocessorCount, dev);
        hipFuncSetAttribute((const void*)mega_fwd, hipFuncAttributeMaxDynamicSharedMemorySize, LDS_BYTES);
        hipOccupancyMaxActiveBlocksPerMultiprocessor(&per_cu, (const void*)mega_fwd, 512, LDS_BYTES);
        if (per_cu < 1) { fprintf(stderr, "kernel_launch: occupancy query reports %d blocks per CU\n", per_cu); per_cu = 1; }
        grid = cus;
        (void)hipGetLastError();
    }
    if (grid < 0) return;
    Args a{};
    const float** p = (const float**)&a;
    for (int i = 0; i < 19; ++i) p[i] = (const float*)d_in[i];
    a.out = (float*)d_out; a.ws = (unsigned char*)d_ws;
    void* args[] = {&a};
    hipError_t e = hipLaunchCooperativeKernel((const void*)mega_fwd, dim3(grid), dim3(512), args, LDS_BYTES, stream);
    if (e != hipSuccess) fprintf(stderr, "cooperative launch failed: %s (grid %d)\n", hipGetErrorString(e), grid);
}
```

```cpp
#include <hip/hip_runtime.h>
#include <hip/hip_cooperative_groups.h>
#include <cstdio>
#include <cstdint>
namespace cg = cooperative_groups;
namespace pg8 {
#define PG8_LAS __attribute__((address_space(3)))
typedef unsigned short bf16_t;
typedef short bf16x8 __attribute__((ext_vector_type(8)));
typedef float f32x4 __attribute__((ext_vector_type(4)));
typedef unsigned u32x4 __attribute__((ext_vector_type(4)));
constexpr int BM = 256, BK = 64, HALF = 128, HTB = HALF * BK * 2  , STAGE_BYTES = 8 * HTB, NXCD = 8, WGM = 8;

__host__ __device__ __forceinline__ int lds_byte(int r, int c) { const int st = (r >> 4) * 2 + (c >> 5), rr = r & 15, cc = c & 31, ob = rr * 64 + cc * 2; return st * 1024 + (ob ^ (((ob >> 9) & 1) << 5)); }
__host__ __device__ __forceinline__ void stage_rc(int b, int& R, int& C) { const int st = b / 1024, sb = b % 1024, swz = sb ^ (((sb >> 9) & 1) << 5); R = (st >> 1) * 16 + swz / 64; C = (st & 1) * 32 + (swz % 64) / 2; }
__host__ __device__ __forceinline__ int perm32(int rho) { const int n = rho >> 4, i = rho & 15; return 8 * (i >> 2) + 4 * n + (i & 3); }

struct Unit { int pm, pn; };
struct Gemm { const bf16_t* A; const bf16_t* Bt; int M, N, K; };

struct StaticOrder {
    int nM, nN, nwg, G, c;
    __host__ __device__ void init(int M, int N, int G_, int c_) { nM = M / BM; nN = N / BM; nwg = nM * nN; G = G_; c = c_; }
    __host__ __device__ bool next(int i, Unit& u) const {
        const long L = (long)i * G + c; if (L >= nwg) return false;
        int wgid = (int)L; { const int q = nwg / NXCD, r = nwg % NXCD, xcd = wgid % NXCD, off = wgid / NXCD; wgid = (xcd < r ? xcd * (q + 1) : r * (q + 1) + (xcd - r) * q) + off; }
        const int nig = WGM * nN, gid = wgid / nig, fm = gid * WGM, gsz = (nM - fm) < WGM ? (nM - fm) : WGM;
        u.pm = fm + ((wgid % nig) % gsz); u.pn = (wgid % nig) / gsz; return true;
    }
    __device__ __forceinline__ void a_ready(const Unit&) const {}
    __device__ __forceinline__ void done(const Unit&) const {}
};

__device__ __forceinline__ unsigned cvt_pk_bf16(float lo, float hi) { unsigned r; asm volatile("v_cvt_pk_bf16_f32 %0, %1, %2" : "=v"(r) : "v"(lo), "v"(hi)); return r; }
template <class Epi, class Sched, bool ALIGN_EPI = false, bool SP2 = false>
__device__ __forceinline__ void gemm_phase(PG8_LAS unsigned char* lds, const Gemm g, const Sched& S, const Epi& E) {
    int tid = threadIdx.x; asm volatile("" : "+v"(tid)); const int wid = __builtin_amdgcn_readfirstlane(tid >> 6), lane = tid & 63, wr = wid >> 2, wc = wid & 3, fr = lane & 15, fq = lane >> 4;
    const int K = g.K, nt = K / BK;
    unsigned voffA[2], voffB[2];
#pragma unroll
    for (int i = 0; i < 2; ++i) { int R, C; stage_rc(tid * 16 + i * 8192, R, C); const int Rb = Epi::PERM ? ((R & ~31) + perm32(R & 31)) : R;
        voffA[i] = (unsigned)(R * K + C) * 2u; voffB[i] = (unsigned)(Rb * K + C) * 2u; }
    const size_t kstep = (size_t)(BK * 2);
    const size_t hstep = (size_t)HALF * K * 2;
    const size_t tstep = 2 * hstep;
    const unsigned ldsw = (unsigned)wid * 1024u;
    const int aoff = lds_byte(wr * 64 + fr, fq * 8), boff = lds_byte(wc * 32 + fr, fq * 8);
#define PG8_SA(b, h) (((b) * 2 + (h)) * HTB)
#define PG8_SB(b, h) ((4 + (b) * 2 + (h)) * HTB)
#define PG8_STAGE(bufoff, gbase, voff) do { _Pragma("unroll") for (int _i = 0; _i < 2; ++_i) \
        __builtin_amdgcn_global_load_lds((const unsigned*)((const char*)(gbase) + (voff)[_i]), (PG8_LAS unsigned*)(lds + (bufoff) + ldsw + _i * 8192), 16, 0, 0); } while (0)
#define PG8_LDA(dst, b, h) do { _Pragma("unroll") for (int m = 0; m < 4; ++m) _Pragma("unroll") for (int k = 0; k < 2; ++k) dst[m][k] = *(const PG8_LAS bf16x8*)(lds + PG8_SA(b, h) + aoff + m * 2048 + k * 1024); } while (0)
#define PG8_LDB(dst, b, h) do { _Pragma("unroll") for (int n = 0; n < 2; ++n) _Pragma("unroll") for (int k = 0; k < 2; ++k) dst[n][k] = *(const PG8_LAS bf16x8*)(lds + PG8_SB(b, h) + boff + n * 2048 + k * 1024); } while (0)
#define PG8_MMA(ai, bj, At, Bt) do { __builtin_amdgcn_s_setprio(1); _Pragma("unroll") for (int m = 0; m < 4; ++m) _Pragma("unroll") for (int n = 0; n < 2; ++n) _Pragma("unroll") for (int k = 0; k < 2; ++k) \
        acc[ai][bj][m][n] = __builtin_amdgcn_mfma_f32_16x16x32_bf16(Bt[n][k], At[m][k], acc[ai][bj][m][n], 0, 0, 0); __builtin_amdgcn_s_setprio(0); } while (0)
#define PG8_WAIT_V(n) asm volatile("s_waitcnt vmcnt(" #n ")" ::: "memory")
#define PG8_WAIT_L(n) asm volatile("s_waitcnt lgkmcnt(" #n ")" ::: "memory")
#define PG8_BAR __builtin_amdgcn_s_barrier()
#define PG8_SCHED __builtin_amdgcn_sched_barrier(0)
    Unit cur, nxt; int ui = 0;
    if (!S.next(0, cur)) return;
    f32x4 acc[2][2][4][2];
#pragma unroll
    for (int a = 0; a < 2; ++a)
#pragma unroll
        for (int b = 0; b < 2; ++b)
#pragma unroll
            for (int m = 0; m < 4; ++m)
#pragma unroll
                for (int n = 0; n < 2; ++n) acc[a][b][m][n] = (f32x4){0.f, 0.f, 0.f, 0.f};
    bf16x8 At[4][2], B0[2][2], B1[2][2];
    const char* cA = (const char*)g.A + (size_t)cur.pm * tstep; const char* cB = (const char*)g.Bt + (size_t)cur.pn * tstep;
    S.a_ready(cur);
    if constexpr (SP2) {
        PG8_STAGE(PG8_SB(0, 0), cB, voffB); PG8_STAGE(PG8_SB(0, 1), cB + hstep, voffB); PG8_STAGE(PG8_SA(0, 0), cA, voffA); PG8_STAGE(PG8_SA(0, 1), cA + hstep, voffA);
        if (wr == 1) PG8_BAR;
        PG8_WAIT_V(2); PG8_BAR;
        PG8_STAGE(PG8_SB(1, 0), cB + kstep, voffB); PG8_STAGE(PG8_SA(1, 0), cA + kstep, voffA); PG8_STAGE(PG8_SB(1, 1), cB + hstep + kstep, voffB);
        PG8_WAIT_V(6); PG8_BAR;
    } else {
        PG8_STAGE(PG8_SB(0, 0), cB, voffB); PG8_STAGE(PG8_SA(0, 0), cA, voffA); PG8_STAGE(PG8_SB(0, 1), cB + hstep, voffB); PG8_STAGE(PG8_SA(0, 1), cA + hstep, voffA);
        if (wr == 1) PG8_BAR;
        PG8_WAIT_V(4); PG8_BAR;
        PG8_STAGE(PG8_SB(1, 0), cB + kstep, voffB); PG8_STAGE(PG8_SA(1, 0), cA + kstep, voffA); PG8_STAGE(PG8_SB(1, 1), cB + hstep + kstep, voffB);
        PG8_WAIT_V(6); PG8_BAR;
    }
    for (;;) {
        const bool has_next = S.next(ui + 1, nxt);
        const char* nA = has_next ? (const char*)g.A + (size_t)nxt.pm * tstep : cA; const char* nB = has_next ? (const char*)g.Bt + (size_t)nxt.pn * tstep : cB;
        for (int t = 0; t < nt; t += 2) {
            const bool last = (t == nt - 2);
            const char* a1 = cA + (size_t)(t + 1) * kstep;
            const char* a2 = last ? nA : cA + (size_t)(t + 2) * kstep; const char* b2 = last ? nB : cB + (size_t)(t + 2) * kstep;
            const char* a3 = a2 + kstep; const char* b3 = b2 + kstep;
            if (last && has_next) S.a_ready(nxt);
            if constexpr (SP2) {
            PG8_LDB(B0, 0, 0); PG8_LDB(B1, 0, 1); PG8_SCHED; PG8_LDA(At, 0, 0); PG8_STAGE(PG8_SA(1, 1), a1 + hstep, voffA);
            PG8_WAIT_V(8); PG8_WAIT_L(0); PG8_BAR; PG8_MMA(0, 0, At, B0); PG8_MMA(0, 1, At, B1); PG8_BAR; PG8_SCHED;
            PG8_LDA(At, 0, 1); PG8_STAGE(PG8_SB(0, 0), b2, voffB); PG8_STAGE(PG8_SB(0, 1), b2 + hstep, voffB); PG8_STAGE(PG8_SA(0, 0), a2, voffA);
            PG8_WAIT_V(8); PG8_WAIT_L(0); PG8_BAR; PG8_MMA(1, 0, At, B0); PG8_MMA(1, 1, At, B1); PG8_BAR; PG8_SCHED;
            PG8_LDB(B0, 1, 0); PG8_LDB(B1, 1, 1); PG8_SCHED; PG8_LDA(At, 1, 0); PG8_STAGE(PG8_SA(0, 1), a2 + hstep, voffA);
            PG8_WAIT_V(8); PG8_WAIT_L(0); PG8_BAR; PG8_MMA(0, 0, At, B0); PG8_MMA(0, 1, At, B1); PG8_BAR; PG8_SCHED;
            PG8_LDA(At, 1, 1); PG8_STAGE(PG8_SB(1, 0), b3, voffB); PG8_STAGE(PG8_SB(1, 1), b3 + hstep, voffB); PG8_STAGE(PG8_SA(1, 0), a3, voffA);
            PG8_WAIT_V(8); PG8_WAIT_L(0); PG8_BAR; PG8_MMA(1, 0, At, B0); PG8_MMA(1, 1, At, B1); PG8_BAR; PG8_SCHED;
            } else {
            PG8_LDB(B0, 0, 0); PG8_SCHED; PG8_LDA(At, 0, 0); PG8_STAGE(PG8_SA(1, 1), a1 + hstep, voffA);
            PG8_WAIT_L(8); PG8_BAR; PG8_WAIT_L(0); PG8_MMA(0, 0, At, B0); PG8_BAR; PG8_SCHED;
            PG8_LDB(B1, 0, 1); PG8_STAGE(PG8_SB(0, 0), b2, voffB);
            PG8_BAR; PG8_WAIT_L(0); PG8_MMA(0, 1, At, B1); PG8_BAR;
            PG8_LDA(At, 0, 1); PG8_STAGE(PG8_SA(0, 0), a2, voffA);
            PG8_BAR; PG8_WAIT_L(0); PG8_MMA(1, 0, At, B0); PG8_BAR; PG8_SCHED;
            PG8_STAGE(PG8_SB(0, 1), b2 + hstep, voffB);
            PG8_WAIT_V(6); PG8_BAR; PG8_MMA(1, 1, At, B1); PG8_BAR;
            PG8_LDB(B0, 1, 0); PG8_SCHED; PG8_LDA(At, 1, 0); PG8_STAGE(PG8_SA(0, 1), a2 + hstep, voffA);
            PG8_WAIT_L(8); PG8_BAR; PG8_WAIT_L(0); PG8_MMA(0, 0, At, B0); PG8_BAR; PG8_SCHED;
            PG8_LDB(B1, 1, 1); PG8_STAGE(PG8_SB(1, 0), b3, voffB);
            PG8_BAR; PG8_WAIT_L(0); PG8_MMA(0, 1, At, B1); PG8_BAR;
            PG8_LDA(At, 1, 1); PG8_STAGE(PG8_SA(1, 0), a3, voffA);
            PG8_BAR; PG8_WAIT_L(0); PG8_MMA(1, 0, At, B0); PG8_BAR; PG8_SCHED;
            PG8_STAGE(PG8_SB(1, 1), b3 + hstep, voffB);
            PG8_WAIT_V(6); PG8_BAR; PG8_MMA(1, 1, At, B1); PG8_BAR;
            }
        }
        if constexpr (ALIGN_EPI) { if (wr == 0) PG8_BAR; }
        if constexpr (!Epi::AFTER_DRAIN) { E(acc, cur, wr, wc, fr, fq); S.done(cur); }
        if (!has_next) break;
#pragma unroll
        for (int a = 0; a < 2; ++a)
#pragma unroll
            for (int b = 0; b < 2; ++b)
#pragma unroll
                for (int m = 0; m < 4; ++m)
#pragma unroll
                    for (int n = 0; n < 2; ++n) acc[a][b][m][n] = (f32x4){0.f, 0.f, 0.f, 0.f};
        cur = nxt; cA = nA; cB = nB; ++ui;
        if constexpr (ALIGN_EPI) { if (wr == 1) PG8_BAR; }
    }
    PG8_WAIT_V(0);
    if constexpr (!ALIGN_EPI) { if (wr == 0) PG8_BAR; }
    PG8_BAR;
    if constexpr (Epi::AFTER_DRAIN) { E.fused(acc, cur, wr, wc, fr, fq, lds, wid, lane); S.done(cur); }
#undef PG8_SA
#undef PG8_SB
#undef PG8_STAGE
#undef PG8_LDA
#undef PG8_LDB
#undef PG8_MMA
#undef PG8_WAIT_V
#undef PG8_WAIT_L
#undef PG8_BAR
#undef PG8_SCHED
}
}
#define LAS __attribute__((address_space(3)))
typedef unsigned short bf16;
using pg8::f32x4; using pg8::u32x4; using pg8::Unit; using pg8::cvt_pk_bf16; using pg8::bf16x8;
typedef unsigned u32x2 __attribute__((ext_vector_type(2)));

constexpr int NB = 8, S = 2048, D = 1024, M = NB * S, NIN = 2304, FF = 2816, NUP = 2 * FF, DEPTH = 2;
constexpr float EPS = 1e-6f;
constexpr float LOG2E = 1.4426950408889634f;
constexpr float QSCALE = 0.125f * LOG2E;
constexpr int XL_OFF = 131072;
constexpr int LDS_BYTES = 131072 + 8192;

__device__ __forceinline__ float dot4(f32x4 a) { return (a[0] * a[0] + a[1] * a[1]) + (a[2] * a[2] + a[3] * a[3]); }
__device__ __forceinline__ float silu_f(float v) { return v * __builtin_amdgcn_rcpf(1.f + __expf(-v)); }

struct EpiInProj {
    static constexpr bool PERM = true, AFTER_DRAIN = false;
    bf16* O; const float* qn_a; const float* kn_a; const float* qn_b; const float* kn_b; const float* cosT; const float* sinT;
    __device__ __forceinline__ void operator()(const f32x4 (&acc)[2][2][4][2], const Unit& u, int wr, int wc, int fr, int fq) const {
        asm volatile("" : "+v"(fr), "+v"(fq));
        const int pn = u.pn;
        const float* g = nullptr; float sc = 1.f;
        if (pn < 2) { g = qn_a; sc = QSCALE; }
        else if (pn == 2) { if (wc < 2) g = kn_a; }
        else if (pn < 5) { g = qn_b; sc = QSCALE; }
        else if (pn < 7) { g = kn_b; }
        const int colb = pn * 256 + wc * 64 + 8 * fq;
        const int row0 = u.pm * 256 + wr * 64 + fr;
        if (g) {
            f32x4 g1[2], g2[2];
#pragma unroll
            for (int n = 0; n < 2; ++n) { g1[n] = *(const f32x4*)(g + 8 * fq + 4 * n); g2[n] = *(const f32x4*)(g + 32 + 8 * fq + 4 * n); }
#pragma unroll
            for (int ai = 0; ai < 2; ++ai)
#pragma unroll
                for (int m = 0; m < 4; ++m) {
                    const int row = row0 + ai * 128 + m * 16;
                    const f32x4 a0 = acc[ai][0][m][0], a1 = acc[ai][0][m][1], b0 = acc[ai][1][m][0], b1 = acc[ai][1][m][1];
                    float ss = (dot4(a0) + dot4(a1)) + (dot4(b0) + dot4(b1));
                    ss += __shfl_xor(ss, 16); ss += __shfl_xor(ss, 32);
                    const float rs = rsqrtf(ss * (1.f / 64.f) + EPS) * sc;
                    const size_t ro = (size_t)(row & (S - 1)) * 32 + 8 * fq;
                    const f32x4 c0 = *(const f32x4*)(cosT + ro), c1 = *(const f32x4*)(cosT + ro + 4), s0 = *(const f32x4*)(sinT + ro), s1 = *(const f32x4*)(sinT + ro + 4);
                    const f32x4 y10 = a0 * rs * g1[0], y11 = a1 * rs * g1[1], y20 = b0 * rs * g2[0], y21 = b1 * rs * g2[1];
                    const f32x4 o10 = y10 * c0 - y20 * s0, o11 = y11 * c1 - y21 * s1, o20 = y20 * c0 + y10 * s0, o21 = y21 * c1 + y11 * s1;
                    u32x4 w1, w2;
                    w1.x = cvt_pk_bf16(o10[0], o10[1]); w1.y = cvt_pk_bf16(o10[2], o10[3]); w1.z = cvt_pk_bf16(o11[0], o11[1]); w1.w = cvt_pk_bf16(o11[2], o11[3]);
                    w2.x = cvt_pk_bf16(o20[0], o20[1]); w2.y = cvt_pk_bf16(o20[2], o20[3]); w2.z = cvt_pk_bf16(o21[0], o21[1]); w2.w = cvt_pk_bf16(o21[2], o21[3]);
                    bf16* op = O + (size_t)row * NIN + colb;
                    *(u32x4*)op = w1; *(u32x4*)(op + 32) = w2;
                }
        } else {
#pragma unroll
            for (int ai = 0; ai < 2; ++ai)
#pragma unroll
                for (int m = 0; m < 4; ++m) {
                    const int row = row0 + ai * 128 + m * 16;
                    bf16* op = O + (size_t)row * NIN + colb;
#pragma unroll
                    for (int bj = 0; bj < 2; ++bj) { const f32x4 v0 = acc[ai][bj][m][0], v1 = acc[ai][bj][m][1]; u32x4 w;
                        w.x = cvt_pk_bf16(v0[0], v0[1]); w.y = cvt_pk_bf16(v0[2], v0[3]); w.z = cvt_pk_bf16(v1[0], v1[1]); w.w = cvt_pk_bf16(v1[2], v1[3]);
                        *(u32x4*)(op + 32 * bj) = w; }
                }
        }
    }
};

struct EpiResid {
    static constexpr bool PERM = true, AFTER_DRAIN = false;
    const float* base; float* out;
    __device__ __forceinline__ void operator()(const f32x4 (&acc)[2][2][4][2], const Unit& u, int wr, int wc, int fr, int fq) const {
        asm volatile("" : "+v"(fr), "+v"(fq));
        const int col0 = u.pn * 256 + wc * 32 + 8 * fq, row0 = u.pm * 256 + wr * 64 + fr;
#pragma unroll
        for (int ai = 0; ai < 2; ++ai)
#pragma unroll
            for (int m = 0; m < 4; ++m) {
                const size_t off = (size_t)(row0 + ai * 128 + m * 16) * D + col0;
#pragma unroll
                for (int bj = 0; bj < 2; ++bj) {
                    const f32x4 x0 = *(const f32x4*)(base + off + bj * 128), x1 = *(const f32x4*)(base + off + bj * 128 + 4);
                    *(f32x4*)(out + off + bj * 128) = x0 + acc[ai][bj][m][0]; *(f32x4*)(out + off + bj * 128 + 4) = x1 + acc[ai][bj][m][1];
                }
            }
    }
};

struct EpiUpConv {
    static constexpr bool PERM = true, AFTER_DRAIN = false;
    bf16* ACT; const float* cw; const float* cb; float* edge; float* part; LAS float* xl;
    __device__ __forceinline__ void operator()(const f32x4 (&acc)[2][2][4][2], const Unit& u, int wr, int wc, int fr, int fq) const {
        asm volatile("" : "+v"(fr), "+v"(fq));
        const int lane = 16 * fq + fr;
        const int cl0 = 32 * wc + 8 * fq, ch0 = 128 * u.pn + cl0;
#pragma unroll
        for (int ai = 0; ai < 2; ++ai) {
            const int chunk = 2 * ai + wr;
            if (fr == 0) { *(LAS f32x4*)(xl + (chunk * 2 + 0) * 128 + cl0) = acc[ai][0][0][0]; *(LAS f32x4*)(xl + (chunk * 2 + 0) * 128 + cl0 + 4) = acc[ai][0][0][1]; }
            if (fr == 15) { *(LAS f32x4*)(xl + (chunk * 2 + 1) * 128 + cl0) = acc[ai][0][3][0]; *(LAS f32x4*)(xl + (chunk * 2 + 1) * 128 + cl0 + 4) = acc[ai][0][3][1]; }
        }
        asm volatile("s_waitcnt lgkmcnt(0)" ::: "memory"); __builtin_amdgcn_s_barrier(); asm volatile("" ::: "memory");
        const int lup = (lane & ~15) | ((fr + 15) & 15), ldn = (lane & ~15) | ((fr + 1) & 15);
        const bool seq_first = (u.pm & 7) == 0, seq_last = (u.pm & 7) == 7;
#pragma unroll
        for (int ai = 0; ai < 2; ++ai) {
            const int chunk = 2 * ai + wr;
#pragma unroll
            for (int n = 0; n < 2; ++n) {
                const int ch = ch0 + 4 * n;
                const f32x4 w0 = *(const f32x4*)(cw + ch), w1 = *(const f32x4*)(cw + FF + ch), w2 = *(const f32x4*)(cw + 2 * FF + ch), bb = *(const f32x4*)(cb + ch);
                const f32x4 above = (chunk > 0) ? *(const LAS f32x4*)(xl + ((chunk - 1) * 2 + 1) * 128 + cl0 + 4 * n) : (f32x4){0.f, 0.f, 0.f, 0.f};
                const f32x4 below = (chunk < 3) ? *(const LAS f32x4*)(xl + ((chunk + 1) * 2 + 0) * 128 + cl0 + 4 * n) : (f32x4){0.f, 0.f, 0.f, 0.f};
                f32x4 Rprev = above, Lcur;
#pragma unroll
                for (int e = 0; e < 4; ++e) Lcur[e] = __shfl(acc[ai][0][0][n][e], ldn);
#pragma unroll
                for (int m = 0; m < 4; ++m) {
                    const int rt = ai * 128 + wr * 64 + m * 16 + fr;
                    const size_t row = (size_t)u.pm * 256 + rt;
                    const f32x4 cur = acc[ai][0][m][n], val = acc[ai][1][m][n];
                    f32x4 Rm, Lnext = below;
#pragma unroll
                    for (int e = 0; e < 4; ++e) { Rm[e] = __shfl(cur[e], lup); if (m < 3) Lnext[e] = __shfl(acc[ai][0][m < 3 ? m + 1 : 3][n][e], ldn); }
                    const f32x4 up = (fr == 0) ? Rprev : Rm, dn = (fr == 15) ? Lnext : Lcur;
                    Rprev = Rm; Lcur = Lnext;
                    const f32x4 pre = bb + w0 * up + w1 * cur + w2 * dn;
                    f32x4 res;
#pragma unroll
                    for (int e = 0; e < 4; ++e) res[e] = silu_f(pre[e]) * val[e];
                    if (rt == 0) {
                        *(f32x4*)(edge + ((size_t)u.pm * 2 + 0) * FF + ch) = cur;
                        if (!seq_first) { float* pp = part + (((size_t)u.pm * 2 + 0) * FF + ch) * 2;
                            *(f32x4*)pp = (f32x4){pre[0], val[0], pre[1], val[1]}; *(f32x4*)(pp + 4) = (f32x4){pre[2], val[2], pre[3], val[3]}; }
                    }
                    if (rt == 255) {
                        *(f32x4*)(edge + ((size_t)u.pm * 2 + 1) * FF + ch) = cur;
                        if (!seq_last) { float* pp = part + (((size_t)u.pm * 2 + 1) * FF + ch) * 2;
                            *(f32x4*)pp = (f32x4){pre[0], val[0], pre[1], val[1]}; *(f32x4*)(pp + 4) = (f32x4){pre[2], val[2], pre[3], val[3]}; }
                    }
                    u32x2 w; w.x = cvt_pk_bf16(res[0], res[1]); w.y = cvt_pk_bf16(res[2], res[3]);
                    *(u32x2*)(ACT + row * FF + ch) = w;
                }
            }
        }
    }
};
namespace att {
typedef __attribute__((ext_vector_type(16))) float f32x16;
typedef __attribute__((ext_vector_type(4))) short s16x4;
typedef short v4i16_t __attribute__((ext_vector_type(4)));
typedef LAS const char* lptr;
__device__ __forceinline__ s16x4 vtr(lptr p) { return __builtin_bit_cast(s16x4, __builtin_amdgcn_ds_read_tr16_b64_v4i16((LAS v4i16_t*)p)); }
__device__ __forceinline__ bf16x8 pack8(const f32x16& s, int b) {
    u32x4 w; w.x = cvt_pk_bf16(s[b], s[b + 1]); w.y = cvt_pk_bf16(s[b + 2], s[b + 3]); w.z = cvt_pk_bf16(s[b + 4], s[b + 5]); w.w = cvt_pk_bf16(s[b + 6], s[b + 7]);
    return __builtin_bit_cast(bf16x8, w);
}
#define MFMA32(a, b, c) __builtin_amdgcn_mfma_f32_32x32x16_bf16((a), (b), (c), 0, 0, 0)
constexpr int KROW = 144, VROWD = 320, VROWA = 192;
constexpr int DSTG = 2 * 64 * KROW + 64 * VROWD;
constexpr int ASTG = 64 * KROW + 64 * VROWA;

__device__ __forceinline__ void diff_unit(LAS char* lds, const bf16* __restrict__ QKV, bf16* __restrict__ Y, int b, int h, int qb, float Mb, float lam, const float* __restrict__ subln, float outscale) {
    int tid = threadIdx.x; asm volatile("" : "+v"(tid)); const int lane = tid & 63, w = __builtin_amdgcn_readfirstlane(tid >> 6), q = lane & 31, hi = lane >> 5;
    const int rg = w >> 1, c = w & 1;
    const size_t rowQ = (size_t)b * S + qb * 128 + rg * 32 + q;
    const bf16* qp = QKV + rowQ * NIN + 768 + (2 * h + c) * 64 + hi * 8;
    bf16x8 qf[4];
#pragma unroll
    for (int ds = 0; ds < 4; ++ds) qf[ds] = *(const bf16x8*)(qp + ds * 16);
    const int lrow = tid >> 4, lcc = tid & 15;
    const bf16* kg = QKV + ((size_t)b * S + lrow) * NIN + 1280 + 128 * h + lcc * 8;
    const bf16* vg = QKV + ((size_t)b * S + lrow) * NIN + 1792 + 128 * h + lcc * 8;
    const int kdst = (lcc >> 3) * (64 * KROW) + lrow * KROW + (lcc & 7) * 16;
    const int vdst = 2 * 64 * KROW + lrow * VROWD + lcc * 16;
    u32x4 st0, st1, st2, st3;
#define DLOAD(t) do { const size_t o_ = (size_t)(t) * 64 * NIN; st0 = *(const u32x4*)(kg + o_); st1 = *(const u32x4*)(kg + o_ + 32 * NIN); st2 = *(const u32x4*)(vg + o_); st3 = *(const u32x4*)(vg + o_ + 32 * NIN); } while (0)
#define DSTORE(bo) do { *(LAS u32x4*)(lds + (bo) + kdst) = st0; *(LAS u32x4*)(lds + (bo) + kdst + 32 * KROW) = st1; *(LAS u32x4*)(lds + (bo) + vdst) = st2; *(LAS u32x4*)(lds + (bo) + vdst + 32 * VROWD) = st3; } while (0)
    f32x16 o[4];
#pragma unroll
    for (int i = 0; i < 4; ++i) o[i] = (f32x16){0.f};
    float l = 0.f;
    DLOAD(0); DSTORE(0); __syncthreads();
    const int koff = c * (64 * KROW) + q * KROW + hi * 16;
    const int voff = 2 * 64 * KROW + (4 * hi + ((lane & 15) >> 2)) * VROWD + ((lane >> 4) & 1) * 32 + (lane & 3) * 8;
    for (int t = 0; t < S / 64; ++t) {
        const int cur = (t & 1) * DSTG, nxt = DSTG - cur;
        if (t + 1 < S / 64) DLOAD(t + 1);
        lptr kb = (lptr)(lds + cur + koff);
        f32x16 s0 = (f32x16){0.f}, s1 = (f32x16){0.f};
#pragma unroll
        for (int ds = 0; ds < 4; ++ds) {
            const bf16x8 k0 = *(const LAS bf16x8*)(kb + ds * 32), k1 = *(const LAS bf16x8*)(kb + 32 * KROW + ds * 32);
            s0 = MFMA32(k0, qf[ds], s0); s1 = MFMA32(k1, qf[ds], s1);
        }
        float ls = 0.f;
#pragma unroll
        for (int r = 0; r < 16; ++r) { s0[r] = __builtin_amdgcn_exp2f(s0[r] - Mb); s1[r] = __builtin_amdgcn_exp2f(s1[r] - Mb); ls += s0[r] + s1[r]; }
        l += ls;
        bf16x8 pf[4]; pf[0] = pack8(s0, 0); pf[1] = pack8(s0, 8); pf[2] = pack8(s1, 0); pf[3] = pack8(s1, 8);
        lptr vb = (lptr)(lds + cur + voff);
#pragma unroll
        for (int ks = 0; ks < 4; ++ks)
#pragma unroll
            for (int db = 0; db < 4; ++db) {
                const s16x4 lo = vtr(vb + ks * 16 * VROWD + db * 64), hh = vtr(vb + ks * 16 * VROWD + 8 * VROWD + db * 64);
                const bf16x8 vf = (bf16x8){lo[0], lo[1], lo[2], lo[3], hh[0], hh[1], hh[2], hh[3]};
                o[db] = MFMA32(vf, pf[ks], o[db]);
            }
        if (t + 1 < S / 64) DSTORE(nxt);
        __syncthreads();
    }
#undef DLOAD
#undef DSTORE
    l += __shfl_xor(l, 32);
    const float inv = 1.f / l;
    LAS f32x4* xb = (LAS f32x4*)lds + rg * (16 * 64) + lane;
    if (c == 1) {
#pragma unroll
        for (int db = 0; db < 4; ++db)
#pragma unroll
            for (int r4 = 0; r4 < 4; ++r4) xb[(db * 4 + r4) * 64] = (f32x4){o[db][4 * r4], o[db][4 * r4 + 1], o[db][4 * r4 + 2], o[db][4 * r4 + 3]} * inv;
    }
    __syncthreads();
    if (c == 0) {
        float ss = 0.f;
#pragma unroll
        for (int db = 0; db < 4; ++db)
#pragma unroll
            for (int r4 = 0; r4 < 4; ++r4) { const f32x4 ot = xb[(db * 4 + r4) * 64];
#pragma unroll
                for (int e = 0; e < 4; ++e) { const float d = o[db][4 * r4 + e] * inv - lam * ot[e]; o[db][4 * r4 + e] = d; ss += d * d; } }
        ss += __shfl_xor(ss, 32);
        const float rs = rsqrtf(ss * (1.f / 128.f) + EPS) * outscale;
        bf16* yp = Y + rowQ * D + 512 + 128 * h + 4 * hi;
#pragma unroll
        for (int db = 0; db < 4; ++db)
#pragma unroll
            for (int r4 = 0; r4 < 4; ++r4) { const f32x4 gw = *(const f32x4*)(subln + 32 * db + 8 * r4 + 4 * hi);
                u32x2 wv; wv.x = cvt_pk_bf16(o[db][4 * r4] * rs * gw[0], o[db][4 * r4 + 1] * rs * gw[1]); wv.y = cvt_pk_bf16(o[db][4 * r4 + 2] * rs * gw[2], o[db][4 * r4 + 3] * rs * gw[3]);
                *(u32x2*)(yp + 32 * db + 8 * r4) = wv; }
    }
    __syncthreads();
}

__device__ __forceinline__ void swa_unit(LAS char* lds, const bf16* __restrict__ QKV, bf16* __restrict__ Y, int b, int kvh, int n, float Mb, const float* __restrict__ sink) {
    int tid = threadIdx.x; asm volatile("" : "+v"(tid)); const int lane = tid & 63, w = __builtin_amdgcn_readfirstlane(tid >> 6), q = lane & 31, hi = lane >> 5;
    const int head = kvh * 4 + (w >> 1), rb = (w & 1) * 64;
    const size_t rowQ = (size_t)b * S + n * 128 + rb + q;
    bf16x8 qf[2][4];
#pragma unroll
    for (int rg = 0; rg < 2; ++rg)
#pragma unroll
        for (int ds = 0; ds < 4; ++ds) qf[rg][ds] = *(const bf16x8*)(QKV + (rowQ + 32 * rg) * NIN + head * 64 + hi * 8 + ds * 16);
    const int lrow = tid >> 3, lcc = tid & 7;
    const long kp0 = (long)b * S + (long)(n - 1) * 128 + lrow;
    const bf16* kg = QKV + kp0 * NIN + 512 + kvh * 64 + lcc * 8;
    const bf16* vg = QKV + kp0 * NIN + 640 + kvh * 64 + lcc * 8;
    const int kdst = lrow * KROW + lcc * 16, vdst = 64 * KROW + lrow * VROWA + lcc * 16;
    u32x4 st0, st1;
#define ALOAD(t) do { const long o_ = (long)(t) * 64 * NIN; st0 = *(const u32x4*)(kg + o_); st1 = *(const u32x4*)(vg + o_); } while (0)
#define ASTORE(bo) do { *(LAS u32x4*)(lds + (bo) + kdst) = st0; *(LAS u32x4*)(lds + (bo) + vdst) = st1; } while (0)
    f32x16 o[2][2];
#pragma unroll
    for (int i = 0; i < 2; ++i)
#pragma unroll
        for (int j = 0; j < 2; ++j) o[i][j] = (f32x16){0.f};
    float l[2] = {0.f, 0.f};
    const int t0 = (n == 0) ? 2 : 0, t1 = (n == S / 128 - 1) ? 4 : 6;
    ALOAD(t0); ASTORE((t0 & 1) * ASTG); __syncthreads();
    const int koff = q * KROW + hi * 16;
    const int voff = 64 * KROW + (4 * hi + ((lane & 15) >> 2)) * VROWA + ((lane >> 4) & 1) * 32 + (lane & 3) * 8;
    for (int t = t0; t < t1; ++t) {
        const int cur = (t & 1) * ASTG, nxt = ASTG - cur;
        if (t + 1 < t1) ALOAD(t + 1);
        lptr kb = (lptr)(lds + cur + koff);
        lptr vb = (lptr)(lds + cur + voff);
#pragma unroll
        for (int rg = 0; rg < 2; ++rg) {
            const int i0 = rb + 32 * rg;
            if (64 * t + 63 >= i0 && 64 * t <= i0 + 31 + 256) {
                f32x16 s0 = (f32x16){0.f}, s1 = (f32x16){0.f};
#pragma unroll
                for (int ds = 0; ds < 4; ++ds) {
                    const bf16x8 k0 = *(const LAS bf16x8*)(kb + ds * 32), k1 = *(const LAS bf16x8*)(kb + 32 * KROW + ds * 32);
                    s0 = MFMA32(k0, qf[rg][ds], s0); s1 = MFMA32(k1, qf[rg][ds], s1);
                }
                const int jb = 64 * t + 4 * hi - (i0 + q);
                float ls = 0.f;
#pragma unroll
                for (int r = 0; r < 16; ++r) {
                    const int d0 = jb + (r & 3) + 8 * (r >> 2), d1 = d0 + 32;
                    const float p0 = __builtin_amdgcn_exp2f(s0[r] - Mb), p1 = __builtin_amdgcn_exp2f(s1[r] - Mb);
                    s0[r] = ((unsigned)d0 <= 256u) ? p0 : 0.f; s1[r] = ((unsigned)d1 <= 256u) ? p1 : 0.f; ls += s0[r] + s1[r];
                }
                l[rg] += ls;
                bf16x8 pf[4]; pf[0] = pack8(s0, 0); pf[1] = pack8(s0, 8); pf[2] = pack8(s1, 0); pf[3] = pack8(s1, 8);
#pragma unroll
                for (int ks = 0; ks < 4; ++ks)
#pragma unroll
                    for (int db = 0; db < 2; ++db) {
                        const s16x4 lo = vtr(vb + ks * 16 * VROWA + db * 64), hh = vtr(vb + ks * 16 * VROWA + 8 * VROWA + db * 64);
                        const bf16x8 vf = (bf16x8){lo[0], lo[1], lo[2], lo[3], hh[0], hh[1], hh[2], hh[3]};
                        o[rg][db] = MFMA32(vf, pf[ks], o[rg][db]);
                    }
            }
        }
        if (t + 1 < t1) ASTORE(nxt);
        __syncthreads();
    }
#undef ALOAD
#undef ASTORE
    const float sk = __builtin_amdgcn_exp2f(sink[head] * LOG2E - Mb);
#pragma unroll
    for (int rg = 0; rg < 2; ++rg) {
        float lt = l[rg]; lt += __shfl_xor(lt, 32);
        const float inv = 1.f / (lt + sk);
        bf16* yp = Y + (rowQ + 32 * rg) * D + head * 64 + 4 * hi;
#pragma unroll
        for (int db = 0; db < 2; ++db)
#pragma unroll
            for (int r4 = 0; r4 < 4; ++r4) { u32x2 wv; wv.x = cvt_pk_bf16(o[rg][db][4 * r4] * inv, o[rg][db][4 * r4 + 1] * inv); wv.y = cvt_pk_bf16(o[rg][db][4 * r4 + 2] * inv, o[rg][db][4 * r4 + 3] * inv);
                *(u32x2*)(yp + 32 * db + 8 * r4) = wv; }
    }
}
}
constexpr size_t MiB = 1u << 20;
constexpr size_t WS_CTL = 0, CTL_BYTES = 65536;
constexpr int MISC_OFF = 131072 + 4096;
constexpr size_t WS_ROPE = 1 * MiB;
constexpr size_t WS_W = 2 * MiB, W_LAYER = 23 * MiB;
constexpr size_t W_IN = 0, W_OUT = (size_t)NIN * D * 2, W_UP = W_OUT + (size_t)D * D * 2, W_DOWN = W_UP + (size_t)NUP * D * 2;
static_assert(W_DOWN + (size_t)D * FF * 2 <= W_LAYER, "weights");
constexpr size_t WS_H = 48 * MiB;
constexpr size_t WS_QKV = 80 * MiB;
constexpr size_t WS_Y = 152 * MiB;
constexpr size_t WS_ACT = 80 * MiB;
constexpr size_t WS_EDGE = 184 * MiB;
constexpr size_t WS_PART = 186 * MiB;
constexpr size_t WS_END = 190 * MiB;
static_assert(WS_ACT + (size_t)M * FF * 2 <= WS_EDGE && WS_QKV + (size_t)M * NIN * 2 <= WS_Y && WS_Y + (size_t)M * D * 2 <= WS_EDGE, "ws map");

#ifndef REP_P0
#define REP_P0 1
#endif
#ifndef REP_P1
#define REP_P1 1
#endif
#ifndef REP_P3B
#define REP_P3B 1
#endif
#ifndef REP_P4
#define REP_P4 1
#endif
#ifndef ATT_REP
#define ATT_REP 1
#endif
#ifndef REP_P5
#define REP_P5 1
#endif
#ifndef REP_P3
#define REP_P3 1
#endif
#ifndef REP_SYNC
#define REP_SYNC 1
#endif
struct Args {
    const float *x, *g_attn, *w_in, *qn_a, *kn_a, *sink, *qn_b, *kn_b, *lq1, *lk1, *lq2, *lk2, *subln, *w_out, *g_ffn, *w_up, *conv_w, *conv_b, *w_down;
    float* out; unsigned char* ws;
    int rep[8];
};

__device__ __forceinline__ float wave_sum(float v) {
#pragma unroll
    for (int o = 1; o < 64; o <<= 1) v += __shfl_xor(v, o);
    return v;
}
__device__ __forceinline__ float wave_max(float v) {
#pragma unroll
    for (int o = 1; o < 64; o <<= 1) v = fmaxf(v, __shfl_xor(v, o));
    return v;
}
__device__ __forceinline__ unsigned f2bf(float f) { unsigned u = __builtin_bit_cast(unsigned, f); return (u + 0x7fffu + ((u >> 16) & 1u)) >> 16; }
__device__ __forceinline__ unsigned pk2(float lo, float hi) { return f2bf(lo) | (f2bf(hi) << 16); }

__device__ __forceinline__ void transpose_item(const float* __restrict__ W, int K, int N, bf16* __restrict__ WT, LAS float* scr, int kb, int nb, int dnb, int lane) {
    const int k0 = 64 * kb, n0 = 32 * nb;
#pragma unroll 8
    for (int i = 0; i < 32; ++i) { const int kk = 2 * i + (lane >> 5); scr[kk * 33 + (lane & 31)] = W[(size_t)(k0 + kk) * N + n0 + (lane & 31)]; }
    asm volatile("s_waitcnt lgkmcnt(0)" ::: "memory");
    const int c = lane & 7;
#pragma unroll
    for (int j = 0; j < 4; ++j) { const int n = (lane >> 3) + 8 * j; const LAS float* s = scr + (8 * c) * 33 + n;
        u32x4 o; o.x = pk2(s[0 * 33], s[1 * 33]); o.y = pk2(s[2 * 33], s[3 * 33]); o.z = pk2(s[4 * 33], s[5 * 33]); o.w = pk2(s[6 * 33], s[7 * 33]);
        *(u32x4*)(WT + (size_t)(32 * dnb + n) * K + k0 + 8 * c) = o; }
    asm volatile("s_waitcnt lgkmcnt(0)" ::: "memory");
}

__device__ __forceinline__ void rms_rows(const float* x, const float* __restrict__ g, bf16* __restrict__ out, int gw, int ngw, int lane) {
    f32x4 gv[4];
#pragma unroll
    for (int j = 0; j < 4; ++j) gv[j] = *(const f32x4*)(g + 4 * lane + 256 * j);
    for (int m = gw; m < M; m += ngw) {
        const f32x4* xr = (const f32x4*)(x + (size_t)m * D) + lane; f32x4 v[4]; float s = 0.f;
#pragma unroll
        for (int j = 0; j < 4; ++j) { v[j] = xr[64 * j]; s += dot4(v[j]); }
        const float rs = rsqrtf(wave_sum(s) * (1.f / D) + EPS);
        u32x2* o8 = (u32x2*)(out + (size_t)m * D) + lane;
#pragma unroll
        for (int j = 0; j < 4; ++j) { const f32x4 y = v[j] * rs * gv[j]; u32x2 wv; wv.x = pk2(y[0], y[1]); wv.y = pk2(y[2], y[3]); o8[64 * j] = wv; }
    }
}

#define XB_TMO      128
#define XB_XCNT(j)  (256  + 64 * (j))
#define XB_XSUB(j)  (1280 + 64 * (j))
#define XB_XGEN(j)  (2304 + 64 * (j))
#define XB_TOP      3328
#define XB_TOPGEN   3392
#define XCD_BAR_WORDS 3456
#define XB_SPIN_CAP (1u << 18)

__device__ __forceinline__ unsigned xb_ld(unsigned* p)              { return __hip_atomic_load(p, __ATOMIC_RELAXED, __HIP_MEMORY_SCOPE_AGENT); }
__device__ __forceinline__ unsigned xb_add(unsigned* p, unsigned v) { return __hip_atomic_fetch_add(p, v, __ATOMIC_RELAXED, __HIP_MEMORY_SCOPE_AGENT); }
__device__ __forceinline__ unsigned xb_xcc_id() { return (unsigned)__builtin_amdgcn_s_getreg((3 << 11) | 20) & 0xFu; }
#define XB_SPIN(cond, bar) do { unsigned _sp = 0; while (cond) { __builtin_amdgcn_s_sleep(1); \
    if ((++_sp & 255u) == 0u) { if (xb_ld(&(bar)[XB_TMO])) break; if (_sp > XB_SPIN_CAP) { atomicAdd(&(bar)[XB_TMO], 1u); break; } } } } while (0)

struct XcdBarrier {
    unsigned* bar; unsigned x;
    volatile LAS unsigned* st;
};

__device__ __forceinline__ XcdBarrier xcd_barrier_post(unsigned* bar, volatile LAS unsigned* st) {
    XcdBarrier b; b.bar = bar; b.x = xb_xcc_id(); b.st = st;
    if (threadIdx.x == 0) (void)xb_add(&bar[XB_XCNT(b.x)], 1u);
    return b;
}
__device__ __forceinline__ void xcd_barrier_complete(unsigned* bar, unsigned x, unsigned& nloc, unsigned& nx) {
    const unsigned G = gridDim.x * gridDim.y * gridDim.z;
    unsigned sum, cnt, mine, sp = 0u;
    for (;;) {
        sum = 0u; cnt = 0u; mine = 0u;
#pragma unroll
        for (unsigned j = 0; j < 16; ++j) { const unsigned c = xb_ld(&bar[XB_XCNT(j)]); sum += c; cnt += (c > 0u) ? 1u : 0u; mine = (j == x) ? c : mine; }
        if (sum == G) break;
        __builtin_amdgcn_s_sleep(1);
        if ((++sp & 255u) == 0u) { if (xb_ld(&bar[XB_TMO])) break; if (sp > XB_SPIN_CAP) { atomicAdd(&bar[XB_TMO], 1u); break; } }
    }
    nloc = mine > 0u ? mine : 1u; nx = cnt > 0u ? cnt : 1u;
}

__device__ __forceinline__ void xcd_barrier(const XcdBarrier& b) {
    asm volatile("s_waitcnt vmcnt(0)" ::: "memory");
    __syncthreads();
    if (threadIdx.x == 0) {
        unsigned* bar = b.bar;
        __builtin_amdgcn_s_waitcnt(0);
        unsigned nloc = b.st[0], nx = b.st[1];
        if (nloc == 0u) { xcd_barrier_complete(bar, b.x, nloc, nx); b.st[0] = nloc; b.st[1] = nx; }
        const unsigned old = xb_add(&bar[XB_XSUB(b.x)], 1u);
        const unsigned gen = old / nloc;
        if (old + 1u == (gen + 1u) * nloc) {
            __builtin_amdgcn_fence(__ATOMIC_RELEASE, "agent");
            asm volatile("s_waitcnt vmcnt(0)" ::: "memory");
            const unsigned og = xb_add(&bar[XB_TOP], 1u);
            const unsigned tg = og / nx;
            if (og + 1u == (tg + 1u) * nx) xb_add(&bar[XB_TOPGEN], 1u);
            else XB_SPIN(xb_ld(&bar[XB_TOPGEN]) == tg, bar);
            __builtin_amdgcn_fence(__ATOMIC_ACQUIRE, "agent");
            xb_add(&bar[XB_XGEN(b.x)], 1u);
            asm volatile("s_waitcnt vmcnt(0)" ::: "memory");
        } else {
            XB_SPIN(xb_ld(&bar[XB_XGEN(b.x)]) == gen, bar);
            __builtin_amdgcn_fence(__ATOMIC_ACQUIRE, "agent");
            asm volatile("s_waitcnt vmcnt(0)" ::: "memory");
        }
    }
    __syncthreads();
}

__global__ void __launch_bounds__(512, 2) mega_fwd(Args a) {
    extern __shared__ __attribute__((aligned(16))) unsigned char lds_raw[];
    LAS unsigned char* lds = (LAS unsigned char*)lds_raw;
    cg::grid_group grid = cg::this_grid();
    const int tid = threadIdx.x, lane = tid & 63, wave = __builtin_amdgcn_readfirstlane(tid >> 6);
    const int G = gridDim.x, bx = blockIdx.x;
    const int vcu = (G % 8 == 0) ? (bx % 8) * (G / 8) + bx / 8 : bx;
    const int gw = vcu * 8 + wave, ngw = G * 8;
    unsigned char* ws = a.ws;
    float* cosT = (float*)(ws + WS_ROPE); float* sinT = cosT + S * 32;
    bf16* Hb = (bf16*)(ws + WS_H); bf16* QKV = (bf16*)(ws + WS_QKV); bf16* Yb = (bf16*)(ws + WS_Y); bf16* ACT = (bf16*)(ws + WS_ACT);
    float* edge = (float*)(ws + WS_EDGE); float* part = (float*)(ws + WS_PART);
    volatile LAS unsigned* misc = (volatile LAS unsigned*)(lds + MISC_OFF);
    if (tid < 16) misc[tid] = 0u;
    __syncthreads();
    const XcdBarrier xbar = xcd_barrier_post((unsigned*)(ws + WS_CTL) + 1024, misc);
    grid.sync();

    for (int rep0 = 0; rep0 < a.rep[0]; ++rep0) {
        LAS float* scr = (LAS float*)(lds + wave * 16384);
        constexpr int I_IN = 16 * 72, I_OUT = 16 * 32, I_UP = 16 * 176, I_DOWN = 44 * 32, I_L = I_IN + I_OUT + I_UP + I_DOWN;
        for (int it = gw; it < DEPTH * I_L; it += ngw) {
            const int l = it / I_L; int r = it % I_L;
            unsigned char* wl = ws + WS_W + (size_t)l * W_LAYER;
            if (r < I_IN) { const int kb = r / 72, nb = r % 72; const int pn = nb >> 3, wc = (nb >> 1) & 3, bj = nb & 1;
                transpose_item(a.w_in + (size_t)l * D * NIN, D, NIN, (bf16*)(wl + W_IN), scr, kb, nb, 8 * pn + 4 * bj + wc, lane); continue; }
            r -= I_IN;
            if (r < I_OUT) { const int kb = r / 32, nb = r % 32; transpose_item(a.w_out + (size_t)l * D * D, D, D, (bf16*)(wl + W_OUT), scr, kb, nb, nb, lane); continue; }
            r -= I_OUT;
            if (r < I_UP) { const int kb = r / 176, nb = r % 176; const int isv = nb >= 88, nn = isv ? nb - 88 : nb; const int dnb = 8 * (nn >> 2) + 4 * isv + (nn & 3);
                transpose_item(a.w_up + (size_t)l * D * NUP, D, NUP, (bf16*)(wl + W_UP), scr, kb, nb, dnb, lane); continue; }
            r -= I_UP;
            { const int kb = r / 32, nb = r % 32; transpose_item(a.w_down + (size_t)l * FF * D, FF, D, (bf16*)(wl + W_DOWN), scr, kb, nb, nb, lane); }
        }
        for (int i = vcu * 512 + tid; i < S * 32; i += G * 512) {
            const int pos = i >> 5, j = i & 31;
            double inv = 1.0; for (int k = 0; k < j; ++k) inv *= 0.74989420933245582730;
            const double ang = (double)pos * inv;
            const double kq = __builtin_rint(ang * 0.15915494309189533577);
            const double rr = (ang - kq * 6.283185307179586232) - kq * 2.4492935982947064e-16;
            const double r2 = rr * rr;
            double sn = 1.0, cs = 1.0;
#pragma unroll
            for (int k = 12; k >= 1; --k) { sn = 1.0 - sn * r2 / (double)((2 * k) * (2 * k + 1)); cs = 1.0 - cs * r2 / (double)((2 * k - 1) * (2 * k)); }
            cosT[i] = (float)cs; sinT[i] = (float)(sn * rr);
        }
        rms_rows(a.x, a.g_attn, Hb, gw, ngw, lane);
    }
    xcd_barrier(xbar);

    const float* xin = a.x;
    for (int l = 0; l < DEPTH; ++l) {
        const float lambda_init = 0.8f - 0.6f * __expf(-0.3f * (float)l);
        unsigned char* wl = ws + WS_W + (size_t)l * W_LAYER;
#ifndef SKIP_P1
        {
            pg8::Gemm g{Hb, (const bf16*)(wl + W_IN), M, NIN, D}; pg8::StaticOrder So; So.init(M, NIN, G, bx);
            EpiInProj E{QKV, a.qn_a + l * 64, a.kn_a + l * 64, a.qn_b + l * 64, a.kn_b + l * 64, cosT, sinT};
            for (int rep1 = 0; rep1 < a.rep[1]; ++rep1) pg8::gemm_phase<EpiInProj, pg8::StaticOrder, true, true>(lds, g, So, E);
        }
#endif
        xcd_barrier(xbar);
#ifndef SKIP_P2
        {
            const float mqa = wave_max(fabsf(a.qn_a[l * 64 + lane])), mka = wave_max(fabsf(a.kn_a[l * 64 + lane]));
            const float mqb = wave_max(fabsf(a.qn_b[l * 64 + lane])), mkb = wave_max(fabsf(a.kn_b[l * 64 + lane]));
            const float MbA = 8.f * mqa * mka * LOG2E * 1.02f, MbB = 8.f * mqb * mkb * LOG2E * 1.02f;
            const float s1 = wave_sum(a.lq1[l * 64 + lane] * a.lk1[l * 64 + lane]), s2 = wave_sum(a.lq2[l * 64 + lane] * a.lk2[l * 64 + lane]);
            const float lam = __expf(s1) - __expf(s2) + lambda_init;
            for (int rep = 0; rep < a.rep[5]; ++rep) {
            for (int uidx = vcu; uidx < NB * 4 * 16; uidx += G) {
                const int bh = uidx >> 4, qb = uidx & 15;
                att::diff_unit((LAS char*)lds, QKV, Yb, bh >> 2, bh & 3, qb, MbB, lam, a.subln + l * 128, 1.f - lambda_init);
            }
            for (int uidx = vcu; uidx < NB * 2 * 16; uidx += G) {
                const int bk = uidx >> 4, n = uidx & 15;
                att::swa_unit((LAS char*)lds, QKV, Yb, bk >> 1, bk & 1, n, MbA, a.sink + l * 8);
            }
            __syncthreads();
            }
        }
#endif
        xcd_barrier(xbar);
#ifndef SKIP_P3
        {
            pg8::Gemm g{Yb, (const bf16*)(wl + W_OUT), M, D, D}; pg8::StaticOrder So; So.init(M, D, G, bx);
            EpiResid E{xin, a.out};
            for (int rep6 = 0; rep6 < (l == 0 ? a.rep[6] : 1); ++rep6) pg8::gemm_phase<EpiResid, pg8::StaticOrder, true, true>(lds, g, So, E);
        }
#endif
        xcd_barrier(xbar);
        for (int rep3 = 0; rep3 < a.rep[2]; ++rep3) rms_rows(a.out, a.g_ffn + l * D, Hb, gw, ngw, lane);
        xcd_barrier(xbar);
#ifndef SKIP_P4
        {
            pg8::Gemm g{Hb, (const bf16*)(wl + W_UP), M, NUP, D}; pg8::StaticOrder So; So.init(M, NUP, G, bx);
            EpiUpConv E{ACT, a.conv_w + (size_t)l * 3 * FF, a.conv_b + (size_t)l * FF, edge, part, (LAS float*)(lds + XL_OFF)};
            for (int rep4 = 0; rep4 < a.rep[3]; ++rep4) pg8::gemm_phase<EpiUpConv, pg8::StaticOrder, true, true>(lds, g, So, E);
        }
#endif
        xcd_barrier(xbar);
        {
            const float* cw = a.conv_w + (size_t)l * 3 * FF;
            for (int i = vcu * 512 + tid; i < 64 * 2 * FF; i += G * 512) {
                const int pm = i / (2 * FF), rem = i % (2 * FF), which = rem / FF, ch = rem % FF;
                if (which == 0 && (pm & 7) != 0) {
                    const float* pp = part + (((size_t)pm * 2 + 0) * FF + ch) * 2;
                    const float pre = pp[0] + cw[ch] * edge[((size_t)(pm - 1) * 2 + 1) * FF + ch];
                    ACT[(size_t)(pm * 256) * FF + ch] = (bf16)f2bf(silu_f(pre) * pp[1]);
                }
                if (which == 1 && (pm & 7) != 7) {
                    const float* pp = part + (((size_t)pm * 2 + 1) * FF + ch) * 2;
                    const float pre = pp[0] + cw[2 * FF + ch] * edge[((size_t)(pm + 1) * 2 + 0) * FF + ch];
                    ACT[(size_t)(pm * 256 + 255) * FF + ch] = (bf16)f2bf(silu_f(pre) * pp[1]);
                }
            }
        }
        xcd_barrier(xbar);
#ifndef SKIP_P5
        {
            pg8::Gemm g{ACT, (const bf16*)(wl + W_DOWN), M, D, FF}; pg8::StaticOrder So; So.init(M, D, G, bx);
            for (int rep7 = a.rep[7] - 1; rep7 >= 0; --rep7) { EpiResid E{a.out, rep7 ? (float*)(ws + 192 * MiB) : a.out};
            pg8::gemm_phase<EpiResid, pg8::StaticOrder, true, true>(lds, g, So, E); }
        }
#endif
        if (l + 1 < DEPTH) {
            xcd_barrier(xbar);
            rms_rows(a.out, a.g_attn + (l + 1) * D, Hb, gw, ngw, lane);
            xcd_barrier(xbar);
        }
        xin = a.out;
    }
}

extern "C" void kernel_launch(void* const* d_in, const int* in_sizes, int n_in, void* d_out, int out_size, void* d_ws, size_t ws_size, hipStream_t stream) {
    static int grid = 0;
    if (grid == 0) {
        if (n_in != 19 || ws_size < WS_END) { fprintf(stderr, "kernel_launch: unexpected inputs (n_in %d, ws %zu)\n", n_in, ws_size); grid = -1; return; }
        int dev = 0, cus = 0, per_cu = 0;
        hipGetDevice(&dev);
        hipDeviceGetAttribute(&cus, hipDeviceAttributeMultiprocessorCount, dev);
        hipFuncSetAttribute((const void*)mega_fwd, hipFuncAttributeMaxDynamicSharedMemorySize, LDS_BYTES);
        hipOccupancyMaxActiveBlocksPerMultiprocessor(&per_cu, (const void*)mega_fwd, 512, LDS_BYTES);
        if (per_cu < 1) { fprintf(stderr, "kernel_launch: occupancy query reports %d blocks per CU\n", per_cu); per_cu = 1; }
        grid = cus;
        (void)hipGetLastError();
    }
    if (grid < 0) return;
    if (hipMemsetAsync((char*)d_ws + WS_CTL, 0, CTL_BYTES, stream) != hipSuccess) { fprintf(stderr, "kernel_launch: memset failed\n"); return; }
    Args a{};
    const float** p = (const float**)&a;
    for (int i = 0; i < 19; ++i) p[i] = (const float*)d_in[i];
    a.out = (float*)d_out; a.ws = (unsigned char*)d_ws;
    { const int reps[8] = {REP_P0, REP_P1, REP_P3B, REP_P4, 1, ATT_REP, REP_P3, REP_P5}; for (int i = 0; i < 8; ++i) a.rep[i] = reps[i]; }
    void* args[] = {&a};
    hipError_t e = hipLaunchCooperativeKernel((const void*)mega_fwd, dim3(grid), dim3(512), args, LDS_BYTES, stream);
    if (e != hipSuccess) fprintf(stderr, "cooperative launch failed: %s (grid %d)\n", hipGetErrorString(e), grid);
}
```

```cpp
#include <hip/hip_runtime.h>
#include <hip/hip_cooperative_groups.h>
#include <cstdio>
#include <cstdint>
namespace cg = cooperative_groups;
namespace pg8 {
#define PG8_LAS __attribute__((address_space(3)))
typedef unsigned short bf16_t;
typedef short bf16x8 __attribute__((ext_vector_type(8)));
typedef float f32x4 __attribute__((ext_vector_type(4)));
typedef unsigned u32x4 __attribute__((ext_vector_type(4)));
constexpr int BM = 256, BK = 64, HALF = 128, HTB = HALF * BK * 2  , STAGE_BYTES = 8 * HTB, NXCD = 8, WGM = 8;

__host__ __device__ __forceinline__ int lds_byte(int r, int c) { const int st = (r >> 4) * 2 + (c >> 5), rr = r & 15, cc = c & 31, ob = rr * 64 + cc * 2; return st * 1024 + (ob ^ (((ob >> 9) & 1) << 5)); }
__host__ __device__ __forceinline__ void stage_rc(int b, int& R, int& C) { const int st = b / 1024, sb = b % 1024, swz = sb ^ (((sb >> 9) & 1) << 5); R = (st >> 1) * 16 + swz / 64; C = (st & 1) * 32 + (swz % 64) / 2; }
__host__ __device__ __forceinline__ int perm32(int rho) { const int n = rho >> 4, i = rho & 15; return 8 * (i >> 2) + 4 * n + (i & 3); }

struct Unit { int pm, pn; };
struct Gemm { const bf16_t* A; const bf16_t* Bt; int M, N, K; };

struct StaticOrder {
    int nM, nN, nwg, G, c;
    __host__ __device__ void init(int M, int N, int G_, int c_) { nM = M / BM; nN = N / BM; nwg = nM * nN; G = G_; c = c_; }
    __host__ __device__ bool next(int i, Unit& u) const {
        const long L = (long)i * G + c; if (L >= nwg) return false;
        int wgid = (int)L; { const int q = nwg / NXCD, r = nwg % NXCD, xcd = wgid % NXCD, off = wgid / NXCD; wgid = (xcd < r ? xcd * (q + 1) : r * (q + 1) + (xcd - r) * q) + off; }
        const int nig = WGM * nN, gid = wgid / nig, fm = gid * WGM, gsz = (nM - fm) < WGM ? (nM - fm) : WGM;
        u.pm = fm + ((wgid % nig) % gsz); u.pn = (wgid % nig) / gsz; return true;
    }
    __device__ __forceinline__ void a_ready(const Unit&) const {}
    __device__ __forceinline__ void done(const Unit&) const {}
};

__device__ __forceinline__ unsigned cvt_pk_bf16(float lo, float hi) { unsigned r; asm volatile("v_cvt_pk_bf16_f32 %0, %1, %2" : "=v"(r) : "v"(lo), "v"(hi)); return r; }
template <class Epi, class Sched, bool ALIGN_EPI = false, bool SP2 = false>
__device__ __forceinline__ void gemm_phase(PG8_LAS unsigned char* lds, const Gemm g, const Sched& S, const Epi& E) {
    int tid = threadIdx.x; asm volatile("" : "+v"(tid)); const int wid = __builtin_amdgcn_readfirstlane(tid >> 6), lane = tid & 63, wr = wid >> 2, wc = wid & 3, fr = lane & 15, fq = lane >> 4;
    const int K = g.K, nt = K / BK;
    unsigned voffA[2], voffB[2];
#pragma unroll
    for (int i = 0; i < 2; ++i) { int R, C; stage_rc(tid * 16 + i * 8192, R, C); const int Rb = Epi::PERM ? ((R & ~31) + perm32(R & 31)) : R;
        voffA[i] = (unsigned)(R * K + C) * 2u; voffB[i] = (unsigned)(Rb * K + C) * 2u; }
    const size_t kstep = (size_t)(BK * 2);
    const size_t hstep = (size_t)HALF * K * 2;
    const size_t tstep = 2 * hstep;
    const unsigned ldsw = (unsigned)wid * 1024u;
    const int aoff = lds_byte(wr * 64 + fr, fq * 8), boff = lds_byte(wc * 32 + fr, fq * 8);
#define PG8_SA(b, h) (((b) * 2 + (h)) * HTB)
#define PG8_SB(b, h) ((4 + (b) * 2 + (h)) * HTB)
#define PG8_STAGE(bufoff, gbase, voff) do { _Pragma("unroll") for (int _i = 0; _i < 2; ++_i) \
        __builtin_amdgcn_global_load_lds((const unsigned*)((const char*)(gbase) + (voff)[_i]), (PG8_LAS unsigned*)(lds + (bufoff) + ldsw + _i * 8192), 16, 0, 0); } while (0)
#define PG8_LDA(dst, b, h) do { _Pragma("unroll") for (int m = 0; m < 4; ++m) _Pragma("unroll") for (int k = 0; k < 2; ++k) dst[m][k] = *(const PG8_LAS bf16x8*)(lds + PG8_SA(b, h) + aoff + m * 2048 + k * 1024); } while (0)
#define PG8_LDB(dst, b, h) do { _Pragma("unroll") for (int n = 0; n < 2; ++n) _Pragma("unroll") for (int k = 0; k < 2; ++k) dst[n][k] = *(const PG8_LAS bf16x8*)(lds + PG8_SB(b, h) + boff + n * 2048 + k * 1024); } while (0)
#define PG8_MMA(ai, bj, At, Bt) do { __builtin_amdgcn_s_setprio(1); _Pragma("unroll") for (int m = 0; m < 4; ++m) _Pragma("unroll") for (int n = 0; n < 2; ++n) _Pragma("unroll") for (int k = 0; k < 2; ++k) \
        acc[ai][bj][m][n] = __builtin_amdgcn_mfma_f32_16x16x32_bf16(Bt[n][k], At[m][k], acc[ai][bj][m][n], 0, 0, 0); __builtin_amdgcn_s_setprio(0); } while (0)
#define PG8_WAIT_V(n) asm volatile("s_waitcnt vmcnt(" #n ")" ::: "memory")
#define PG8_WAIT_L(n) asm volatile("s_waitcnt lgkmcnt(" #n ")" ::: "memory")
#define PG8_BAR __builtin_amdgcn_s_barrier()
#define PG8_SCHED __builtin_amdgcn_sched_barrier(0)
    Unit cur, nxt; int ui = 0;
    if (!S.next(0, cur)) return;
    f32x4 acc[2][2][4][2];
#pragma unroll
    for (int a = 0; a < 2; ++a)
#pragma unroll
        for (int b = 0; b < 2; ++b)
#pragma unroll
            for (int m = 0; m < 4; ++m)
#pragma unroll
                for (int n = 0; n < 2; ++n) acc[a][b][m][n] = (f32x4){0.f, 0.f, 0.f, 0.f};
    bf16x8 At[4][2], B0[2][2], B1[2][2];
    const char* cA = (const char*)g.A + (size_t)cur.pm * tstep; const char* cB = (const char*)g.Bt + (size_t)cur.pn * tstep;
    S.a_ready(cur);
    if constexpr (SP2) {
        PG8_STAGE(PG8_SB(0, 0), cB, voffB); PG8_STAGE(PG8_SB(0, 1), cB + hstep, voffB); PG8_STAGE(PG8_SA(0, 0), cA, voffA); PG8_STAGE(PG8_SA(0, 1), cA + hstep, voffA);
        if (wr == 1) PG8_BAR;
        PG8_WAIT_V(2); PG8_BAR;
        PG8_STAGE(PG8_SB(1, 0), cB + kstep, voffB); PG8_STAGE(PG8_SA(1, 0), cA + kstep, voffA); PG8_STAGE(PG8_SB(1, 1), cB + hstep + kstep, voffB);
        PG8_WAIT_V(6); PG8_BAR;
    } else {
        PG8_STAGE(PG8_SB(0, 0), cB, voffB); PG8_STAGE(PG8_SA(0, 0), cA, voffA); PG8_STAGE(PG8_SB(0, 1), cB + hstep, voffB); PG8_STAGE(PG8_SA(0, 1), cA + hstep, voffA);
        if (wr == 1) PG8_BAR;
        PG8_WAIT_V(4); PG8_BAR;
        PG8_STAGE(PG8_SB(1, 0), cB + kstep, voffB); PG8_STAGE(PG8_SA(1, 0), cA + kstep, voffA); PG8_STAGE(PG8_SB(1, 1), cB + hstep + kstep, voffB);
        PG8_WAIT_V(6); PG8_BAR;
    }
    for (;;) {
        const bool has_next = S.next(ui + 1, nxt);
        const char* nA = has_next ? (const char*)g.A + (size_t)nxt.pm * tstep : cA; const char* nB = has_next ? (const char*)g.Bt + (size_t)nxt.pn * tstep : cB;
        for (int t = 0; t < nt; t += 2) {
            const bool last = (t == nt - 2);
            const char* a1 = cA + (size_t)(t + 1) * kstep;
            const char* a2 = last ? nA : cA + (size_t)(t + 2) * kstep; const char* b2 = last ? nB : cB + (size_t)(t + 2) * kstep;
            const char* a3 = a2 + kstep; const char* b3 = b2 + kstep;
            if (last && has_next) S.a_ready(nxt);
            if constexpr (SP2) {
            PG8_LDB(B0, 0, 0); PG8_LDB(B1, 0, 1); PG8_SCHED; PG8_LDA(At, 0, 0); PG8_STAGE(PG8_SA(1, 1), a1 + hstep, voffA);
            PG8_WAIT_V(8); PG8_WAIT_L(0); PG8_BAR; PG8_MMA(0, 0, At, B0); PG8_MMA(0, 1, At, B1); PG8_BAR; PG8_SCHED;
            PG8_LDA(At, 0, 1); PG8_STAGE(PG8_SB(0, 0), b2, voffB); PG8_STAGE(PG8_SB(0, 1), b2 + hstep, voffB); PG8_STAGE(PG8_SA(0, 0), a2, voffA);
            PG8_WAIT_V(8); PG8_WAIT_L(0); PG8_BAR; PG8_MMA(1, 0, At, B0); PG8_MMA(1, 1, At, B1); PG8_BAR; PG8_SCHED;
            PG8_LDB(B0, 1, 0); PG8_LDB(B1, 1, 1); PG8_SCHED; PG8_LDA(At, 1, 0); PG8_STAGE(PG8_SA(0, 1), a2 + hstep, voffA);
            PG8_WAIT_V(8); PG8_WAIT_L(0); PG8_BAR; PG8_MMA(0, 0, At, B0); PG8_MMA(0, 1, At, B1); PG8_BAR; PG8_SCHED;
            PG8_LDA(At, 1, 1); PG8_STAGE(PG8_SB(1, 0), b3, voffB); PG8_STAGE(PG8_SB(1, 1), b3 + hstep, voffB); PG8_STAGE(PG8_SA(1, 0), a3, voffA);
            PG8_WAIT_V(8); PG8_WAIT_L(0); PG8_BAR; PG8_MMA(1, 0, At, B0); PG8_MMA(1, 1, At, B1); PG8_BAR; PG8_SCHED;
            } else {
            PG8_LDB(B0, 0, 0); PG8_SCHED; PG8_LDA(At, 0, 0); PG8_STAGE(PG8_SA(1, 1), a1 + hstep, voffA);
            PG8_WAIT_L(8); PG8_BAR; PG8_WAIT_L(0); PG8_MMA(0, 0, At, B0); PG8_BAR; PG8_SCHED;
            PG8_LDB(B1, 0, 1); PG8_STAGE(PG8_SB(0, 0), b2, voffB);
            PG8_BAR; PG8_WAIT_L(0); PG8_MMA(0, 1, At, B1); PG8_BAR;
            PG8_LDA(At, 0, 1); PG8_STAGE(PG8_SA(0, 0), a2, voffA);
            PG8_BAR; PG8_WAIT_L(0); PG8_MMA(1, 0, At, B0); PG8_BAR; PG8_SCHED;
            PG8_STAGE(PG8_SB(0, 1), b2 + hstep, voffB);
            PG8_WAIT_V(6); PG8_BAR; PG8_MMA(1, 1, At, B1); PG8_BAR;
            PG8_LDB(B0, 1, 0); PG8_SCHED; PG8_LDA(At, 1, 0); PG8_STAGE(PG8_SA(0, 1), a2 + hstep, voffA);
            PG8_WAIT_L(8); PG8_BAR; PG8_WAIT_L(0); PG8_MMA(0, 0, At, B0); PG8_BAR; PG8_SCHED;
            PG8_LDB(B1, 1, 1); PG8_STAGE(PG8_SB(1, 0), b3, voffB);
            PG8_BAR; PG8_WAIT_L(0); PG8_MMA(0, 1, At, B1); PG8_BAR;
            PG8_LDA(At, 1, 1); PG8_STAGE(PG8_SA(1, 0), a3, voffA);
            PG8_BAR; PG8_WAIT_L(0); PG8_MMA(1, 0, At, B0); PG8_BAR; PG8_SCHED;
            PG8_STAGE(PG8_SB(1, 1), b3 + hstep, voffB);
            PG8_WAIT_V(6); PG8_BAR; PG8_MMA(1, 1, At, B1); PG8_BAR;
            }
        }
        if constexpr (ALIGN_EPI) { if (wr == 0) PG8_BAR; }
        if constexpr (!Epi::AFTER_DRAIN) { E(acc, cur, wr, wc, fr, fq); S.done(cur); }
        if (!has_next) break;
#pragma unroll
        for (int a = 0; a < 2; ++a)
#pragma unroll
            for (int b = 0; b < 2; ++b)
#pragma unroll
                for (int m = 0; m < 4; ++m)
#pragma unroll
                    for (int n = 0; n < 2; ++n) acc[a][b][m][n] = (f32x4){0.f, 0.f, 0.f, 0.f};
        cur = nxt; cA = nA; cB = nB; ++ui;
        if constexpr (ALIGN_EPI) { if (wr == 1) PG8_BAR; }
    }
    PG8_WAIT_V(0);
    if constexpr (!ALIGN_EPI) { if (wr == 0) PG8_BAR; }
    PG8_BAR;
    if constexpr (Epi::AFTER_DRAIN) { E.fused(acc, cur, wr, wc, fr, fq, lds, wid, lane); S.done(cur); }
#undef PG8_SA
#undef PG8_SB
#undef PG8_STAGE
#undef PG8_LDA
#undef PG8_LDB
#undef PG8_MMA
#undef PG8_WAIT_V
#undef PG8_WAIT_L
#undef PG8_BAR
#undef PG8_SCHED
}
}
#define LAS __attribute__((address_space(3)))
typedef unsigned short bf16;
using pg8::f32x4; using pg8::u32x4; using pg8::Unit; using pg8::cvt_pk_bf16; using pg8::bf16x8;
typedef unsigned u32x2 __attribute__((ext_vector_type(2)));

constexpr int NB = 8, S = 2048, D = 1024, M = NB * S, NIN = 2304, FF = 2816, NUP = 2 * FF, DEPTH = 2;
constexpr float EPS = 1e-6f;
constexpr float LOG2E = 1.4426950408889634f;
constexpr float QSCALE = 0.125f * LOG2E;
constexpr int XL_OFF = 131072;
constexpr int LDS_BYTES = 131072 + 8192;

__device__ __forceinline__ float dot4(f32x4 a) { return (a[0] * a[0] + a[1] * a[1]) + (a[2] * a[2] + a[3] * a[3]); }
__device__ __forceinline__ float silu_f(float v) { return v * __builtin_amdgcn_rcpf(1.f + __expf(-v)); }

struct EpiInProj {
    static constexpr bool PERM = true, AFTER_DRAIN = false;
    bf16* O; const float* qn_a; const float* kn_a; const float* qn_b; const float* kn_b; const float* cosT; const float* sinT;
    __device__ __forceinline__ void operator()(const f32x4 (&acc)[2][2][4][2], const Unit& u, int wr, int wc, int fr, int fq) const {
        asm volatile("" : "+v"(fr), "+v"(fq));
        const int pn = u.pn;
        const float* g = nullptr; float sc = 1.f;
        if (pn < 2) { g = qn_a; sc = QSCALE; }
        else if (pn == 2) { if (wc < 2) g = kn_a; }
        else if (pn < 5) { g = qn_b; sc = QSCALE; }
        else if (pn < 7) { g = kn_b; }
        const int colb = pn * 256 + wc * 64 + 8 * fq;
        const int row0 = u.pm * 256 + wr * 64 + fr;
        if (g) {
            f32x4 g1[2], g2[2];
#pragma unroll
            for (int n = 0; n < 2; ++n) { g1[n] = *(const f32x4*)(g + 8 * fq + 4 * n); g2[n] = *(const f32x4*)(g + 32 + 8 * fq + 4 * n); }
#pragma unroll
            for (int ai = 0; ai < 2; ++ai)
#pragma unroll
                for (int m = 0; m < 4; ++m) {
                    const int row = row0 + ai * 128 + m * 16;
                    const f32x4 a0 = acc[ai][0][m][0], a1 = acc[ai][0][m][1], b0 = acc[ai][1][m][0], b1 = acc[ai][1][m][1];
                    float ss = (dot4(a0) + dot4(a1)) + (dot4(b0) + dot4(b1));
                    ss += __shfl_xor(ss, 16); ss += __shfl_xor(ss, 32);
                    const float rs = rsqrtf(ss * (1.f / 64.f) + EPS) * sc;
                    const size_t ro = (size_t)(row & (S - 1)) * 32 + 8 * fq;
                    const f32x4 c0 = *(const f32x4*)(cosT + ro), c1 = *(const f32x4*)(cosT + ro + 4), s0 = *(const f32x4*)(sinT + ro), s1 = *(const f32x4*)(sinT + ro + 4);
                    const f32x4 y10 = a0 * rs * g1[0], y11 = a1 * rs * g1[1], y20 = b0 * rs * g2[0], y21 = b1 * rs * g2[1];
                    const f32x4 o10 = y10 * c0 - y20 * s0, o11 = y11 * c1 - y21 * s1, o20 = y20 * c0 + y10 * s0, o21 = y21 * c1 + y11 * s1;
                    u32x4 w1, w2;
                    w1.x = cvt_pk_bf16(o10[0], o10[1]); w1.y = cvt_pk_bf16(o10[2], o10[3]); w1.z = cvt_pk_bf16(o11[0], o11[1]); w1.w = cvt_pk_bf16(o11[2], o11[3]);
                    w2.x = cvt_pk_bf16(o20[0], o20[1]); w2.y = cvt_pk_bf16(o20[2], o20[3]); w2.z = cvt_pk_bf16(o21[0], o21[1]); w2.w = cvt_pk_bf16(o21[2], o21[3]);
                    bf16* op = O + (size_t)row * NIN + colb;
                    *(u32x4*)op = w1; *(u32x4*)(op + 32) = w2;
                }
        } else {
#pragma unroll
            for (int ai = 0; ai < 2; ++ai)
#pragma unroll
                for (int m = 0; m < 4; ++m) {
                    const int row = row0 + ai * 128 + m * 16;
                    bf16* op = O + (size_t)row * NIN + colb;
#pragma unroll
                    for (int bj = 0; bj < 2; ++bj) { const f32x4 v0 = acc[ai][bj][m][0], v1 = acc[ai][bj][m][1]; u32x4 w;
                        w.x = cvt_pk_bf16(v0[0], v0[1]); w.y = cvt_pk_bf16(v0[2], v0[3]); w.z = cvt_pk_bf16(v1[0], v1[1]); w.w = cvt_pk_bf16(v1[2], v1[3]);
                        *(u32x4*)(op + 32 * bj) = w; }
                }
        }
    }
};

struct EpiResid {
    static constexpr bool PERM = true, AFTER_DRAIN = false;
    const float* base; float* out;
    __device__ __forceinline__ void operator()(const f32x4 (&acc)[2][2][4][2], const Unit& u, int wr, int wc, int fr, int fq) const {
        asm volatile("" : "+v"(fr), "+v"(fq));
        const int col0 = u.pn * 256 + wc * 32 + 8 * fq, row0 = u.pm * 256 + wr * 64 + fr;
#pragma unroll
        for (int ai = 0; ai < 2; ++ai) {
            f32x4 x[4][2][2];
#pragma unroll
            for (int m = 0; m < 4; ++m) { const size_t off = (size_t)(row0 + ai * 128 + m * 16) * D + col0;
#pragma unroll
                for (int bj = 0; bj < 2; ++bj) { x[m][bj][0] = *(const f32x4*)(base + off + bj * 128); x[m][bj][1] = *(const f32x4*)(base + off + bj * 128 + 4); } }
            asm volatile("" ::: "memory");
#pragma unroll
            for (int m = 0; m < 4; ++m) { const size_t off = (size_t)(row0 + ai * 128 + m * 16) * D + col0;
#pragma unroll
                for (int bj = 0; bj < 2; ++bj) { *(f32x4*)(out + off + bj * 128) = x[m][bj][0] + acc[ai][bj][m][0]; *(f32x4*)(out + off + bj * 128 + 4) = x[m][bj][1] + acc[ai][bj][m][1]; } }
            asm volatile("" ::: "memory");
        }
    }
};

struct EpiUpConv {
    static constexpr bool PERM = true, AFTER_DRAIN = false;
    bf16* ACT; const float* cw; const float* cb; float* edge; float* part; LAS float* xl;
    __device__ __forceinline__ void operator()(const f32x4 (&acc)[2][2][4][2], const Unit& u, int wr, int wc, int fr, int fq) const {
        asm volatile("" : "+v"(fr), "+v"(fq));
        const int lane = 16 * fq + fr;
        const int cl0 = 32 * wc + 8 * fq, ch0 = 128 * u.pn + cl0;
#pragma unroll
        for (int ai = 0; ai < 2; ++ai) {
            const int chunk = 2 * ai + wr;
            if (fr == 0) { *(LAS f32x4*)(xl + (chunk * 2 + 0) * 128 + cl0) = acc[ai][0][0][0]; *(LAS f32x4*)(xl + (chunk * 2 + 0) * 128 + cl0 + 4) = acc[ai][0][0][1]; }
            if (fr == 15) { *(LAS f32x4*)(xl + (chunk * 2 + 1) * 128 + cl0) = acc[ai][0][3][0]; *(LAS f32x4*)(xl + (chunk * 2 + 1) * 128 + cl0 + 4) = acc[ai][0][3][1]; }
        }
        asm volatile("s_waitcnt lgkmcnt(0)" ::: "memory"); __builtin_amdgcn_s_barrier(); asm volatile("" ::: "memory");
        const int lup = (lane & ~15) | ((fr + 15) & 15), ldn = (lane & ~15) | ((fr + 1) & 15);
        const bool seq_first = (u.pm & 7) == 0, seq_last = (u.pm & 7) == 7;
#pragma unroll
        for (int ai = 0; ai < 2; ++ai) {
            const int chunk = 2 * ai + wr;
#pragma unroll
            for (int n = 0; n < 2; ++n) {
                const int ch = ch0 + 4 * n;
                const f32x4 w0 = *(const f32x4*)(cw + ch), w1 = *(const f32x4*)(cw + FF + ch), w2 = *(const f32x4*)(cw + 2 * FF + ch), bb = *(const f32x4*)(cb + ch);
                const f32x4 above = (chunk > 0) ? *(const LAS f32x4*)(xl + ((chunk - 1) * 2 + 1) * 128 + cl0 + 4 * n) : (f32x4){0.f, 0.f, 0.f, 0.f};
                const f32x4 below = (chunk < 3) ? *(const LAS f32x4*)(xl + ((chunk + 1) * 2 + 0) * 128 + cl0 + 4 * n) : (f32x4){0.f, 0.f, 0.f, 0.f};
                f32x4 Rprev = above, Lcur;
#pragma unroll
                for (int e = 0; e < 4; ++e) Lcur[e] = __shfl(acc[ai][0][0][n][e], ldn);
#pragma unroll
                for (int m = 0; m < 4; ++m) {
                    const int rt = ai * 128 + wr * 64 + m * 16 + fr;
                    const size_t row = (size_t)u.pm * 256 + rt;
                    const f32x4 cur = acc[ai][0][m][n], val = acc[ai][1][m][n];
                    f32x4 Rm, Lnext = below;
#pragma unroll
                    for (int e = 0; e < 4; ++e) { Rm[e] = __shfl(cur[e], lup); if (m < 3) Lnext[e] = __shfl(acc[ai][0][m < 3 ? m + 1 : 3][n][e], ldn); }
                    const f32x4 up = (fr == 0) ? Rprev : Rm, dn = (fr == 15) ? Lnext : Lcur;
                    Rprev = Rm; Lcur = Lnext;
                    const f32x4 pre = bb + w0 * up + w1 * cur + w2 * dn;
                    f32x4 res;
#pragma unroll
                    for (int e = 0; e < 4; ++e) res[e] = silu_f(pre[e]) * val[e];
                    if (rt == 0) {
                        *(f32x4*)(edge + ((size_t)u.pm * 2 + 0) * FF + ch) = cur;
                        if (!seq_first) { float* pp = part + (((size_t)u.pm * 2 + 0) * FF + ch) * 2;
                            *(f32x4*)pp = (f32x4){pre[0], val[0], pre[1], val[1]}; *(f32x4*)(pp + 4) = (f32x4){pre[2], val[2], pre[3], val[3]}; }
                    }
                    if (rt == 255) {
                        *(f32x4*)(edge + ((size_t)u.pm * 2 + 1) * FF + ch) = cur;
                        if (!seq_last) { float* pp = part + (((size_t)u.pm * 2 + 1) * FF + ch) * 2;
                            *(f32x4*)pp = (f32x4){pre[0], val[0], pre[1], val[1]}; *(f32x4*)(pp + 4) = (f32x4){pre[2], val[2], pre[3], val[3]}; }
                    }
                    u32x2 w; w.x = cvt_pk_bf16(res[0], res[1]); w.y = cvt_pk_bf16(res[2], res[3]);
                    *(u32x2*)(ACT + row * FF + ch) = w;
                }
            }
        }
    }
};
namespace att {
typedef __attribute__((ext_vector_type(16))) float f32x16;
typedef __attribute__((ext_vector_type(4))) short s16x4;
typedef short v4i16_t __attribute__((ext_vector_type(4)));
typedef LAS const char* lptr;
__device__ __forceinline__ s16x4 vtr(lptr p) { return __builtin_bit_cast(s16x4, __builtin_amdgcn_ds_read_tr16_b64_v4i16((LAS v4i16_t*)p)); }
__device__ __forceinline__ bf16x8 pack8(const f32x16& s, int b) {
    u32x4 w; w.x = cvt_pk_bf16(s[b], s[b + 1]); w.y = cvt_pk_bf16(s[b + 2], s[b + 3]); w.z = cvt_pk_bf16(s[b + 4], s[b + 5]); w.w = cvt_pk_bf16(s[b + 6], s[b + 7]);
    return __builtin_bit_cast(bf16x8, w);
}
#define MFMA32(a, b, c) __builtin_amdgcn_mfma_f32_32x32x16_bf16((a), (b), (c), 0, 0, 0)

#define LGKM_WAIT(n) asm volatile("s_waitcnt lgkmcnt(" #n ")" ::: "memory")
#define SCHED_FENCE() __builtin_amdgcn_sched_barrier(0)
__device__ __forceinline__ bf16x8 rd128(unsigned addr, int off) { bf16x8 r; asm volatile("ds_read_b128 %0, %1 offset:%c2" : "=&v"(r) : "v"(addr), "i"(off) : "memory"); return r; }
__device__ __forceinline__ s16x4 rdtr(unsigned addr, int off) { s16x4 r; asm volatile("ds_read_b64_tr_b16 %0, %1 offset:%c2" : "=&v"(r) : "v"(addr), "i"(off) : "memory"); return r; }
#define VFRAG(lo, hh) ((bf16x8){lo[0], lo[1], lo[2], lo[3], hh[0], hh[1], hh[2], hh[3]})
constexpr int KROW = 144, VROWD = 320, VROWA = 192;
constexpr int DSTG = 2 * 64 * KROW + 64 * VROWD;
constexpr int ASTG = 64 * KROW + 64 * VROWA;

constexpr int DST3 = 32768;
__device__ __forceinline__ void diff_unit(LAS char* lds, const bf16* __restrict__ QKV, bf16* __restrict__ Y, int b, int h, int qb, float Mb, float lam, const float* __restrict__ subln, float outscale) {
    int tid = threadIdx.x; asm volatile("" : "+v"(tid)); const int lane = tid & 63, w = __builtin_amdgcn_readfirstlane(tid >> 6), q = lane & 31, hi = lane >> 5;
    const int rg = w >> 1, c = w & 1;
    const size_t rowQ = (size_t)b * S + qb * 128 + rg * 32 + q;
    const bf16* qp = QKV + rowQ * NIN + 768 + (2 * h + c) * 64 + hi * 8;
    bf16x8 qf[4];
#pragma unroll
    for (int ds = 0; ds < 4; ++ds) qf[ds] = *(const bf16x8*)(qp + ds * 16);
    const int krow = 8 * w + (lane >> 3), kch = (lane & 7) ^ ((krow >> 1) & 7);
    const int vrow = 4 * w + (lane >> 4), vch = (lane & 15) ^ ((vrow & 3) << 2);
    const bf16* kg = QKV + ((size_t)b * S + krow) * NIN + 1280 + 128 * h + kch * 8;
    const bf16* vg = QKV + ((size_t)b * S + vrow) * NIN + 1792 + 128 * h + vch * 8;
#define DDMA(t, so) do { const size_t o_ = (size_t)(t) * 64 * NIN; LAS unsigned char* d_ = (LAS unsigned char*)lds + (so) + w * 1024; \
        __builtin_amdgcn_global_load_lds((const unsigned*)(kg + o_), (LAS unsigned*)(d_), 16, 0, 0); \
        __builtin_amdgcn_global_load_lds((const unsigned*)(kg + o_ + 64), (LAS unsigned*)(d_ + 8192), 16, 0, 0); \
        __builtin_amdgcn_global_load_lds((const unsigned*)(vg + o_), (LAS unsigned*)(d_ + 16384), 16, 0, 0); \
        __builtin_amdgcn_global_load_lds((const unsigned*)(vg + o_ + 32 * NIN), (LAS unsigned*)(d_ + 16384 + 8192), 16, 0, 0); } while (0)
    f32x16 o[4];
#pragma unroll
    for (int i = 0; i < 4; ++i) o[i] = (f32x16){0.f};
    float l = 0.f;
    constexpr int NT = S / 64;
    DDMA(0, 0); DDMA(1, DST3);
    const unsigned lbase = (unsigned)(size_t)lds;
    unsigned kofs[4], vofs[4];
    { const int sw = (q >> 1) & 7, vq = (lane & 15) >> 2;
#pragma unroll
      for (int ds = 0; ds < 4; ++ds) kofs[ds] = (unsigned)(c * 8192 + q * 128 + (((2 * ds + hi) ^ sw) << 4));
#pragma unroll
      for (int db = 0; db < 4; ++db) vofs[db] = (unsigned)(16384 + (4 * hi + vq) * 256 + ((db ^ vq) << 6) + ((lane >> 4) & 1) * 32 + (lane & 3) * 8); }
    f32x16 negm;
#pragma unroll
    for (int r = 0; r < 16; ++r) negm[r] = -Mb;
    int so_cur = 0, so_nxt2 = 2 * DST3;
    for (int t = 0; t < NT; ++t) {
        asm volatile("s_waitcnt vmcnt(4)" ::: "memory");
        __builtin_amdgcn_s_barrier();
        asm volatile("" ::: "memory");
        { const int tn = (t + 2 < NT) ? t + 2 : NT - 1; DDMA(tn, so_nxt2); }
        const unsigned sb = lbase + so_cur;
        bf16x8 kf[8];
#pragma unroll
        for (int ds = 0; ds < 4; ++ds) { kf[2 * ds] = rd128(sb + kofs[ds], 0); kf[2 * ds + 1] = rd128(sb + kofs[ds], 32 * 128); }
        s16x4 vl[2][4], vh[2][4];
#pragma unroll
        for (int db = 0; db < 4; ++db) { vl[0][db] = rdtr(sb + vofs[db], 0); vh[0][db] = rdtr(sb + vofs[db], 8 * 256); }
        LGKM_WAIT(8); SCHED_FENCE();
        f32x16 s0 = negm, s1 = negm;
#pragma unroll
        for (int ds = 0; ds < 4; ++ds) { s0 = MFMA32(kf[2 * ds], qf[ds], s0); s1 = MFMA32(kf[2 * ds + 1], qf[ds], s1); }
        float ls = 0.f;
#pragma unroll
        for (int r = 0; r < 16; ++r) { s0[r] = __builtin_amdgcn_exp2f(s0[r]); s1[r] = __builtin_amdgcn_exp2f(s1[r]); ls += s0[r] + s1[r]; }
        l += ls;
        bf16x8 pf[4]; pf[0] = pack8(s0, 0); pf[1] = pack8(s0, 8); pf[2] = pack8(s1, 0); pf[3] = pack8(s1, 8);
        SCHED_FENCE();
#pragma unroll
        for (int ks = 0; ks < 4; ++ks) {
            if (ks < 3) {
#pragma unroll
                for (int db = 0; db < 4; ++db) { vl[(ks + 1) & 1][db] = rdtr(sb + vofs[db], (ks + 1) * 16 * 256); vh[(ks + 1) & 1][db] = rdtr(sb + vofs[db], (ks + 1) * 16 * 256 + 8 * 256); }
                LGKM_WAIT(8);
            } else { LGKM_WAIT(0); }
            SCHED_FENCE();
#pragma unroll
            for (int db = 0; db < 4; ++db) o[db] = MFMA32(VFRAG(vl[ks & 1][db], vh[ks & 1][db]), pf[ks], o[db]);
            SCHED_FENCE();
        }
        so_cur = (so_cur == 2 * DST3) ? 0 : so_cur + DST3; so_nxt2 = (so_nxt2 == 2 * DST3) ? 0 : so_nxt2 + DST3;
    }
#undef DDMA
    asm volatile("s_waitcnt vmcnt(0)" ::: "memory");
    __syncthreads();
    l += __shfl_xor(l, 32);
    const float inv = 1.f / l;
    LAS f32x4* xb = (LAS f32x4*)lds + rg * (16 * 64) + lane;
    if (c == 1) {
#pragma unroll
        for (int db = 0; db < 4; ++db)
#pragma unroll
            for (int r4 = 0; r4 < 4; ++r4) xb[(db * 4 + r4) * 64] = (f32x4){o[db][4 * r4], o[db][4 * r4 + 1], o[db][4 * r4 + 2], o[db][4 * r4 + 3]} * inv;
    }
    __syncthreads();
    if (c == 0) {
        float ss = 0.f;
#pragma unroll
        for (int db = 0; db < 4; ++db)
#pragma unroll
            for (int r4 = 0; r4 < 4; ++r4) { const f32x4 ot = xb[(db * 4 + r4) * 64];
#pragma unroll
                for (int e = 0; e < 4; ++e) { const float d = o[db][4 * r4 + e] * inv - lam * ot[e]; o[db][4 * r4 + e] = d; ss += d * d; } }
        ss += __shfl_xor(ss, 32);
        const float rs = rsqrtf(ss * (1.f / 128.f) + EPS) * outscale;
        bf16* yp = Y + rowQ * D + 512 + 128 * h + 4 * hi;
#pragma unroll
        for (int db = 0; db < 4; ++db)
#pragma unroll
            for (int r4 = 0; r4 < 4; ++r4) { const f32x4 gw = *(const f32x4*)(subln + 32 * db + 8 * r4 + 4 * hi);
                u32x2 wv; wv.x = cvt_pk_bf16(o[db][4 * r4] * rs * gw[0], o[db][4 * r4 + 1] * rs * gw[1]); wv.y = cvt_pk_bf16(o[db][4 * r4 + 2] * rs * gw[2], o[db][4 * r4 + 3] * rs * gw[3]);
                *(u32x2*)(yp + 32 * db + 8 * r4) = wv; }
    }
    __syncthreads();
}

__device__ __forceinline__ void swa_unit(LAS char* lds, const bf16* __restrict__ QKV, bf16* __restrict__ Y, int b, int kvh, int n, float Mb, const float* __restrict__ sink) {
    int tid = threadIdx.x; asm volatile("" : "+v"(tid)); const int lane = tid & 63, w = __builtin_amdgcn_readfirstlane(tid >> 6), q = lane & 31, hi = lane >> 5;
    const int head = kvh * 4 + (w >> 1), rb = (w & 1) * 64;
    const size_t rowQ = (size_t)b * S + n * 128 + rb + q;
    bf16x8 qf[2][4];
#pragma unroll
    for (int rg = 0; rg < 2; ++rg)
#pragma unroll
        for (int ds = 0; ds < 4; ++ds) qf[rg][ds] = *(const bf16x8*)(QKV + (rowQ + 32 * rg) * NIN + head * 64 + hi * 8 + ds * 16);
    const int lrow = tid >> 3, lcc = tid & 7;
    const long kp0 = (long)b * S + (long)(n - 1) * 128 + lrow;
    const bf16* kg = QKV + kp0 * NIN + 512 + kvh * 64 + lcc * 8;
    const bf16* vg = QKV + kp0 * NIN + 640 + kvh * 64 + lcc * 8;
    const int kdst = lrow * KROW + lcc * 16, vdst = 64 * KROW + lrow * VROWA + lcc * 16;
    u32x4 st0, st1;
#define ALOAD(t) do { const long o_ = (long)(t) * 64 * NIN; st0 = *(const u32x4*)(kg + o_); st1 = *(const u32x4*)(vg + o_); } while (0)
#define ASTORE(bo) do { *(LAS u32x4*)(lds + (bo) + kdst) = st0; *(LAS u32x4*)(lds + (bo) + vdst) = st1; } while (0)
    f32x16 o[2][2];
#pragma unroll
    for (int i = 0; i < 2; ++i)
#pragma unroll
        for (int j = 0; j < 2; ++j) o[i][j] = (f32x16){0.f};
    float l[2] = {0.f, 0.f};
    const int t0 = (n == 0) ? 2 : 0, t1 = (n == S / 128 - 1) ? 4 : 6;
    ALOAD(t0); ASTORE((t0 & 1) * ASTG); __syncthreads();
    const int koff = q * KROW + hi * 16;
    const int voff = 64 * KROW + (4 * hi + ((lane & 15) >> 2)) * VROWA + ((lane >> 4) & 1) * 32 + (lane & 3) * 8;
    for (int t = t0; t < t1; ++t) {
        const int cur = (t & 1) * ASTG, nxt = ASTG - cur;
        if (t + 1 < t1) ALOAD(t + 1);
        lptr kb = (lptr)(lds + cur + koff);
        lptr vb = (lptr)(lds + cur + voff);
#pragma unroll
        for (int rg = 0; rg < 2; ++rg) {
            const int i0 = rb + 32 * rg;
            if (64 * t + 63 >= i0 && 64 * t <= i0 + 31 + 256) {
                f32x16 s0 = (f32x16){0.f}, s1 = (f32x16){0.f};
#pragma unroll
                for (int ds = 0; ds < 4; ++ds) {
                    const bf16x8 k0 = *(const LAS bf16x8*)(kb + ds * 32), k1 = *(const LAS bf16x8*)(kb + 32 * KROW + ds * 32);
                    s0 = MFMA32(k0, qf[rg][ds], s0); s1 = MFMA32(k1, qf[rg][ds], s1);
                }
                const int jb = 64 * t + 4 * hi - (i0 + q);
                float ls = 0.f;
#pragma unroll
                for (int r = 0; r < 16; ++r) {
                    const int d0 = jb + (r & 3) + 8 * (r >> 2), d1 = d0 + 32;
                    const float p0 = __builtin_amdgcn_exp2f(s0[r] - Mb), p1 = __builtin_amdgcn_exp2f(s1[r] - Mb);
                    s0[r] = ((unsigned)d0 <= 256u) ? p0 : 0.f; s1[r] = ((unsigned)d1 <= 256u) ? p1 : 0.f; ls += s0[r] + s1[r];
                }
                l[rg] += ls;
                bf16x8 pf[4]; pf[0] = pack8(s0, 0); pf[1] = pack8(s0, 8); pf[2] = pack8(s1, 0); pf[3] = pack8(s1, 8);
#pragma unroll
                for (int ks = 0; ks < 4; ++ks)
#pragma unroll
                    for (int db = 0; db < 2; ++db) {
                        const s16x4 lo = vtr(vb + ks * 16 * VROWA + db * 64), hh = vtr(vb + ks * 16 * VROWA + 8 * VROWA + db * 64);
                        const bf16x8 vf = (bf16x8){lo[0], lo[1], lo[2], lo[3], hh[0], hh[1], hh[2], hh[3]};
                        o[rg][db] = MFMA32(vf, pf[ks], o[rg][db]);
                    }
            }
        }
        if (t + 1 < t1) ASTORE(nxt);
        __syncthreads();
    }
#undef ALOAD
#undef ASTORE
    const float sk = __builtin_amdgcn_exp2f(sink[head] * LOG2E - Mb);
#pragma unroll
    for (int rg = 0; rg < 2; ++rg) {
        float lt = l[rg]; lt += __shfl_xor(lt, 32);
        const float inv = 1.f / (lt + sk);
        bf16* yp = Y + (rowQ + 32 * rg) * D + head * 64 + 4 * hi;
#pragma unroll
        for (int db = 0; db < 2; ++db)
#pragma unroll
            for (int r4 = 0; r4 < 4; ++r4) { u32x2 wv; wv.x = cvt_pk_bf16(o[rg][db][4 * r4] * inv, o[rg][db][4 * r4 + 1] * inv); wv.y = cvt_pk_bf16(o[rg][db][4 * r4 + 2] * inv, o[rg][db][4 * r4 + 3] * inv);
                *(u32x2*)(yp + 32 * db + 8 * r4) = wv; }
    }
}
}
constexpr size_t MiB = 1u << 20;
constexpr size_t WS_CTL = 0, CTL_BYTES = 65536;
constexpr int MISC_OFF = 131072 + 4096;
constexpr size_t WS_ROPE = 1 * MiB;
constexpr size_t WS_W = 2 * MiB, W_LAYER = 23 * MiB;
constexpr size_t W_IN = 0, W_OUT = (size_t)NIN * D * 2, W_UP = W_OUT + (size_t)D * D * 2, W_DOWN = W_UP + (size_t)NUP * D * 2;
static_assert(W_DOWN + (size_t)D * FF * 2 <= W_LAYER, "weights");
constexpr size_t WS_H = 48 * MiB;
constexpr size_t WS_QKV = 80 * MiB;
constexpr size_t WS_Y = 152 * MiB;
constexpr size_t WS_ACT = 80 * MiB;
constexpr size_t WS_EDGE = 184 * MiB;
constexpr size_t WS_PART = 186 * MiB;
constexpr size_t WS_END = 190 * MiB;
static_assert(WS_ACT + (size_t)M * FF * 2 <= WS_EDGE && WS_QKV + (size_t)M * NIN * 2 <= WS_Y && WS_Y + (size_t)M * D * 2 <= WS_EDGE, "ws map");

#ifndef REP_P0
#define REP_P0 1
#endif
#ifndef REP_P1
#define REP_P1 1
#endif
#ifndef REP_P3B
#define REP_P3B 1
#endif
#ifndef REP_P4
#define REP_P4 1
#endif
#ifndef ATT_REP
#define ATT_REP 1
#endif
#ifndef REP_P5
#define REP_P5 1
#endif
#ifndef REP_P3
#define REP_P3 1
#endif
#ifndef REP_SYNC
#define REP_SYNC 1
#endif
struct Args {
    const float *x, *g_attn, *w_in, *qn_a, *kn_a, *sink, *qn_b, *kn_b, *lq1, *lk1, *lq2, *lk2, *subln, *w_out, *g_ffn, *w_up, *conv_w, *conv_b, *w_down;
    float* out; unsigned char* ws;
    int rep[8];
};

__device__ __forceinline__ float wave_sum(float v) {
#pragma unroll
    for (int o = 1; o < 64; o <<= 1) v += __shfl_xor(v, o);
    return v;
}
__device__ __forceinline__ float wave_max(float v) {
#pragma unroll
    for (int o = 1; o < 64; o <<= 1) v = fmaxf(v, __shfl_xor(v, o));
    return v;
}
__device__ __forceinline__ unsigned f2bf(float f) { unsigned u = __builtin_bit_cast(unsigned, f); return (u + 0x7fffu + ((u >> 16) & 1u)) >> 16; }
__device__ __forceinline__ unsigned pk2(float lo, float hi) { return f2bf(lo) | (f2bf(hi) << 16); }

__device__ __forceinline__ void transpose_item(const float* __restrict__ W, int K, int N, bf16* __restrict__ WT, LAS float* scr, int kb, int nb, int dnb, int lane) {
    const int k0 = 64 * kb, n0 = 32 * nb;
#pragma unroll 8
    for (int i = 0; i < 32; ++i) { const int kk = 2 * i + (lane >> 5); scr[kk * 33 + (lane & 31)] = W[(size_t)(k0 + kk) * N + n0 + (lane & 31)]; }
    asm volatile("s_waitcnt lgkmcnt(0)" ::: "memory");
    const int c = lane & 7;
#pragma unroll
    for (int j = 0; j < 4; ++j) { const int n = (lane >> 3) + 8 * j; const LAS float* s = scr + (8 * c) * 33 + n;
        u32x4 o; o.x = pk2(s[0 * 33], s[1 * 33]); o.y = pk2(s[2 * 33], s[3 * 33]); o.z = pk2(s[4 * 33], s[5 * 33]); o.w = pk2(s[6 * 33], s[7 * 33]);
        *(u32x4*)(WT + (size_t)(32 * dnb + n) * K + k0 + 8 * c) = o; }
    asm volatile("s_waitcnt lgkmcnt(0)" ::: "memory");
}

__device__ __forceinline__ void rms_rows(const float* x, const float* __restrict__ g, bf16* __restrict__ out, int gw, int ngw, int lane) {
    f32x4 gv[4];
#pragma unroll
    for (int j = 0; j < 4; ++j) gv[j] = *(const f32x4*)(g + 4 * lane + 256 * j);
    for (int m = gw; m < M; m += ngw) {
        const f32x4* xr = (const f32x4*)(x + (size_t)m * D) + lane; f32x4 v[4]; float s = 0.f;
#pragma unroll
        for (int j = 0; j < 4; ++j) { v[j] = xr[64 * j]; s += dot4(v[j]); }
        const float rs = rsqrtf(wave_sum(s) * (1.f / D) + EPS);
        u32x2* o8 = (u32x2*)(out + (size_t)m * D) + lane;
#pragma unroll
        for (int j = 0; j < 4; ++j) { const f32x4 y = v[j] * rs * gv[j]; u32x2 wv; wv.x = pk2(y[0], y[1]); wv.y = pk2(y[2], y[3]); o8[64 * j] = wv; }
    }
}

#define XB_TMO      128
#define XB_XCNT(j)  (256  + 64 * (j))
#define XB_XSUB(j)  (1280 + 64 * (j))
#define XB_XGEN(j)  (2304 + 64 * (j))
#define XB_TOP      3328
#define XB_TOPGEN   3392
#define XCD_BAR_WORDS 3456
#define XB_SPIN_CAP (1u << 18)

__device__ __forceinline__ unsigned xb_ld(unsigned* p)              { return __hip_atomic_load(p, __ATOMIC_RELAXED, __HIP_MEMORY_SCOPE_AGENT); }
__device__ __forceinline__ unsigned xb_add(unsigned* p, unsigned v) { return __hip_atomic_fetch_add(p, v, __ATOMIC_RELAXED, __HIP_MEMORY_SCOPE_AGENT); }
__device__ __forceinline__ unsigned xb_xcc_id() { return (unsigned)__builtin_amdgcn_s_getreg((3 << 11) | 20) & 0xFu; }
#define XB_SPIN(cond, bar) do { unsigned _sp = 0; while (cond) { __builtin_amdgcn_s_sleep(1); \
    if ((++_sp & 255u) == 0u) { if (xb_ld(&(bar)[XB_TMO])) break; if (_sp > XB_SPIN_CAP) { atomicAdd(&(bar)[XB_TMO], 1u); break; } } } } while (0)

struct XcdBarrier {
    unsigned* bar; unsigned x;
    volatile LAS unsigned* st;
};

__device__ __forceinline__ XcdBarrier xcd_barrier_post(unsigned* bar, volatile LAS unsigned* st) {
    XcdBarrier b; b.bar = bar; b.x = xb_xcc_id(); b.st = st;
    if (threadIdx.x == 0) (void)xb_add(&bar[XB_XCNT(b.x)], 1u);
    return b;
}
__device__ __forceinline__ void xcd_barrier_complete(unsigned* bar, unsigned x, unsigned& nloc, unsigned& nx) {
    const unsigned G = gridDim.x * gridDim.y * gridDim.z;
    unsigned sum, cnt, mine, sp = 0u;
    for (;;) {
        sum = 0u; cnt = 0u; mine = 0u;
#pragma unroll
        for (unsigned j = 0; j < 16; ++j) { const unsigned c = xb_ld(&bar[XB_XCNT(j)]); sum += c; cnt += (c > 0u) ? 1u : 0u; mine = (j == x) ? c : mine; }
        if (sum == G) break;
        __builtin_amdgcn_s_sleep(1);
        if ((++sp & 255u) == 0u) { if (xb_ld(&bar[XB_TMO])) break; if (sp > XB_SPIN_CAP) { atomicAdd(&bar[XB_TMO], 1u); break; } }
    }
    nloc = mine > 0u ? mine : 1u; nx = cnt > 0u ? cnt : 1u;
}

__device__ __forceinline__ void xcd_barrier(const XcdBarrier& b) {
    asm volatile("s_waitcnt vmcnt(0)" ::: "memory");
    __syncthreads();
    if (threadIdx.x == 0) {
        unsigned* bar = b.bar;
        __builtin_amdgcn_s_waitcnt(0);
        unsigned nloc = b.st[0], nx = b.st[1];
        if (nloc == 0u) { xcd_barrier_complete(bar, b.x, nloc, nx); b.st[0] = nloc; b.st[1] = nx; }
        const unsigned old = xb_add(&bar[XB_XSUB(b.x)], 1u);
        const unsigned gen = old / nloc;
        if (old + 1u == (gen + 1u) * nloc) {
            __builtin_amdgcn_fence(__ATOMIC_RELEASE, "agent");
            asm volatile("s_waitcnt vmcnt(0)" ::: "memory");
            const unsigned og = xb_add(&bar[XB_TOP], 1u);
            const unsigned tg = og / nx;
            if (og + 1u == (tg + 1u) * nx) xb_add(&bar[XB_TOPGEN], 1u);
            else XB_SPIN(xb_ld(&bar[XB_TOPGEN]) == tg, bar);
            __builtin_amdgcn_fence(__ATOMIC_ACQUIRE, "agent");
            xb_add(&bar[XB_XGEN(b.x)], 1u);
            asm volatile("s_waitcnt vmcnt(0)" ::: "memory");
        } else {
            XB_SPIN(xb_ld(&bar[XB_XGEN(b.x)]) == gen, bar);
            __builtin_amdgcn_fence(__ATOMIC_ACQUIRE, "agent");
            asm volatile("s_waitcnt vmcnt(0)" ::: "memory");
        }
    }
    __syncthreads();
}

__global__ void __launch_bounds__(512, 2) mega_fwd(Args a) {
    extern __shared__ __attribute__((aligned(16))) unsigned char lds_raw[];
    LAS unsigned char* lds = (LAS unsigned char*)lds_raw;
    cg::grid_group grid = cg::this_grid();
    const int tid = threadIdx.x, lane = tid & 63, wave = __builtin_amdgcn_readfirstlane(tid >> 6);
    const int G = gridDim.x, bx = blockIdx.x;
    const int vcu = (G % 8 == 0) ? (bx % 8) * (G / 8) + bx / 8 : bx;
    const int gw = vcu * 8 + wave, ngw = G * 8;
    unsigned char* ws = a.ws;
    float* cosT = (float*)(ws + WS_ROPE); float* sinT = cosT + S * 32;
    bf16* Hb = (bf16*)(ws + WS_H); bf16* QKV = (bf16*)(ws + WS_QKV); bf16* Yb = (bf16*)(ws + WS_Y); bf16* ACT = (bf16*)(ws + WS_ACT);
    float* edge = (float*)(ws + WS_EDGE); float* part = (float*)(ws + WS_PART);
    volatile LAS unsigned* misc = (volatile LAS unsigned*)(lds + MISC_OFF);
    if (tid < 16) misc[tid] = 0u;
    __syncthreads();
    const XcdBarrier xbar = xcd_barrier_post((unsigned*)(ws + WS_CTL) + 1024, misc);
    grid.sync();

    for (int rep0 = 0; rep0 < a.rep[0]; ++rep0) {
        LAS float* scr = (LAS float*)(lds + wave * 16384);
        constexpr int I_IN = 16 * 72, I_OUT = 16 * 32, I_UP = 16 * 176, I_DOWN = 44 * 32, I_L = I_IN + I_OUT + I_UP + I_DOWN;
        for (int it = gw; it < DEPTH * I_L; it += ngw) {
            const int l = it / I_L; int r = it % I_L;
            unsigned char* wl = ws + WS_W + (size_t)l * W_LAYER;
            if (r < I_IN) { const int kb = r / 72, nb = r % 72; const int pn = nb >> 3, wc = (nb >> 1) & 3, bj = nb & 1;
                transpose_item(a.w_in + (size_t)l * D * NIN, D, NIN, (bf16*)(wl + W_IN), scr, kb, nb, 8 * pn + 4 * bj + wc, lane); continue; }
            r -= I_IN;
            if (r < I_OUT) { const int kb = r / 32, nb = r % 32; transpose_item(a.w_out + (size_t)l * D * D, D, D, (bf16*)(wl + W_OUT), scr, kb, nb, nb, lane); continue; }
            r -= I_OUT;
            if (r < I_UP) { const int kb = r / 176, nb = r % 176; const int isv = nb >= 88, nn = isv ? nb - 88 : nb; const int dnb = 8 * (nn >> 2) + 4 * isv + (nn & 3);
                transpose_item(a.w_up + (size_t)l * D * NUP, D, NUP, (bf16*)(wl + W_UP), scr, kb, nb, dnb, lane); continue; }
            r -= I_UP;
            { const int kb = r / 32, nb = r % 32; transpose_item(a.w_down + (size_t)l * FF * D, FF, D, (bf16*)(wl + W_DOWN), scr, kb, nb, nb, lane); }
        }
        for (int i = vcu * 512 + tid; i < S * 32; i += G * 512) {
            const int pos = i >> 5, j = i & 31;
            double inv = 1.0; for (int k = 0; k < j; ++k) inv *= 0.74989420933245582730;
            const double ang = (double)pos * inv;
            const double kq = __builtin_rint(ang * 0.15915494309189533577);
            const double rr = (ang - kq * 6.283185307179586232) - kq * 2.4492935982947064e-16;
            const double r2 = rr * rr;
            double sn = 1.0, cs = 1.0;
#pragma unroll
            for (int k = 12; k >= 1; --k) { sn = 1.0 - sn * r2 / (double)((2 * k) * (2 * k + 1)); cs = 1.0 - cs * r2 / (double)((2 * k - 1) * (2 * k)); }
            cosT[i] = (float)cs; sinT[i] = (float)(sn * rr);
        }
        rms_rows(a.x, a.g_attn, Hb, gw, ngw, lane);
    }
    xcd_barrier(xbar);

    const float* xin = a.x;
    for (int l = 0; l < DEPTH; ++l) {
        const float lambda_init = 0.8f - 0.6f * __expf(-0.3f * (float)l);
        unsigned char* wl = ws + WS_W + (size_t)l * W_LAYER;
#ifndef SKIP_P1
        {
            pg8::Gemm g{Hb, (const bf16*)(wl + W_IN), M, NIN, D}; pg8::StaticOrder So; So.init(M, NIN, G, bx);
            EpiInProj E{QKV, a.qn_a + l * 64, a.kn_a + l * 64, a.qn_b + l * 64, a.kn_b + l * 64, cosT, sinT};
            for (int rep1 = 0; rep1 < a.rep[1]; ++rep1) pg8::gemm_phase<EpiInProj, pg8::StaticOrder, true, true>(lds, g, So, E);
        }
#endif
        xcd_barrier(xbar);
#ifndef SKIP_P2
        {
            const float mqa = wave_max(fabsf(a.qn_a[l * 64 + lane])), mka = wave_max(fabsf(a.kn_a[l * 64 + lane]));
            const float mqb = wave_max(fabsf(a.qn_b[l * 64 + lane])), mkb = wave_max(fabsf(a.kn_b[l * 64 + lane]));
            const float MbA = 8.f * mqa * mka * LOG2E * 1.02f, MbB = 8.f * mqb * mkb * LOG2E * 1.02f;
            const float s1 = wave_sum(a.lq1[l * 64 + lane] * a.lk1[l * 64 + lane]), s2 = wave_sum(a.lq2[l * 64 + lane] * a.lk2[l * 64 + lane]);
            const float lam = __expf(s1) - __expf(s2) + lambda_init;
            for (int rep = 0; rep < a.rep[5]; ++rep) {
            for (int uidx = vcu; uidx < NB * 4 * 16; uidx += G) {
                const int bh = uidx >> 4, qb = uidx & 15;
                att::diff_unit((LAS char*)lds, QKV, Yb, bh >> 2, bh & 3, qb, MbB, lam, a.subln + l * 128, 1.f - lambda_init);
            }
            for (int uidx = vcu; uidx < NB * 2 * 16; uidx += G) {
                const int bk = uidx >> 4, n = uidx & 15;
                att::swa_unit((LAS char*)lds, QKV, Yb, bk >> 1, bk & 1, n, MbA, a.sink + l * 8);
            }
            __syncthreads();
            }
        }
#endif
        xcd_barrier(xbar);
#ifndef SKIP_P3
        {
            pg8::Gemm g{Yb, (const bf16*)(wl + W_OUT), M, D, D}; pg8::StaticOrder So; So.init(M, D, G, bx);
            EpiResid E{xin, a.out};
            for (int rep6 = 0; rep6 < (l == 0 ? a.rep[6] : 1); ++rep6) pg8::gemm_phase<EpiResid, pg8::StaticOrder, true, true>(lds, g, So, E);
        }
#endif
        xcd_barrier(xbar);
        for (int rep3 = 0; rep3 < a.rep[2]; ++rep3) rms_rows(a.out, a.g_ffn + l * D, Hb, gw, ngw, lane);
        xcd_barrier(xbar);
#ifndef SKIP_P4
        {
            pg8::Gemm g{Hb, (const bf16*)(wl + W_UP), M, NUP, D}; pg8::StaticOrder So; So.init(M, NUP, G, bx);
            EpiUpConv E{ACT, a.conv_w + (size_t)l * 3 * FF, a.conv_b + (size_t)l * FF, edge, part, (LAS float*)(lds + XL_OFF)};
            for (int rep4 = 0; rep4 < a.rep[3]; ++rep4) pg8::gemm_phase<EpiUpConv, pg8::StaticOrder, true, true>(lds, g, So, E);
        }
#endif
        xcd_barrier(xbar);
        {
            const float* cw = a.conv_w + (size_t)l * 3 * FF;
            for (int i = vcu * 512 + tid; i < 64 * 2 * FF; i += G * 512) {
                const int pm = i / (2 * FF), rem = i % (2 * FF), which = rem / FF, ch = rem % FF;
                if (which == 0 && (pm & 7) != 0) {
                    const float* pp = part + (((size_t)pm * 2 + 0) * FF + ch) * 2;
                    const float pre = pp[0] + cw[ch] * edge[((size_t)(pm - 1) * 2 + 1) * FF + ch];
                    ACT[(size_t)(pm * 256) * FF + ch] = (bf16)f2bf(silu_f(pre) * pp[1]);
                }
                if (which == 1 && (pm & 7) != 7) {
                    const float* pp = part + (((size_t)pm * 2 + 1) * FF + ch) * 2;
                    const float pre = pp[0] + cw[2 * FF + ch] * edge[((size_t)(pm + 1) * 2 + 0) * FF + ch];
                    ACT[(size_t)(pm * 256 + 255) * FF + ch] = (bf16)f2bf(silu_f(pre) * pp[1]);
                }
            }
        }
        xcd_barrier(xbar);
#ifndef SKIP_P5
        {
            pg8::Gemm g{ACT, (const bf16*)(wl + W_DOWN), M, D, FF}; pg8::StaticOrder So; So.init(M, D, G, bx);
            for (int rep7 = a.rep[7] - 1; rep7 >= 0; --rep7) { EpiResid E{a.out, rep7 ? (float*)(ws + 192 * MiB) : a.out};
            pg8::gemm_phase<EpiResid, pg8::StaticOrder, true, true>(lds, g, So, E); }
        }
#endif
        if (l + 1 < DEPTH) {
            xcd_barrier(xbar);
            rms_rows(a.out, a.g_attn + (l + 1) * D, Hb, gw, ngw, lane);
            xcd_barrier(xbar);
        }
        xin = a.out;
    }
}

extern "C" void kernel_launch(void* const* d_in, const int* in_sizes, int n_in, void* d_out, int out_size, void* d_ws, size_t ws_size, hipStream_t stream) {
    static int grid = 0;
    if (grid == 0) {
        if (n_in != 19 || ws_size < WS_END) { fprintf(stderr, "kernel_launch: unexpected inputs (n_in %d, ws %zu)\n", n_in, ws_size); grid = -1; return; }
        int dev = 0, cus = 0, per_cu = 0;
        hipGetDevice(&dev);
        hipDeviceGetAttribute(&cus, hipDeviceAttributeMultiprocessorCount, dev);
        hipFuncSetAttribute((const void*)mega_fwd, hipFuncAttributeMaxDynamicSharedMemorySize, LDS_BYTES);
        hipOccupancyMaxActiveBlocksPerMultiprocessor(&per_cu, (const void*)mega_fwd, 512, LDS_BYTES);
        if (per_cu < 1) { fprintf(stderr, "kernel_launch: occupancy query reports %d blocks per CU\n", per_cu); per_cu = 1; }
        grid = cus;
        (void)hipGetLastError();
    }
    if (grid < 0) return;
    if (hipMemsetAsync((char*)d_ws + WS_CTL, 0, CTL_BYTES, stream) != hipSuccess) { fprintf(stderr, "kernel_launch: memset failed\n"); return; }
    Args a{};
    const float** p = (const float**)&a;
    for (int i = 0; i < 19; ++i) p[i] = (const float*)d_in[i];
    a.out = (float*)d_out; a.ws = (unsigned char*)d_ws;
    { const int reps[8] = {REP_P0, REP_P1, REP_P3B, REP_P4, 1, ATT_REP, REP_P3, REP_P5}; for (int i = 0; i < 8; ++i) a.rep[i] = reps[i]; }
    void* args[] = {&a};
    hipError_t e = hipLaunchCooperativeKernel((const void*)mega_fwd, dim3(grid), dim3(512), args, LDS_BYTES, stream);
    if (e != hipSuccess) fprintf(stderr, "cooperative launch failed: %s (grid %d)\n", hipGetErrorString(e), grid);
}
```

```cpp
#include <hip/hip_runtime.h>
#include <hip/hip_cooperative_groups.h>
#include <cstdio>
#include <cstdint>
namespace cg = cooperative_groups;
namespace pg8 {
#define PG8_LAS __attribute__((address_space(3)))
typedef unsigned short bf16_t;
typedef short bf16x8 __attribute__((ext_vector_type(8)));
typedef float f32x4 __attribute__((ext_vector_type(4)));
typedef unsigned u32x4 __attribute__((ext_vector_type(4)));
constexpr int BM = 256, BK = 64, HALF = 128, HTB = HALF * BK * 2  , STAGE_BYTES = 8 * HTB, NXCD = 8, WGM = 8;

__host__ __device__ __forceinline__ int lds_byte(int r, int c) { const int st = (r >> 4) * 2 + (c >> 5), rr = r & 15, cc = c & 31, ob = rr * 64 + cc * 2; return st * 1024 + (ob ^ (((ob >> 9) & 1) << 5)); }
__host__ __device__ __forceinline__ void stage_rc(int b, int& R, int& C) { const int st = b / 1024, sb = b % 1024, swz = sb ^ (((sb >> 9) & 1) << 5); R = (st >> 1) * 16 + swz / 64; C = (st & 1) * 32 + (swz % 64) / 2; }
__host__ __device__ __forceinline__ int perm32(int rho) { const int n = rho >> 4, i = rho & 15; return 8 * (i >> 2) + 4 * n + (i & 3); }

struct Unit { int pm, pn; };
struct Gemm { const bf16_t* A; const bf16_t* Bt; int M, N, K; };

struct StaticOrder {
    int nM, nN, nwg, G, c;
    __host__ __device__ void init(int M, int N, int G_, int c_) { nM = M / BM; nN = N / BM; nwg = nM * nN; G = G_; c = c_; }
    __host__ __device__ bool next(int i, Unit& u) const {
        const long L = (long)i * G + c; if (L >= nwg) return false;
        int wgid = (int)L; { const int q = nwg / NXCD, r = nwg % NXCD, xcd = wgid % NXCD, off = wgid / NXCD; wgid = (xcd < r ? xcd * (q + 1) : r * (q + 1) + (xcd - r) * q) + off; }
        const int nig = WGM * nN, gid = wgid / nig, fm = gid * WGM, gsz = (nM - fm) < WGM ? (nM - fm) : WGM;
        u.pm = fm + ((wgid % nig) % gsz); u.pn = (wgid % nig) / gsz; return true;
    }
    __device__ __forceinline__ void a_ready(const Unit&) const {}
    __device__ __forceinline__ void done(const Unit&) const {}
};

__device__ __forceinline__ unsigned cvt_pk_bf16(float lo, float hi) { unsigned r; asm volatile("v_cvt_pk_bf16_f32 %0, %1, %2" : "=v"(r) : "v"(lo), "v"(hi)); return r; }
template <class Epi, class Sched, bool ALIGN_EPI = false, bool SP2 = false>
__device__ __forceinline__ void gemm_phase(PG8_LAS unsigned char* lds, const Gemm g, const Sched& S, const Epi& E) {
    int tid = threadIdx.x; asm volatile("" : "+v"(tid)); const int wid = __builtin_amdgcn_readfirstlane(tid >> 6), lane = tid & 63, wr = wid >> 2, wc = wid & 3, fr = lane & 15, fq = lane >> 4;
    const int K = g.K, nt = K / BK;
    unsigned voffA[2], voffB[2];
#pragma unroll
    for (int i = 0; i < 2; ++i) { int R, C; stage_rc(tid * 16 + i * 8192, R, C); const int Rb = Epi::PERM ? ((R & ~31) + perm32(R & 31)) : R;
        voffA[i] = (unsigned)(R * K + C) * 2u; voffB[i] = (unsigned)(Rb * K + C) * 2u; }
    const size_t kstep = (size_t)(BK * 2);
    const size_t hstep = (size_t)HALF * K * 2;
    const size_t tstep = 2 * hstep;
    const unsigned ldsw = (unsigned)wid * 1024u;
    const int aoff = lds_byte(wr * 64 + fr, fq * 8), boff = lds_byte(wc * 32 + fr, fq * 8);
#define PG8_SA(b, h) (((b) * 2 + (h)) * HTB)
#define PG8_SB(b, h) ((4 + (b) * 2 + (h)) * HTB)
#define PG8_STAGE(bufoff, gbase, voff) do { _Pragma("unroll") for (int _i = 0; _i < 2; ++_i) \
        __builtin_amdgcn_global_load_lds((const unsigned*)((const char*)(gbase) + (voff)[_i]), (PG8_LAS unsigned*)(lds + (bufoff) + ldsw + _i * 8192), 16, 0, 0); } while (0)
#define PG8_LDA(dst, b, h) do { _Pragma("unroll") for (int m = 0; m < 4; ++m) _Pragma("unroll") for (int k = 0; k < 2; ++k) dst[m][k] = *(const PG8_LAS bf16x8*)(lds + PG8_SA(b, h) + aoff + m * 2048 + k * 1024); } while (0)
#define PG8_LDB(dst, b, h) do { _Pragma("unroll") for (int n = 0; n < 2; ++n) _Pragma("unroll") for (int k = 0; k < 2; ++k) dst[n][k] = *(const PG8_LAS bf16x8*)(lds + PG8_SB(b, h) + boff + n * 2048 + k * 1024); } while (0)
#define PG8_MMA(ai, bj, At, Bt) do { __builtin_amdgcn_s_setprio(1); _Pragma("unroll") for (int m = 0; m < 4; ++m) _Pragma("unroll") for (int n = 0; n < 2; ++n) _Pragma("unroll") for (int k = 0; k < 2; ++k) \
        acc[ai][bj][m][n] = __builtin_amdgcn_mfma_f32_16x16x32_bf16(Bt[n][k], At[m][k], acc[ai][bj][m][n], 0, 0, 0); __builtin_amdgcn_s_setprio(0); } while (0)
#define PG8_WAIT_V(n) asm volatile("s_waitcnt vmcnt(" #n ")" ::: "memory")
#define PG8_WAIT_L(n) asm volatile("s_waitcnt lgkmcnt(" #n ")" ::: "memory")
#define PG8_BAR __builtin_amdgcn_s_barrier()
#define PG8_SCHED __builtin_amdgcn_sched_barrier(0)
    Unit cur, nxt; int ui = 0;
    if (!S.next(0, cur)) return;
    f32x4 acc[2][2][4][2];
#pragma unroll
    for (int a = 0; a < 2; ++a)
#pragma unroll
        for (int b = 0; b < 2; ++b)
#pragma unroll
            for (int m = 0; m < 4; ++m)
#pragma unroll
                for (int n = 0; n < 2; ++n) acc[a][b][m][n] = (f32x4){0.f, 0.f, 0.f, 0.f};
    bf16x8 At[4][2], B0[2][2], B1[2][2];
    const char* cA = (const char*)g.A + (size_t)cur.pm * tstep; const char* cB = (const char*)g.Bt + (size_t)cur.pn * tstep;
    S.a_ready(cur);
    if constexpr (SP2) {
        PG8_STAGE(PG8_SB(0, 0), cB, voffB); PG8_STAGE(PG8_SB(0, 1), cB + hstep, voffB); PG8_STAGE(PG8_SA(0, 0), cA, voffA); PG8_STAGE(PG8_SA(0, 1), cA + hstep, voffA);
        if (wr == 1) PG8_BAR;
        PG8_WAIT_V(2); PG8_BAR;
        PG8_STAGE(PG8_SB(1, 0), cB + kstep, voffB); PG8_STAGE(PG8_SA(1, 0), cA + kstep, voffA); PG8_STAGE(PG8_SB(1, 1), cB + hstep + kstep, voffB);
        PG8_WAIT_V(6); PG8_BAR;
    } else {
        PG8_STAGE(PG8_SB(0, 0), cB, voffB); PG8_STAGE(PG8_SA(0, 0), cA, voffA); PG8_STAGE(PG8_SB(0, 1), cB + hstep, voffB); PG8_STAGE(PG8_SA(0, 1), cA + hstep, voffA);
        if (wr == 1) PG8_BAR;
        PG8_WAIT_V(4); PG8_BAR;
        PG8_STAGE(PG8_SB(1, 0), cB + kstep, voffB); PG8_STAGE(PG8_SA(1, 0), cA + kstep, voffA); PG8_STAGE(PG8_SB(1, 1), cB + hstep + kstep, voffB);
        PG8_WAIT_V(6); PG8_BAR;
    }
    for (;;) {
        const bool has_next = S.next(ui + 1, nxt);
        const char* nA = has_next ? (const char*)g.A + (size_t)nxt.pm * tstep : cA; const char* nB = has_next ? (const char*)g.Bt + (size_t)nxt.pn * tstep : cB;
        for (int t = 0; t < nt; t += 2) {
            const bool last = (t == nt - 2);
            const char* a1 = cA + (size_t)(t + 1) * kstep;
            const char* a2 = last ? nA : cA + (size_t)(t + 2) * kstep; const char* b2 = last ? nB : cB + (size_t)(t + 2) * kstep;
            const char* a3 = a2 + kstep; const char* b3 = b2 + kstep;
            if (last && has_next) S.a_ready(nxt);
            if constexpr (SP2) {
            PG8_LDB(B0, 0, 0); PG8_LDB(B1, 0, 1); PG8_SCHED; PG8_LDA(At, 0, 0); PG8_STAGE(PG8_SA(1, 1), a1 + hstep, voffA);
            PG8_WAIT_V(8); PG8_WAIT_L(0); PG8_BAR; PG8_MMA(0, 0, At, B0); PG8_MMA(0, 1, At, B1); PG8_BAR; PG8_SCHED;
            PG8_LDA(At, 0, 1); PG8_STAGE(PG8_SB(0, 0), b2, voffB); PG8_STAGE(PG8_SB(0, 1), b2 + hstep, voffB); PG8_STAGE(PG8_SA(0, 0), a2, voffA);
            PG8_WAIT_V(8); PG8_WAIT_L(0); PG8_BAR; PG8_MMA(1, 0, At, B0); PG8_MMA(1, 1, At, B1); PG8_BAR; PG8_SCHED;
            PG8_LDB(B0, 1, 0); PG8_LDB(B1, 1, 1); PG8_SCHED; PG8_LDA(At, 1, 0); PG8_STAGE(PG8_SA(0, 1), a2 + hstep, voffA);
            PG8_WAIT_V(8); PG8_WAIT_L(0); PG8_BAR; PG8_MMA(0, 0, At, B0); PG8_MMA(0, 1, At, B1); PG8_BAR; PG8_SCHED;
            PG8_LDA(At, 1, 1); PG8_STAGE(PG8_SB(1, 0), b3, voffB); PG8_STAGE(PG8_SB(1, 1), b3 + hstep, voffB); PG8_STAGE(PG8_SA(1, 0), a3, voffA);
            PG8_WAIT_V(8); PG8_WAIT_L(0); PG8_BAR; PG8_MMA(1, 0, At, B0); PG8_MMA(1, 1, At, B1); PG8_BAR; PG8_SCHED;
            } else {
            PG8_LDB(B0, 0, 0); PG8_SCHED; PG8_LDA(At, 0, 0); PG8_STAGE(PG8_SA(1, 1), a1 + hstep, voffA);
            PG8_WAIT_L(8); PG8_BAR; PG8_WAIT_L(0); PG8_MMA(0, 0, At, B0); PG8_BAR; PG8_SCHED;
            PG8_LDB(B1, 0, 1); PG8_STAGE(PG8_SB(0, 0), b2, voffB);
            PG8_BAR; PG8_WAIT_L(0); PG8_MMA(0, 1, At, B1); PG8_BAR;
            PG8_LDA(At, 0, 1); PG8_STAGE(PG8_SA(0, 0), a2, voffA);
            PG8_BAR; PG8_WAIT_L(0); PG8_MMA(1, 0, At, B0); PG8_BAR; PG8_SCHED;
            PG8_STAGE(PG8_SB(0, 1), b2 + hstep, voffB);
            PG8_WAIT_V(6); PG8_BAR; PG8_MMA(1, 1, At, B1); PG8_BAR;
            PG8_LDB(B0, 1, 0); PG8_SCHED; PG8_LDA(At, 1, 0); PG8_STAGE(PG8_SA(0, 1), a2 + hstep, voffA);
            PG8_WAIT_L(8); PG8_BAR; PG8_WAIT_L(0); PG8_MMA(0, 0, At, B0); PG8_BAR; PG8_SCHED;
            PG8_LDB(B1, 1, 1); PG8_STAGE(PG8_SB(1, 0), b3, voffB);
            PG8_BAR; PG8_WAIT_L(0); PG8_MMA(0, 1, At, B1); PG8_BAR;
            PG8_LDA(At, 1, 1); PG8_STAGE(PG8_SA(1, 0), a3, voffA);
            PG8_BAR; PG8_WAIT_L(0); PG8_MMA(1, 0, At, B0); PG8_BAR; PG8_SCHED;
            PG8_STAGE(PG8_SB(1, 1), b3 + hstep, voffB);
            PG8_WAIT_V(6); PG8_BAR; PG8_MMA(1, 1, At, B1); PG8_BAR;
            }
        }
        if constexpr (ALIGN_EPI) { if (wr == 0) PG8_BAR; }
        if constexpr (!Epi::AFTER_DRAIN) { E(acc, cur, wr, wc, fr, fq); S.done(cur); }
        if (!has_next) break;
#pragma unroll
        for (int a = 0; a < 2; ++a)
#pragma unroll
            for (int b = 0; b < 2; ++b)
#pragma unroll
                for (int m = 0; m < 4; ++m)
#pragma unroll
                    for (int n = 0; n < 2; ++n) acc[a][b][m][n] = (f32x4){0.f, 0.f, 0.f, 0.f};
        cur = nxt; cA = nA; cB = nB; ++ui;
        if constexpr (ALIGN_EPI) { if (wr == 1) PG8_BAR; }
    }
    PG8_WAIT_V(0);
    if constexpr (!ALIGN_EPI) { if (wr == 0) PG8_BAR; }
    PG8_BAR;
    if constexpr (Epi::AFTER_DRAIN) { E.fused(acc, cur, wr, wc, fr, fq, lds, wid, lane); S.done(cur); }
#undef PG8_SA
#undef PG8_SB
#undef PG8_STAGE
#undef PG8_LDA
#undef PG8_LDB
#undef PG8_MMA
#undef PG8_WAIT_V
#undef PG8_WAIT_L
#undef PG8_BAR
#undef PG8_SCHED
}
}
#define LAS __attribute__((address_space(3)))
typedef unsigned short bf16;
using pg8::f32x4; using pg8::u32x4; using pg8::Unit; using pg8::cvt_pk_bf16; using pg8::bf16x8;
typedef unsigned u32x2 __attribute__((ext_vector_type(2)));

constexpr int NB = 8, S = 2048, D = 1024, M = NB * S, NIN = 2304, FF = 2816, NUP = 2 * FF, DEPTH = 2;
constexpr float EPS = 1e-6f;
constexpr float LOG2E = 1.4426950408889634f;
constexpr float QSCALE = 0.125f * LOG2E;
constexpr int XL_OFF = 131072;
constexpr int LDS_BYTES = 131072 + 8192;

__device__ __forceinline__ float dot4(f32x4 a) { return (a[0] * a[0] + a[1] * a[1]) + (a[2] * a[2] + a[3] * a[3]); }
__device__ __forceinline__ float silu_f(float v) { return v * __builtin_amdgcn_rcpf(1.f + __expf(-v)); }

struct EpiInProj {
    static constexpr bool PERM = true, AFTER_DRAIN = false;
    bf16* O; const float* qn_a; const float* kn_a; const float* qn_b; const float* kn_b; const float* cosT; const float* sinT; const float* rowsq;
    __device__ __forceinline__ void operator()(const f32x4 (&acc)[2][2][4][2], const Unit& u, int wr, int wc, int fr, int fq) const {
        asm volatile("" : "+v"(fr), "+v"(fq));
        const int pn = u.pn;
        const float* g = nullptr; float sc = 1.f;
        if (pn < 2) { g = qn_a; sc = QSCALE; }
        else if (pn == 2) { if (wc < 2) g = kn_a; }
        else if (pn < 5) { g = qn_b; sc = QSCALE; }
        else if (pn < 7) { g = kn_b; }
        const int colb = pn * 256 + wc * 64 + 8 * fq;
        const int row0 = u.pm * 256 + wr * 64 + fr;
        if (g) {
            f32x4 g1[2], g2[2];
#pragma unroll
            for (int n = 0; n < 2; ++n) { g1[n] = *(const f32x4*)(g + 8 * fq + 4 * n); g2[n] = *(const f32x4*)(g + 32 + 8 * fq + 4 * n); }
#pragma unroll
            for (int ai = 0; ai < 2; ++ai)
#pragma unroll
                for (int m = 0; m < 4; ++m) {
                    const int row = row0 + ai * 128 + m * 16;
                    const f32x4 a0 = acc[ai][0][m][0], a1 = acc[ai][0][m][1], b0 = acc[ai][1][m][0], b1 = acc[ai][1][m][1];
                    float ss = (dot4(a0) + dot4(a1)) + (dot4(b0) + dot4(b1));
                    ss += __shfl_xor(ss, 16); ss += __shfl_xor(ss, 32);
                    const float rx = rsqrtf(rowsq[row] * (1.f / D) + EPS);
                    const float rs = rsqrtf(ss * rx * rx * (1.f / 64.f) + EPS) * rx * sc;
                    const size_t ro = (size_t)(row & (S - 1)) * 32 + 8 * fq;
                    const f32x4 c0 = *(const f32x4*)(cosT + ro), c1 = *(const f32x4*)(cosT + ro + 4), s0 = *(const f32x4*)(sinT + ro), s1 = *(const f32x4*)(sinT + ro + 4);
                    const f32x4 y10 = a0 * rs * g1[0], y11 = a1 * rs * g1[1], y20 = b0 * rs * g2[0], y21 = b1 * rs * g2[1];
                    const f32x4 o10 = y10 * c0 - y20 * s0, o11 = y11 * c1 - y21 * s1, o20 = y20 * c0 + y10 * s0, o21 = y21 * c1 + y11 * s1;
                    u32x4 w1, w2;
                    w1.x = cvt_pk_bf16(o10[0], o10[1]); w1.y = cvt_pk_bf16(o10[2], o10[3]); w1.z = cvt_pk_bf16(o11[0], o11[1]); w1.w = cvt_pk_bf16(o11[2], o11[3]);
                    w2.x = cvt_pk_bf16(o20[0], o20[1]); w2.y = cvt_pk_bf16(o20[2], o20[3]); w2.z = cvt_pk_bf16(o21[0], o21[1]); w2.w = cvt_pk_bf16(o21[2], o21[3]);
                    bf16* op = O + (size_t)row * NIN + colb;
                    *(u32x4*)op = w1; *(u32x4*)(op + 32) = w2;
                }
        } else {
#pragma unroll
            for (int ai = 0; ai < 2; ++ai)
#pragma unroll
                for (int m = 0; m < 4; ++m) {
                    const int row = row0 + ai * 128 + m * 16;
                    bf16* op = O + (size_t)row * NIN + colb;
                    const float rx = rsqrtf(rowsq[row] * (1.f / D) + EPS);
#pragma unroll
                    for (int bj = 0; bj < 2; ++bj) { const f32x4 v0 = acc[ai][bj][m][0] * rx, v1 = acc[ai][bj][m][1] * rx; u32x4 w;
                        w.x = cvt_pk_bf16(v0[0], v0[1]); w.y = cvt_pk_bf16(v0[2], v0[3]); w.z = cvt_pk_bf16(v1[0], v1[1]); w.w = cvt_pk_bf16(v1[2], v1[3]);
                        *(u32x4*)(op + 32 * bj) = w; }
                }
        }
    }
};

__device__ __forceinline__ f32x4 bf2f_lo(unsigned a, unsigned b) { return (f32x4){__uint_as_float(a << 16), __uint_as_float(a & 0xffff0000u), __uint_as_float(b << 16), __uint_as_float(b & 0xffff0000u)}; }
struct EpiResid {
    static constexpr bool PERM = true, AFTER_DRAIN = false;
    bf16* XB; float* rowsq; float* outf;
    __device__ __forceinline__ void operator()(const f32x4 (&acc)[2][2][4][2], const Unit& u, int wr, int wc, int fr, int fq) const {
        asm volatile("" : "+v"(fr), "+v"(fq));
        const int col0 = u.pn * 256 + wc * 32 + 8 * fq, row0 = u.pm * 256 + wr * 64 + fr;
#pragma unroll
        for (int ai = 0; ai < 2; ++ai) {
            u32x4 xr[4][2];
#pragma unroll
            for (int m = 0; m < 4; ++m) { const size_t off = (size_t)(row0 + ai * 128 + m * 16) * D + col0;
#pragma unroll
                for (int bj = 0; bj < 2; ++bj) xr[m][bj] = *(const u32x4*)(XB + off + bj * 128); }
            asm volatile("" ::: "memory");
#pragma unroll
            for (int m = 0; m < 4; ++m) { const int row = row0 + ai * 128 + m * 16; const size_t off = (size_t)row * D + col0; float ss = 0.f;
#pragma unroll
                for (int bj = 0; bj < 2; ++bj) {
                    const f32x4 y0 = bf2f_lo(xr[m][bj].x, xr[m][bj].y) + acc[ai][bj][m][0], y1 = bf2f_lo(xr[m][bj].z, xr[m][bj].w) + acc[ai][bj][m][1];
                    ss += dot4(y0) + dot4(y1);
                    if (outf) { *(f32x4*)(outf + off + bj * 128) = y0; *(f32x4*)(outf + off + bj * 128 + 4) = y1; }
                    else { u32x4 w; w.x = cvt_pk_bf16(y0[0], y0[1]); w.y = cvt_pk_bf16(y0[2], y0[3]); w.z = cvt_pk_bf16(y1[0], y1[1]); w.w = cvt_pk_bf16(y1[2], y1[3]); *(u32x4*)(XB + off + bj * 128) = w; }
                }
                if (rowsq) { ss += __shfl_xor(ss, 16); ss += __shfl_xor(ss, 32); if (fq == 0) atomicAdd(rowsq + row, ss); }
            }
            asm volatile("" ::: "memory");
        }
    }
};

struct EpiUpConv {
    static constexpr bool PERM = true, AFTER_DRAIN = false;
    bf16* ACT; const float* cw; const float* cb; float* edge; float* part; LAS float* xl; const float* rowsq;
    __device__ __forceinline__ void operator()(f32x4 (&acc)[2][2][4][2], const Unit& u, int wr, int wc, int fr, int fq) const {
        asm volatile("" : "+v"(fr), "+v"(fq));
        const int lane = 16 * fq + fr;
        const int cl0 = 32 * wc + 8 * fq, ch0 = 128 * u.pn + cl0;
#pragma unroll
        for (int ai = 0; ai < 2; ++ai)
#pragma unroll
            for (int m = 0; m < 4; ++m) { const float rx = rsqrtf(rowsq[u.pm * 256 + ai * 128 + wr * 64 + m * 16 + fr] * (1.f / D) + EPS);
#pragma unroll
                for (int bj = 0; bj < 2; ++bj) { acc[ai][bj][m][0] *= rx; acc[ai][bj][m][1] *= rx; } }
#pragma unroll
        for (int ai = 0; ai < 2; ++ai) {
            const int chunk = 2 * ai + wr;
            if (fr == 0) { *(LAS f32x4*)(xl + (chunk * 2 + 0) * 128 + cl0) = acc[ai][0][0][0]; *(LAS f32x4*)(xl + (chunk * 2 + 0) * 128 + cl0 + 4) = acc[ai][0][0][1]; }
            if (fr == 15) { *(LAS f32x4*)(xl + (chunk * 2 + 1) * 128 + cl0) = acc[ai][0][3][0]; *(LAS f32x4*)(xl + (chunk * 2 + 1) * 128 + cl0 + 4) = acc[ai][0][3][1]; }
        }
        asm volatile("s_waitcnt lgkmcnt(0)" ::: "memory"); __builtin_amdgcn_s_barrier(); asm volatile("" ::: "memory");
        const int lup = (lane & ~15) | ((fr + 15) & 15), ldn = (lane & ~15) | ((fr + 1) & 15);
        const bool seq_first = (u.pm & 7) == 0, seq_last = (u.pm & 7) == 7;
#pragma unroll
        for (int ai = 0; ai < 2; ++ai) {
            const int chunk = 2 * ai + wr;
#pragma unroll
            for (int n = 0; n < 2; ++n) {
                const int ch = ch0 + 4 * n;
                const f32x4 w0 = *(const f32x4*)(cw + ch), w1 = *(const f32x4*)(cw + FF + ch), w2 = *(const f32x4*)(cw + 2 * FF + ch), bb = *(const f32x4*)(cb + ch);
                const f32x4 above = (chunk > 0) ? *(const LAS f32x4*)(xl + ((chunk - 1) * 2 + 1) * 128 + cl0 + 4 * n) : (f32x4){0.f, 0.f, 0.f, 0.f};
                const f32x4 below = (chunk < 3) ? *(const LAS f32x4*)(xl + ((chunk + 1) * 2 + 0) * 128 + cl0 + 4 * n) : (f32x4){0.f, 0.f, 0.f, 0.f};
                f32x4 Rprev = above, Lcur;
#pragma unroll
                for (int e = 0; e < 4; ++e) Lcur[e] = __shfl(acc[ai][0][0][n][e], ldn);
#pragma unroll
                for (int m = 0; m < 4; ++m) {
                    const int rt = ai * 128 + wr * 64 + m * 16 + fr;
                    const size_t row = (size_t)u.pm * 256 + rt;
                    const f32x4 cur = acc[ai][0][m][n], val = acc[ai][1][m][n];
                    f32x4 Rm, Lnext = below;
#pragma unroll
                    for (int e = 0; e < 4; ++e) { Rm[e] = __shfl(cur[e], lup); if (m < 3) Lnext[e] = __shfl(acc[ai][0][m < 3 ? m + 1 : 3][n][e], ldn); }
                    const f32x4 up = (fr == 0) ? Rprev : Rm, dn = (fr == 15) ? Lnext : Lcur;
                    Rprev = Rm; Lcur = Lnext;
                    const f32x4 pre = bb + w0 * up + w1 * cur + w2 * dn;
                    f32x4 res;
#pragma unroll
                    for (int e = 0; e < 4; ++e) res[e] = silu_f(pre[e]) * val[e];
                    if (rt == 0) {
                        *(f32x4*)(edge + ((size_t)u.pm * 2 + 0) * FF + ch) = cur;
                        if (!seq_first) { float* pp = part + (((size_t)u.pm * 2 + 0) * FF + ch) * 2;
                            *(f32x4*)pp = (f32x4){pre[0], val[0], pre[1], val[1]}; *(f32x4*)(pp + 4) = (f32x4){pre[2], val[2], pre[3], val[3]}; }
                    }
                    if (rt == 255) {
                        *(f32x4*)(edge + ((size_t)u.pm * 2 + 1) * FF + ch) = cur;
                        if (!seq_last) { float* pp = part + (((size_t)u.pm * 2 + 1) * FF + ch) * 2;
                            *(f32x4*)pp = (f32x4){pre[0], val[0], pre[1], val[1]}; *(f32x4*)(pp + 4) = (f32x4){pre[2], val[2], pre[3], val[3]}; }
                    }
                    u32x2 w; w.x = cvt_pk_bf16(res[0], res[1]); w.y = cvt_pk_bf16(res[2], res[3]);
                    *(u32x2*)(ACT + row * FF + ch) = w;
                }
            }
        }
    }
};
namespace att {
typedef __attribute__((ext_vector_type(16))) float f32x16;
typedef __attribute__((ext_vector_type(4))) short s16x4;
typedef short v4i16_t __attribute__((ext_vector_type(4)));
typedef LAS const char* lptr;
__device__ __forceinline__ s16x4 vtr(lptr p) { return __builtin_bit_cast(s16x4, __builtin_amdgcn_ds_read_tr16_b64_v4i16((LAS v4i16_t*)p)); }
__device__ __forceinline__ bf16x8 pack8(const f32x16& s, int b) {
    u32x4 w; w.x = cvt_pk_bf16(s[b], s[b + 1]); w.y = cvt_pk_bf16(s[b + 2], s[b + 3]); w.z = cvt_pk_bf16(s[b + 4], s[b + 5]); w.w = cvt_pk_bf16(s[b + 6], s[b + 7]);
    return __builtin_bit_cast(bf16x8, w);
}
#define MFMA32(a, b, c) __builtin_amdgcn_mfma_f32_32x32x16_bf16((a), (b), (c), 0, 0, 0)

#define LGKM_WAIT(n) asm volatile("s_waitcnt lgkmcnt(" #n ")" ::: "memory")
#define SCHED_FENCE() __builtin_amdgcn_sched_barrier(0)
__device__ __forceinline__ bf16x8 rd128(unsigned addr, int off) { bf16x8 r; asm volatile("ds_read_b128 %0, %1 offset:%c2" : "=&v"(r) : "v"(addr), "i"(off) : "memory"); return r; }
__device__ __forceinline__ s16x4 rdtr(unsigned addr, int off) { s16x4 r; asm volatile("ds_read_b64_tr_b16 %0, %1 offset:%c2" : "=&v"(r) : "v"(addr), "i"(off) : "memory"); return r; }
#define VFRAG(lo, hh) ((bf16x8){lo[0], lo[1], lo[2], lo[3], hh[0], hh[1], hh[2], hh[3]})
constexpr int KROW = 144, VROWD = 320, VROWA = 192;
constexpr int DSTG = 2 * 64 * KROW + 64 * VROWD;
constexpr int ASTG = 64 * KROW + 64 * VROWA;

constexpr int DST3 = 32768;
__device__ __forceinline__ void diff_unit(LAS char* lds, const bf16* __restrict__ QKV, bf16* __restrict__ Y, int b, int h, int qb, float Mb, float lam, const float* __restrict__ subln, float outscale) {
    int tid = threadIdx.x; asm volatile("" : "+v"(tid)); const int lane = tid & 63, w = __builtin_amdgcn_readfirstlane(tid >> 6), q = lane & 31, hi = lane >> 5;
    const int rg = w >> 1, c = w & 1;
    const size_t rowQ = (size_t)b * S + qb * 128 + rg * 32 + q;
    const bf16* qp = QKV + rowQ * NIN + 768 + (2 * h + c) * 64 + hi * 8;
    bf16x8 qf[4];
#pragma unroll
    for (int ds = 0; ds < 4; ++ds) qf[ds] = *(const bf16x8*)(qp + ds * 16);
    const int krow = 8 * w + (lane >> 3), kch = (lane & 7) ^ ((krow >> 1) & 7);
    const int vrow = 4 * w + (lane >> 4), vch = (lane & 15) ^ ((vrow & 3) << 2);
    const bf16* kg = QKV + ((size_t)b * S + krow) * NIN + 1280 + 128 * h + kch * 8;
    const bf16* vg = QKV + ((size_t)b * S + vrow) * NIN + 1792 + 128 * h + vch * 8;
#define DDMA(t, so) do { const size_t o_ = (size_t)(t) * 64 * NIN; LAS unsigned char* d_ = (LAS unsigned char*)lds + (so) + w * 1024; \
        __builtin_amdgcn_global_load_lds((const unsigned*)(kg + o_), (LAS unsigned*)(d_), 16, 0, 0); \
        __builtin_amdgcn_global_load_lds((const unsigned*)(kg + o_ + 64), (LAS unsigned*)(d_ + 8192), 16, 0, 0); \
        __builtin_amdgcn_global_load_lds((const unsigned*)(vg + o_), (LAS unsigned*)(d_ + 16384), 16, 0, 0); \
        __builtin_amdgcn_global_load_lds((const unsigned*)(vg + o_ + 32 * NIN), (LAS unsigned*)(d_ + 16384 + 8192), 16, 0, 0); } while (0)
    f32x16 o[4];
#pragma unroll
    for (int i = 0; i < 4; ++i) o[i] = (f32x16){0.f};
    float l = 0.f;
    constexpr int NT = S / 64;
    DDMA(0, 0); DDMA(1, DST3);
    const unsigned lbase = (unsigned)(size_t)lds;
    unsigned kofs[4], vofs[4];
    { const int sw = (q >> 1) & 7, vq = (lane & 15) >> 2;
#pragma unroll
      for (int ds = 0; ds < 4; ++ds) kofs[ds] = (unsigned)(c * 8192 + q * 128 + (((2 * ds + hi) ^ sw) << 4));
#pragma unroll
      for (int db = 0; db < 4; ++db) vofs[db] = (unsigned)(16384 + (4 * hi + vq) * 256 + ((db ^ vq) << 6) + ((lane >> 4) & 1) * 32 + (lane & 3) * 8); }
    f32x16 negm;
#pragma unroll
    for (int r = 0; r < 16; ++r) negm[r] = -Mb;
    int so_cur = 0, so_nxt2 = 2 * DST3;
    for (int t = 0; t < NT; ++t) {
        asm volatile("s_waitcnt vmcnt(4)" ::: "memory");
        __builtin_amdgcn_s_barrier();
        asm volatile("" ::: "memory");
        { const int tn = (t + 2 < NT) ? t + 2 : NT - 1; DDMA(tn, so_nxt2); }
        const unsigned sb = lbase + so_cur;
        bf16x8 kf[8];
#pragma unroll
        for (int ds = 0; ds < 4; ++ds) { kf[2 * ds] = rd128(sb + kofs[ds], 0); kf[2 * ds + 1] = rd128(sb + kofs[ds], 32 * 128); }
        s16x4 vl[2][4], vh[2][4];
#pragma unroll
        for (int db = 0; db < 4; ++db) { vl[0][db] = rdtr(sb + vofs[db], 0); vh[0][db] = rdtr(sb + vofs[db], 8 * 256); }
        LGKM_WAIT(8); SCHED_FENCE();
        f32x16 s0 = negm, s1 = negm;
#pragma unroll
        for (int ds = 0; ds < 4; ++ds) { s0 = MFMA32(kf[2 * ds], qf[ds], s0); s1 = MFMA32(kf[2 * ds + 1], qf[ds], s1); }
        float ls = 0.f;
#pragma unroll
        for (int r = 0; r < 16; ++r) { s0[r] = __builtin_amdgcn_exp2f(s0[r]); s1[r] = __builtin_amdgcn_exp2f(s1[r]); ls += s0[r] + s1[r]; }
        l += ls;
        bf16x8 pf[4]; pf[0] = pack8(s0, 0); pf[1] = pack8(s0, 8); pf[2] = pack8(s1, 0); pf[3] = pack8(s1, 8);
        SCHED_FENCE();
#pragma unroll
        for (int ks = 0; ks < 4; ++ks) {
            if (ks < 3) {
#pragma unroll
                for (int db = 0; db < 4; ++db) { vl[(ks + 1) & 1][db] = rdtr(sb + vofs[db], (ks + 1) * 16 * 256); vh[(ks + 1) & 1][db] = rdtr(sb + vofs[db], (ks + 1) * 16 * 256 + 8 * 256); }
                LGKM_WAIT(8);
            } else { LGKM_WAIT(0); }
            SCHED_FENCE();
#pragma unroll
            for (int db = 0; db < 4; ++db) o[db] = MFMA32(VFRAG(vl[ks & 1][db], vh[ks & 1][db]), pf[ks], o[db]);
            SCHED_FENCE();
        }
        so_cur = (so_cur == 2 * DST3) ? 0 : so_cur + DST3; so_nxt2 = (so_nxt2 == 2 * DST3) ? 0 : so_nxt2 + DST3;
    }
#undef DDMA
    asm volatile("s_waitcnt vmcnt(0)" ::: "memory");
    __syncthreads();
    l += __shfl_xor(l, 32);
    const float inv = 1.f / l;
    LAS f32x4* xb = (LAS f32x4*)lds + rg * (16 * 64) + lane;
    if (c == 1) {
#pragma unroll
        for (int db = 0; db < 4; ++db)
#pragma unroll
            for (int r4 = 0; r4 < 4; ++r4) xb[(db * 4 + r4) * 64] = (f32x4){o[db][4 * r4], o[db][4 * r4 + 1], o[db][4 * r4 + 2], o[db][4 * r4 + 3]} * inv;
    }
    __syncthreads();
    if (c == 0) {
        float ss = 0.f;
#pragma unroll
        for (int db = 0; db < 4; ++db)
#pragma unroll
            for (int r4 = 0; r4 < 4; ++r4) { const f32x4 ot = xb[(db * 4 + r4) * 64];
#pragma unroll
                for (int e = 0; e < 4; ++e) { const float d = o[db][4 * r4 + e] * inv - lam * ot[e]; o[db][4 * r4 + e] = d; ss += d * d; } }
        ss += __shfl_xor(ss, 32);
        const float rs = rsqrtf(ss * (1.f / 128.f) + EPS) * outscale;
        bf16* yp = Y + rowQ * D + 512 + 128 * h + 4 * hi;
#pragma unroll
        for (int db = 0; db < 4; ++db)
#pragma unroll
            for (int r4 = 0; r4 < 4; ++r4) { const f32x4 gw = *(const f32x4*)(subln + 32 * db + 8 * r4 + 4 * hi);
                u32x2 wv; wv.x = cvt_pk_bf16(o[db][4 * r4] * rs * gw[0], o[db][4 * r4 + 1] * rs * gw[1]); wv.y = cvt_pk_bf16(o[db][4 * r4 + 2] * rs * gw[2], o[db][4 * r4 + 3] * rs * gw[3]);
                *(u32x2*)(yp + 32 * db + 8 * r4) = wv; }
    }
    __syncthreads();
}

__device__ __forceinline__ void swa_unit(LAS char* lds, const bf16* __restrict__ QKV, bf16* __restrict__ Y, int b, int kvh, int n, float Mb, const float* __restrict__ sink) {
    int tid = threadIdx.x; asm volatile("" : "+v"(tid)); const int lane = tid & 63, w = __builtin_amdgcn_readfirstlane(tid >> 6), q = lane & 31, hi = lane >> 5;
    const int head = kvh * 4 + (w >> 1), rb = (w & 1) * 64;
    const size_t rowQ = (size_t)b * S + n * 128 + rb + q;
    bf16x8 qf[2][4];
#pragma unroll
    for (int rg = 0; rg < 2; ++rg)
#pragma unroll
        for (int ds = 0; ds < 4; ++ds) qf[rg][ds] = *(const bf16x8*)(QKV + (rowQ + 32 * rg) * NIN + head * 64 + hi * 8 + ds * 16);
    const int lrow = tid >> 3, lcc = tid & 7;
    const long kp0 = (long)b * S + (long)(n - 1) * 128 + lrow;
    const bf16* kg = QKV + kp0 * NIN + 512 + kvh * 64 + lcc * 8;
    const bf16* vg = QKV + kp0 * NIN + 640 + kvh * 64 + lcc * 8;
    const int kdst = lrow * KROW + lcc * 16, vdst = 64 * KROW + lrow * VROWA + lcc * 16;
    u32x4 st0, st1;
#define ALOAD(t) do { const long o_ = (long)(t) * 64 * NIN; st0 = *(const u32x4*)(kg + o_); st1 = *(const u32x4*)(vg + o_); } while (0)
#define ASTORE(bo) do { *(LAS u32x4*)(lds + (bo) + kdst) = st0; *(LAS u32x4*)(lds + (bo) + vdst) = st1; } while (0)
    f32x16 o[2][2];
#pragma unroll
    for (int i = 0; i < 2; ++i)
#pragma unroll
        for (int j = 0; j < 2; ++j) o[i][j] = (f32x16){0.f};
    float l[2] = {0.f, 0.f};
    const int t0 = (n == 0) ? 2 : 0, t1 = (n == S / 128 - 1) ? 4 : 6;
    ALOAD(t0); ASTORE((t0 & 1) * ASTG); __syncthreads();
    const int koff = q * KROW + hi * 16;
    const int voff = 64 * KROW + (4 * hi + ((lane & 15) >> 2)) * VROWA + ((lane >> 4) & 1) * 32 + (lane & 3) * 8;
    for (int t = t0; t < t1; ++t) {
        const int cur = (t & 1) * ASTG, nxt = ASTG - cur;
        if (t + 1 < t1) ALOAD(t + 1);
        lptr kb = (lptr)(lds + cur + koff);
        lptr vb = (lptr)(lds + cur + voff);
#pragma unroll
        for (int rg = 0; rg < 2; ++rg) {
            const int i0 = rb + 32 * rg;
            if (64 * t + 63 >= i0 && 64 * t <= i0 + 31 + 256) {
                f32x16 s0 = (f32x16){0.f}, s1 = (f32x16){0.f};
#pragma unroll
                for (int ds = 0; ds < 4; ++ds) {
                    const bf16x8 k0 = *(const LAS bf16x8*)(kb + ds * 32), k1 = *(const LAS bf16x8*)(kb + 32 * KROW + ds * 32);
                    s0 = MFMA32(k0, qf[rg][ds], s0); s1 = MFMA32(k1, qf[rg][ds], s1);
                }
                const int jb = 64 * t + 4 * hi - (i0 + q);
                float ls = 0.f;
#pragma unroll
                for (int r = 0; r < 16; ++r) {
                    const int d0 = jb + (r & 3) + 8 * (r >> 2), d1 = d0 + 32;
                    const float p0 = __builtin_amdgcn_exp2f(s0[r] - Mb), p1 = __builtin_amdgcn_exp2f(s1[r] - Mb);
                    s0[r] = ((unsigned)d0 <= 256u) ? p0 : 0.f; s1[r] = ((unsigned)d1 <= 256u) ? p1 : 0.f; ls += s0[r] + s1[r];
                }
                l[rg] += ls;
                bf16x8 pf[4]; pf[0] = pack8(s0, 0); pf[1] = pack8(s0, 8); pf[2] = pack8(s1, 0); pf[3] = pack8(s1, 8);
#pragma unroll
                for (int ks = 0; ks < 4; ++ks)
#pragma unroll
                    for (int db = 0; db < 2; ++db) {
                        const s16x4 lo = vtr(vb + ks * 16 * VROWA + db * 64), hh = vtr(vb + ks * 16 * VROWA + 8 * VROWA + db * 64);
                        const bf16x8 vf = (bf16x8){lo[0], lo[1], lo[2], lo[3], hh[0], hh[1], hh[2], hh[3]};
                        o[rg][db] = MFMA32(vf, pf[ks], o[rg][db]);
                    }
            }
        }
        if (t + 1 < t1) ASTORE(nxt);
        __syncthreads();
    }
#undef ALOAD
#undef ASTORE
    const float sk = __builtin_amdgcn_exp2f(sink[head] * LOG2E - Mb);
#pragma unroll
    for (int rg = 0; rg < 2; ++rg) {
        float lt = l[rg]; lt += __shfl_xor(lt, 32);
        const float inv = 1.f / (lt + sk);
        bf16* yp = Y + (rowQ + 32 * rg) * D + head * 64 + 4 * hi;
#pragma unroll
        for (int db = 0; db < 2; ++db)
#pragma unroll
            for (int r4 = 0; r4 < 4; ++r4) { u32x2 wv; wv.x = cvt_pk_bf16(o[rg][db][4 * r4] * inv, o[rg][db][4 * r4 + 1] * inv); wv.y = cvt_pk_bf16(o[rg][db][4 * r4 + 2] * inv, o[rg][db][4 * r4 + 3] * inv);
                *(u32x2*)(yp + 32 * db + 8 * r4) = wv; }
    }
}
}
constexpr size_t MiB = 1u << 20;
constexpr size_t WS_CTL = 0, CTL_BYTES = 65536 + 4 * 65536;
constexpr size_t WS_ROWSQ = 65536;
constexpr int MISC_OFF = 131072 + 4096;
constexpr size_t WS_ROPE = 1 * MiB;
constexpr size_t WS_W = 2 * MiB, W_LAYER = 23 * MiB;
constexpr size_t W_IN = 0, W_OUT = (size_t)NIN * D * 2, W_UP = W_OUT + (size_t)D * D * 2, W_DOWN = W_UP + (size_t)NUP * D * 2;
static_assert(W_DOWN + (size_t)D * FF * 2 <= W_LAYER, "weights");
constexpr size_t WS_H = 48 * MiB;
constexpr size_t WS_QKV = 80 * MiB;
constexpr size_t WS_Y = 152 * MiB;
constexpr size_t WS_ACT = 80 * MiB;
constexpr size_t WS_EDGE = 184 * MiB;
constexpr size_t WS_PART = 186 * MiB;
constexpr size_t WS_END = 190 * MiB;
static_assert(WS_ACT + (size_t)M * FF * 2 <= WS_EDGE && WS_QKV + (size_t)M * NIN * 2 <= WS_Y && WS_Y + (size_t)M * D * 2 <= WS_EDGE, "ws map");

#ifndef REP_P0
#define REP_P0 1
#endif
#ifndef REP_P1
#define REP_P1 1
#endif
#ifndef REP_P3B
#define REP_P3B 1
#endif
#ifndef REP_P4
#define REP_P4 1
#endif
#ifndef ATT_REP
#define ATT_REP 1
#endif
#ifndef REP_P5
#define REP_P5 1
#endif
#ifndef REP_P3
#define REP_P3 1
#endif
#ifndef REP_SYNC
#define REP_SYNC 1
#endif
struct Args {
    const float *x, *g_attn, *w_in, *qn_a, *kn_a, *sink, *qn_b, *kn_b, *lq1, *lk1, *lq2, *lk2, *subln, *w_out, *g_ffn, *w_up, *conv_w, *conv_b, *w_down;
    float* out; unsigned char* ws;
    int rep[8];
};

__device__ __forceinline__ float wave_sum(float v) {
#pragma unroll
    for (int o = 1; o < 64; o <<= 1) v += __shfl_xor(v, o);
    return v;
}
__device__ __forceinline__ float wave_max(float v) {
#pragma unroll
    for (int o = 1; o < 64; o <<= 1) v = fmaxf(v, __shfl_xor(v, o));
    return v;
}
__device__ __forceinline__ unsigned f2bf(float f) { unsigned u = __builtin_bit_cast(unsigned, f); return (u + 0x7fffu + ((u >> 16) & 1u)) >> 16; }
__device__ __forceinline__ unsigned pk2(float lo, float hi) { return f2bf(lo) | (f2bf(hi) << 16); }

__device__ __forceinline__ void transpose_item(const float* __restrict__ W, int K, int N, bf16* __restrict__ WT, LAS float* scr, int kb, int nb, int dnb, int lane, const float* __restrict__ g) {
    const int k0 = 64 * kb, n0 = 32 * nb;
#pragma unroll 8
    for (int i = 0; i < 32; ++i) { const int kk = 2 * i + (lane >> 5); scr[kk * 33 + (lane & 31)] = W[(size_t)(k0 + kk) * N + n0 + (lane & 31)] * (g ? g[k0 + kk] : 1.f); }
    asm volatile("s_waitcnt lgkmcnt(0)" ::: "memory");
    const int c = lane & 7;
#pragma unroll
    for (int j = 0; j < 4; ++j) { const int n = (lane >> 3) + 8 * j; const LAS float* s = scr + (8 * c) * 33 + n;
        u32x4 o; o.x = pk2(s[0 * 33], s[1 * 33]); o.y = pk2(s[2 * 33], s[3 * 33]); o.z = pk2(s[4 * 33], s[5 * 33]); o.w = pk2(s[6 * 33], s[7 * 33]);
        *(u32x4*)(WT + (size_t)(32 * dnb + n) * K + k0 + 8 * c) = o; }
    asm volatile("s_waitcnt lgkmcnt(0)" ::: "memory");
}

__device__ __forceinline__ void convert_rows(const float* __restrict__ x, bf16* __restrict__ out, float* __restrict__ rowsq, int gw, int ngw, int lane) {
    for (int m = gw; m < M; m += ngw) {
        const f32x4* xr = (const f32x4*)(x + (size_t)m * D) + lane; f32x4 v[4]; float s = 0.f;
#pragma unroll
        for (int j = 0; j < 4; ++j) { v[j] = xr[64 * j]; s += dot4(v[j]); }
        s = wave_sum(s);
        if (lane == 0) rowsq[m] = s;
        u32x2* o8 = (u32x2*)(out + (size_t)m * D) + lane;
#pragma unroll
        for (int j = 0; j < 4; ++j) { u32x2 wv; wv.x = pk2(v[j][0], v[j][1]); wv.y = pk2(v[j][2], v[j][3]); o8[64 * j] = wv; }
    }
}

#define XB_TMO      128
#define XB_XCNT(j)  (256  + 64 * (j))
#define XB_XSUB(j)  (1280 + 64 * (j))
#define XB_XGEN(j)  (2304 + 64 * (j))
#define XB_TOP      3328
#define XB_TOPGEN   3392
#define XCD_BAR_WORDS 3456
#define XB_SPIN_CAP (1u << 18)

__device__ __forceinline__ unsigned xb_ld(unsigned* p)              { return __hip_atomic_load(p, __ATOMIC_RELAXED, __HIP_MEMORY_SCOPE_AGENT); }
__device__ __forceinline__ unsigned xb_add(unsigned* p, unsigned v) { return __hip_atomic_fetch_add(p, v, __ATOMIC_RELAXED, __HIP_MEMORY_SCOPE_AGENT); }
__device__ __forceinline__ unsigned xb_xcc_id() { return (unsigned)__builtin_amdgcn_s_getreg((3 << 11) | 20) & 0xFu; }
#define XB_SPIN(cond, bar) do { unsigned _sp = 0; while (cond) { __builtin_amdgcn_s_sleep(1); \
    if ((++_sp & 255u) == 0u) { if (xb_ld(&(bar)[XB_TMO])) break; if (_sp > XB_SPIN_CAP) { atomicAdd(&(bar)[XB_TMO], 1u); break; } } } } while (0)

struct XcdBarrier {
    unsigned* bar; unsigned x;
    volatile LAS unsigned* st;
};

__device__ __forceinline__ XcdBarrier xcd_barrier_post(unsigned* bar, volatile LAS unsigned* st) {
    XcdBarrier b; b.bar = bar; b.x = xb_xcc_id(); b.st = st;
    if (threadIdx.x == 0) (void)xb_add(&bar[XB_XCNT(b.x)], 1u);
    return b;
}
__device__ __forceinline__ void xcd_barrier_complete(unsigned* bar, unsigned x, unsigned& nloc, unsigned& nx) {
    const unsigned G = gridDim.x * gridDim.y * gridDim.z;
    unsigned sum, cnt, mine, sp = 0u;
    for (;;) {
        sum = 0u; cnt = 0u; mine = 0u;
#pragma unroll
        for (unsigned j = 0; j < 16; ++j) { const unsigned c = xb_ld(&bar[XB_XCNT(j)]); sum += c; cnt += (c > 0u) ? 1u : 0u; mine = (j == x) ? c : mine; }
        if (sum == G) break;
        __builtin_amdgcn_s_sleep(1);
        if ((++sp & 255u) == 0u) { if (xb_ld(&bar[XB_TMO])) break; if (sp > XB_SPIN_CAP) { atomicAdd(&bar[XB_TMO], 1u); break; } }
    }
    nloc = mine > 0u ? mine : 1u; nx = cnt > 0u ? cnt : 1u;
}

__device__ __forceinline__ void xcd_barrier(const XcdBarrier& b) {
    asm volatile("s_waitcnt vmcnt(0)" ::: "memory");
    __syncthreads();
    if (threadIdx.x == 0) {
        unsigned* bar = b.bar;
        __builtin_amdgcn_s_waitcnt(0);
        unsigned nloc = b.st[0], nx = b.st[1];
        if (nloc == 0u) { xcd_barrier_complete(bar, b.x, nloc, nx); b.st[0] = nloc; b.st[1] = nx; }
        const unsigned old = xb_add(&bar[XB_XSUB(b.x)], 1u);
        const unsigned gen = old / nloc;
        if (old + 1u == (gen + 1u) * nloc) {
            __builtin_amdgcn_fence(__ATOMIC_RELEASE, "agent");
            asm volatile("s_waitcnt vmcnt(0)" ::: "memory");
            const unsigned og = xb_add(&bar[XB_TOP], 1u);
            const unsigned tg = og / nx;
            if (og + 1u == (tg + 1u) * nx) xb_add(&bar[XB_TOPGEN], 1u);
            else XB_SPIN(xb_ld(&bar[XB_TOPGEN]) == tg, bar);
            __builtin_amdgcn_fence(__ATOMIC_ACQUIRE, "agent");
            xb_add(&bar[XB_XGEN(b.x)], 1u);
            asm volatile("s_waitcnt vmcnt(0)" ::: "memory");
        } else {
            XB_SPIN(xb_ld(&bar[XB_XGEN(b.x)]) == gen, bar);
            __builtin_amdgcn_fence(__ATOMIC_ACQUIRE, "agent");
            asm volatile("s_waitcnt vmcnt(0)" ::: "memory");
        }
    }
    __syncthreads();
}

__global__ void __launch_bounds__(512, 2) mega_fwd(Args a) {
    extern __shared__ __attribute__((aligned(16))) unsigned char lds_raw[];
    LAS unsigned char* lds = (LAS unsigned char*)lds_raw;
    cg::grid_group grid = cg::this_grid();
    const int tid = threadIdx.x, lane = tid & 63, wave = __builtin_amdgcn_readfirstlane(tid >> 6);
    const int G = gridDim.x, bx = blockIdx.x;
    const int vcu = (G % 8 == 0) ? (bx % 8) * (G / 8) + bx / 8 : bx;
    const int gw = vcu * 8 + wave, ngw = G * 8;
    unsigned char* ws = a.ws;
    float* cosT = (float*)(ws + WS_ROPE); float* sinT = cosT + S * 32;
    bf16* Hb = (bf16*)(ws + WS_H); bf16* QKV = (bf16*)(ws + WS_QKV); bf16* Yb = (bf16*)(ws + WS_Y); bf16* ACT = (bf16*)(ws + WS_ACT);
    float* edge = (float*)(ws + WS_EDGE); float* part = (float*)(ws + WS_PART); float* rowsq = (float*)(ws + WS_ROWSQ);
    volatile LAS unsigned* misc = (volatile LAS unsigned*)(lds + MISC_OFF);
    if (tid < 16) misc[tid] = 0u;
    __syncthreads();
    const XcdBarrier xbar = xcd_barrier_post((unsigned*)(ws + WS_CTL) + 1024, misc);
    grid.sync();

    for (int rep0 = 0; rep0 < a.rep[0]; ++rep0) {
        LAS float* scr = (LAS float*)(lds + wave * 16384);
        constexpr int I_IN = 16 * 72, I_OUT = 16 * 32, I_UP = 16 * 176, I_DOWN = 44 * 32, I_L = I_IN + I_OUT + I_UP + I_DOWN;
        for (int it = gw; it < DEPTH * I_L; it += ngw) {
            const int l = it / I_L; int r = it % I_L;
            unsigned char* wl = ws + WS_W + (size_t)l * W_LAYER;
            if (r < I_IN) { const int kb = r / 72, nb = r % 72; const int pn = nb >> 3, wc = (nb >> 1) & 3, bj = nb & 1;
                transpose_item(a.w_in + (size_t)l * D * NIN, D, NIN, (bf16*)(wl + W_IN), scr, kb, nb, 8 * pn + 4 * bj + wc, lane, a.g_attn + l * D); continue; }
            r -= I_IN;
            if (r < I_OUT) { const int kb = r / 32, nb = r % 32; transpose_item(a.w_out + (size_t)l * D * D, D, D, (bf16*)(wl + W_OUT), scr, kb, nb, nb, lane, nullptr); continue; }
            r -= I_OUT;
            if (r < I_UP) { const int kb = r / 176, nb = r % 176; const int isv = nb >= 88, nn = isv ? nb - 88 : nb; const int dnb = 8 * (nn >> 2) + 4 * isv + (nn & 3);
                transpose_item(a.w_up + (size_t)l * D * NUP, D, NUP, (bf16*)(wl + W_UP), scr, kb, nb, dnb, lane, a.g_ffn + l * D); continue; }
            r -= I_UP;
            { const int kb = r / 32, nb = r % 32; transpose_item(a.w_down + (size_t)l * FF * D, FF, D, (bf16*)(wl + W_DOWN), scr, kb, nb, nb, lane, nullptr); }
        }
        for (int i = vcu * 512 + tid; i < S * 32; i += G * 512) {
            const int pos = i >> 5, j = i & 31;
            double inv = 1.0; for (int k = 0; k < j; ++k) inv *= 0.74989420933245582730;
            const double ang = (double)pos * inv;
            const double kq = __builtin_rint(ang * 0.15915494309189533577);
            const double rr = (ang - kq * 6.283185307179586232) - kq * 2.4492935982947064e-16;
            const double r2 = rr * rr;
            double sn = 1.0, cs = 1.0;
#pragma unroll
            for (int k = 12; k >= 1; --k) { sn = 1.0 - sn * r2 / (double)((2 * k) * (2 * k + 1)); cs = 1.0 - cs * r2 / (double)((2 * k - 1) * (2 * k)); }
            cosT[i] = (float)cs; sinT[i] = (float)(sn * rr);
        }
        convert_rows(a.x, Hb, rowsq, gw, ngw, lane);
    }
    xcd_barrier(xbar);

    for (int l = 0; l < DEPTH; ++l) {
        const float lambda_init = 0.8f - 0.6f * __expf(-0.3f * (float)l);
        unsigned char* wl = ws + WS_W + (size_t)l * W_LAYER;
        {
            pg8::Gemm g{Hb, (const bf16*)(wl + W_IN), M, NIN, D}; pg8::StaticOrder So; So.init(M, NIN, G, bx);
            EpiInProj E{QKV, a.qn_a + l * 64, a.kn_a + l * 64, a.qn_b + l * 64, a.kn_b + l * 64, cosT, sinT, rowsq + (size_t)(2 * l) * M};
            for (int rep1 = 0; rep1 < a.rep[1]; ++rep1) pg8::gemm_phase<EpiInProj, pg8::StaticOrder, true, true>(lds, g, So, E);
        }
        xcd_barrier(xbar);
        {
            const float mqa = wave_max(fabsf(a.qn_a[l * 64 + lane])), mka = wave_max(fabsf(a.kn_a[l * 64 + lane]));
            const float mqb = wave_max(fabsf(a.qn_b[l * 64 + lane])), mkb = wave_max(fabsf(a.kn_b[l * 64 + lane]));
            const float MbA = 8.f * mqa * mka * LOG2E * 1.02f, MbB = 8.f * mqb * mkb * LOG2E * 1.02f;
            const float s1 = wave_sum(a.lq1[l * 64 + lane] * a.lk1[l * 64 + lane]), s2 = wave_sum(a.lq2[l * 64 + lane] * a.lk2[l * 64 + lane]);
            const float lam = __expf(s1) - __expf(s2) + lambda_init;
            for (int rep = 0; rep < a.rep[5]; ++rep) {
            for (int uidx = vcu; uidx < NB * 4 * 16; uidx += G) {
                const int bh = uidx >> 4, qb = uidx & 15;
                att::diff_unit((LAS char*)lds, QKV, Yb, bh >> 2, bh & 3, qb, MbB, lam, a.subln + l * 128, 1.f - lambda_init);
            }
            for (int uidx = vcu; uidx < NB * 2 * 16; uidx += G) {
                const int bk = uidx >> 4, n = uidx & 15;
                att::swa_unit((LAS char*)lds, QKV, Yb, bk >> 1, bk & 1, n, MbA, a.sink + l * 8);
            }
            __syncthreads();
            }
        }
        xcd_barrier(xbar);
        {
            pg8::Gemm g{Yb, (const bf16*)(wl + W_OUT), M, D, D}; pg8::StaticOrder So; So.init(M, D, G, bx);
            EpiResid E{Hb, rowsq + (size_t)(2 * l + 1) * M, nullptr};
            pg8::gemm_phase<EpiResid, pg8::StaticOrder, true, true>(lds, g, So, E);
        }
        xcd_barrier(xbar);
        {
            pg8::Gemm g{Hb, (const bf16*)(wl + W_UP), M, NUP, D}; pg8::StaticOrder So; So.init(M, NUP, G, bx);
            EpiUpConv E{ACT, a.conv_w + (size_t)l * 3 * FF, a.conv_b + (size_t)l * FF, edge, part, (LAS float*)(lds + XL_OFF), rowsq + (size_t)(2 * l + 1) * M};
            for (int rep4 = 0; rep4 < a.rep[3]; ++rep4) pg8::gemm_phase<EpiUpConv, pg8::StaticOrder, true, true>(lds, g, So, E);
        }
        xcd_barrier(xbar);
        {
            const float* cw = a.conv_w + (size_t)l * 3 * FF;
            for (int i = vcu * 512 + tid; i < 64 * 2 * FF; i += G * 512) {
                const int pm = i / (2 * FF), rem = i % (2 * FF), which = rem / FF, ch = rem % FF;
                if (which == 0 && (pm & 7) != 0) {
                    const float* pp = part + (((size_t)pm * 2 + 0) * FF + ch) * 2;
                    const float pre = pp[0] + cw[ch] * edge[((size_t)(pm - 1) * 2 + 1) * FF + ch];
                    ACT[(size_t)(pm * 256) * FF + ch] = (bf16)f2bf(silu_f(pre) * pp[1]);
                }
                if (which == 1 && (pm & 7) != 7) {
                    const float* pp = part + (((size_t)pm * 2 + 1) * FF + ch) * 2;
                    const float pre = pp[0] + cw[2 * FF + ch] * edge[((size_t)(pm + 1) * 2 + 0) * FF + ch];
                    ACT[(size_t)(pm * 256 + 255) * FF + ch] = (bf16)f2bf(silu_f(pre) * pp[1]);
                }
            }
        }
        xcd_barrier(xbar);
        {
            pg8::Gemm g{ACT, (const bf16*)(wl + W_DOWN), M, D, FF}; pg8::StaticOrder So; So.init(M, D, G, bx);
            const bool lastl = (l + 1 == DEPTH);
            EpiResid E{Hb, lastl ? nullptr : rowsq + (size_t)(2 * l + 2) * M, lastl ? a.out : nullptr};
            pg8::gemm_phase<EpiResid, pg8::StaticOrder, true, true>(lds, g, So, E);
        }
        if (l + 1 < DEPTH) xcd_barrier(xbar);
    }
}

extern "C" void kernel_launch(void* const* d_in, const int* in_sizes, int n_in, void* d_out, int out_size, void* d_ws, size_t ws_size, hipStream_t stream) {
    static int grid = 0;
    if (grid == 0) {
        if (n_in != 19 || ws_size < WS_END) { fprintf(stderr, "kernel_launch: unexpected inputs (n_in %d, ws %zu)\n", n_in, ws_size); grid = -1; return; }
        int dev = 0, cus = 0, per_cu = 0;
        hipGetDevice(&dev);
        hipDeviceGetAttribute(&cus, hipDeviceAttributeMultiprocessorCount, dev);
        hipFuncSetAttribute((const void*)mega_fwd, hipFuncAttributeMaxDynamicSharedMemorySize, LDS_BYTES);
        hipOccupancyMaxActiveBlocksPerMultiprocessor(&per_cu, (const void*)mega_fwd, 512, LDS_BYTES);
        if (per_cu < 1) { fprintf(stderr, "kernel_launch: occupancy query reports %d blocks per CU\n", per_cu); per_cu = 1; }
        grid = cus;
        (void)hipGetLastError();
    }
    if (grid < 0) return;
    if (hipMemsetAsync((char*)d_ws + WS_CTL, 0, CTL_BYTES, stream) != hipSuccess) { fprintf(stderr, "kernel_launch: memset failed\n"); return; }
    Args a{};
    const float** p = (const float**)&a;
    for (int i = 0; i < 19; ++i) p[i] = (const float*)d_in[i];
    a.out = (float*)d_out; a.ws = (unsigned char*)d_ws;
    { const int reps[8] = {REP_P0, REP_P1, REP_P3B, REP_P4, 1, ATT_REP, REP_P3, REP_P5}; for (int i = 0; i < 8; ++i) a.rep[i] = reps[i]; }
    void* args[] = {&a};
    hipError_t e = hipLaunchCooperativeKernel((const void*)mega_fwd, dim3(grid), dim3(512), args, LDS_BYTES, stream);
    if (e != hipSuccess) fprintf(stderr, "cooperative launch failed: %s (grid %d)\n", hipGetErrorString(e), grid);
}
```

```cpp
#include <hip/hip_runtime.h>
#include <hip/hip_cooperative_groups.h>
#include <cstdio>
#include <cstdint>
namespace cg = cooperative_groups;
namespace pg8 {
#define PG8_LAS __attribute__((address_space(3)))
typedef unsigned short bf16_t;
typedef short bf16x8 __attribute__((ext_vector_type(8)));
typedef float f32x4 __attribute__((ext_vector_type(4)));
typedef unsigned u32x4 __attribute__((ext_vector_type(4)));
constexpr int BM = 256, BK = 64, HALF = 128, HTB = HALF * BK * 2  , STAGE_BYTES = 8 * HTB, NXCD = 8, WGM = 8;

__host__ __device__ __forceinline__ int lds_byte(int r, int c) { const int st = (r >> 4) * 2 + (c >> 5), rr = r & 15, cc = c & 31, ob = rr * 64 + cc * 2; return st * 1024 + (ob ^ (((ob >> 9) & 1) << 5)); }
__host__ __device__ __forceinline__ void stage_rc(int b, int& R, int& C) { const int st = b / 1024, sb = b % 1024, swz = sb ^ (((sb >> 9) & 1) << 5); R = (st >> 1) * 16 + swz / 64; C = (st & 1) * 32 + (swz % 64) / 2; }
__host__ __device__ __forceinline__ int perm32(int rho) { const int n = rho >> 4, i = rho & 15; return 8 * (i >> 2) + 4 * n + (i & 3); }

struct Unit { int pm, pn; };
struct Gemm { const bf16_t* A; const bf16_t* Bt; int M, N, K; };

struct StaticOrder {
    int nM, nN, nwg, G, c;
    __host__ __device__ void init(int M, int N, int G_, int c_) { nM = M / BM; nN = N / BM; nwg = nM * nN; G = G_; c = c_; }
    __host__ __device__ bool next(int i, Unit& u) const {
        const long L = (long)i * G + c; if (L >= nwg) return false;
        int wgid = (int)L; { const int q = nwg / NXCD, r = nwg % NXCD, xcd = wgid % NXCD, off = wgid / NXCD; wgid = (xcd < r ? xcd * (q + 1) : r * (q + 1) + (xcd - r) * q) + off; }
        const int nig = WGM * nN, gid = wgid / nig, fm = gid * WGM, gsz = (nM - fm) < WGM ? (nM - fm) : WGM;
        u.pm = fm + ((wgid % nig) % gsz); u.pn = (wgid % nig) / gsz; return true;
    }
    __device__ __forceinline__ void a_ready(const Unit&) const {}
    __device__ __forceinline__ void done(const Unit&) const {}
};

__device__ __forceinline__ unsigned cvt_pk_bf16(float lo, float hi) { unsigned r; asm volatile("v_cvt_pk_bf16_f32 %0, %1, %2" : "=v"(r) : "v"(lo), "v"(hi)); return r; }
template <class Epi, class Sched, bool ALIGN_EPI = false, bool SP2 = false>
__device__ __forceinline__ void gemm_phase(PG8_LAS unsigned char* lds, const Gemm g, const Sched& S, const Epi& E) {
    int tid = threadIdx.x; asm volatile("" : "+v"(tid)); const int wid = __builtin_amdgcn_readfirstlane(tid >> 6), lane = tid & 63, wr = wid >> 2, wc = wid & 3, fr = lane & 15, fq = lane >> 4;
    const int K = g.K, nt = K / BK;
    unsigned voffA[2], voffB[2];
#pragma unroll
    for (int i = 0; i < 2; ++i) { int R, C; stage_rc(tid * 16 + i * 8192, R, C); const int Rb = Epi::PERM ? ((R & ~31) + perm32(R & 31)) : R;
        voffA[i] = (unsigned)(R * K + C) * 2u; voffB[i] = (unsigned)(Rb * K + C) * 2u; }
    const size_t kstep = (size_t)(BK * 2);
    const size_t hstep = (size_t)HALF * K * 2;
    const size_t tstep = 2 * hstep;
    const unsigned ldsw = (unsigned)wid * 1024u;
    const int aoff = lds_byte(wr * 64 + fr, fq * 8), boff = lds_byte(wc * 32 + fr, fq * 8);
#define PG8_SA(b, h) (((b) * 2 + (h)) * HTB)
#define PG8_SB(b, h) ((4 + (b) * 2 + (h)) * HTB)
#define PG8_STAGE(bufoff, gbase, voff) do { _Pragma("unroll") for (int _i = 0; _i < 2; ++_i) \
        __builtin_amdgcn_global_load_lds((const unsigned*)((const char*)(gbase) + (voff)[_i]), (PG8_LAS unsigned*)(lds + (bufoff) + ldsw + _i * 8192), 16, 0, 0); } while (0)
#define PG8_LDA(dst, b, h) do { _Pragma("unroll") for (int m = 0; m < 4; ++m) _Pragma("unroll") for (int k = 0; k < 2; ++k) dst[m][k] = *(const PG8_LAS bf16x8*)(lds + PG8_SA(b, h) + aoff + m * 2048 + k * 1024); } while (0)
#define PG8_LDB(dst, b, h) do { _Pragma("unroll") for (int n = 0; n < 2; ++n) _Pragma("unroll") for (int k = 0; k < 2; ++k) dst[n][k] = *(const PG8_LAS bf16x8*)(lds + PG8_SB(b, h) + boff + n * 2048 + k * 1024); } while (0)
#define PG8_MMA(ai, bj, At, Bt) do { __builtin_amdgcn_s_setprio(1); _Pragma("unroll") for (int m = 0; m < 4; ++m) _Pragma("unroll") for (int n = 0; n < 2; ++n) _Pragma("unroll") for (int k = 0; k < 2; ++k) \
        acc[ai][bj][m][n] = __builtin_amdgcn_mfma_f32_16x16x32_bf16(Bt[n][k], At[m][k], acc[ai][bj][m][n], 0, 0, 0); __builtin_amdgcn_s_setprio(0); } while (0)
#define PG8_WAIT_V(n) asm volatile("s_waitcnt vmcnt(" #n ")" ::: "memory")
#define PG8_WAIT_L(n) asm volatile("s_waitcnt lgkmcnt(" #n ")" ::: "memory")
#define PG8_BAR __builtin_amdgcn_s_barrier()
#define PG8_SCHED __builtin_amdgcn_sched_barrier(0)
    Unit cur, nxt; int ui = 0;
    if (!S.next(0, cur)) return;
    f32x4 acc[2][2][4][2];
#pragma unroll
    for (int a = 0; a < 2; ++a)
#pragma unroll
        for (int b = 0; b < 2; ++b)
#pragma unroll
            for (int m = 0; m < 4; ++m)
#pragma unroll
                for (int n = 0; n < 2; ++n) acc[a][b][m][n] = (f32x4){0.f, 0.f, 0.f, 0.f};
    bf16x8 At[4][2], B0[2][2], B1[2][2];
    const char* cA = (const char*)g.A + (size_t)cur.pm * tstep; const char* cB = (const char*)g.Bt + (size_t)cur.pn * tstep;
    S.a_ready(cur);
    if constexpr (SP2) {
        PG8_STAGE(PG8_SB(0, 0), cB, voffB); PG8_STAGE(PG8_SB(0, 1), cB + hstep, voffB); PG8_STAGE(PG8_SA(0, 0), cA, voffA); PG8_STAGE(PG8_SA(0, 1), cA + hstep, voffA);
        if (wr == 1) PG8_BAR;
        PG8_WAIT_V(2); PG8_BAR;
        PG8_STAGE(PG8_SB(1, 0), cB + kstep, voffB); PG8_STAGE(PG8_SA(1, 0), cA + kstep, voffA); PG8_STAGE(PG8_SB(1, 1), cB + hstep + kstep, voffB);
        PG8_WAIT_V(6); PG8_BAR;
    } else {
        PG8_STAGE(PG8_SB(0, 0), cB, voffB); PG8_STAGE(PG8_SA(0, 0), cA, voffA); PG8_STAGE(PG8_SB(0, 1), cB + hstep, voffB); PG8_STAGE(PG8_SA(0, 1), cA + hstep, voffA);
        if (wr == 1) PG8_BAR;
        PG8_WAIT_V(4); PG8_BAR;
        PG8_STAGE(PG8_SB(1, 0), cB + kstep, voffB); PG8_STAGE(PG8_SA(1, 0), cA + kstep, voffA); PG8_STAGE(PG8_SB(1, 1), cB + hstep + kstep, voffB);
        PG8_WAIT_V(6); PG8_BAR;
    }
    for (;;) {
        const bool has_next = S.next(ui + 1, nxt);
        const char* nA = has_next ? (const char*)g.A + (size_t)nxt.pm * tstep : cA; const char* nB = has_next ? (const char*)g.Bt + (size_t)nxt.pn * tstep : cB;
        for (int t = 0; t < nt; t += 2) {
            const bool last = (t == nt - 2);
            const char* a1 = cA + (size_t)(t + 1) * kstep;
            const char* a2 = last ? nA : cA + (size_t)(t + 2) * kstep; const char* b2 = last ? nB : cB + (size_t)(t + 2) * kstep;
            const char* a3 = a2 + kstep; const char* b3 = b2 + kstep;
            if (last && has_next) S.a_ready(nxt);
            if constexpr (SP2) {
            PG8_LDB(B0, 0, 0); PG8_LDB(B1, 0, 1); PG8_SCHED; PG8_LDA(At, 0, 0); PG8_STAGE(PG8_SA(1, 1), a1 + hstep, voffA);
            PG8_WAIT_V(8); PG8_WAIT_L(0); PG8_BAR; PG8_MMA(0, 0, At, B0); PG8_MMA(0, 1, At, B1); PG8_BAR; PG8_SCHED;
            PG8_LDA(At, 0, 1); PG8_STAGE(PG8_SB(0, 0), b2, voffB); PG8_STAGE(PG8_SB(0, 1), b2 + hstep, voffB); PG8_STAGE(PG8_SA(0, 0), a2, voffA);
            PG8_WAIT_V(8); PG8_WAIT_L(0); PG8_BAR; PG8_MMA(1, 0, At, B0); PG8_MMA(1, 1, At, B1); PG8_BAR; PG8_SCHED;
            PG8_LDB(B0, 1, 0); PG8_LDB(B1, 1, 1); PG8_SCHED; PG8_LDA(At, 1, 0); PG8_STAGE(PG8_SA(0, 1), a2 + hstep, voffA);
            PG8_WAIT_V(8); PG8_WAIT_L(0); PG8_BAR; PG8_MMA(0, 0, At, B0); PG8_MMA(0, 1, At, B1); PG8_BAR; PG8_SCHED;
            PG8_LDA(At, 1, 1); PG8_STAGE(PG8_SB(1, 0), b3, voffB); PG8_STAGE(PG8_SB(1, 1), b3 + hstep, voffB); PG8_STAGE(PG8_SA(1, 0), a3, voffA);
            PG8_WAIT_V(8); PG8_WAIT_L(0); PG8_BAR; PG8_MMA(1, 0, At, B0); PG8_MMA(1, 1, At, B1); PG8_BAR; PG8_SCHED;
            } else {
            PG8_LDB(B0, 0, 0); PG8_SCHED; PG8_LDA(At, 0, 0); PG8_STAGE(PG8_SA(1, 1), a1 + hstep, voffA);
            PG8_WAIT_L(8); PG8_BAR; PG8_WAIT_L(0); PG8_MMA(0, 0, At, B0); PG8_BAR; PG8_SCHED;
            PG8_LDB(B1, 0, 1); PG8_STAGE(PG8_SB(0, 0), b2, voffB);
            PG8_BAR; PG8_WAIT_L(0); PG8_MMA(0, 1, At, B1); PG8_BAR;
            PG8_LDA(At, 0, 1); PG8_STAGE(PG8_SA(0, 0), a2, voffA);
            PG8_BAR; PG8_WAIT_L(0); PG8_MMA(1, 0, At, B0); PG8_BAR; PG8_SCHED;
            PG8_STAGE(PG8_SB(0, 1), b2 + hstep, voffB);
            PG8_WAIT_V(6); PG8_BAR; PG8_MMA(1, 1, At, B1); PG8_BAR;
            PG8_LDB(B0, 1, 0); PG8_SCHED; PG8_LDA(At, 1, 0); PG8_STAGE(PG8_SA(0, 1), a2 + hstep, voffA);
            PG8_WAIT_L(8); PG8_BAR; PG8_WAIT_L(0); PG8_MMA(0, 0, At, B0); PG8_BAR; PG8_SCHED;
            PG8_LDB(B1, 1, 1); PG8_STAGE(PG8_SB(1, 0), b3, voffB);
            PG8_BAR; PG8_WAIT_L(0); PG8_MMA(0, 1, At, B1); PG8_BAR;
            PG8_LDA(At, 1, 1); PG8_STAGE(PG8_SA(1, 0), a3, voffA);
            PG8_BAR; PG8_WAIT_L(0); PG8_MMA(1, 0, At, B0); PG8_BAR; PG8_SCHED;
            PG8_STAGE(PG8_SB(1, 1), b3 + hstep, voffB);
            PG8_WAIT_V(6); PG8_BAR; PG8_MMA(1, 1, At, B1); PG8_BAR;
            }
        }
        if constexpr (ALIGN_EPI) { if (wr == 0) PG8_BAR; }
        if constexpr (!Epi::AFTER_DRAIN) { E(acc, cur, wr, wc, fr, fq); S.done(cur); }
        if (!has_next) break;
#pragma unroll
        for (int a = 0; a < 2; ++a)
#pragma unroll
            for (int b = 0; b < 2; ++b)
#pragma unroll
                for (int m = 0; m < 4; ++m)
#pragma unroll
                    for (int n = 0; n < 2; ++n) acc[a][b][m][n] = (f32x4){0.f, 0.f, 0.f, 0.f};
        cur = nxt; cA = nA; cB = nB; ++ui;
        if constexpr (ALIGN_EPI) { if (wr == 1) PG8_BAR; }
    }
    PG8_WAIT_V(0);
    if constexpr (!ALIGN_EPI) { if (wr == 0) PG8_BAR; }
    PG8_BAR;
    if constexpr (Epi::AFTER_DRAIN) { E.fused(acc, cur, wr, wc, fr, fq, lds, wid, lane); S.done(cur); }
#undef PG8_SA
#undef PG8_SB
#undef PG8_STAGE
#undef PG8_LDA
#undef PG8_LDB
#undef PG8_MMA
#undef PG8_WAIT_V
#undef PG8_WAIT_L
#undef PG8_BAR
#undef PG8_SCHED
}
}
#define LAS __attribute__((address_space(3)))
typedef unsigned short bf16;
using pg8::f32x4; using pg8::u32x4; using pg8::Unit; using pg8::cvt_pk_bf16; using pg8::bf16x8;
typedef unsigned u32x2 __attribute__((ext_vector_type(2)));

constexpr int NB = 8, S = 2048, D = 1024, M = NB * S, NIN = 2304, FF = 2816, NUP = 2 * FF, DEPTH = 2;
constexpr float EPS = 1e-6f;
constexpr float LOG2E = 1.4426950408889634f;
constexpr float QSCALE = 0.125f * LOG2E;
constexpr int XL_OFF = 131072;
constexpr int LDS_BYTES = 131072 + 8192;

__device__ __forceinline__ float dot4(f32x4 a) { return (a[0] * a[0] + a[1] * a[1]) + (a[2] * a[2] + a[3] * a[3]); }
__device__ __forceinline__ float silu_f(float v) { return v * __builtin_amdgcn_rcpf(1.f + __expf(-v)); }

struct EpiInProj {
    static constexpr bool PERM = true, AFTER_DRAIN = false;
    bf16* O; const float* qn_a; const float* kn_a; const float* qn_b; const float* kn_b; const float* cosT; const float* sinT; const float* rowsq;
    __device__ __forceinline__ void operator()(const f32x4 (&acc)[2][2][4][2], const Unit& u, int wr, int wc, int fr, int fq) const {
        asm volatile("" : "+v"(fr), "+v"(fq));
        const int pn = u.pn;
        const float* g = nullptr; float sc = 1.f;
        if (pn < 2) { g = qn_a; sc = QSCALE; }
        else if (pn == 2) { if (wc < 2) g = kn_a; }
        else if (pn < 5) { g = qn_b; sc = QSCALE; }
        else if (pn < 7) { g = kn_b; }
        const int colb = pn * 256 + wc * 64 + 8 * fq;
        const int row0 = u.pm * 256 + wr * 64 + fr;
        if (g) {
            f32x4 g1[2], g2[2];
#pragma unroll
            for (int n = 0; n < 2; ++n) { g1[n] = *(const f32x4*)(g + 8 * fq + 4 * n); g2[n] = *(const f32x4*)(g + 32 + 8 * fq + 4 * n); }
#pragma unroll
            for (int ai = 0; ai < 2; ++ai)
#pragma unroll
                for (int m = 0; m < 4; ++m) {
                    const int row = row0 + ai * 128 + m * 16;
                    const f32x4 a0 = acc[ai][0][m][0], a1 = acc[ai][0][m][1], b0 = acc[ai][1][m][0], b1 = acc[ai][1][m][1];
                    float ss = (dot4(a0) + dot4(a1)) + (dot4(b0) + dot4(b1));
                    ss += __shfl_xor(ss, 16); ss += __shfl_xor(ss, 32);
                    const float rx = rsqrtf(rowsq[row] * (1.f / D) + EPS);
                    const float rs = rsqrtf(ss * rx * rx * (1.f / 64.f) + EPS) * rx * sc;
                    const size_t ro = (size_t)(row & (S - 1)) * 32 + 8 * fq;
                    const f32x4 c0 = *(const f32x4*)(cosT + ro), c1 = *(const f32x4*)(cosT + ro + 4), s0 = *(const f32x4*)(sinT + ro), s1 = *(const f32x4*)(sinT + ro + 4);
                    const f32x4 y10 = a0 * rs * g1[0], y11 = a1 * rs * g1[1], y20 = b0 * rs * g2[0], y21 = b1 * rs * g2[1];
                    const f32x4 o10 = y10 * c0 - y20 * s0, o11 = y11 * c1 - y21 * s1, o20 = y20 * c0 + y10 * s0, o21 = y21 * c1 + y11 * s1;
                    u32x4 w1, w2;
                    w1.x = cvt_pk_bf16(o10[0], o10[1]); w1.y = cvt_pk_bf16(o10[2], o10[3]); w1.z = cvt_pk_bf16(o11[0], o11[1]); w1.w = cvt_pk_bf16(o11[2], o11[3]);
                    w2.x = cvt_pk_bf16(o20[0], o20[1]); w2.y = cvt_pk_bf16(o20[2], o20[3]); w2.z = cvt_pk_bf16(o21[0], o21[1]); w2.w = cvt_pk_bf16(o21[2], o21[3]);
                    bf16* op = O + (size_t)row * NIN + colb;
                    *(u32x4*)op = w1; *(u32x4*)(op + 32) = w2;
                }
        } else {
#pragma unroll
            for (int ai = 0; ai < 2; ++ai)
#pragma unroll
                for (int m = 0; m < 4; ++m) {
                    const int row = row0 + ai * 128 + m * 16;
                    bf16* op = O + (size_t)row * NIN + colb;
                    const float rx = rsqrtf(rowsq[row] * (1.f / D) + EPS);
#pragma unroll
                    for (int bj = 0; bj < 2; ++bj) { const f32x4 v0 = acc[ai][bj][m][0] * rx, v1 = acc[ai][bj][m][1] * rx; u32x4 w;
                        w.x = cvt_pk_bf16(v0[0], v0[1]); w.y = cvt_pk_bf16(v0[2], v0[3]); w.z = cvt_pk_bf16(v1[0], v1[1]); w.w = cvt_pk_bf16(v1[2], v1[3]);
                        *(u32x4*)(op + 32 * bj) = w; }
                }
        }
    }
};

__device__ __forceinline__ f32x4 bf2f_lo(unsigned a, unsigned b) { return (f32x4){__uint_as_float(a << 16), __uint_as_float(a & 0xffff0000u), __uint_as_float(b << 16), __uint_as_float(b & 0xffff0000u)}; }
struct EpiResid {
    static constexpr bool PERM = true, AFTER_DRAIN = false;
    bf16* XB; float* rowsq; float* outf;
    __device__ __forceinline__ void operator()(const f32x4 (&acc)[2][2][4][2], const Unit& u, int wr, int wc, int fr, int fq) const {
        asm volatile("" : "+v"(fr), "+v"(fq));
        const int col0 = u.pn * 256 + wc * 32 + 8 * fq, row0 = u.pm * 256 + wr * 64 + fr;
#pragma unroll
        for (int ai = 0; ai < 2; ++ai) {
            u32x4 xr[4][2];
#pragma unroll
            for (int m = 0; m < 4; ++m) { const size_t off = (size_t)(row0 + ai * 128 + m * 16) * D + col0;
#pragma unroll
                for (int bj = 0; bj < 2; ++bj) xr[m][bj] = *(const u32x4*)(XB + off + bj * 128); }
            asm volatile("" ::: "memory");
#pragma unroll
            for (int m = 0; m < 4; ++m) { const int row = row0 + ai * 128 + m * 16; const size_t off = (size_t)row * D + col0; float ss = 0.f;
#pragma unroll
                for (int bj = 0; bj < 2; ++bj) {
                    const f32x4 y0 = bf2f_lo(xr[m][bj].x, xr[m][bj].y) + acc[ai][bj][m][0], y1 = bf2f_lo(xr[m][bj].z, xr[m][bj].w) + acc[ai][bj][m][1];
                    ss += dot4(y0) + dot4(y1);
                    if (outf) { *(f32x4*)(outf + off + bj * 128) = y0; *(f32x4*)(outf + off + bj * 128 + 4) = y1; }
                    else { u32x4 w; w.x = cvt_pk_bf16(y0[0], y0[1]); w.y = cvt_pk_bf16(y0[2], y0[3]); w.z = cvt_pk_bf16(y1[0], y1[1]); w.w = cvt_pk_bf16(y1[2], y1[3]); *(u32x4*)(XB + off + bj * 128) = w; }
                }
                if (rowsq) { ss += __shfl_xor(ss, 16); ss += __shfl_xor(ss, 32); if (fq == 0) atomicAdd(rowsq + row, ss); }
            }
            asm volatile("" ::: "memory");
        }
    }
};

struct EpiUpConv {
    static constexpr bool PERM = true, AFTER_DRAIN = false;
    bf16* ACT; const float* cw; const float* cb; float* edge; float* part; LAS float* xl; const float* rowsq;
    __device__ __forceinline__ void operator()(f32x4 (&acc)[2][2][4][2], const Unit& u, int wr, int wc, int fr, int fq) const {
        asm volatile("" : "+v"(fr), "+v"(fq));
        const int lane = 16 * fq + fr;
        const int cl0 = 32 * wc + 8 * fq, ch0 = 128 * u.pn + cl0;
#pragma unroll
        for (int ai = 0; ai < 2; ++ai)
#pragma unroll
            for (int m = 0; m < 4; ++m) { const float rx = rsqrtf(rowsq[u.pm * 256 + ai * 128 + wr * 64 + m * 16 + fr] * (1.f / D) + EPS);
#pragma unroll
                for (int bj = 0; bj < 2; ++bj) { acc[ai][bj][m][0] *= rx; acc[ai][bj][m][1] *= rx; } }
#pragma unroll
        for (int ai = 0; ai < 2; ++ai) {
            const int chunk = 2 * ai + wr;
            if (fr == 0) { *(LAS f32x4*)(xl + (chunk * 2 + 0) * 128 + cl0) = acc[ai][0][0][0]; *(LAS f32x4*)(xl + (chunk * 2 + 0) * 128 + cl0 + 4) = acc[ai][0][0][1]; }
            if (fr == 15) { *(LAS f32x4*)(xl + (chunk * 2 + 1) * 128 + cl0) = acc[ai][0][3][0]; *(LAS f32x4*)(xl + (chunk * 2 + 1) * 128 + cl0 + 4) = acc[ai][0][3][1]; }
        }
        asm volatile("s_waitcnt lgkmcnt(0)" ::: "memory"); __builtin_amdgcn_s_barrier(); asm volatile("" ::: "memory");
        const int lup = (lane & ~15) | ((fr + 15) & 15), ldn = (lane & ~15) | ((fr + 1) & 15);
        const bool seq_first = (u.pm & 7) == 0, seq_last = (u.pm & 7) == 7;
#pragma unroll
        for (int ai = 0; ai < 2; ++ai) {
            const int chunk = 2 * ai + wr;
#pragma unroll
            for (int n = 0; n < 2; ++n) {
                const int ch = ch0 + 4 * n;
                const f32x4 w0 = *(const f32x4*)(cw + ch), w1 = *(const f32x4*)(cw + FF + ch), w2 = *(const f32x4*)(cw + 2 * FF + ch), bb = *(const f32x4*)(cb + ch);
                const f32x4 above = (chunk > 0) ? *(const LAS f32x4*)(xl + ((chunk - 1) * 2 + 1) * 128 + cl0 + 4 * n) : (f32x4){0.f, 0.f, 0.f, 0.f};
                const f32x4 below = (chunk < 3) ? *(const LAS f32x4*)(xl + ((chunk + 1) * 2 + 0) * 128 + cl0 + 4 * n) : (f32x4){0.f, 0.f, 0.f, 0.f};
                f32x4 Rprev = above, Lcur;
#pragma unroll
                for (int e = 0; e < 4; ++e) Lcur[e] = __shfl(acc[ai][0][0][n][e], ldn);
#pragma unroll
                for (int m = 0; m < 4; ++m) {
                    const int rt = ai * 128 + wr * 64 + m * 16 + fr;
                    const size_t row = (size_t)u.pm * 256 + rt;
                    const f32x4 cur = acc[ai][0][m][n], val = acc[ai][1][m][n];
                    f32x4 Rm, Lnext = below;
#pragma unroll
                    for (int e = 0; e < 4; ++e) { Rm[e] = __shfl(cur[e], lup); if (m < 3) Lnext[e] = __shfl(acc[ai][0][m < 3 ? m + 1 : 3][n][e], ldn); }
                    const f32x4 up = (fr == 0) ? Rprev : Rm, dn = (fr == 15) ? Lnext : Lcur;
                    Rprev = Rm; Lcur = Lnext;
                    const f32x4 pre = bb + w0 * up + w1 * cur + w2 * dn;
                    f32x4 res;
#pragma unroll
                    for (int e = 0; e < 4; ++e) res[e] = silu_f(pre[e]) * val[e];
                    if (rt == 0) {
                        *(f32x4*)(edge + ((size_t)u.pm * 2 + 0) * FF + ch) = cur;
                        if (!seq_first) { float* pp = part + (((size_t)u.pm * 2 + 0) * FF + ch) * 2;
                            *(f32x4*)pp = (f32x4){pre[0], val[0], pre[1], val[1]}; *(f32x4*)(pp + 4) = (f32x4){pre[2], val[2], pre[3], val[3]}; }
                    }
                    if (rt == 255) {
                        *(f32x4*)(edge + ((size_t)u.pm * 2 + 1) * FF + ch) = cur;
                        if (!seq_last) { float* pp = part + (((size_t)u.pm * 2 + 1) * FF + ch) * 2;
                            *(f32x4*)pp = (f32x4){pre[0], val[0], pre[1], val[1]}; *(f32x4*)(pp + 4) = (f32x4){pre[2], val[2], pre[3], val[3]}; }
                    }
                    u32x2 w; w.x = cvt_pk_bf16(res[0], res[1]); w.y = cvt_pk_bf16(res[2], res[3]);
                    *(u32x2*)(ACT + row * FF + ch) = w;
                }
            }
        }
    }
};
namespace att {
typedef __attribute__((ext_vector_type(16))) float f32x16;
typedef __attribute__((ext_vector_type(4))) short s16x4;
typedef short v4i16_t __attribute__((ext_vector_type(4)));
typedef LAS const char* lptr;
__device__ __forceinline__ s16x4 vtr(lptr p) { return __builtin_bit_cast(s16x4, __builtin_amdgcn_ds_read_tr16_b64_v4i16((LAS v4i16_t*)p)); }
__device__ __forceinline__ bf16x8 pack8(const f32x16& s, int b) {
    u32x4 w; w.x = cvt_pk_bf16(s[b], s[b + 1]); w.y = cvt_pk_bf16(s[b + 2], s[b + 3]); w.z = cvt_pk_bf16(s[b + 4], s[b + 5]); w.w = cvt_pk_bf16(s[b + 6], s[b + 7]);
    return __builtin_bit_cast(bf16x8, w);
}
#define MFMA32(a, b, c) __builtin_amdgcn_mfma_f32_32x32x16_bf16((a), (b), (c), 0, 0, 0)

#define LGKM_WAIT(n) asm volatile("s_waitcnt lgkmcnt(" #n ")" ::: "memory")
#define SCHED_FENCE() __builtin_amdgcn_sched_barrier(0)
__device__ __forceinline__ bf16x8 rd128(unsigned addr, int off) { bf16x8 r; asm volatile("ds_read_b128 %0, %1 offset:%c2" : "=&v"(r) : "v"(addr), "i"(off) : "memory"); return r; }
__device__ __forceinline__ s16x4 rdtr(unsigned addr, int off) { s16x4 r; asm volatile("ds_read_b64_tr_b16 %0, %1 offset:%c2" : "=&v"(r) : "v"(addr), "i"(off) : "memory"); return r; }
#define VFRAG(lo, hh) ((bf16x8){lo[0], lo[1], lo[2], lo[3], hh[0], hh[1], hh[2], hh[3]})
constexpr int KROW = 144, VROWD = 320, VROWA = 192;
constexpr int DSTG = 2 * 64 * KROW + 64 * VROWD;
constexpr int ASTG = 64 * KROW + 64 * VROWA;

constexpr int DST3 = 32768;
__device__ __forceinline__ void diff_unit(LAS char* lds, const bf16* __restrict__ QKV, bf16* __restrict__ Y, int b, int h, int qb, float Mb, float lam, const float* __restrict__ subln, float outscale) {
    int tid = threadIdx.x; asm volatile("" : "+v"(tid)); const int lane = tid & 63, w = __builtin_amdgcn_readfirstlane(tid >> 6), q = lane & 31, hi = lane >> 5;
    const int rg = w >> 1, c = w & 1;
    const size_t rowQ = (size_t)b * S + qb * 128 + rg * 32 + q;
    const bf16* qp = QKV + rowQ * NIN + 768 + (2 * h + c) * 64 + hi * 8;
    bf16x8 qf[4];
#pragma unroll
    for (int ds = 0; ds < 4; ++ds) qf[ds] = *(const bf16x8*)(qp + ds * 16);
    const int krow = 8 * w + (lane >> 3), kch = (lane & 7) ^ ((krow >> 1) & 7);
    const int vrow = 4 * w + (lane >> 4), vch = (lane & 15) ^ ((vrow & 3) << 2);
    const bf16* kg = QKV + ((size_t)b * S + krow) * NIN + 1280 + 128 * h + kch * 8;
    const bf16* vg = QKV + ((size_t)b * S + vrow) * NIN + 1792 + 128 * h + vch * 8;
#define DDMA(t, so) do { const size_t o_ = (size_t)(t) * 64 * NIN; LAS unsigned char* d_ = (LAS unsigned char*)lds + (so) + w * 1024; \
        __builtin_amdgcn_global_load_lds((const unsigned*)(kg + o_), (LAS unsigned*)(d_), 16, 0, 0); \
        __builtin_amdgcn_global_load_lds((const unsigned*)(kg + o_ + 64), (LAS unsigned*)(d_ + 8192), 16, 0, 0); \
        __builtin_amdgcn_global_load_lds((const unsigned*)(vg + o_), (LAS unsigned*)(d_ + 16384), 16, 0, 0); \
        __builtin_amdgcn_global_load_lds((const unsigned*)(vg + o_ + 32 * NIN), (LAS unsigned*)(d_ + 16384 + 8192), 16, 0, 0); } while (0)
    f32x16 o[4];
#pragma unroll
    for (int i = 0; i < 4; ++i) o[i] = (f32x16){0.f};
    float l = 0.f;
    constexpr int NT = S / 64;
    DDMA(0, 0); DDMA(1, DST3);
    const unsigned lbase = (unsigned)(size_t)lds;
    unsigned kofs[4], vofs[4];
    { const int sw = (q >> 1) & 7, vq = (lane & 15) >> 2;
#pragma unroll
      for (int ds = 0; ds < 4; ++ds) kofs[ds] = (unsigned)(c * 8192 + q * 128 + (((2 * ds + hi) ^ sw) << 4));
#pragma unroll
      for (int db = 0; db < 4; ++db) vofs[db] = (unsigned)(16384 + (4 * hi + vq) * 256 + ((db ^ vq) << 6) + ((lane >> 4) & 1) * 32 + (lane & 3) * 8); }
    f32x16 negm;
#pragma unroll
    for (int r = 0; r < 16; ++r) negm[r] = -Mb;
    int so_cur = 0, so_nxt2 = 2 * DST3;
    for (int t = 0; t < NT; ++t) {
        asm volatile("s_waitcnt vmcnt(4)" ::: "memory");
        __builtin_amdgcn_s_barrier();
        asm volatile("" ::: "memory");
        { const int tn = (t + 2 < NT) ? t + 2 : NT - 1; DDMA(tn, so_nxt2); }
        const unsigned sb = lbase + so_cur;
        bf16x8 kf[8];
#pragma unroll
        for (int ds = 0; ds < 4; ++ds) { kf[2 * ds] = rd128(sb + kofs[ds], 0); kf[2 * ds + 1] = rd128(sb + kofs[ds], 32 * 128); }
        s16x4 vl[2][4], vh[2][4];
#pragma unroll
        for (int db = 0; db < 4; ++db) { vl[0][db] = rdtr(sb + vofs[db], 0); vh[0][db] = rdtr(sb + vofs[db], 8 * 256); }
        LGKM_WAIT(8); SCHED_FENCE();
        f32x16 s0 = negm, s1 = negm;
#pragma unroll
        for (int ds = 0; ds < 4; ++ds) { s0 = MFMA32(kf[2 * ds], qf[ds], s0); s1 = MFMA32(kf[2 * ds + 1], qf[ds], s1); }
        float ls = 0.f;
#pragma unroll
        for (int r = 0; r < 16; ++r) { s0[r] = __builtin_amdgcn_exp2f(s0[r]); s1[r] = __builtin_amdgcn_exp2f(s1[r]); ls += s0[r] + s1[r]; }
        l += ls;
        bf16x8 pf[4]; pf[0] = pack8(s0, 0); pf[1] = pack8(s0, 8); pf[2] = pack8(s1, 0); pf[3] = pack8(s1, 8);
        SCHED_FENCE();
#pragma unroll
        for (int ks = 0; ks < 4; ++ks) {
            if (ks < 3) {
#pragma unroll
                for (int db = 0; db < 4; ++db) { vl[(ks + 1) & 1][db] = rdtr(sb + vofs[db], (ks + 1) * 16 * 256); vh[(ks + 1) & 1][db] = rdtr(sb + vofs[db], (ks + 1) * 16 * 256 + 8 * 256); }
                LGKM_WAIT(8);
            } else { LGKM_WAIT(0); }
            SCHED_FENCE();
#pragma unroll
            for (int db = 0; db < 4; ++db) o[db] = MFMA32(VFRAG(vl[ks & 1][db], vh[ks & 1][db]), pf[ks], o[db]);
            SCHED_FENCE();
        }
        so_cur = (so_cur == 2 * DST3) ? 0 : so_cur + DST3; so_nxt2 = (so_nxt2 == 2 * DST3) ? 0 : so_nxt2 + DST3;
    }
#undef DDMA
    asm volatile("s_waitcnt vmcnt(0)" ::: "memory");
    __syncthreads();
    l += __shfl_xor(l, 32);
    const float inv = 1.f / l;
    LAS f32x4* xb = (LAS f32x4*)lds + rg * (16 * 64) + lane;
    if (c == 1) {
#pragma unroll
        for (int db = 0; db < 4; ++db)
#pragma unroll
            for (int r4 = 0; r4 < 4; ++r4) xb[(db * 4 + r4) * 64] = (f32x4){o[db][4 * r4], o[db][4 * r4 + 1], o[db][4 * r4 + 2], o[db][4 * r4 + 3]} * inv;
    }
    __syncthreads();
    if (c == 0) {
        float ss = 0.f;
#pragma unroll
        for (int db = 0; db < 4; ++db)
#pragma unroll
            for (int r4 = 0; r4 < 4; ++r4) { const f32x4 ot = xb[(db * 4 + r4) * 64];
#pragma unroll
                for (int e = 0; e < 4; ++e) { const float d = o[db][4 * r4 + e] * inv - lam * ot[e]; o[db][4 * r4 + e] = d; ss += d * d; } }
        ss += __shfl_xor(ss, 32);
        const float rs = rsqrtf(ss * (1.f / 128.f) + EPS) * outscale;
        bf16* yp = Y + rowQ * D + 512 + 128 * h + 4 * hi;
#pragma unroll
        for (int db = 0; db < 4; ++db)
#pragma unroll
            for (int r4 = 0; r4 < 4; ++r4) { const f32x4 gw = *(const f32x4*)(subln + 32 * db + 8 * r4 + 4 * hi);
                u32x2 wv; wv.x = cvt_pk_bf16(o[db][4 * r4] * rs * gw[0], o[db][4 * r4 + 1] * rs * gw[1]); wv.y = cvt_pk_bf16(o[db][4 * r4 + 2] * rs * gw[2], o[db][4 * r4 + 3] * rs * gw[3]);
                *(u32x2*)(yp + 32 * db + 8 * r4) = wv; }
    }
    __syncthreads();
}

__device__ __forceinline__ void swa_unit(LAS char* lds, const bf16* __restrict__ QKV, bf16* __restrict__ Y, int b, int kvh, int n, float Mb, const float* __restrict__ sink) {
    int tid = threadIdx.x; asm volatile("" : "+v"(tid)); const int lane = tid & 63, w = __builtin_amdgcn_readfirstlane(tid >> 6), q = lane & 31, hi = lane >> 5;
    const int head = kvh * 4 + (w >> 1), rb = (w & 1) * 64;
    const size_t rowQ = (size_t)b * S + n * 128 + rb + q;
    bf16x8 qf[2][4];
#pragma unroll
    for (int rg = 0; rg < 2; ++rg)
#pragma unroll
        for (int ds = 0; ds < 4; ++ds) qf[rg][ds] = *(const bf16x8*)(QKV + (rowQ + 32 * rg) * NIN + head * 64 + hi * 8 + ds * 16);
    const int lrow = tid >> 3, lcc = tid & 7;
    const long kp0 = (long)b * S + (long)(n - 1) * 128 + lrow;
    const bf16* kg = QKV + kp0 * NIN + 512 + kvh * 64 + lcc * 8;
    const bf16* vg = QKV + kp0 * NIN + 640 + kvh * 64 + lcc * 8;
    const int kdst = lrow * KROW + lcc * 16, vdst = 64 * KROW + lrow * VROWA + lcc * 16;
    u32x4 st0, st1;
#define ALOAD(t) do { const long o_ = (long)(t) * 64 * NIN; st0 = *(const u32x4*)(kg + o_); st1 = *(const u32x4*)(vg + o_); } while (0)
#define ASTORE(bo) do { *(LAS u32x4*)(lds + (bo) + kdst) = st0; *(LAS u32x4*)(lds + (bo) + vdst) = st1; } while (0)
    f32x16 o[2][2];
#pragma unroll
    for (int i = 0; i < 2; ++i)
#pragma unroll
        for (int j = 0; j < 2; ++j) o[i][j] = (f32x16){0.f};
    float l[2] = {0.f, 0.f};
    const int t0 = (n == 0) ? 2 : 0, t1 = (n == S / 128 - 1) ? 4 : 6;
    ALOAD(t0); ASTORE((t0 & 1) * ASTG); __syncthreads();
    const int koff = q * KROW + hi * 16;
    const int voff = 64 * KROW + (4 * hi + ((lane & 15) >> 2)) * VROWA + ((lane >> 4) & 1) * 32 + (lane & 3) * 8;
    for (int t = t0; t < t1; ++t) {
        const int cur = (t & 1) * ASTG, nxt = ASTG - cur;
        if (t + 1 < t1) ALOAD(t + 1);
        lptr kb = (lptr)(lds + cur + koff);
        lptr vb = (lptr)(lds + cur + voff);
#pragma unroll
        for (int rg = 0; rg < 2; ++rg) {
            const int i0 = rb + 32 * rg;
            if (64 * t + 63 >= i0 && 64 * t <= i0 + 31 + 256) {
                f32x16 s0 = (f32x16){0.f}, s1 = (f32x16){0.f};
#pragma unroll
                for (int ds = 0; ds < 4; ++ds) {
                    const bf16x8 k0 = *(const LAS bf16x8*)(kb + ds * 32), k1 = *(const LAS bf16x8*)(kb + 32 * KROW + ds * 32);
                    s0 = MFMA32(k0, qf[rg][ds], s0); s1 = MFMA32(k1, qf[rg][ds], s1);
                }
                const int jb = 64 * t + 4 * hi - (i0 + q);
                float ls = 0.f;
#pragma unroll
                for (int r = 0; r < 16; ++r) {
                    const int d0 = jb + (r & 3) + 8 * (r >> 2), d1 = d0 + 32;
                    const float p0 = __builtin_amdgcn_exp2f(s0[r] - Mb), p1 = __builtin_amdgcn_exp2f(s1[r] - Mb);
                    s0[r] = ((unsigned)d0 <= 256u) ? p0 : 0.f; s1[r] = ((unsigned)d1 <= 256u) ? p1 : 0.f; ls += s0[r] + s1[r];
                }
                l[rg] += ls;
                bf16x8 pf[4]; pf[0] = pack8(s0, 0); pf[1] = pack8(s0, 8); pf[2] = pack8(s1, 0); pf[3] = pack8(s1, 8);
#pragma unroll
                for (int ks = 0; ks < 4; ++ks)
#pragma unroll
                    for (int db = 0; db < 2; ++db) {
                        const s16x4 lo = vtr(vb + ks * 16 * VROWA + db * 64), hh = vtr(vb + ks * 16 * VROWA + 8 * VROWA + db * 64);
                        const bf16x8 vf = (bf16x8){lo[0], lo[1], lo[2], lo[3], hh[0], hh[1], hh[2], hh[3]};
                        o[rg][db] = MFMA32(vf, pf[ks], o[rg][db]);
                    }
            }
        }
        if (t + 1 < t1) ASTORE(nxt);
        __syncthreads();
    }
#undef ALOAD
#undef ASTORE
    const float sk = __builtin_amdgcn_exp2f(sink[head] * LOG2E - Mb);
#pragma unroll
    for (int rg = 0; rg < 2; ++rg) {
        float lt = l[rg]; lt += __shfl_xor(lt, 32);
        const float inv = 1.f / (lt + sk);
        bf16* yp = Y + (rowQ + 32 * rg) * D + head * 64 + 4 * hi;
#pragma unroll
        for (int db = 0; db < 2; ++db)
#pragma unroll
            for (int r4 = 0; r4 < 4; ++r4) { u32x2 wv; wv.x = cvt_pk_bf16(o[rg][db][4 * r4] * inv, o[rg][db][4 * r4 + 1] * inv); wv.y = cvt_pk_bf16(o[rg][db][4 * r4 + 2] * inv, o[rg][db][4 * r4 + 3] * inv);
                *(u32x2*)(yp + 32 * db + 8 * r4) = wv; }
    }
}
}
constexpr size_t MiB = 1u << 20;
constexpr size_t WS_CTL = 0, CTL_BYTES = 65536 + 4 * 65536;
constexpr size_t WS_ROWSQ = 65536;
constexpr int MISC_OFF = 131072 + 4096;
constexpr size_t WS_ROPE = 1 * MiB;
constexpr size_t WS_W = 2 * MiB, W_LAYER = 23 * MiB;
constexpr size_t W_IN = 0, W_OUT = (size_t)NIN * D * 2, W_UP = W_OUT + (size_t)D * D * 2, W_DOWN = W_UP + (size_t)NUP * D * 2;
static_assert(W_DOWN + (size_t)D * FF * 2 <= W_LAYER, "weights");
constexpr size_t WS_H = 48 * MiB;
constexpr size_t WS_QKV = 80 * MiB;
constexpr size_t WS_Y = 152 * MiB;
constexpr size_t WS_ACT = 80 * MiB;
constexpr size_t WS_EDGE = 184 * MiB;
constexpr size_t WS_PART = 186 * MiB;
constexpr size_t WS_END = 190 * MiB;
static_assert(WS_ACT + (size_t)M * FF * 2 <= WS_EDGE && WS_QKV + (size_t)M * NIN * 2 <= WS_Y && WS_Y + (size_t)M * D * 2 <= WS_EDGE, "ws map");

#ifndef REP_P0
#define REP_P0 1
#endif
#ifndef REP_P1
#define REP_P1 1
#endif
#ifndef REP_P3B
#define REP_P3B 1
#endif
#ifndef REP_P4
#define REP_P4 1
#endif
#ifndef ATT_REP
#define ATT_REP 1
#endif
#ifndef REP_P5
#define REP_P5 1
#endif
#ifndef REP_P3
#define REP_P3 1
#endif
#ifndef REP_SYNC
#define REP_SYNC 1
#endif
struct Args {
    const float *x, *g_attn, *w_in, *qn_a, *kn_a, *sink, *qn_b, *kn_b, *lq1, *lk1, *lq2, *lk2, *subln, *w_out, *g_ffn, *w_up, *conv_w, *conv_b, *w_down;
    float* out; unsigned char* ws;
    int rep[8];
};

__device__ __forceinline__ float wave_sum(float v) {
#pragma unroll
    for (int o = 1; o < 64; o <<= 1) v += __shfl_xor(v, o);
    return v;
}
__device__ __forceinline__ float wave_max(float v) {
#pragma unroll
    for (int o = 1; o < 64; o <<= 1) v = fmaxf(v, __shfl_xor(v, o));
    return v;
}
__device__ __forceinline__ unsigned f2bf(float f) { unsigned u = __builtin_bit_cast(unsigned, f); return (u + 0x7fffu + ((u >> 16) & 1u)) >> 16; }
__device__ __forceinline__ unsigned pk2(float lo, float hi) { return f2bf(lo) | (f2bf(hi) << 16); }

__device__ __forceinline__ void transpose_item(const float* __restrict__ W, int K, int N, bf16* __restrict__ WT, LAS float* scr, int kb, int nb, int dnb, int lane, const float* __restrict__ g) {
    const int k0 = 64 * kb, n0 = 32 * nb;
#pragma unroll 8
    for (int i = 0; i < 32; ++i) { const int kk = 2 * i + (lane >> 5); scr[kk * 33 + (lane & 31)] = W[(size_t)(k0 + kk) * N + n0 + (lane & 31)] * (g ? g[k0 + kk] : 1.f); }
    asm volatile("s_waitcnt lgkmcnt(0)" ::: "memory");
    const int c = lane & 7;
#pragma unroll
    for (int j = 0; j < 4; ++j) { const int n = (lane >> 3) + 8 * j; const LAS float* s = scr + (8 * c) * 33 + n;
        u32x4 o; o.x = pk2(s[0 * 33], s[1 * 33]); o.y = pk2(s[2 * 33], s[3 * 33]); o.z = pk2(s[4 * 33], s[5 * 33]); o.w = pk2(s[6 * 33], s[7 * 33]);
        *(u32x4*)(WT + (size_t)(32 * dnb + n) * K + k0 + 8 * c) = o; }
    asm volatile("s_waitcnt lgkmcnt(0)" ::: "memory");
}

__device__ __forceinline__ void convert_rows(const float* __restrict__ x, bf16* __restrict__ out, float* __restrict__ rowsq, int gw, int ngw, int lane) {
    for (int m = gw; m < M; m += ngw) {
        const f32x4* xr = (const f32x4*)(x + (size_t)m * D) + lane; f32x4 v[4]; float s = 0.f;
#pragma unroll
        for (int j = 0; j < 4; ++j) { v[j] = xr[64 * j]; s += dot4(v[j]); }
        s = wave_sum(s);
        if (lane == 0) rowsq[m] = s;
        u32x2* o8 = (u32x2*)(out + (size_t)m * D) + lane;
#pragma unroll
        for (int j = 0; j < 4; ++j) { u32x2 wv; wv.x = pk2(v[j][0], v[j][1]); wv.y = pk2(v[j][2], v[j][3]); o8[64 * j] = wv; }
    }
}

#define XB_TMO      128
#define XB_XCNT(j)  (256  + 64 * (j))
#define XB_XSUB(j)  (1280 + 64 * (j))
#define XB_XGEN(j)  (2304 + 64 * (j))
#define XB_TOP      3328
#define XB_TOPGEN   3392
#define XCD_BAR_WORDS 3456
#define XB_SPIN_CAP (1u << 18)

__device__ __forceinline__ unsigned xb_ld(unsigned* p)              { return __hip_atomic_load(p, __ATOMIC_RELAXED, __HIP_MEMORY_SCOPE_AGENT); }
__device__ __forceinline__ unsigned xb_add(unsigned* p, unsigned v) { return __hip_atomic_fetch_add(p, v, __ATOMIC_RELAXED, __HIP_MEMORY_SCOPE_AGENT); }
__device__ __forceinline__ unsigned xb_xcc_id() { return (unsigned)__builtin_amdgcn_s_getreg((3 << 11) | 20) & 0xFu; }
#define XB_SPIN(cond, bar) do { unsigned _sp = 0; while (cond) { __builtin_amdgcn_s_sleep(1); \
    if ((++_sp & 255u) == 0u) { if (xb_ld(&(bar)[XB_TMO])) break; if (_sp > XB_SPIN_CAP) { atomicAdd(&(bar)[XB_TMO], 1u); break; } } } } while (0)

struct XcdBarrier {
    unsigned* bar; unsigned x;
    volatile LAS unsigned* st;
};

__device__ __forceinline__ XcdBarrier xcd_barrier_post(unsigned* bar, volatile LAS unsigned* st) {
    XcdBarrier b; b.bar = bar; b.x = xb_xcc_id(); b.st = st;
    if (threadIdx.x == 0) (void)xb_add(&bar[XB_XCNT(b.x)], 1u);
    return b;
}
__device__ __forceinline__ void xcd_barrier_complete(unsigned* bar, unsigned x, unsigned& nloc, unsigned& nx) {
    const unsigned G = gridDim.x * gridDim.y * gridDim.z;
    unsigned sum, cnt, mine, sp = 0u;
    for (;;) {
        sum = 0u; cnt = 0u; mine = 0u;
#pragma unroll
        for (unsigned j = 0; j < 16; ++j) { const unsigned c = xb_ld(&bar[XB_XCNT(j)]); sum += c; cnt += (c > 0u) ? 1u : 0u; mine = (j == x) ? c : mine; }
        if (sum == G) break;
        __builtin_amdgcn_s_sleep(1);
        if ((++sp & 255u) == 0u) { if (xb_ld(&bar[XB_TMO])) break; if (sp > XB_SPIN_CAP) { atomicAdd(&bar[XB_TMO], 1u); break; } }
    }
    nloc = mine > 0u ? mine : 1u; nx = cnt > 0u ? cnt : 1u;
}

__device__ __forceinline__ void xcd_barrier(const XcdBarrier& b) {
    asm volatile("s_waitcnt vmcnt(0)" ::: "memory");
    __syncthreads();
    if (threadIdx.x == 0) {
        unsigned* bar = b.bar;
        __builtin_amdgcn_s_waitcnt(0);
        unsigned nloc = b.st[0], nx = b.st[1];
        if (nloc == 0u) { xcd_barrier_complete(bar, b.x, nloc, nx); b.st[0] = nloc; b.st[1] = nx; }
        const unsigned old = xb_add(&bar[XB_XSUB(b.x)], 1u);
        const unsigned gen = old / nloc;
        if (old + 1u == (gen + 1u) * nloc) {
            __builtin_amdgcn_fence(__ATOMIC_RELEASE, "agent");
            asm volatile("s_waitcnt vmcnt(0)" ::: "memory");
            const unsigned og = xb_add(&bar[XB_TOP], 1u);
            const unsigned tg = og / nx;
            if (og + 1u == (tg + 1u) * nx) xb_add(&bar[XB_TOPGEN], 1u);
            else XB_SPIN(xb_ld(&bar[XB_TOPGEN]) == tg, bar);
            __builtin_amdgcn_fence(__ATOMIC_ACQUIRE, "agent");
            xb_add(&bar[XB_XGEN(b.x)], 1u);
            asm volatile("s_waitcnt vmcnt(0)" ::: "memory");
        } else {
            XB_SPIN(xb_ld(&bar[XB_XGEN(b.x)]) == gen, bar);
            __builtin_amdgcn_fence(__ATOMIC_ACQUIRE, "agent");
            asm volatile("s_waitcnt vmcnt(0)" ::: "memory");
        }
    }
    __syncthreads();
}

__global__ void __launch_bounds__(512, 2) mega_fwd(Args a) {
    extern __shared__ __attribute__((aligned(16))) unsigned char lds_raw[];
    LAS unsigned char* lds = (LAS unsigned char*)lds_raw;
    cg::grid_group grid = cg::this_grid();
    const int tid = threadIdx.x, lane = tid & 63, wave = __builtin_amdgcn_readfirstlane(tid >> 6);
    const int G = gridDim.x, bx = blockIdx.x;
    const int vcu = (G % 8 == 0) ? (bx % 8) * (G / 8) + bx / 8 : bx;
    const int gw = vcu * 8 + wave, ngw = G * 8;
    unsigned char* ws = a.ws;
    float* cosT = (float*)(ws + WS_ROPE); float* sinT = cosT + S * 32;
    bf16* Hb = (bf16*)(ws + WS_H); bf16* QKV = (bf16*)(ws + WS_QKV); bf16* Yb = (bf16*)(ws + WS_Y); bf16* ACT = (bf16*)(ws + WS_ACT);
    float* edge = (float*)(ws + WS_EDGE); float* part = (float*)(ws + WS_PART); float* rowsq = (float*)(ws + WS_ROWSQ);
    volatile LAS unsigned* misc = (volatile LAS unsigned*)(lds + MISC_OFF);
    if (tid < 16) misc[tid] = 0u;
    __syncthreads();
    const XcdBarrier xbar = xcd_barrier_post((unsigned*)(ws + WS_CTL) + 1024, misc);

#define CONVERT_WEIGHTS(L, wv, nwv) do { \
        int lane = threadIdx.x & 63; asm volatile("" : "+v"(lane)); \
        LAS float* scr = (LAS float*)(lds + wave * 16384); \
        constexpr int I_IN = 16 * 72, I_OUT = 16 * 32, I_UP = 16 * 176, I_DOWN = 44 * 32, I_L = I_IN + I_OUT + I_UP + I_DOWN; \
        unsigned char* wl_ = ws + WS_W + (size_t)(L) * W_LAYER; \
        for (int it = (wv); it < I_L; it += (nwv)) { \
            int r = it; \
            if (r < I_IN) { const int kb = r / 72, nb = r % 72; const int pn = nb >> 3, wc = (nb >> 1) & 3, bj = nb & 1; \
                transpose_item(a.w_in + (size_t)(L) * D * NIN, D, NIN, (bf16*)(wl_ + W_IN), scr, kb, nb, 8 * pn + 4 * bj + wc, lane, a.g_attn + (L) * D); continue; } \
            r -= I_IN; \
            if (r < I_OUT) { const int kb = r / 32, nb = r % 32; transpose_item(a.w_out + (size_t)(L) * D * D, D, D, (bf16*)(wl_ + W_OUT), scr, kb, nb, nb, lane, nullptr); continue; } \
            r -= I_OUT; \
            if (r < I_UP) { const int kb = r / 176, nb = r % 176; const int isv = nb >= 88, nn = isv ? nb - 88 : nb; const int dnb = 8 * (nn >> 2) + 4 * isv + (nn & 3); \
                transpose_item(a.w_up + (size_t)(L) * D * NUP, D, NUP, (bf16*)(wl_ + W_UP), scr, kb, nb, dnb, lane, a.g_ffn + (L) * D); continue; } \
            r -= I_UP; \
            { const int kb = r / 32, nb = r % 32; transpose_item(a.w_down + (size_t)(L) * FF * D, FF, D, (bf16*)(wl_ + W_DOWN), scr, kb, nb, nb, lane, nullptr); } \
        } } while (0)
    {
        CONVERT_WEIGHTS(0, gw, ngw);
        for (int i = vcu * 512 + tid; i < S * 32; i += G * 512) {
            const int pos = i >> 5, j = i & 31;
            double inv = 1.0; for (int k = 0; k < j; ++k) inv *= 0.74989420933245582730;
            const double ang = (double)pos * inv;
            const double kq = __builtin_rint(ang * 0.15915494309189533577);
            const double rr = (ang - kq * 6.283185307179586232) - kq * 2.4492935982947064e-16;
            const double r2 = rr * rr;
            double sn = 1.0, cs = 1.0;
#pragma unroll
            for (int k = 12; k >= 1; --k) { sn = 1.0 - sn * r2 / (double)((2 * k) * (2 * k + 1)); cs = 1.0 - cs * r2 / (double)((2 * k - 1) * (2 * k)); }
            cosT[i] = (float)cs; sinT[i] = (float)(sn * rr);
        }
        convert_rows(a.x, Hb, rowsq, gw, ngw, lane);
    }
    asm volatile("s_waitcnt vmcnt(0)" ::: "memory");
    __syncthreads();
    if (tid == 0) { __builtin_amdgcn_fence(__ATOMIC_RELEASE, "agent"); asm volatile("s_waitcnt vmcnt(0)" ::: "memory"); }
    grid.sync();
    if (tid == 0) { __builtin_amdgcn_fence(__ATOMIC_ACQUIRE, "agent"); asm volatile("s_waitcnt vmcnt(0)" ::: "memory"); }
    __syncthreads();

    for (int l = 0; l < DEPTH; ++l) {
        const float lambda_init = 0.8f - 0.6f * __expf(-0.3f * (float)l);
        unsigned char* wl = ws + WS_W + (size_t)l * W_LAYER;
        {
            pg8::Gemm g{Hb, (const bf16*)(wl + W_IN), M, NIN, D}; pg8::StaticOrder So; So.init(M, NIN, G, bx);
            EpiInProj E{QKV, a.qn_a + l * 64, a.kn_a + l * 64, a.qn_b + l * 64, a.kn_b + l * 64, cosT, sinT, rowsq + (size_t)(2 * l) * M};
            for (int rep1 = 0; rep1 < a.rep[1]; ++rep1) pg8::gemm_phase<EpiInProj, pg8::StaticOrder, true, true>(lds, g, So, E);
            if (l == 0 && DEPTH > 1) {
                const int nidle = G - 64;
                if (nidle >= 64) { if (bx >= 64) CONVERT_WEIGHTS(1, (bx - 64) * 8 + wave, nidle * 8); }
                else CONVERT_WEIGHTS(1, gw, ngw);
            }
        }
        xcd_barrier(xbar);
        {
            int lane = threadIdx.x & 63; asm volatile("" : "+v"(lane));
            const float mqa = wave_max(fabsf(a.qn_a[l * 64 + lane])), mka = wave_max(fabsf(a.kn_a[l * 64 + lane]));
            const float mqb = wave_max(fabsf(a.qn_b[l * 64 + lane])), mkb = wave_max(fabsf(a.kn_b[l * 64 + lane]));
            const float MbA = 8.f * mqa * mka * LOG2E * 1.02f, MbB = 8.f * mqb * mkb * LOG2E * 1.02f;
            const float s1 = wave_sum(a.lq1[l * 64 + lane] * a.lk1[l * 64 + lane]), s2 = wave_sum(a.lq2[l * 64 + lane] * a.lk2[l * 64 + lane]);
            const float lam = __expf(s1) - __expf(s2) + lambda_init;
            for (int rep = 0; rep < a.rep[5]; ++rep) {
            for (int uidx = vcu; uidx < NB * 4 * 16; uidx += G) {
                const int bh = uidx >> 4, qb = uidx & 15;
                att::diff_unit((LAS char*)lds, QKV, Yb, bh >> 2, bh & 3, qb, MbB, lam, a.subln + l * 128, 1.f - lambda_init);
            }
            for (int uidx = vcu; uidx < NB * 2 * 16; uidx += G) {
                const int bk = uidx >> 4, n = uidx & 15;
                att::swa_unit((LAS char*)lds, QKV, Yb, bk >> 1, bk & 1, n, MbA, a.sink + l * 8);
            }
            __syncthreads();
            }
        }
        xcd_barrier(xbar);
        {
            pg8::Gemm g{Yb, (const bf16*)(wl + W_OUT), M, D, D}; pg8::StaticOrder So; So.init(M, D, G, bx);
            EpiResid E{Hb, rowsq + (size_t)(2 * l + 1) * M, nullptr};
            pg8::gemm_phase<EpiResid, pg8::StaticOrder, true, true>(lds, g, So, E);
        }
        xcd_barrier(xbar);
        {
            pg8::Gemm g{Hb, (const bf16*)(wl + W_UP), M, NUP, D}; pg8::StaticOrder So; So.init(M, NUP, G, bx);
            EpiUpConv E{ACT, a.conv_w + (size_t)l * 3 * FF, a.conv_b + (size_t)l * FF, edge, part, (LAS float*)(lds + XL_OFF), rowsq + (size_t)(2 * l + 1) * M};
            for (int rep4 = 0; rep4 < a.rep[3]; ++rep4) pg8::gemm_phase<EpiUpConv, pg8::StaticOrder, true, true>(lds, g, So, E);
        }
        xcd_barrier(xbar);
        {
            pg8::Gemm g{ACT, (const bf16*)(wl + W_DOWN), M, D, FF}; pg8::StaticOrder So; So.init(M, D, G, bx);
            { const float* cw = a.conv_w + (size_t)l * 3 * FF; pg8::Unit uu; int tid = threadIdx.x; asm volatile("" : "+v"(tid));
              for (int ui = 0; So.next(ui, uu); ++ui) { const int pm = uu.pm;
                for (int i = tid; i < 2 * FF; i += 512) { const int which = i / FF, ch = i % FF;
                    if (which == 0 && (pm & 7) != 0) { const float* pp = part + (((size_t)pm * 2 + 0) * FF + ch) * 2;
                        const float pre = pp[0] + cw[ch] * edge[((size_t)(pm - 1) * 2 + 1) * FF + ch];
                        ACT[(size_t)(pm * 256) * FF + ch] = (bf16)f2bf(silu_f(pre) * pp[1]); }
                    if (which == 1 && (pm & 7) != 7) { const float* pp = part + (((size_t)pm * 2 + 1) * FF + ch) * 2;
                        const float pre = pp[0] + cw[2 * FF + ch] * edge[((size_t)(pm + 1) * 2 + 0) * FF + ch];
                        ACT[(size_t)(pm * 256 + 255) * FF + ch] = (bf16)f2bf(silu_f(pre) * pp[1]); } } }
              asm volatile("s_waitcnt vmcnt(0)" ::: "memory"); __syncthreads(); }
            const bool lastl = (l + 1 == DEPTH);
            EpiResid E{Hb, lastl ? nullptr : rowsq + (size_t)(2 * l + 2) * M, lastl ? a.out : nullptr};
            pg8::gemm_phase<EpiResid, pg8::StaticOrder, true, true>(lds, g, So, E);
        }
        if (l + 1 < DEPTH) xcd_barrier(xbar);
    }
}

extern "C" void kernel_launch(void* const* d_in, const int* in_sizes, int n_in, void* d_out, int out_size, void* d_ws, size_t ws_size, hipStream_t stream) {
    static int grid = 0;
    if (grid == 0) {
        if (n_in != 19 || ws_size < WS_END) { fprintf(stderr, "kernel_launch: unexpected inputs (n_in %d, ws %zu)\n", n_in, ws_size); grid = -1; return; }
        int dev = 0, cus = 0, per_cu = 0;
        hipGetDevice(&dev);
        hipDeviceGetAttribute(&cus, hipDeviceAttributeMultiprocessorCount, dev);
        hipFuncSetAttribute((const void*)mega_fwd, hipFuncAttributeMaxDynamicSharedMemorySize, LDS_BYTES);
        hipOccupancyMaxActiveBlocksPerMultiprocessor(&per_cu, (const void*)mega_fwd, 512, LDS_BYTES);
        if (per_cu < 1) { fprintf(stderr, "kernel_launch: occupancy query reports %d blocks per CU\n", per_cu); per_cu = 1; }
        grid = cus;
        (void)hipGetLastError();
    }
    if (grid < 0) return;
    if (hipMemsetAsync((char*)d_ws + WS_CTL, 0, CTL_BYTES, stream) != hipSuccess) { fprintf(stderr, "kernel_launch: memset failed\n"); return; }
    Args a{};
    const float** p = (const float**)&a;
    for (int i = 0; i < 19; ++i) p[i] = (const float*)d_in[i];
    a.out = (float*)d_out; a.ws = (unsigned char*)d_ws;
    { const int reps[8] = {REP_P0, REP_P1, REP_P3B, REP_P4, 1, ATT_REP, REP_P3, REP_P5}; for (int i = 0; i < 8; ++i) a.rep[i] = reps[i]; }
    void* args[] = {&a};
    hipError_t e = hipLaunchCooperativeKernel((const void*)mega_fwd, dim3(grid), dim3(512), args, LDS_BYTES, stream);
    if (e != hipSuccess) fprintf(stderr, "cooperative launch failed: %s (grid %d)\n", hipGetErrorString(e), grid);
}
```

```cpp
#include <hip/hip_runtime.h>
#include <hip/hip_cooperative_groups.h>
#include <cstdio>
#include <cstdint>
namespace cg = cooperative_groups;
namespace pg8 {
#define PG8_LAS __attribute__((address_space(3)))
typedef unsigned short bf16_t;
typedef short bf16x8 __attribute__((ext_vector_type(8)));
typedef float f32x4 __attribute__((ext_vector_type(4)));
typedef unsigned u32x4 __attribute__((ext_vector_type(4)));
constexpr int BM = 256, BK = 64, HALF = 128, HTB = HALF * BK * 2  , STAGE_BYTES = 8 * HTB, NXCD = 8, WGM = 8;

__host__ __device__ __forceinline__ int lds_byte(int r, int c) { const int st = (r >> 4) * 2 + (c >> 5), rr = r & 15, cc = c & 31, ob = rr * 64 + cc * 2; return st * 1024 + (ob ^ (((ob >> 9) & 1) << 5)); }
__host__ __device__ __forceinline__ void stage_rc(int b, int& R, int& C) { const int st = b / 1024, sb = b % 1024, swz = sb ^ (((sb >> 9) & 1) << 5); R = (st >> 1) * 16 + swz / 64; C = (st & 1) * 32 + (swz % 64) / 2; }
__host__ __device__ __forceinline__ int perm32(int rho) { const int n = rho >> 4, i = rho & 15; return 8 * (i >> 2) + 4 * n + (i & 3); }

struct Unit { int pm, pn; };
struct Gemm { const bf16_t* A; const bf16_t* Bt; int M, N, K; };

struct StaticOrder {
    int nM, nN, nwg, G, c;
    __host__ __device__ void init(int M, int N, int G_, int c_) { nM = M / BM; nN = N / BM; nwg = nM * nN; G = G_; c = c_; }
    __host__ __device__ bool next(int i, Unit& u) const {
        const long L = (long)i * G + c; if (L >= nwg) return false;
        int wgid = (int)L; { const int q = nwg / NXCD, r = nwg % NXCD, xcd = wgid % NXCD, off = wgid / NXCD; wgid = (xcd < r ? xcd * (q + 1) : r * (q + 1) + (xcd - r) * q) + off; }
        const int nig = WGM * nN, gid = wgid / nig, fm = gid * WGM, gsz = (nM - fm) < WGM ? (nM - fm) : WGM;
        u.pm = fm + ((wgid % nig) % gsz); u.pn = (wgid % nig) / gsz; return true;
    }
    __device__ __forceinline__ void a_ready(const Unit&) const {}
    __device__ __forceinline__ void done(const Unit&) const {}
};

__device__ __forceinline__ unsigned cvt_pk_bf16(float lo, float hi) { unsigned r; asm volatile("v_cvt_pk_bf16_f32 %0, %1, %2" : "=v"(r) : "v"(lo), "v"(hi)); return r; }
template <class Epi, class Sched, bool ALIGN_EPI = false, bool SP2 = false>
__device__ __forceinline__ void gemm_phase(PG8_LAS unsigned char* lds, const Gemm g, const Sched& S, const Epi& E) {
    int tid = threadIdx.x; asm volatile("" : "+v"(tid)); const int wid = __builtin_amdgcn_readfirstlane(tid >> 6), lane = tid & 63, wr = wid >> 2, wc = wid & 3, fr = lane & 15, fq = lane >> 4;
    const int K = g.K, nt = K / BK;
    unsigned voffA[2], voffB[2];
#pragma unroll
    for (int i = 0; i < 2; ++i) { int R, C; stage_rc(tid * 16 + i * 8192, R, C); const int Rb = Epi::PERM ? ((R & ~31) + perm32(R & 31)) : R;
        voffA[i] = (unsigned)(R * K + C) * 2u; voffB[i] = (unsigned)(Rb * K + C) * 2u; }
    const size_t kstep = (size_t)(BK * 2);
    const size_t hstep = (size_t)HALF * K * 2;
    const size_t tstep = 2 * hstep;
    const unsigned ldsw = (unsigned)wid * 1024u;
    const int aoff = lds_byte(wr * 64 + fr, fq * 8), boff = lds_byte(wc * 32 + fr, fq * 8);
#define PG8_SA(b, h) (((b) * 2 + (h)) * HTB)
#define PG8_SB(b, h) ((4 + (b) * 2 + (h)) * HTB)
#define PG8_STAGE(bufoff, gbase, voff) do { _Pragma("unroll") for (int _i = 0; _i < 2; ++_i) \
        __builtin_amdgcn_global_load_lds((const unsigned*)((const char*)(gbase) + (voff)[_i]), (PG8_LAS unsigned*)(lds + (bufoff) + ldsw + _i * 8192), 16, 0, 0); } while (0)
#define PG8_LDA(dst, b, h) do { _Pragma("unroll") for (int m = 0; m < 4; ++m) _Pragma("unroll") for (int k = 0; k < 2; ++k) dst[m][k] = *(const PG8_LAS bf16x8*)(lds + PG8_SA(b, h) + aoff + m * 2048 + k * 1024); } while (0)
#define PG8_LDB(dst, b, h) do { _Pragma("unroll") for (int n = 0; n < 2; ++n) _Pragma("unroll") for (int k = 0; k < 2; ++k) dst[n][k] = *(const PG8_LAS bf16x8*)(lds + PG8_SB(b, h) + boff + n * 2048 + k * 1024); } while (0)
#define PG8_MMA(ai, bj, At, Bt) do { __builtin_amdgcn_s_setprio(1); _Pragma("unroll") for (int m = 0; m < 4; ++m) _Pragma("unroll") for (int n = 0; n < 2; ++n) _Pragma("unroll") for (int k = 0; k < 2; ++k) \
        acc[ai][bj][m][n] = __builtin_amdgcn_mfma_f32_16x16x32_bf16(Bt[n][k], At[m][k], acc[ai][bj][m][n], 0, 0, 0); __builtin_amdgcn_s_setprio(0); } while (0)
#define PG8_WAIT_V(n) asm volatile("s_waitcnt vmcnt(" #n ")" ::: "memory")
#define PG8_WAIT_L(n) asm volatile("s_waitcnt lgkmcnt(" #n ")" ::: "memory")
#define PG8_BAR __builtin_amdgcn_s_barrier()
#define PG8_SCHED __builtin_amdgcn_sched_barrier(0)
    Unit cur, nxt; int ui = 0;
    if (!S.next(0, cur)) return;
    f32x4 acc[2][2][4][2];
#pragma unroll
    for (int a = 0; a < 2; ++a)
#pragma unroll
        for (int b = 0; b < 2; ++b)
#pragma unroll
            for (int m = 0; m < 4; ++m)
#pragma unroll
                for (int n = 0; n < 2; ++n) acc[a][b][m][n] = (f32x4){0.f, 0.f, 0.f, 0.f};
    bf16x8 At[4][2], B0[2][2], B1[2][2];
    const char* cA = (const char*)g.A + (size_t)cur.pm * tstep; const char* cB = (const char*)g.Bt + (size_t)cur.pn * tstep;
    S.a_ready(cur);
    if constexpr (SP2) {
        PG8_STAGE(PG8_SB(0, 0), cB, voffB); PG8_STAGE(PG8_SB(0, 1), cB + hstep, voffB); PG8_STAGE(PG8_SA(0, 0), cA, voffA); PG8_STAGE(PG8_SA(0, 1), cA + hstep, voffA);
        if (wr == 1) PG8_BAR;
        PG8_WAIT_V(2); PG8_BAR;
        PG8_STAGE(PG8_SB(1, 0), cB + kstep, voffB); PG8_STAGE(PG8_SA(1, 0), cA + kstep, voffA); PG8_STAGE(PG8_SB(1, 1), cB + hstep + kstep, voffB);
        PG8_WAIT_V(6); PG8_BAR;
    } else {
        PG8_STAGE(PG8_SB(0, 0), cB, voffB); PG8_STAGE(PG8_SA(0, 0), cA, voffA); PG8_STAGE(PG8_SB(0, 1), cB + hstep, voffB); PG8_STAGE(PG8_SA(0, 1), cA + hstep, voffA);
        if (wr == 1) PG8_BAR;
        PG8_WAIT_V(4); PG8_BAR;
        PG8_STAGE(PG8_SB(1, 0), cB + kstep, voffB); PG8_STAGE(PG8_SA(1, 0), cA + kstep, voffA); PG8_STAGE(PG8_SB(1, 1), cB + hstep + kstep, voffB);
        PG8_WAIT_V(6); PG8_BAR;
    }
    for (;;) {
        const bool has_next = S.next(ui + 1, nxt);
        const char* nA = has_next ? (const char*)g.A + (size_t)nxt.pm * tstep : cA; const char* nB = has_next ? (const char*)g.Bt + (size_t)nxt.pn * tstep : cB;
        for (int t = 0; t < nt; t += 2) {
            const bool last = (t == nt - 2);
            const char* a1 = cA + (size_t)(t + 1) * kstep;
            const char* a2 = last ? nA : cA + (size_t)(t + 2) * kstep; const char* b2 = last ? nB : cB + (size_t)(t + 2) * kstep;
            const char* a3 = a2 + kstep; const char* b3 = b2 + kstep;
            if (last && has_next) S.a_ready(nxt);
            if constexpr (SP2) {
            PG8_LDB(B0, 0, 0); PG8_LDB(B1, 0, 1); PG8_SCHED; PG8_LDA(At, 0, 0); PG8_STAGE(PG8_SA(1, 1), a1 + hstep, voffA);
            PG8_WAIT_V(8); PG8_WAIT_L(0); PG8_BAR; PG8_MMA(0, 0, At, B0); PG8_MMA(0, 1, At, B1); PG8_BAR; PG8_SCHED;
            PG8_LDA(At, 0, 1); PG8_STAGE(PG8_SB(0, 0), b2, voffB); PG8_STAGE(PG8_SB(0, 1), b2 + hstep, voffB); PG8_STAGE(PG8_SA(0, 0), a2, voffA);
            PG8_WAIT_V(8); PG8_WAIT_L(0); PG8_BAR; PG8_MMA(1, 0, At, B0); PG8_MMA(1, 1, At, B1); PG8_BAR; PG8_SCHED;
            PG8_LDB(B0, 1, 0); PG8_LDB(B1, 1, 1); PG8_SCHED; PG8_LDA(At, 1, 0); PG8_STAGE(PG8_SA(0, 1), a2 + hstep, voffA);
            PG8_WAIT_V(8); PG8_WAIT_L(0); PG8_BAR; PG8_MMA(0, 0, At, B0); PG8_MMA(0, 1, At, B1); PG8_BAR; PG8_SCHED;
            PG8_LDA(At, 1, 1); PG8_STAGE(PG8_SB(1, 0), b3, voffB); PG8_STAGE(PG8_SB(1, 1), b3 + hstep, voffB); PG8_STAGE(PG8_SA(1, 0), a3, voffA);
            PG8_WAIT_V(8); PG8_WAIT_L(0); PG8_BAR; PG8_MMA(1, 0, At, B0); PG8_MMA(1, 1, At, B1); PG8_BAR; PG8_SCHED;
            } else {
            PG8_LDB(B0, 0, 0); PG8_SCHED; PG8_LDA(At, 0, 0); PG8_STAGE(PG8_SA(1, 1), a1 + hstep, voffA);
            PG8_WAIT_L(8); PG8_BAR; PG8_WAIT_L(0); PG8_MMA(0, 0, At, B0); PG8_BAR; PG8_SCHED;
            PG8_LDB(B1, 0, 1); PG8_STAGE(PG8_SB(0, 0), b2, voffB);
            PG8_BAR; PG8_WAIT_L(0); PG8_MMA(0, 1, At, B1); PG8_BAR;
            PG8_LDA(At, 0, 1); PG8_STAGE(PG8_SA(0, 0), a2, voffA);
            PG8_BAR; PG8_WAIT_L(0); PG8_MMA(1, 0, At, B0); PG8_BAR; PG8_SCHED;
            PG8_STAGE(PG8_SB(0, 1), b2 + hstep, voffB);
            PG8_WAIT_V(6); PG8_BAR; PG8_MMA(1, 1, At, B1); PG8_BAR;
            PG8_LDB(B0, 1, 0); PG8_SCHED; PG8_LDA(At, 1, 0); PG8_STAGE(PG8_SA(0, 1), a2 + hstep, voffA);
            PG8_WAIT_L(8); PG8_BAR; PG8_WAIT_L(0); PG8_MMA(0, 0, At, B0); PG8_BAR; PG8_SCHED;
            PG8_LDB(B1, 1, 1); PG8_STAGE(PG8_SB(1, 0), b3, voffB);
            PG8_BAR; PG8_WAIT_L(0); PG8_MMA(0, 1, At, B1); PG8_BAR;
            PG8_LDA(At, 1, 1); PG8_STAGE(PG8_SA(1, 0), a3, voffA);
            PG8_BAR; PG8_WAIT_L(0); PG8_MMA(1, 0, At, B0); PG8_BAR; PG8_SCHED;
            PG8_STAGE(PG8_SB(1, 1), b3 + hstep, voffB);
            PG8_WAIT_V(6); PG8_BAR; PG8_MMA(1, 1, At, B1); PG8_BAR;
            }
        }
        if constexpr (ALIGN_EPI) { if (wr == 0) PG8_BAR; }
        if constexpr (!Epi::AFTER_DRAIN) { E(acc, cur, wr, wc, fr, fq); S.done(cur); }
        if (!has_next) break;
#pragma unroll
        for (int a = 0; a < 2; ++a)
#pragma unroll
            for (int b = 0; b < 2; ++b)
#pragma unroll
                for (int m = 0; m < 4; ++m)
#pragma unroll
                    for (int n = 0; n < 2; ++n) acc[a][b][m][n] = (f32x4){0.f, 0.f, 0.f, 0.f};
        cur = nxt; cA = nA; cB = nB; ++ui;
        if constexpr (ALIGN_EPI) { if (wr == 1) PG8_BAR; }
    }
    PG8_WAIT_V(0);
    if constexpr (!ALIGN_EPI) { if (wr == 0) PG8_BAR; }
    PG8_BAR;
    if constexpr (Epi::AFTER_DRAIN) { E.fused(acc, cur, wr, wc, fr, fq, lds, wid, lane); S.done(cur); }
#undef PG8_SA
#undef PG8_SB
#undef PG8_STAGE
#undef PG8_LDA
#undef PG8_LDB
#undef PG8_MMA
#undef PG8_WAIT_V
#undef PG8_WAIT_L
#undef PG8_BAR
#undef PG8_SCHED
}
}
#define LAS __attribute__((address_space(3)))
typedef unsigned short bf16;
using pg8::f32x4; using pg8::u32x4; using pg8::Unit; using pg8::cvt_pk_bf16; using pg8::bf16x8;
typedef unsigned u32x2 __attribute__((ext_vector_type(2)));

constexpr int NB = 8, S = 2048, D = 1024, M = NB * S, NIN = 2304, FF = 2816, NUP = 2 * FF, DEPTH = 2;
constexpr float EPS = 1e-6f;
constexpr float LOG2E = 1.4426950408889634f;
constexpr float QSCALE = 0.125f * LOG2E;
constexpr int XL_OFF = 131072;
constexpr int LDS_BYTES = 131072 + 8192;

__device__ __forceinline__ float dot4(f32x4 a) { return (a[0] * a[0] + a[1] * a[1]) + (a[2] * a[2] + a[3] * a[3]); }
__device__ __forceinline__ float silu_f(float v) { return v * __builtin_amdgcn_rcpf(1.f + __expf(-v)); }

struct EpiInProj {
    static constexpr bool PERM = true, AFTER_DRAIN = false;
    bf16* O; const float* qn_a; const float* kn_a; const float* qn_b; const float* kn_b; const float* cosT; const float* sinT; const float* rowsq;
    __device__ __forceinline__ void operator()(const f32x4 (&acc)[2][2][4][2], const Unit& u, int wr, int wc, int fr, int fq) const {
        asm volatile("" : "+v"(fr), "+v"(fq));
        const int pn = u.pn;
        const float* g = nullptr; float sc = 1.f;
        if (pn < 2) { g = qn_a; sc = QSCALE; }
        else if (pn == 2) { if (wc < 2) g = kn_a; }
        else if (pn < 5) { g = qn_b; sc = QSCALE; }
        else if (pn < 7) { g = kn_b; }
        const int colb = pn * 256 + wc * 64 + 8 * fq;
        const int row0 = u.pm * 256 + wr * 64 + fr;
        if (g) {
            f32x4 g1[2], g2[2];
#pragma unroll
            for (int n = 0; n < 2; ++n) { g1[n] = *(const f32x4*)(g + 8 * fq + 4 * n); g2[n] = *(const f32x4*)(g + 32 + 8 * fq + 4 * n); }
#pragma unroll
            for (int ai = 0; ai < 2; ++ai)
#pragma unroll
                for (int m = 0; m < 4; ++m) {
                    const int row = row0 + ai * 128 + m * 16;
                    const f32x4 a0 = acc[ai][0][m][0], a1 = acc[ai][0][m][1], b0 = acc[ai][1][m][0], b1 = acc[ai][1][m][1];
                    float ss = (dot4(a0) + dot4(a1)) + (dot4(b0) + dot4(b1));
                    ss += __shfl_xor(ss, 16); ss += __shfl_xor(ss, 32);
                    const float rx = rsqrtf(rowsq[row] * (1.f / D) + EPS);
                    const float rs = rsqrtf(ss * rx * rx * (1.f / 64.f) + EPS) * rx * sc;
                    const size_t ro = (size_t)(row & (S - 1)) * 32 + 8 * fq;
                    const f32x4 c0 = *(const f32x4*)(cosT + ro), c1 = *(const f32x4*)(cosT + ro + 4), s0 = *(const f32x4*)(sinT + ro), s1 = *(const f32x4*)(sinT + ro + 4);
                    const f32x4 y10 = a0 * rs * g1[0], y11 = a1 * rs * g1[1], y20 = b0 * rs * g2[0], y21 = b1 * rs * g2[1];
                    const f32x4 o10 = y10 * c0 - y20 * s0, o11 = y11 * c1 - y21 * s1, o20 = y20 * c0 + y10 * s0, o21 = y21 * c1 + y11 * s1;
                    u32x4 w1, w2;
                    w1.x = cvt_pk_bf16(o10[0], o10[1]); w1.y = cvt_pk_bf16(o10[2], o10[3]); w1.z = cvt_pk_bf16(o11[0], o11[1]); w1.w = cvt_pk_bf16(o11[2], o11[3]);
                    w2.x = cvt_pk_bf16(o20[0], o20[1]); w2.y = cvt_pk_bf16(o20[2], o20[3]); w2.z = cvt_pk_bf16(o21[0], o21[1]); w2.w = cvt_pk_bf16(o21[2], o21[3]);
                    bf16* op = O + (size_t)row * NIN + colb;
                    *(u32x4*)op = w1; *(u32x4*)(op + 32) = w2;
                }
        } else {
#pragma unroll
            for (int ai = 0; ai < 2; ++ai)
#pragma unroll
                for (int m = 0; m < 4; ++m) {
                    const int row = row0 + ai * 128 + m * 16;
                    bf16* op = O + (size_t)row * NIN + colb;
                    const float rx = rsqrtf(rowsq[row] * (1.f / D) + EPS);
#pragma unroll
                    for (int bj = 0; bj < 2; ++bj) { const f32x4 v0 = acc[ai][bj][m][0] * rx, v1 = acc[ai][bj][m][1] * rx; u32x4 w;
                        w.x = cvt_pk_bf16(v0[0], v0[1]); w.y = cvt_pk_bf16(v0[2], v0[3]); w.z = cvt_pk_bf16(v1[0], v1[1]); w.w = cvt_pk_bf16(v1[2], v1[3]);
                        *(u32x4*)(op + 32 * bj) = w; }
                }
        }
    }
};

__device__ __forceinline__ f32x4 bf2f_lo(unsigned a, unsigned b) { return (f32x4){__uint_as_float(a << 16), __uint_as_float(a & 0xffff0000u), __uint_as_float(b << 16), __uint_as_float(b & 0xffff0000u)}; }
struct EpiResid {
    static constexpr bool PERM = true, AFTER_DRAIN = false;
    bf16* XB; float* rowsq; float* outf;
    __device__ __forceinline__ void operator()(const f32x4 (&acc)[2][2][4][2], const Unit& u, int wr, int wc, int fr, int fq) const {
        asm volatile("" : "+v"(fr), "+v"(fq));
        const int col0 = u.pn * 256 + wc * 32 + 8 * fq, row0 = u.pm * 256 + wr * 64 + fr;
#pragma unroll
        for (int ai = 0; ai < 2; ++ai) {
            u32x4 xr[4][2];
#pragma unroll
            for (int m = 0; m < 4; ++m) { const size_t off = (size_t)(row0 + ai * 128 + m * 16) * D + col0;
#pragma unroll
                for (int bj = 0; bj < 2; ++bj) xr[m][bj] = *(const u32x4*)(XB + off + bj * 128); }
            asm volatile("" ::: "memory");
#pragma unroll
            for (int m = 0; m < 4; ++m) { const int row = row0 + ai * 128 + m * 16; const size_t off = (size_t)row * D + col0; float ss = 0.f;
#pragma unroll
                for (int bj = 0; bj < 2; ++bj) {
                    const f32x4 y0 = bf2f_lo(xr[m][bj].x, xr[m][bj].y) + acc[ai][bj][m][0], y1 = bf2f_lo(xr[m][bj].z, xr[m][bj].w) + acc[ai][bj][m][1];
                    ss += dot4(y0) + dot4(y1);
                    if (outf) { *(f32x4*)(outf + off + bj * 128) = y0; *(f32x4*)(outf + off + bj * 128 + 4) = y1; }
                    else { u32x4 w; w.x = cvt_pk_bf16(y0[0], y0[1]); w.y = cvt_pk_bf16(y0[2], y0[3]); w.z = cvt_pk_bf16(y1[0], y1[1]); w.w = cvt_pk_bf16(y1[2], y1[3]); *(u32x4*)(XB + off + bj * 128) = w; }
                }
                if (rowsq) { ss += __shfl_xor(ss, 16); ss += __shfl_xor(ss, 32); if (fq == 0) atomicAdd(rowsq + row, ss); }
            }
            asm volatile("" ::: "memory");
        }
    }
};

struct EpiUpConv {
    static constexpr bool PERM = true, AFTER_DRAIN = false;
    bf16* ACT; const float* cw; const float* cb; float* edge; float* part; LAS float* xl; const float* rowsq;
    __device__ __forceinline__ void operator()(f32x4 (&acc)[2][2][4][2], const Unit& u, int wr, int wc, int fr, int fq) const {
        asm volatile("" : "+v"(fr), "+v"(fq));
        const int lane = 16 * fq + fr;
        const int cl0 = 32 * wc + 8 * fq, ch0 = 128 * u.pn + cl0;
#pragma unroll
        for (int ai = 0; ai < 2; ++ai)
#pragma unroll
            for (int m = 0; m < 4; ++m) { const float rx = rsqrtf(rowsq[u.pm * 256 + ai * 128 + wr * 64 + m * 16 + fr] * (1.f / D) + EPS);
#pragma unroll
                for (int bj = 0; bj < 2; ++bj) { acc[ai][bj][m][0] *= rx; acc[ai][bj][m][1] *= rx; } }
#pragma unroll
        for (int ai = 0; ai < 2; ++ai) {
            const int chunk = 2 * ai + wr;
            if (fr == 0) { *(LAS f32x4*)(xl + (chunk * 2 + 0) * 128 + cl0) = acc[ai][0][0][0]; *(LAS f32x4*)(xl + (chunk * 2 + 0) * 128 + cl0 + 4) = acc[ai][0][0][1]; }
            if (fr == 15) { *(LAS f32x4*)(xl + (chunk * 2 + 1) * 128 + cl0) = acc[ai][0][3][0]; *(LAS f32x4*)(xl + (chunk * 2 + 1) * 128 + cl0 + 4) = acc[ai][0][3][1]; }
        }
        asm volatile("s_waitcnt lgkmcnt(0)" ::: "memory"); __builtin_amdgcn_s_barrier(); asm volatile("" ::: "memory");
        const int lup = (lane & ~15) | ((fr + 15) & 15), ldn = (lane & ~15) | ((fr + 1) & 15);
        const bool seq_first = (u.pm & 7) == 0, seq_last = (u.pm & 7) == 7;
#pragma unroll
        for (int ai = 0; ai < 2; ++ai) {
            const int chunk = 2 * ai + wr;
#pragma unroll
            for (int n = 0; n < 2; ++n) {
                const int ch = ch0 + 4 * n;
                const f32x4 w0 = *(const f32x4*)(cw + ch), w1 = *(const f32x4*)(cw + FF + ch), w2 = *(const f32x4*)(cw + 2 * FF + ch), bb = *(const f32x4*)(cb + ch);
                const f32x4 above = (chunk > 0) ? *(const LAS f32x4*)(xl + ((chunk - 1) * 2 + 1) * 128 + cl0 + 4 * n) : (f32x4){0.f, 0.f, 0.f, 0.f};
                const f32x4 below = (chunk < 3) ? *(const LAS f32x4*)(xl + ((chunk + 1) * 2 + 0) * 128 + cl0 + 4 * n) : (f32x4){0.f, 0.f, 0.f, 0.f};
                f32x4 Rprev = above, Lcur;
#pragma unroll
                for (int e = 0; e < 4; ++e) Lcur[e] = __shfl(acc[ai][0][0][n][e], ldn);
#pragma unroll
                for (int m = 0; m < 4; ++m) {
                    const int rt = ai * 128 + wr * 64 + m * 16 + fr;
                    const size_t row = (size_t)u.pm * 256 + rt;
                    const f32x4 cur = acc[ai][0][m][n], val = acc[ai][1][m][n];
                    f32x4 Rm, Lnext = below;
#pragma unroll
                    for (int e = 0; e < 4; ++e) { Rm[e] = __shfl(cur[e], lup); if (m < 3) Lnext[e] = __shfl(acc[ai][0][m < 3 ? m + 1 : 3][n][e], ldn); }
                    const f32x4 up = (fr == 0) ? Rprev : Rm, dn = (fr == 15) ? Lnext : Lcur;
                    Rprev = Rm; Lcur = Lnext;
                    const f32x4 pre = bb + w0 * up + w1 * cur + w2 * dn;
                    f32x4 res;
#pragma unroll
                    for (int e = 0; e < 4; ++e) res[e] = silu_f(pre[e]) * val[e];
                    if (rt == 0) {
                        *(f32x4*)(edge + ((size_t)u.pm * 2 + 0) * FF + ch) = cur;
                        if (!seq_first) { float* pp = part + (((size_t)u.pm * 2 + 0) * FF + ch) * 2;
                            *(f32x4*)pp = (f32x4){pre[0], val[0], pre[1], val[1]}; *(f32x4*)(pp + 4) = (f32x4){pre[2], val[2], pre[3], val[3]}; }
                    }
                    if (rt == 255) {
                        *(f32x4*)(edge + ((size_t)u.pm * 2 + 1) * FF + ch) = cur;
                        if (!seq_last) { float* pp = part + (((size_t)u.pm * 2 + 1) * FF + ch) * 2;
                            *(f32x4*)pp = (f32x4){pre[0], val[0], pre[1], val[1]}; *(f32x4*)(pp + 4) = (f32x4){pre[2], val[2], pre[3], val[3]}; }
                    }
                    u32x2 w; w.x = cvt_pk_bf16(res[0], res[1]); w.y = cvt_pk_bf16(res[2], res[3]);
                    *(u32x2*)(ACT + row * FF + ch) = w;
                }
            }
        }
    }
};
namespace att {
typedef __attribute__((ext_vector_type(16))) float f32x16;
typedef __attribute__((ext_vector_type(4))) short s16x4;
typedef short v4i16_t __attribute__((ext_vector_type(4)));
typedef LAS const char* lptr;
__device__ __forceinline__ s16x4 vtr(lptr p) { return __builtin_bit_cast(s16x4, __builtin_amdgcn_ds_read_tr16_b64_v4i16((LAS v4i16_t*)p)); }
typedef float f32x2_t __attribute__((ext_vector_type(2))); typedef __bf16 bf16x2_t __attribute__((ext_vector_type(2)));
__device__ __forceinline__ unsigned cvtpk_s(float lo, float hi) { f32x2_t v = {lo, hi}; bf16x2_t b = __builtin_convertvector(v, bf16x2_t); return __builtin_bit_cast(unsigned, b); }
__device__ __forceinline__ bf16x8 pack8(const f32x16& s, int b) {
    u32x4 w; w.x = cvtpk_s(s[b], s[b + 1]); w.y = cvtpk_s(s[b + 2], s[b + 3]); w.z = cvtpk_s(s[b + 4], s[b + 5]); w.w = cvtpk_s(s[b + 6], s[b + 7]);
    return __builtin_bit_cast(bf16x8, w);
}
#define MFMA32(a, b, c) __builtin_amdgcn_mfma_f32_32x32x16_bf16((a), (b), (c), 0, 0, 0)

#define LGKM_WAIT(n) asm volatile("s_waitcnt lgkmcnt(" #n ")" ::: "memory")
#define SCHED_FENCE() __builtin_amdgcn_sched_barrier(0)
__device__ __forceinline__ bf16x8 rd128(unsigned addr, int off) { bf16x8 r; asm volatile("ds_read_b128 %0, %1 offset:%c2" : "=&v"(r) : "v"(addr), "i"(off) : "memory"); return r; }
__device__ __forceinline__ s16x4 rdtr(unsigned addr, int off) { s16x4 r; asm volatile("ds_read_b64_tr_b16 %0, %1 offset:%c2" : "=&v"(r) : "v"(addr), "i"(off) : "memory"); return r; }
#define VFRAG(lo, hh) ((bf16x8){lo[0], lo[1], lo[2], lo[3], hh[0], hh[1], hh[2], hh[3]})
constexpr int KROW = 144, VROWD = 320, VROWA = 192;
constexpr int DSTG = 2 * 64 * KROW + 64 * VROWD;
constexpr int ASTG = 64 * KROW + 64 * VROWA;

constexpr int DST3 = 32768;
#define SGB(mask, n) __builtin_amdgcn_sched_group_barrier((mask), (n), 0)
__device__ __forceinline__ void diff_unit(LAS char* lds, const bf16* __restrict__ QKV, bf16* __restrict__ Y, int b, int h, int qb, float Mb, float lam, const float* __restrict__ subln, float outscale) {
    int tid = threadIdx.x; asm volatile("" : "+v"(tid)); const int lane = tid & 63, w = __builtin_amdgcn_readfirstlane(tid >> 6), q = lane & 31, hi = lane >> 5;
    const int rg = w >> 1, c = w & 1;
    const size_t rowQ = (size_t)b * S + qb * 128 + rg * 32 + q;
    const bf16* qp = QKV + rowQ * NIN + 768 + (2 * h + c) * 64 + hi * 8;
    bf16x8 qf[4];
#pragma unroll
    for (int ds = 0; ds < 4; ++ds) qf[ds] = *(const bf16x8*)(qp + ds * 16);
    const int krow = 8 * w + (lane >> 3), kch = (lane & 7) ^ ((krow >> 1) & 7);
    const int vrow = 4 * w + (lane >> 4), vch = (lane & 15) ^ ((vrow & 3) << 2);
    const bf16* kg = QKV + ((size_t)b * S + krow) * NIN + 1280 + 128 * h + kch * 8;
    const bf16* vg = QKV + ((size_t)b * S + vrow) * NIN + 1792 + 128 * h + vch * 8;
#define DDMA(t, so) do { const size_t o_ = (size_t)(t) * 64 * NIN; LAS unsigned char* d_ = (LAS unsigned char*)lds + (so) + w * 1024; \
        __builtin_amdgcn_global_load_lds((const unsigned*)(kg + o_), (LAS unsigned*)(d_), 16, 0, 0); \
        __builtin_amdgcn_global_load_lds((const unsigned*)(kg + o_ + 64), (LAS unsigned*)(d_ + 8192), 16, 0, 0); \
        __builtin_amdgcn_global_load_lds((const unsigned*)(vg + o_), (LAS unsigned*)(d_ + 16384), 16, 0, 0); \
        __builtin_amdgcn_global_load_lds((const unsigned*)(vg + o_ + 32 * NIN), (LAS unsigned*)(d_ + 16384 + 8192), 16, 0, 0); } while (0)
    f32x16 o[4];
#pragma unroll
    for (int i = 0; i < 4; ++i) o[i] = (f32x16){0.f};
    float l = 0.f;
    constexpr int NT = S / 64;
    DDMA(0, 0); DDMA(1, DST3); DDMA(2, 2 * DST3);
    const unsigned lbase = (unsigned)(size_t)lds;
    unsigned kofs[4], vofs[4];
    { const int sw = (q >> 1) & 7, vq = (lane & 15) >> 2;
#pragma unroll
      for (int ds = 0; ds < 4; ++ds) kofs[ds] = (unsigned)(c * 8192 + q * 128 + (((2 * ds + hi) ^ sw) << 4));
#pragma unroll
      for (int db = 0; db < 4; ++db) vofs[db] = (unsigned)(16384 + (4 * hi + vq) * 256 + ((db ^ vq) << 6) + ((lane >> 4) & 1) * 32 + (lane & 3) * 8); }
    f32x16 negm;
#pragma unroll
    for (int r = 0; r < 16; ++r) negm[r] = -Mb;
    f32x16 s0, s1;
    { asm volatile("s_waitcnt vmcnt(8)" ::: "memory"); __builtin_amdgcn_s_barrier(); asm volatile("" ::: "memory");
      bf16x8 kf[8];
#pragma unroll
      for (int ds = 0; ds < 4; ++ds) { kf[2 * ds] = rd128(lbase + kofs[ds], 0); kf[2 * ds + 1] = rd128(lbase + kofs[ds], 32 * 128); }
      LGKM_WAIT(0); SCHED_FENCE();
      s0 = negm; s1 = negm;
#pragma unroll
      for (int ds = 0; ds < 4; ++ds) { s0 = MFMA32(kf[2 * ds], qf[ds], s0); s1 = MFMA32(kf[2 * ds + 1], qf[ds], s1); }
      SCHED_FENCE(); }
    int so_cur = 0, so_n1 = DST3, so_n3 = 3 * DST3;
    for (int t = 0; t < NT; ++t) {
        asm volatile("s_waitcnt vmcnt(4)" ::: "memory");
        __builtin_amdgcn_s_barrier();
        asm volatile("" ::: "memory");
        { const int tn = (t + 3 < NT) ? t + 3 : NT - 1; DDMA(tn, so_n3); }
        const unsigned sb = lbase + so_cur, sn = lbase + so_n1;
        bf16x8 kf[8];
#pragma unroll
        for (int ds = 0; ds < 4; ++ds) { kf[2 * ds] = rd128(sn + kofs[ds], 0); kf[2 * ds + 1] = rd128(sn + kofs[ds], 32 * 128); }
        s16x4 vl[2][4], vh[2][4];
#pragma unroll
        for (int db = 0; db < 4; ++db) { vl[0][db] = rdtr(sb + vofs[db], 0); vh[0][db] = rdtr(sb + vofs[db], 8 * 256); }
        LGKM_WAIT(0); SCHED_FENCE();
        f32x16 n0 = negm, n1 = negm;
#pragma unroll
        for (int ds = 0; ds < 4; ++ds) { n0 = MFMA32(kf[2 * ds], qf[ds], n0); n1 = MFMA32(kf[2 * ds + 1], qf[ds], n1); }
        float ls = 0.f;
#pragma unroll
        for (int r = 0; r < 16; ++r) { s0[r] = __builtin_amdgcn_exp2f(s0[r]); ls += s0[r]; }
        bf16x8 pf[4]; pf[0] = pack8(s0, 0); pf[1] = pack8(s0, 8);
#pragma unroll
        for (int i = 0; i < 8; ++i) { SGB(0x008, 1); SGB(0x400, 2); SGB(0x002, 3); }
        SCHED_FENCE();
#pragma unroll
        for (int db = 0; db < 4; ++db) { vl[1][db] = rdtr(sb + vofs[db], 16 * 256); vh[1][db] = rdtr(sb + vofs[db], 16 * 256 + 8 * 256); }
        s16x4 wl[2][4], wh[2][4];
#pragma unroll
        for (int ks = 0; ks < 2; ++ks)
#pragma unroll
            for (int db = 0; db < 4; ++db) { wl[ks][db] = rdtr(sb + vofs[db], (ks + 2) * 16 * 256); wh[ks][db] = rdtr(sb + vofs[db], (ks + 2) * 16 * 256 + 8 * 256); }
        LGKM_WAIT(15); SCHED_FENCE();
#pragma unroll
        for (int ks = 0; ks < 2; ++ks)
#pragma unroll
            for (int db = 0; db < 4; ++db) o[db] = MFMA32(VFRAG(vl[ks][db], vh[ks][db]), pf[ks], o[db]);
#pragma unroll
        for (int r = 0; r < 16; ++r) { s1[r] = __builtin_amdgcn_exp2f(s1[r]); ls += s1[r]; }
        l += ls;
        pf[2] = pack8(s1, 0); pf[3] = pack8(s1, 8);
#pragma unroll
        for (int i = 0; i < 8; ++i) { SGB(0x008, 1); SGB(0x400, 2); SGB(0x002, 3); }
        SCHED_FENCE();
        LGKM_WAIT(0); SCHED_FENCE();
#pragma unroll
        for (int ks = 0; ks < 2; ++ks)
#pragma unroll
            for (int db = 0; db < 4; ++db) o[db] = MFMA32(VFRAG(wl[ks][db], wh[ks][db]), pf[2 + ks], o[db]);
        SCHED_FENCE();
        s0 = n0; s1 = n1;
        so_cur = so_n1; so_n1 = (so_n1 == 3 * DST3) ? 0 : so_n1 + DST3; so_n3 = (so_n3 == 3 * DST3) ? 0 : so_n3 + DST3;
    }
#undef DDMA
    asm volatile("s_waitcnt vmcnt(0)" ::: "memory");
    __syncthreads();
    l += __shfl_xor(l, 32);
    const float inv = 1.f / l;
    LAS f32x4* xb = (LAS f32x4*)lds + rg * (16 * 64) + lane;
    if (c == 1) {
#pragma unroll
        for (int db = 0; db < 4; ++db)
#pragma unroll
            for (int r4 = 0; r4 < 4; ++r4) xb[(db * 4 + r4) * 64] = (f32x4){o[db][4 * r4], o[db][4 * r4 + 1], o[db][4 * r4 + 2], o[db][4 * r4 + 3]} * inv;
    }
    __syncthreads();
    if (c == 0) {
        float ss = 0.f;
#pragma unroll
        for (int db = 0; db < 4; ++db)
#pragma unroll
            for (int r4 = 0; r4 < 4; ++r4) { const f32x4 ot = xb[(db * 4 + r4) * 64];
#pragma unroll
                for (int e = 0; e < 4; ++e) { const float d = o[db][4 * r4 + e] * inv - lam * ot[e]; o[db][4 * r4 + e] = d; ss += d * d; } }
        ss += __shfl_xor(ss, 32);
        const float rs = rsqrtf(ss * (1.f / 128.f) + EPS) * outscale;
        bf16* yp = Y + rowQ * D + 512 + 128 * h + 4 * hi;
#pragma unroll
        for (int db = 0; db < 4; ++db)
#pragma unroll
            for (int r4 = 0; r4 < 4; ++r4) { const f32x4 gw = *(const f32x4*)(subln + 32 * db + 8 * r4 + 4 * hi);
                u32x2 wv; wv.x = cvt_pk_bf16(o[db][4 * r4] * rs * gw[0], o[db][4 * r4 + 1] * rs * gw[1]); wv.y = cvt_pk_bf16(o[db][4 * r4 + 2] * rs * gw[2], o[db][4 * r4 + 3] * rs * gw[3]);
                *(u32x2*)(yp + 32 * db + 8 * r4) = wv; }
    }
    __syncthreads();
}

__device__ __forceinline__ void swa_unit(LAS char* lds, const bf16* __restrict__ QKV, bf16* __restrict__ Y, int b, int kvh, int n, float Mb, const float* __restrict__ sink) {
    int tid = threadIdx.x; asm volatile("" : "+v"(tid)); const int lane = tid & 63, w = __builtin_amdgcn_readfirstlane(tid >> 6), q = lane & 31, hi = lane >> 5;
    const int head = kvh * 4 + (w >> 1), rb = (w & 1) * 64;
    const size_t rowQ = (size_t)b * S + n * 128 + rb + q;
    bf16x8 qf[2][4];
#pragma unroll
    for (int rg = 0; rg < 2; ++rg)
#pragma unroll
        for (int ds = 0; ds < 4; ++ds) qf[rg][ds] = *(const bf16x8*)(QKV + (rowQ + 32 * rg) * NIN + head * 64 + hi * 8 + ds * 16);
    const int lrow = tid >> 3, lcc = tid & 7;
    const long kp0 = (long)b * S + (long)(n - 1) * 128 + lrow;
    const bf16* kg = QKV + kp0 * NIN + 512 + kvh * 64 + lcc * 8;
    const bf16* vg = QKV + kp0 * NIN + 640 + kvh * 64 + lcc * 8;
    const int kdst = lrow * KROW + lcc * 16, vdst = 64 * KROW + lrow * VROWA + lcc * 16;
    u32x4 st0, st1;
#define ALOAD(t) do { const long o_ = (long)(t) * 64 * NIN; st0 = *(const u32x4*)(kg + o_); st1 = *(const u32x4*)(vg + o_); } while (0)
#define ASTORE(bo) do { *(LAS u32x4*)(lds + (bo) + kdst) = st0; *(LAS u32x4*)(lds + (bo) + vdst) = st1; } while (0)
    f32x16 o[2][2];
#pragma unroll
    for (int i = 0; i < 2; ++i)
#pragma unroll
        for (int j = 0; j < 2; ++j) o[i][j] = (f32x16){0.f};
    float l[2] = {0.f, 0.f};
    const int t0 = (n == 0) ? 2 : 0, t1 = (n == S / 128 - 1) ? 4 : 6;
    ALOAD(t0); ASTORE((t0 & 1) * ASTG); __syncthreads();
    const int koff = q * KROW + hi * 16;
    const int voff = 64 * KROW + (4 * hi + ((lane & 15) >> 2)) * VROWA + ((lane >> 4) & 1) * 32 + (lane & 3) * 8;
    for (int t = t0; t < t1; ++t) {
        const int cur = (t & 1) * ASTG, nxt = ASTG - cur;
        if (t + 1 < t1) ALOAD(t + 1);
        lptr kb = (lptr)(lds + cur + koff);
        lptr vb = (lptr)(lds + cur + voff);
#pragma unroll
        for (int rg = 0; rg < 2; ++rg) {
            const int i0 = rb + 32 * rg;
            if (64 * t + 63 >= i0 && 64 * t <= i0 + 31 + 256) {
                f32x16 s0 = (f32x16){0.f}, s1 = (f32x16){0.f};
#pragma unroll
                for (int ds = 0; ds < 4; ++ds) {
                    const bf16x8 k0 = *(const LAS bf16x8*)(kb + ds * 32), k1 = *(const LAS bf16x8*)(kb + 32 * KROW + ds * 32);
                    s0 = MFMA32(k0, qf[rg][ds], s0); s1 = MFMA32(k1, qf[rg][ds], s1);
                }
                const int jb = 64 * t + 4 * hi - (i0 + q);
                float ls = 0.f;
#pragma unroll
                for (int r = 0; r < 16; ++r) {
                    const int d0 = jb + (r & 3) + 8 * (r >> 2), d1 = d0 + 32;
                    const float p0 = __builtin_amdgcn_exp2f(s0[r] - Mb), p1 = __builtin_amdgcn_exp2f(s1[r] - Mb);
                    s0[r] = ((unsigned)d0 <= 256u) ? p0 : 0.f; s1[r] = ((unsigned)d1 <= 256u) ? p1 : 0.f; ls += s0[r] + s1[r];
                }
                l[rg] += ls;
                bf16x8 pf[4]; pf[0] = pack8(s0, 0); pf[1] = pack8(s0, 8); pf[2] = pack8(s1, 0); pf[3] = pack8(s1, 8);
#pragma unroll
                for (int ks = 0; ks < 4; ++ks)
#pragma unroll
                    for (int db = 0; db < 2; ++db) {
                        const s16x4 lo = vtr(vb + ks * 16 * VROWA + db * 64), hh = vtr(vb + ks * 16 * VROWA + 8 * VROWA + db * 64);
                        const bf16x8 vf = (bf16x8){lo[0], lo[1], lo[2], lo[3], hh[0], hh[1], hh[2], hh[3]};
                        o[rg][db] = MFMA32(vf, pf[ks], o[rg][db]);
                    }
            }
        }
        if (t + 1 < t1) ASTORE(nxt);
        __syncthreads();
    }
#undef ALOAD
#undef ASTORE
    const float sk = __builtin_amdgcn_exp2f(sink[head] * LOG2E - Mb);
#pragma unroll
    for (int rg = 0; rg < 2; ++rg) {
        float lt = l[rg]; lt += __shfl_xor(lt, 32);
        const float inv = 1.f / (lt + sk);
        bf16* yp = Y + (rowQ + 32 * rg) * D + head * 64 + 4 * hi;
#pragma unroll
        for (int db = 0; db < 2; ++db)
#pragma unroll
            for (int r4 = 0; r4 < 4; ++r4) { u32x2 wv; wv.x = cvt_pk_bf16(o[rg][db][4 * r4] * inv, o[rg][db][4 * r4 + 1] * inv); wv.y = cvt_pk_bf16(o[rg][db][4 * r4 + 2] * inv, o[rg][db][4 * r4 + 3] * inv);
                *(u32x2*)(yp + 32 * db + 8 * r4) = wv; }
    }
}
}
constexpr size_t MiB = 1u << 20;
constexpr size_t WS_CTL = 0, CTL_BYTES = 65536 + 4 * 65536;
constexpr size_t WS_ROWSQ = 65536;
constexpr int MISC_OFF = 131072 + 4096;
constexpr size_t WS_ROPE = 1 * MiB;
constexpr size_t WS_W = 2 * MiB, W_LAYER = 23 * MiB;
constexpr size_t W_IN = 0, W_OUT = (size_t)NIN * D * 2, W_UP = W_OUT + (size_t)D * D * 2, W_DOWN = W_UP + (size_t)NUP * D * 2;
static_assert(W_DOWN + (size_t)D * FF * 2 <= W_LAYER, "weights");
constexpr size_t WS_H = 48 * MiB;
constexpr size_t WS_QKV = 80 * MiB;
constexpr size_t WS_Y = 152 * MiB;
constexpr size_t WS_ACT = 80 * MiB;
constexpr size_t WS_EDGE = 184 * MiB;
constexpr size_t WS_PART = 186 * MiB;
constexpr size_t WS_END = 190 * MiB;
static_assert(WS_ACT + (size_t)M * FF * 2 <= WS_EDGE && WS_QKV + (size_t)M * NIN * 2 <= WS_Y && WS_Y + (size_t)M * D * 2 <= WS_EDGE, "ws map");

#ifndef REP_P0
#define REP_P0 1
#endif
#ifndef REP_P1
#define REP_P1 1
#endif
#ifndef REP_P3B
#define REP_P3B 1
#endif
#ifndef REP_P4
#define REP_P4 1
#endif
#ifndef ATT_REP
#define ATT_REP 1
#endif
#ifndef REP_P5
#define REP_P5 1
#endif
#ifndef REP_P3
#define REP_P3 1
#endif
#ifndef REP_SYNC
#define REP_SYNC 1
#endif
struct Args {
    const float *x, *g_attn, *w_in, *qn_a, *kn_a, *sink, *qn_b, *kn_b, *lq1, *lk1, *lq2, *lk2, *subln, *w_out, *g_ffn, *w_up, *conv_w, *conv_b, *w_down;
    float* out; unsigned char* ws;
};

__device__ __forceinline__ float wave_sum(float v) {
#pragma unroll
    for (int o = 1; o < 64; o <<= 1) v += __shfl_xor(v, o);
    return v;
}
__device__ __forceinline__ float uniform_f(float v) { return __uint_as_float(__builtin_amdgcn_readfirstlane(__float_as_uint(v))); }
__device__ __forceinline__ float wave_max(float v) {
#pragma unroll
    for (int o = 1; o < 64; o <<= 1) v = fmaxf(v, __shfl_xor(v, o));
    return v;
}
__device__ __forceinline__ unsigned f2bf(float f) { unsigned u = __builtin_bit_cast(unsigned, f); return (u + 0x7fffu + ((u >> 16) & 1u)) >> 16; }
__device__ __forceinline__ unsigned pk2(float lo, float hi) { return f2bf(lo) | (f2bf(hi) << 16); }

__device__ __forceinline__ void transpose_item(const float* __restrict__ W, int K, int N, bf16* __restrict__ WT, LAS float* scr, int kb, int nb, int dnb, int lane, const float* __restrict__ g) {
    const int k0 = 64 * kb, n0 = 32 * nb;
#pragma unroll 8
    for (int i = 0; i < 32; ++i) { const int kk = 2 * i + (lane >> 5); scr[kk * 33 + (lane & 31)] = W[(size_t)(k0 + kk) * N + n0 + (lane & 31)] * (g ? g[k0 + kk] : 1.f); }
    asm volatile("s_waitcnt lgkmcnt(0)" ::: "memory");
    const int c = lane & 7;
#pragma unroll
    for (int j = 0; j < 4; ++j) { const int n = (lane >> 3) + 8 * j; const LAS float* s = scr + (8 * c) * 33 + n;
        u32x4 o; o.x = pk2(s[0 * 33], s[1 * 33]); o.y = pk2(s[2 * 33], s[3 * 33]); o.z = pk2(s[4 * 33], s[5 * 33]); o.w = pk2(s[6 * 33], s[7 * 33]);
        *(u32x4*)(WT + (size_t)(32 * dnb + n) * K + k0 + 8 * c) = o; }
    asm volatile("s_waitcnt lgkmcnt(0)" ::: "memory");
}

__device__ __forceinline__ void convert_rows(const float* __restrict__ x, bf16* __restrict__ out, float* __restrict__ rowsq, int gw, int ngw, int lane) {
    for (int m = gw; m < M; m += ngw) {
        const f32x4* xr = (const f32x4*)(x + (size_t)m * D) + lane; f32x4 v[4]; float s = 0.f;
#pragma unroll
        for (int j = 0; j < 4; ++j) { v[j] = xr[64 * j]; s += dot4(v[j]); }
        s = wave_sum(s);
        if (lane == 0) rowsq[m] = s;
        u32x2* o8 = (u32x2*)(out + (size_t)m * D) + lane;
#pragma unroll
        for (int j = 0; j < 4; ++j) { u32x2 wv; wv.x = pk2(v[j][0], v[j][1]); wv.y = pk2(v[j][2], v[j][3]); o8[64 * j] = wv; }
    }
}

#define XB_TMO      128
#define XB_XCNT(j)  (256  + 64 * (j))
#define XB_XSUB(j)  (1280 + 64 * (j))
#define XB_XGEN(j)  (2304 + 64 * (j))
#define XB_TOP      3328
#define XB_TOPGEN   3392
#define XCD_BAR_WORDS 3456
#define XB_SPIN_CAP (1u << 18)

__device__ __forceinline__ unsigned xb_ld(unsigned* p)              { return __hip_atomic_load(p, __ATOMIC_RELAXED, __HIP_MEMORY_SCOPE_AGENT); }
__device__ __forceinline__ unsigned xb_add(unsigned* p, unsigned v) { return __hip_atomic_fetch_add(p, v, __ATOMIC_RELAXED, __HIP_MEMORY_SCOPE_AGENT); }
__device__ __forceinline__ unsigned xb_xcc_id() { return (unsigned)__builtin_amdgcn_s_getreg((3 << 11) | 20) & 0xFu; }
#define XB_SPIN(cond, bar) do { unsigned _sp = 0; while (cond) { __builtin_amdgcn_s_sleep(1); \
    if ((++_sp & 255u) == 0u) { if (xb_ld(&(bar)[XB_TMO])) break; if (_sp > XB_SPIN_CAP) { atomicAdd(&(bar)[XB_TMO], 1u); break; } } } } while (0)

struct XcdBarrier {
    unsigned* bar; unsigned x;
    volatile LAS unsigned* st;
};

__device__ __forceinline__ XcdBarrier xcd_barrier_post(unsigned* bar, volatile LAS unsigned* st) {
    XcdBarrier b; b.bar = bar; b.x = xb_xcc_id(); b.st = st;
    if (threadIdx.x == 0) (void)xb_add(&bar[XB_XCNT(b.x)], 1u);
    return b;
}
__device__ __forceinline__ void xcd_barrier_complete(unsigned* bar, unsigned x, unsigned& nloc, unsigned& nx) {
    const unsigned G = gridDim.x * gridDim.y * gridDim.z;
    unsigned sum, cnt, mine, sp = 0u;
    for (;;) {
        sum = 0u; cnt = 0u; mine = 0u;
#pragma unroll
        for (unsigned j = 0; j < 16; ++j) { const unsigned c = xb_ld(&bar[XB_XCNT(j)]); sum += c; cnt += (c > 0u) ? 1u : 0u; mine = (j == x) ? c : mine; }
        if (sum == G) break;
        __builtin_amdgcn_s_sleep(1);
        if ((++sp & 255u) == 0u) { if (xb_ld(&bar[XB_TMO])) break; if (sp > XB_SPIN_CAP) { atomicAdd(&bar[XB_TMO], 1u); break; } }
    }
    nloc = mine > 0u ? mine : 1u; nx = cnt > 0u ? cnt : 1u;
}

__device__ __forceinline__ void xcd_barrier(const XcdBarrier& b) {
    asm volatile("s_waitcnt vmcnt(0)" ::: "memory");
    __syncthreads();
    if (threadIdx.x == 0) {
        unsigned* bar = b.bar;
        __builtin_amdgcn_s_waitcnt(0);
        unsigned nloc = b.st[0], nx = b.st[1];
        if (nloc == 0u) { xcd_barrier_complete(bar, b.x, nloc, nx); b.st[0] = nloc; b.st[1] = nx; }
        const unsigned old = xb_add(&bar[XB_XSUB(b.x)], 1u);
        const unsigned gen = old / nloc;
        if (old + 1u == (gen + 1u) * nloc) {
            __builtin_amdgcn_fence(__ATOMIC_RELEASE, "agent");
            asm volatile("s_waitcnt vmcnt(0)" ::: "memory");
            const unsigned og = xb_add(&bar[XB_TOP], 1u);
            const unsigned tg = og / nx;
            if (og + 1u == (tg + 1u) * nx) xb_add(&bar[XB_TOPGEN], 1u);
            else XB_SPIN(xb_ld(&bar[XB_TOPGEN]) == tg, bar);
            __builtin_amdgcn_fence(__ATOMIC_ACQUIRE, "agent");
            xb_add(&bar[XB_XGEN(b.x)], 1u);
            asm volatile("s_waitcnt vmcnt(0)" ::: "memory");
        } else {
            XB_SPIN(xb_ld(&bar[XB_XGEN(b.x)]) == gen, bar);
            __builtin_amdgcn_fence(__ATOMIC_ACQUIRE, "agent");
            asm volatile("s_waitcnt vmcnt(0)" ::: "memory");
        }
    }
    __syncthreads();
}

__global__ void __launch_bounds__(512, 2) mega_fwd(Args a) {
    extern __shared__ __attribute__((aligned(16))) unsigned char lds_raw[];
    LAS unsigned char* lds = (LAS unsigned char*)lds_raw;
    cg::grid_group grid = cg::this_grid();
    const int tid = threadIdx.x, lane = tid & 63, wave = __builtin_amdgcn_readfirstlane(tid >> 6);
    const int G = gridDim.x, bx = blockIdx.x;
    const int vcu = (G % 8 == 0) ? (bx % 8) * (G / 8) + bx / 8 : bx;
    const int gw = vcu * 8 + wave, ngw = G * 8;
    typedef const __attribute__((address_space(4))) Args* kargs_t;
    const kargs_t kap = (kargs_t)__builtin_amdgcn_kernarg_segment_ptr();
#define PHASE_ARGS() kargs_t ap = kap; asm volatile("" : "+s"(ap)); unsigned char* const ws = ap->ws; \
    float* const cosT = (float*)(ws + WS_ROPE); float* const sinT = cosT + S * 32; \
    bf16* const Hb = (bf16*)(ws + WS_H); bf16* const QKV = (bf16*)(ws + WS_QKV); bf16* const Yb = (bf16*)(ws + WS_Y); bf16* const ACT = (bf16*)(ws + WS_ACT); \
    float* const edge = (float*)(ws + WS_EDGE); float* const part = (float*)(ws + WS_PART); float* const rowsq = (float*)(ws + WS_ROWSQ); \
    (void)cosT; (void)sinT; (void)Hb; (void)QKV; (void)Yb; (void)ACT; (void)edge; (void)part; (void)rowsq
    volatile LAS unsigned* misc = (volatile LAS unsigned*)(lds + MISC_OFF);
    if (tid < 16) misc[tid] = 0u;
    __syncthreads();
    XcdBarrier xbar; { PHASE_ARGS(); xbar = xcd_barrier_post((unsigned*)(ws + WS_CTL) + 1024, misc); }

#define CONVERT_WEIGHTS(L, wv, nwv) do { \
        int lane = threadIdx.x & 63; asm volatile("" : "+v"(lane)); \
        LAS float* scr = (LAS float*)(lds + wave * 16384); \
        constexpr int I_IN = 16 * 72, I_OUT = 16 * 32, I_UP = 16 * 176, I_DOWN = 44 * 32, I_L = I_IN + I_OUT + I_UP + I_DOWN; \
        unsigned char* wl_ = ws + WS_W + (size_t)(L) * W_LAYER; \
        for (int it = (wv); it < I_L; it += (nwv)) { \
            int r = it; \
            if (r < I_IN) { const int kb = r / 72, nb = r % 72; const int pn = nb >> 3, wc = (nb >> 1) & 3, bj = nb & 1; \
                transpose_item(ap->w_in + (size_t)(L) * D * NIN, D, NIN, (bf16*)(wl_ + W_IN), scr, kb, nb, 8 * pn + 4 * bj + wc, lane, ap->g_attn + (L) * D); continue; } \
            r -= I_IN; \
            if (r < I_OUT) { const int kb = r / 32, nb = r % 32; transpose_item(ap->w_out + (size_t)(L) * D * D, D, D, (bf16*)(wl_ + W_OUT), scr, kb, nb, nb, lane, nullptr); continue; } \
            r -= I_OUT; \
            if (r < I_UP) { const int kb = r / 176, nb = r % 176; const int isv = nb >= 88, nn = isv ? nb - 88 : nb; const int dnb = 8 * (nn >> 2) + 4 * isv + (nn & 3); \
                transpose_item(ap->w_up + (size_t)(L) * D * NUP, D, NUP, (bf16*)(wl_ + W_UP), scr, kb, nb, dnb, lane, ap->g_ffn + (L) * D); continue; } \
            r -= I_UP; \
            { const int kb = r / 32, nb = r % 32; transpose_item(ap->w_down + (size_t)(L) * FF * D, FF, D, (bf16*)(wl_ + W_DOWN), scr, kb, nb, nb, lane, nullptr); } \
        } } while (0)
    {
        PHASE_ARGS();
        CONVERT_WEIGHTS(0, gw, ngw);
        for (int i = vcu * 512 + tid; i < S * 32; i += G * 512) {
            const int pos = i >> 5, j = i & 31;
            double inv = 1.0; for (int k = 0; k < j; ++k) inv *= 0.74989420933245582730;
            const double ang = (double)pos * inv;
            const double kq = __builtin_rint(ang * 0.15915494309189533577);
            const double rr = (ang - kq * 6.283185307179586232) - kq * 2.4492935982947064e-16;
            const double r2 = rr * rr;
            double sn = 1.0, cs = 1.0;
#pragma unroll
            for (int k = 12; k >= 1; --k) { sn = 1.0 - sn * r2 / (double)((2 * k) * (2 * k + 1)); cs = 1.0 - cs * r2 / (double)((2 * k - 1) * (2 * k)); }
            cosT[i] = (float)cs; sinT[i] = (float)(sn * rr);
        }
        convert_rows(ap->x, Hb, rowsq, gw, ngw, lane);
    }
    asm volatile("s_waitcnt vmcnt(0)" ::: "memory");
    __syncthreads();
    if (tid == 0) { __builtin_amdgcn_fence(__ATOMIC_RELEASE, "agent"); asm volatile("s_waitcnt vmcnt(0)" ::: "memory"); }
    grid.sync();
    if (tid == 0) { __builtin_amdgcn_fence(__ATOMIC_ACQUIRE, "agent"); asm volatile("s_waitcnt vmcnt(0)" ::: "memory"); }
    __syncthreads();

    for (int l = 0; l < DEPTH; ++l) {
        const float lambda_init = 0.8f - 0.6f * __expf(-0.3f * (float)l);
        {
            PHASE_ARGS(); unsigned char* const wl = ws + WS_W + (size_t)l * W_LAYER; (void)wl;
            pg8::Gemm g{Hb, (const bf16*)(wl + W_IN), M, NIN, D}; pg8::StaticOrder So; So.init(M, NIN, G, bx);
            EpiInProj E{QKV, ap->qn_a + l * 64, ap->kn_a + l * 64, ap->qn_b + l * 64, ap->kn_b + l * 64, cosT, sinT, rowsq + (size_t)(2 * l) * M};
            pg8::gemm_phase<EpiInProj, pg8::StaticOrder, true, true>(lds, g, So, E);
            if (l == 0 && DEPTH > 1) {
                const int nidle = G - 64;
                if (nidle >= 64) { if (bx >= 64) CONVERT_WEIGHTS(1, (bx - 64) * 8 + wave, nidle * 8); }
                else CONVERT_WEIGHTS(1, gw, ngw);
            }
        }
        xcd_barrier(xbar);
        {
            PHASE_ARGS(); unsigned char* const wl = ws + WS_W + (size_t)l * W_LAYER; (void)wl;
            int lane = threadIdx.x & 63; asm volatile("" : "+v"(lane));
            const float mqa = wave_max(fabsf(ap->qn_a[l * 64 + lane])), mka = wave_max(fabsf(ap->kn_a[l * 64 + lane]));
            const float mqb = wave_max(fabsf(ap->qn_b[l * 64 + lane])), mkb = wave_max(fabsf(ap->kn_b[l * 64 + lane]));
            const float MbA = uniform_f(8.f * mqa * mka * LOG2E * 1.02f), MbB = uniform_f(8.f * mqb * mkb * LOG2E * 1.02f);
            const float s1 = wave_sum(ap->lq1[l * 64 + lane] * ap->lk1[l * 64 + lane]), s2 = wave_sum(ap->lq2[l * 64 + lane] * ap->lk2[l * 64 + lane]);
            const float lam = uniform_f(__expf(s1) - __expf(s2) + lambda_init);
            {
            for (int uidx = vcu; uidx < NB * 4 * 16; uidx += G) {
                const int bh = uidx >> 4, qb = uidx & 15;
                att::diff_unit((LAS char*)lds, QKV, Yb, bh >> 2, bh & 3, qb, MbB, lam, ap->subln + l * 128, 1.f - lambda_init);
            }
            for (int uidx = vcu; uidx < NB * 2 * 16; uidx += G) {
                const int bk = uidx >> 4, n = uidx & 15;
                att::swa_unit((LAS char*)lds, QKV, Yb, bk >> 1, bk & 1, n, MbA, ap->sink + l * 8);
            }
            __syncthreads();
            }
        }
        xcd_barrier(xbar);
        {
            PHASE_ARGS(); unsigned char* const wl = ws + WS_W + (size_t)l * W_LAYER; (void)wl;
            pg8::Gemm g{Yb, (const bf16*)(wl + W_OUT), M, D, D}; pg8::StaticOrder So; So.init(M, D, G, bx);
            EpiResid E{Hb, rowsq + (size_t)(2 * l + 1) * M, nullptr};
            pg8::gemm_phase<EpiResid, pg8::StaticOrder, true, true>(lds, g, So, E);
        }
        xcd_barrier(xbar);
        {
            PHASE_ARGS(); unsigned char* const wl = ws + WS_W + (size_t)l * W_LAYER; (void)wl;
            pg8::Gemm g{Hb, (const bf16*)(wl + W_UP), M, NUP, D}; pg8::StaticOrder So; So.init(M, NUP, G, bx);
            EpiUpConv E{ACT, ap->conv_w + (size_t)l * 3 * FF, ap->conv_b + (size_t)l * FF, edge, part, (LAS float*)(lds + XL_OFF), rowsq + (size_t)(2 * l + 1) * M};
            pg8::gemm_phase<EpiUpConv, pg8::StaticOrder, true, true>(lds, g, So, E);
        }
        xcd_barrier(xbar);
        {
            PHASE_ARGS(); unsigned char* const wl = ws + WS_W + (size_t)l * W_LAYER; (void)wl;
            pg8::Gemm g{ACT, (const bf16*)(wl + W_DOWN), M, D, FF}; pg8::StaticOrder So; So.init(M, D, G, bx);
            { const float* cw = ap->conv_w + (size_t)l * 3 * FF; pg8::Unit uu; int tid = threadIdx.x; asm volatile("" : "+v"(tid));
              for (int ui = 0; So.next(ui, uu); ++ui) { const int pm = uu.pm;
                for (int i = tid; i < 2 * FF; i += 512) { const int which = i / FF, ch = i % FF;
                    if (which == 0 && (pm & 7) != 0) { const float* pp = part + (((size_t)pm * 2 + 0) * FF + ch) * 2;
                        const float pre = pp[0] + cw[ch] * edge[((size_t)(pm - 1) * 2 + 1) * FF + ch];
                        ACT[(size_t)(pm * 256) * FF + ch] = (bf16)f2bf(silu_f(pre) * pp[1]); }
                    if (which == 1 && (pm & 7) != 7) { const float* pp = part + (((size_t)pm * 2 + 1) * FF + ch) * 2;
                        const float pre = pp[0] + cw[2 * FF + ch] * edge[((size_t)(pm + 1) * 2 + 0) * FF + ch];
                        ACT[(size_t)(pm * 256 + 255) * FF + ch] = (bf16)f2bf(silu_f(pre) * pp[1]); } } }
              asm volatile("s_waitcnt vmcnt(0)" ::: "memory"); __syncthreads(); }
            const bool lastl = (l + 1 == DEPTH);
            EpiResid E{Hb, lastl ? nullptr : rowsq + (size_t)(2 * l + 2) * M, lastl ? ap->out : nullptr};
            pg8::gemm_phase<EpiResid, pg8::StaticOrder, true, true>(lds, g, So, E);
        }
        if (l + 1 < DEPTH) xcd_barrier(xbar);
    }
}

extern "C" void kernel_launch(void* const* d_in, const int* in_sizes, int n_in, void* d_out, int out_size, void* d_ws, size_t ws_size, hipStream_t stream) {
    static int grid = 0;
    if (grid == 0) {
        if (n_in != 19 || ws_size < WS_END) { fprintf(stderr, "kernel_launch: unexpected inputs (n_in %d, ws %zu)\n", n_in, ws_size); grid = -1; return; }
        int dev = 0, cus = 0, per_cu = 0;
        hipGetDevice(&dev);
        hipDeviceGetAttribute(&cus, hipDeviceAttributeMultiprocessorCount, dev);
        hipFuncSetAttribute((const void*)mega_fwd, hipFuncAttributeMaxDynamicSharedMemorySize, LDS_BYTES);
        hipOccupancyMaxActiveBlocksPerMultiprocessor(&per_cu, (const void*)mega_fwd, 512, LDS_BYTES);
        if (per_cu < 1) { fprintf(stderr, "kernel_launch: occupancy query reports %d blocks per CU\n", per_cu); per_cu = 1; }
        grid = cus;
        (void)hipGetLastError();
    }
    if (grid < 0) return;
    if (hipMemsetAsync((char*)d_ws + WS_CTL, 0, CTL_BYTES, stream) != hipSuccess) { fprintf(stderr, "kernel_launch: memset failed\n"); return; }
    Args a{};
    const float** p = (const float**)&a;
    for (int i = 0; i < 19; ++i) p[i] = (const float*)d_in[i];
    a.out = (float*)d_out; a.ws = (unsigned char*)d_ws;
    void* args[] = {&a};
    hipError_t e = hipLaunchCooperativeKernel((const void*)mega_fwd, dim3(grid), dim3(512), args, LDS_BYTES, stream);
    if (e != hipSuccess) fprintf(stderr, "cooperative launch failed: %s (grid %d)\n", hipGetErrorString(e), grid);
}
```

```cpp
#include <hip/hip_runtime.h>
#include <hip/hip_cooperative_groups.h>
#include <cstdio>
#include <cstdint>
namespace cg = cooperative_groups;
namespace pg8 {
#define PG8_LAS __attribute__((address_space(3)))
typedef unsigned short bf16_t;
typedef short bf16x8 __attribute__((ext_vector_type(8)));
typedef float f32x4 __attribute__((ext_vector_type(4)));
typedef unsigned u32x4 __attribute__((ext_vector_type(4)));
constexpr int BM = 256, BK = 64, HALF = 128, HTB = HALF * BK * 2  , STAGE_BYTES = 8 * HTB, NXCD = 8, WGM = 8;

__host__ __device__ __forceinline__ int lds_byte(int r, int c) { const int st = (r >> 4) * 2 + (c >> 5), rr = r & 15, cc = c & 31, ob = rr * 64 + cc * 2; return st * 1024 + (ob ^ (((ob >> 9) & 1) << 5)); }
__host__ __device__ __forceinline__ void stage_rc(int b, int& R, int& C) { const int st = b / 1024, sb = b % 1024, swz = sb ^ (((sb >> 9) & 1) << 5); R = (st >> 1) * 16 + swz / 64; C = (st & 1) * 32 + (swz % 64) / 2; }
__host__ __device__ __forceinline__ int perm32(int rho) { const int n = rho >> 4, i = rho & 15; return 8 * (i >> 2) + 4 * n + (i & 3); }

struct Unit { int pm, pn; };
struct Gemm { const bf16_t* A; const bf16_t* Bt; int M, N, K; };

struct StaticOrder {
    int nM, nN, nwg, G, c;
    __host__ __device__ void init(int M, int N, int G_, int c_) { nM = M / BM; nN = N / BM; nwg = nM * nN; G = G_; c = c_; }
    __host__ __device__ bool next(int i, Unit& u) const {
        const long L = (long)i * G + c; if (L >= nwg) return false;
        int wgid = (int)L; { const int q = nwg / NXCD, r = nwg % NXCD, xcd = wgid % NXCD, off = wgid / NXCD; wgid = (xcd < r ? xcd * (q + 1) : r * (q + 1) + (xcd - r) * q) + off; }
        const int nig = WGM * nN, gid = wgid / nig, fm = gid * WGM, gsz = (nM - fm) < WGM ? (nM - fm) : WGM;
        u.pm = fm + ((wgid % nig) % gsz); u.pn = (wgid % nig) / gsz; return true;
    }
    __device__ __forceinline__ void a_ready(const Unit&) const {}
    __device__ __forceinline__ void done(const Unit&) const {}
};

__device__ __forceinline__ unsigned cvt_pk_bf16(float lo, float hi) { unsigned r; asm volatile("v_cvt_pk_bf16_f32 %0, %1, %2" : "=v"(r) : "v"(lo), "v"(hi)); return r; }
template <class Epi, class Sched, bool ALIGN_EPI = false, bool SP2 = false>
__device__ __forceinline__ void gemm_phase(PG8_LAS unsigned char* lds, const Gemm g, const Sched& S, const Epi& E) {
    int tid = threadIdx.x; asm volatile("" : "+v"(tid)); const int wid = __builtin_amdgcn_readfirstlane(tid >> 6), lane = tid & 63, wr = wid >> 2, wc = wid & 3, fr = lane & 15, fq = lane >> 4;
    const int K = g.K, nt = K / BK;
    unsigned voffA[2], voffB[2];
#pragma unroll
    for (int i = 0; i < 2; ++i) { int R, C; stage_rc(tid * 16 + i * 8192, R, C); const int Rb = Epi::PERM ? ((R & ~31) + perm32(R & 31)) : R;
        voffA[i] = (unsigned)(R * K + C) * 2u; voffB[i] = (unsigned)(Rb * K + C) * 2u; }
    const size_t kstep = (size_t)(BK * 2);
    const size_t hstep = (size_t)HALF * K * 2;
    const size_t tstep = 2 * hstep;
    const unsigned ldsw = (unsigned)wid * 1024u;
    const int aoff = lds_byte(wr * 64 + fr, fq * 8), boff = lds_byte(wc * 32 + fr, fq * 8);
#define PG8_SA(b, h) (((b) * 2 + (h)) * HTB)
#define PG8_SB(b, h) ((4 + (b) * 2 + (h)) * HTB)
#define PG8_STAGE(bufoff, gbase, voff) do { _Pragma("unroll") for (int _i = 0; _i < 2; ++_i) \
        __builtin_amdgcn_global_load_lds((const unsigned*)((const char*)(gbase) + (voff)[_i]), (PG8_LAS unsigned*)(lds + (bufoff) + ldsw + _i * 8192), 16, 0, 0); } while (0)
#define PG8_LDA(dst, b, h) do { _Pragma("unroll") for (int m = 0; m < 4; ++m) _Pragma("unroll") for (int k = 0; k < 2; ++k) dst[m][k] = *(const PG8_LAS bf16x8*)(lds + PG8_SA(b, h) + aoff + m * 2048 + k * 1024); } while (0)
#define PG8_LDB(dst, b, h) do { _Pragma("unroll") for (int n = 0; n < 2; ++n) _Pragma("unroll") for (int k = 0; k < 2; ++k) dst[n][k] = *(const PG8_LAS bf16x8*)(lds + PG8_SB(b, h) + boff + n * 2048 + k * 1024); } while (0)
#define PG8_MMA(ai, bj, At, Bt) do { __builtin_amdgcn_s_setprio(1); _Pragma("unroll") for (int m = 0; m < 4; ++m) _Pragma("unroll") for (int n = 0; n < 2; ++n) _Pragma("unroll") for (int k = 0; k < 2; ++k) \
        acc[ai][bj][m][n] = __builtin_amdgcn_mfma_f32_16x16x32_bf16(Bt[n][k], At[m][k], acc[ai][bj][m][n], 0, 0, 0); __builtin_amdgcn_s_setprio(0); } while (0)
#define PG8_WAIT_V(n) asm volatile("s_waitcnt vmcnt(" #n ")" ::: "memory")
#define PG8_WAIT_L(n) asm volatile("s_waitcnt lgkmcnt(" #n ")" ::: "memory")
#define PG8_BAR __builtin_amdgcn_s_barrier()
#define PG8_SCHED __builtin_amdgcn_sched_barrier(0)
    Unit cur, nxt; int ui = 0;
    if (!S.next(0, cur)) return;
    f32x4 acc[2][2][4][2];
#pragma unroll
    for (int a = 0; a < 2; ++a)
#pragma unroll
        for (int b = 0; b < 2; ++b)
#pragma unroll
            for (int m = 0; m < 4; ++m)
#pragma unroll
                for (int n = 0; n < 2; ++n) acc[a][b][m][n] = (f32x4){0.f, 0.f, 0.f, 0.f};
    bf16x8 At[4][2], B0[2][2], B1[2][2];
    const char* cA = (const char*)g.A + (size_t)cur.pm * tstep; const char* cB = (const char*)g.Bt + (size_t)cur.pn * tstep;
    S.a_ready(cur);
    if constexpr (SP2) {
        PG8_STAGE(PG8_SB(0, 0), cB, voffB); PG8_STAGE(PG8_SB(0, 1), cB + hstep, voffB); PG8_STAGE(PG8_SA(0, 0), cA, voffA); PG8_STAGE(PG8_SA(0, 1), cA + hstep, voffA);
        if (wr == 1) PG8_BAR;
        PG8_WAIT_V(2); PG8_BAR;
        PG8_STAGE(PG8_SB(1, 0), cB + kstep, voffB); PG8_STAGE(PG8_SA(1, 0), cA + kstep, voffA); PG8_STAGE(PG8_SB(1, 1), cB + hstep + kstep, voffB);
        PG8_WAIT_V(6); PG8_BAR;
    } else {
        PG8_STAGE(PG8_SB(0, 0), cB, voffB); PG8_STAGE(PG8_SA(0, 0), cA, voffA); PG8_STAGE(PG8_SB(0, 1), cB + hstep, voffB); PG8_STAGE(PG8_SA(0, 1), cA + hstep, voffA);
        if (wr == 1) PG8_BAR;
        PG8_WAIT_V(4); PG8_BAR;
        PG8_STAGE(PG8_SB(1, 0), cB + kstep, voffB); PG8_STAGE(PG8_SA(1, 0), cA + kstep, voffA); PG8_STAGE(PG8_SB(1, 1), cB + hstep + kstep, voffB);
        PG8_WAIT_V(6); PG8_BAR;
    }
    for (;;) {
        const bool has_next = S.next(ui + 1, nxt);
        const char* nA = has_next ? (const char*)g.A + (size_t)nxt.pm * tstep : cA; const char* nB = has_next ? (const char*)g.Bt + (size_t)nxt.pn * tstep : cB;
        for (int t = 0; t < nt; t += 2) {
            const bool last = (t == nt - 2);
            const char* a1 = cA + (size_t)(t + 1) * kstep;
            const char* a2 = last ? nA : cA + (size_t)(t + 2) * kstep; const char* b2 = last ? nB : cB + (size_t)(t + 2) * kstep;
            const char* a3 = a2 + kstep; const char* b3 = b2 + kstep;
            if (last && has_next) S.a_ready(nxt);
            if constexpr (SP2) {
            PG8_LDB(B0, 0, 0); PG8_LDB(B1, 0, 1); PG8_SCHED; PG8_LDA(At, 0, 0); PG8_STAGE(PG8_SA(1, 1), a1 + hstep, voffA);
            PG8_WAIT_V(8); PG8_WAIT_L(0); PG8_BAR; PG8_MMA(0, 0, At, B0); PG8_MMA(0, 1, At, B1); PG8_BAR; PG8_SCHED;
            PG8_LDA(At, 0, 1); PG8_STAGE(PG8_SB(0, 0), b2, voffB); PG8_STAGE(PG8_SB(0, 1), b2 + hstep, voffB); PG8_STAGE(PG8_SA(0, 0), a2, voffA);
            PG8_WAIT_V(8); PG8_WAIT_L(0); PG8_BAR; PG8_MMA(1, 0, At, B0); PG8_MMA(1, 1, At, B1); PG8_BAR; PG8_SCHED;
            PG8_LDB(B0, 1, 0); PG8_LDB(B1, 1, 1); PG8_SCHED; PG8_LDA(At, 1, 0); PG8_STAGE(PG8_SA(0, 1), a2 + hstep, voffA);
            PG8_WAIT_V(8); PG8_WAIT_L(0); PG8_BAR; PG8_MMA(0, 0, At, B0); PG8_MMA(0, 1, At, B1); PG8_BAR; PG8_SCHED;
            PG8_LDA(At, 1, 1); PG8_STAGE(PG8_SB(1, 0), b3, voffB); PG8_STAGE(PG8_SB(1, 1), b3 + hstep, voffB); PG8_STAGE(PG8_SA(1, 0), a3, voffA);
            PG8_WAIT_V(8); PG8_WAIT_L(0); PG8_BAR; PG8_MMA(1, 0, At, B0); PG8_MMA(1, 1, At, B1); PG8_BAR; PG8_SCHED;
            } else {
            PG8_LDB(B0, 0, 0); PG8_SCHED; PG8_LDA(At, 0, 0); PG8_STAGE(PG8_SA(1, 1), a1 + hstep, voffA);
            PG8_WAIT_L(8); PG8_BAR; PG8_WAIT_L(0); PG8_MMA(0, 0, At, B0); PG8_BAR; PG8_SCHED;
            PG8_LDB(B1, 0, 1); PG8_STAGE(PG8_SB(0, 0), b2, voffB);
            PG8_BAR; PG8_WAIT_L(0); PG8_MMA(0, 1, At, B1); PG8_BAR;
            PG8_LDA(At, 0, 1); PG8_STAGE(PG8_SA(0, 0), a2, voffA);
            PG8_BAR; PG8_WAIT_L(0); PG8_MMA(1, 0, At, B0); PG8_BAR; PG8_SCHED;
            PG8_STAGE(PG8_SB(0, 1), b2 + hstep, voffB);
            PG8_WAIT_V(6); PG8_BAR; PG8_MMA(1, 1, At, B1); PG8_BAR;
            PG8_LDB(B0, 1, 0); PG8_SCHED; PG8_LDA(At, 1, 0); PG8_STAGE(PG8_SA(0, 1), a2 + hstep, voffA);
            PG8_WAIT_L(8); PG8_BAR; PG8_WAIT_L(0); PG8_MMA(0, 0, At, B0); PG8_BAR; PG8_SCHED;
            PG8_LDB(B1, 1, 1); PG8_STAGE(PG8_SB(1, 0), b3, voffB);
            PG8_BAR; PG8_WAIT_L(0); PG8_MMA(0, 1, At, B1); PG8_BAR;
            PG8_LDA(At, 1, 1); PG8_STAGE(PG8_SA(1, 0), a3, voffA);
            PG8_BAR; PG8_WAIT_L(0); PG8_MMA(1, 0, At, B0); PG8_BAR; PG8_SCHED;
            PG8_STAGE(PG8_SB(1, 1), b3 + hstep, voffB);
            PG8_WAIT_V(6); PG8_BAR; PG8_MMA(1, 1, At, B1); PG8_BAR;
            }
        }
        if constexpr (ALIGN_EPI) { if (wr == 0) PG8_BAR; }
        if constexpr (!Epi::AFTER_DRAIN) { E(acc, cur, wr, wc, fr, fq); S.done(cur); }
        if (!has_next) break;
#pragma unroll
        for (int a = 0; a < 2; ++a)
#pragma unroll
            for (int b = 0; b < 2; ++b)
#pragma unroll
                for (int m = 0; m < 4; ++m)
#pragma unroll
                    for (int n = 0; n < 2; ++n) acc[a][b][m][n] = (f32x4){0.f, 0.f, 0.f, 0.f};
        cur = nxt; cA = nA; cB = nB; ++ui;
        if constexpr (ALIGN_EPI) { if (wr == 1) PG8_BAR; }
    }
    PG8_WAIT_V(0);
    if constexpr (!ALIGN_EPI) { if (wr == 0) PG8_BAR; }
    PG8_BAR;
    if constexpr (Epi::AFTER_DRAIN) { E.fused(acc, cur, wr, wc, fr, fq, lds, wid, lane); S.done(cur); }
#undef PG8_SA
#undef PG8_SB
#undef PG8_STAGE
#undef PG8_LDA
#undef PG8_LDB
#undef PG8_MMA
#undef PG8_WAIT_V
#undef PG8_WAIT_L
#undef PG8_BAR
#undef PG8_SCHED
}
}
#define LAS __attribute__((address_space(3)))
typedef unsigned short bf16;
using pg8::f32x4; using pg8::u32x4; using pg8::Unit; using pg8::cvt_pk_bf16; using pg8::bf16x8;
typedef unsigned u32x2 __attribute__((ext_vector_type(2)));

constexpr int NB = 8, S = 2048, D = 1024, M = NB * S, NIN = 2304, FF = 2816, NUP = 2 * FF, DEPTH = 2;
constexpr float EPS = 1e-6f;
constexpr float LOG2E = 1.4426950408889634f;
constexpr float QSCALE = 0.125f * LOG2E;
constexpr int XL_OFF = 131072;
constexpr int LDS_BYTES = 131072 + 8192;

__device__ __forceinline__ float dot4(f32x4 a) { return (a[0] * a[0] + a[1] * a[1]) + (a[2] * a[2] + a[3] * a[3]); }
__device__ __forceinline__ float silu_f(float v) { return v * __builtin_amdgcn_rcpf(1.f + __expf(-v)); }

struct EpiInProj {
    static constexpr bool PERM = true, AFTER_DRAIN = false;
    bf16* O; const float* qn_a; const float* kn_a; const float* qn_b; const float* kn_b; const float* cosT; const float* sinT; const float* rowsq;
    __device__ __forceinline__ void operator()(const f32x4 (&acc)[2][2][4][2], const Unit& u, int wr, int wc, int fr, int fq) const {
        asm volatile("" : "+v"(fr), "+v"(fq));
        const int pn = u.pn;
        const float* g = nullptr; float sc = 1.f;
        if (pn < 2) { g = qn_a; sc = QSCALE; }
        else if (pn == 2) { if (wc < 2) g = kn_a; }
        else if (pn < 5) { g = qn_b; sc = QSCALE; }
        else if (pn < 7) { g = kn_b; }
        const int colb = pn * 256 + wc * 64 + 8 * fq;
        const int row0 = u.pm * 256 + wr * 64 + fr;
        if (g) {
            f32x4 g1[2], g2[2];
#pragma unroll
            for (int n = 0; n < 2; ++n) { g1[n] = *(const f32x4*)(g + 8 * fq + 4 * n); g2[n] = *(const f32x4*)(g + 32 + 8 * fq + 4 * n); }
#pragma unroll
            for (int ai = 0; ai < 2; ++ai)
#pragma unroll
                for (int m = 0; m < 4; ++m) {
                    const int row = row0 + ai * 128 + m * 16;
                    const f32x4 a0 = acc[ai][0][m][0], a1 = acc[ai][0][m][1], b0 = acc[ai][1][m][0], b1 = acc[ai][1][m][1];
                    float ss = (dot4(a0) + dot4(a1)) + (dot4(b0) + dot4(b1));
                    ss += __shfl_xor(ss, 16); ss += __shfl_xor(ss, 32);
                    const float rx = rsqrtf(rowsq[row] * (1.f / D) + EPS);
                    const float rs = rsqrtf(ss * rx * rx * (1.f / 64.f) + EPS) * rx * sc;
                    const size_t ro = (size_t)(row & (S - 1)) * 32 + 8 * fq;
                    const f32x4 c0 = *(const f32x4*)(cosT + ro), c1 = *(const f32x4*)(cosT + ro + 4), s0 = *(const f32x4*)(sinT + ro), s1 = *(const f32x4*)(sinT + ro + 4);
                    const f32x4 y10 = a0 * rs * g1[0], y11 = a1 * rs * g1[1], y20 = b0 * rs * g2[0], y21 = b1 * rs * g2[1];
                    const f32x4 o10 = y10 * c0 - y20 * s0, o11 = y11 * c1 - y21 * s1, o20 = y20 * c0 + y10 * s0, o21 = y21 * c1 + y11 * s1;
                    u32x4 w1, w2;
                    w1.x = cvt_pk_bf16(o10[0], o10[1]); w1.y = cvt_pk_bf16(o10[2], o10[3]); w1.z = cvt_pk_bf16(o11[0], o11[1]); w1.w = cvt_pk_bf16(o11[2], o11[3]);
                    w2.x = cvt_pk_bf16(o20[0], o20[1]); w2.y = cvt_pk_bf16(o20[2], o20[3]); w2.z = cvt_pk_bf16(o21[0], o21[1]); w2.w = cvt_pk_bf16(o21[2], o21[3]);
                    bf16* op = O + (size_t)row * NIN + colb;
                    *(u32x4*)op = w1; *(u32x4*)(op + 32) = w2;
                }
        } else {
#pragma unroll
            for (int ai = 0; ai < 2; ++ai)
#pragma unroll
                for (int m = 0; m < 4; ++m) {
                    const int row = row0 + ai * 128 + m * 16;
                    bf16* op = O + (size_t)row * NIN + colb;
                    const float rx = rsqrtf(rowsq[row] * (1.f / D) + EPS);
#pragma unroll
                    for (int bj = 0; bj < 2; ++bj) { const f32x4 v0 = acc[ai][bj][m][0] * rx, v1 = acc[ai][bj][m][1] * rx; u32x4 w;
                        w.x = cvt_pk_bf16(v0[0], v0[1]); w.y = cvt_pk_bf16(v0[2], v0[3]); w.z = cvt_pk_bf16(v1[0], v1[1]); w.w = cvt_pk_bf16(v1[2], v1[3]);
                        *(u32x4*)(op + 32 * bj) = w; }
                }
        }
    }
};

__device__ __forceinline__ f32x4 bf2f_lo(unsigned a, unsigned b) { return (f32x4){__uint_as_float(a << 16), __uint_as_float(a & 0xffff0000u), __uint_as_float(b << 16), __uint_as_float(b & 0xffff0000u)}; }
struct EpiResid {
    static constexpr bool PERM = true, AFTER_DRAIN = false;
    bf16* XB; float* rowsq; float* outf;
    __device__ __forceinline__ void operator()(const f32x4 (&acc)[2][2][4][2], const Unit& u, int wr, int wc, int fr, int fq) const {
        asm volatile("" : "+v"(fr), "+v"(fq));
        const int col0 = u.pn * 256 + wc * 32 + 8 * fq, row0 = u.pm * 256 + wr * 64 + fr;
#pragma unroll
        for (int ai = 0; ai < 2; ++ai) {
            u32x4 xr[4][2];
#pragma unroll
            for (int m = 0; m < 4; ++m) { const size_t off = (size_t)(row0 + ai * 128 + m * 16) * D + col0;
#pragma unroll
                for (int bj = 0; bj < 2; ++bj) xr[m][bj] = *(const u32x4*)(XB + off + bj * 128); }
            asm volatile("" ::: "memory");
#pragma unroll
            for (int m = 0; m < 4; ++m) { const int row = row0 + ai * 128 + m * 16; const size_t off = (size_t)row * D + col0; float ss = 0.f;
#pragma unroll
                for (int bj = 0; bj < 2; ++bj) {
                    const f32x4 y0 = bf2f_lo(xr[m][bj].x, xr[m][bj].y) + acc[ai][bj][m][0], y1 = bf2f_lo(xr[m][bj].z, xr[m][bj].w) + acc[ai][bj][m][1];
                    ss += dot4(y0) + dot4(y1);
                    if (outf) { *(f32x4*)(outf + off + bj * 128) = y0; *(f32x4*)(outf + off + bj * 128 + 4) = y1; }
                    else { u32x4 w; w.x = cvt_pk_bf16(y0[0], y0[1]); w.y = cvt_pk_bf16(y0[2], y0[3]); w.z = cvt_pk_bf16(y1[0], y1[1]); w.w = cvt_pk_bf16(y1[2], y1[3]); *(u32x4*)(XB + off + bj * 128) = w; }
                }
                if (rowsq) { ss += __shfl_xor(ss, 16); ss += __shfl_xor(ss, 32); if (fq == 0) atomicAdd(rowsq + row, ss); }
            }
            asm volatile("" ::: "memory");
        }
    }
};

struct EpiUpConv {
    static constexpr bool PERM = true, AFTER_DRAIN = false;
    bf16* ACT; const float* cw; const float* cb; float* edge; float* part; LAS float* xl; const float* rowsq;
    __device__ __forceinline__ void operator()(f32x4 (&acc)[2][2][4][2], const Unit& u, int wr, int wc, int fr, int fq) const {
        asm volatile("" : "+v"(fr), "+v"(fq));
        const int lane = 16 * fq + fr;
        const int cl0 = 32 * wc + 8 * fq, ch0 = 128 * u.pn + cl0;
#pragma unroll
        for (int ai = 0; ai < 2; ++ai)
#pragma unroll
            for (int m = 0; m < 4; ++m) { const float rx = rsqrtf(rowsq[u.pm * 256 + ai * 128 + wr * 64 + m * 16 + fr] * (1.f / D) + EPS);
#pragma unroll
                for (int bj = 0; bj < 2; ++bj) { acc[ai][bj][m][0] *= rx; acc[ai][bj][m][1] *= rx; } }
#pragma unroll
        for (int ai = 0; ai < 2; ++ai) {
            const int chunk = 2 * ai + wr;
            if (fr == 0) { *(LAS f32x4*)(xl + (chunk * 2 + 0) * 128 + cl0) = acc[ai][0][0][0]; *(LAS f32x4*)(xl + (chunk * 2 + 0) * 128 + cl0 + 4) = acc[ai][0][0][1]; }
            if (fr == 15) { *(LAS f32x4*)(xl + (chunk * 2 + 1) * 128 + cl0) = acc[ai][0][3][0]; *(LAS f32x4*)(xl + (chunk * 2 + 1) * 128 + cl0 + 4) = acc[ai][0][3][1]; }
        }
        asm volatile("s_waitcnt lgkmcnt(0)" ::: "memory"); __builtin_amdgcn_s_barrier(); asm volatile("" ::: "memory");
        const int lup = (lane & ~15) | ((fr + 15) & 15), ldn = (lane & ~15) | ((fr + 1) & 15);
        const bool seq_first = (u.pm & 7) == 0, seq_last = (u.pm & 7) == 7;
#pragma unroll
        for (int ai = 0; ai < 2; ++ai) {
            const int chunk = 2 * ai + wr;
#pragma unroll
            for (int n = 0; n < 2; ++n) {
                const int ch = ch0 + 4 * n;
                const f32x4 w0 = *(const f32x4*)(cw + ch), w1 = *(const f32x4*)(cw + FF + ch), w2 = *(const f32x4*)(cw + 2 * FF + ch), bb = *(const f32x4*)(cb + ch);
                const f32x4 above = (chunk > 0) ? *(const LAS f32x4*)(xl + ((chunk - 1) * 2 + 1) * 128 + cl0 + 4 * n) : (f32x4){0.f, 0.f, 0.f, 0.f};
                const f32x4 below = (chunk < 3) ? *(const LAS f32x4*)(xl + ((chunk + 1) * 2 + 0) * 128 + cl0 + 4 * n) : (f32x4){0.f, 0.f, 0.f, 0.f};
                f32x4 Rprev = above, Lcur;
#pragma unroll
                for (int e = 0; e < 4; ++e) Lcur[e] = __shfl(acc[ai][0][0][n][e], ldn);
#pragma unroll
                for (int m = 0; m < 4; ++m) {
                    const int rt = ai * 128 + wr * 64 + m * 16 + fr;
                    const size_t row = (size_t)u.pm * 256 + rt;
                    const f32x4 cur = acc[ai][0][m][n], val = acc[ai][1][m][n];
                    f32x4 Rm, Lnext = below;
#pragma unroll
                    for (int e = 0; e < 4; ++e) { Rm[e] = __shfl(cur[e], lup); if (m < 3) Lnext[e] = __shfl(acc[ai][0][m < 3 ? m + 1 : 3][n][e], ldn); }
                    const f32x4 up = (fr == 0) ? Rprev : Rm, dn = (fr == 15) ? Lnext : Lcur;
                    Rprev = Rm; Lcur = Lnext;
                    const f32x4 pre = bb + w0 * up + w1 * cur + w2 * dn;
                    f32x4 res;
#pragma unroll
                    for (int e = 0; e < 4; ++e) res[e] = silu_f(pre[e]) * val[e];
                    if (rt == 0) {
                        *(f32x4*)(edge + ((size_t)u.pm * 2 + 0) * FF + ch) = cur;
                        if (!seq_first) { float* pp = part + (((size_t)u.pm * 2 + 0) * FF + ch) * 2;
                            *(f32x4*)pp = (f32x4){pre[0], val[0], pre[1], val[1]}; *(f32x4*)(pp + 4) = (f32x4){pre[2], val[2], pre[3], val[3]}; }
                    }
                    if (rt == 255) {
                        *(f32x4*)(edge + ((size_t)u.pm * 2 + 1) * FF + ch) = cur;
                        if (!seq_last) { float* pp = part + (((size_t)u.pm * 2 + 1) * FF + ch) * 2;
                            *(f32x4*)pp = (f32x4){pre[0], val[0], pre[1], val[1]}; *(f32x4*)(pp + 4) = (f32x4){pre[2], val[2], pre[3], val[3]}; }
                    }
                    u32x2 w; w.x = cvt_pk_bf16(res[0], res[1]); w.y = cvt_pk_bf16(res[2], res[3]);
                    *(u32x2*)(ACT + row * FF + ch) = w;
                }
            }
        }
    }
};
namespace att {
typedef __attribute__((ext_vector_type(16))) float f32x16;
typedef __attribute__((ext_vector_type(4))) short s16x4;
typedef short v4i16_t __attribute__((ext_vector_type(4)));
typedef LAS const char* lptr;
__device__ __forceinline__ s16x4 vtr(lptr p) { return __builtin_bit_cast(s16x4, __builtin_amdgcn_ds_read_tr16_b64_v4i16((LAS v4i16_t*)p)); }
typedef float f32x2_t __attribute__((ext_vector_type(2))); typedef __bf16 bf16x2_t __attribute__((ext_vector_type(2)));
__device__ __forceinline__ unsigned cvtpk_s(float lo, float hi) { f32x2_t v = {lo, hi}; bf16x2_t b = __builtin_convertvector(v, bf16x2_t); return __builtin_bit_cast(unsigned, b); }
__device__ __forceinline__ bf16x8 pack8(const f32x16& s, int b) {
    u32x4 w; w.x = cvtpk_s(s[b], s[b + 1]); w.y = cvtpk_s(s[b + 2], s[b + 3]); w.z = cvtpk_s(s[b + 4], s[b + 5]); w.w = cvtpk_s(s[b + 6], s[b + 7]);
    return __builtin_bit_cast(bf16x8, w);
}
#define MFMA32(a, b, c) __builtin_amdgcn_mfma_f32_32x32x16_bf16((a), (b), (c), 0, 0, 0)

#define LGKM_WAIT(n) asm volatile("s_waitcnt lgkmcnt(" #n ")" ::: "memory")
#define SCHED_FENCE() __builtin_amdgcn_sched_barrier(0)
__device__ __forceinline__ bf16x8 rd128(unsigned addr, int off) { bf16x8 r; asm volatile("ds_read_b128 %0, %1 offset:%c2" : "=&v"(r) : "v"(addr), "i"(off) : "memory"); return r; }
__device__ __forceinline__ s16x4 rdtr(unsigned addr, int off) { s16x4 r; asm volatile("ds_read_b64_tr_b16 %0, %1 offset:%c2" : "=&v"(r) : "v"(addr), "i"(off) : "memory"); return r; }
#define VFRAG(lo, hh) ((bf16x8){lo[0], lo[1], lo[2], lo[3], hh[0], hh[1], hh[2], hh[3]})
constexpr int KROW = 144, VROWD = 320, VROWA = 192;
constexpr int DSTG = 2 * 64 * KROW + 64 * VROWD;
constexpr int ASTG = 64 * KROW + 64 * VROWA;

constexpr int DST3 = 32768;
#define SGB(mask, n) __builtin_amdgcn_sched_group_barrier((mask), (n), 0)
__device__ __forceinline__ void diff_unit(LAS char* lds, const bf16* __restrict__ QKV, bf16* __restrict__ Y, int b, int h, int qb, float Mb, float lam, const float* __restrict__ subln, float outscale) {
    int tid = threadIdx.x; asm volatile("" : "+v"(tid)); const int lane = tid & 63, w = __builtin_amdgcn_readfirstlane(tid >> 6), q = lane & 31, hi = lane >> 5;
    const int rg = w >> 1, c = w & 1;
    const size_t rowQ = (size_t)b * S + qb * 128 + rg * 32 + q;
    const bf16* qp = QKV + rowQ * NIN + 768 + (2 * h + c) * 64 + hi * 8;
    bf16x8 qf[4];
#pragma unroll
    for (int ds = 0; ds < 4; ++ds) qf[ds] = *(const bf16x8*)(qp + ds * 16);
    const int krow = 8 * w + (lane >> 3), kch = (lane & 7) ^ ((krow >> 1) & 7);
    const int vrow = 4 * w + (lane >> 4), vch = (lane & 15) ^ ((vrow & 3) << 2);
    const bf16* kg = QKV + ((size_t)b * S + krow) * NIN + 1280 + 128 * h + kch * 8;
    const bf16* vg = QKV + ((size_t)b * S + vrow) * NIN + 1792 + 128 * h + vch * 8;
#define DDMA(t, so) do { const size_t o_ = (size_t)(t) * 64 * NIN; LAS unsigned char* d_ = (LAS unsigned char*)lds + (so) + w * 1024; \
        __builtin_amdgcn_global_load_lds((const unsigned*)(kg + o_), (LAS unsigned*)(d_), 16, 0, 0); \
        __builtin_amdgcn_global_load_lds((const unsigned*)(kg + o_ + 64), (LAS unsigned*)(d_ + 8192), 16, 0, 0); \
        __builtin_amdgcn_global_load_lds((const unsigned*)(vg + o_), (LAS unsigned*)(d_ + 16384), 16, 0, 0); \
        __builtin_amdgcn_global_load_lds((const unsigned*)(vg + o_ + 32 * NIN), (LAS unsigned*)(d_ + 16384 + 8192), 16, 0, 0); } while (0)
    f32x16 o[4];
#pragma unroll
    for (int i = 0; i < 4; ++i) o[i] = (f32x16){0.f};
    float l = 0.f;
    constexpr int NT = S / 64;
    DDMA(0, 0); DDMA(1, DST3); DDMA(2, 2 * DST3);
    const unsigned lbase = (unsigned)(size_t)lds;
    unsigned kofs[4], vofs[4];
    { const int sw = (q >> 1) & 7, vq = (lane & 15) >> 2;
#pragma unroll
      for (int ds = 0; ds < 4; ++ds) kofs[ds] = (unsigned)(c * 8192 + q * 128 + (((2 * ds + hi) ^ sw) << 4));
#pragma unroll
      for (int db = 0; db < 4; ++db) vofs[db] = (unsigned)(16384 + (4 * hi + vq) * 256 + ((db ^ vq) << 6) + ((lane >> 4) & 1) * 32 + (lane & 3) * 8); }
    f32x16 negm;
#pragma unroll
    for (int r = 0; r < 16; ++r) negm[r] = -Mb;
    f32x16 s0, s1;
    { asm volatile("s_waitcnt vmcnt(8)" ::: "memory"); __builtin_amdgcn_s_barrier(); asm volatile("" ::: "memory");
      bf16x8 kf[8];
#pragma unroll
      for (int ds = 0; ds < 4; ++ds) { kf[2 * ds] = rd128(lbase + kofs[ds], 0); kf[2 * ds + 1] = rd128(lbase + kofs[ds], 32 * 128); }
      LGKM_WAIT(0); SCHED_FENCE();
      s0 = negm; s1 = negm;
#pragma unroll
      for (int ds = 0; ds < 4; ++ds) { s0 = MFMA32(kf[2 * ds], qf[ds], s0); s1 = MFMA32(kf[2 * ds + 1], qf[ds], s1); }
      SCHED_FENCE(); }
    int so_cur = 0, so_n1 = DST3, so_n3 = 3 * DST3;
    for (int t = 0; t < NT; ++t) {
        asm volatile("s_waitcnt vmcnt(4)" ::: "memory");
        __builtin_amdgcn_s_barrier();
        asm volatile("" ::: "memory");
        { const int tn = (t + 3 < NT) ? t + 3 : NT - 1; DDMA(tn, so_n3); }
        const unsigned sb = lbase + so_cur, sn = lbase + so_n1;
        bf16x8 kf[8];
#pragma unroll
        for (int ds = 0; ds < 4; ++ds) { kf[2 * ds] = rd128(sn + kofs[ds], 0); kf[2 * ds + 1] = rd128(sn + kofs[ds], 32 * 128); }
        s16x4 vl[2][4], vh[2][4];
#pragma unroll
        for (int db = 0; db < 4; ++db) { vl[0][db] = rdtr(sb + vofs[db], 0); vh[0][db] = rdtr(sb + vofs[db], 8 * 256); }
        LGKM_WAIT(0); SCHED_FENCE();
        f32x16 n0 = negm, n1 = negm;
#pragma unroll
        for (int ds = 0; ds < 4; ++ds) { n0 = MFMA32(kf[2 * ds], qf[ds], n0); n1 = MFMA32(kf[2 * ds + 1], qf[ds], n1); }
        float ls = 0.f;
#pragma unroll
        for (int r = 0; r < 16; ++r) { s0[r] = __builtin_amdgcn_exp2f(s0[r]); ls += s0[r]; }
        bf16x8 pf[4]; pf[0] = pack8(s0, 0); pf[1] = pack8(s0, 8);
#pragma unroll
        for (int i = 0; i < 8; ++i) { SGB(0x008, 1); SGB(0x400, 2); SGB(0x002, 3); }
        SCHED_FENCE();
#pragma unroll
        for (int db = 0; db < 4; ++db) { vl[1][db] = rdtr(sb + vofs[db], 16 * 256); vh[1][db] = rdtr(sb + vofs[db], 16 * 256 + 8 * 256); }
        s16x4 wl[2][4], wh[2][4];
#pragma unroll
        for (int ks = 0; ks < 2; ++ks)
#pragma unroll
            for (int db = 0; db < 4; ++db) { wl[ks][db] = rdtr(sb + vofs[db], (ks + 2) * 16 * 256); wh[ks][db] = rdtr(sb + vofs[db], (ks + 2) * 16 * 256 + 8 * 256); }
        LGKM_WAIT(15); SCHED_FENCE();
#pragma unroll
        for (int ks = 0; ks < 2; ++ks)
#pragma unroll
            for (int db = 0; db < 4; ++db) o[db] = MFMA32(VFRAG(vl[ks][db], vh[ks][db]), pf[ks], o[db]);
#pragma unroll
        for (int r = 0; r < 16; ++r) { s1[r] = __builtin_amdgcn_exp2f(s1[r]); ls += s1[r]; }
        l += ls;
        pf[2] = pack8(s1, 0); pf[3] = pack8(s1, 8);
#pragma unroll
        for (int i = 0; i < 8; ++i) { SGB(0x008, 1); SGB(0x400, 2); SGB(0x002, 3); }
        SCHED_FENCE();
        LGKM_WAIT(0); SCHED_FENCE();
#pragma unroll
        for (int ks = 0; ks < 2; ++ks)
#pragma unroll
            for (int db = 0; db < 4; ++db) o[db] = MFMA32(VFRAG(wl[ks][db], wh[ks][db]), pf[2 + ks], o[db]);
        SCHED_FENCE();
        s0 = n0; s1 = n1;
        so_cur = so_n1; so_n1 = (so_n1 == 3 * DST3) ? 0 : so_n1 + DST3; so_n3 = (so_n3 == 3 * DST3) ? 0 : so_n3 + DST3;
    }
#undef DDMA
    asm volatile("s_waitcnt vmcnt(0)" ::: "memory");
    __syncthreads();
    l += __shfl_xor(l, 32);
    const float inv = 1.f / l;
    LAS f32x4* xb = (LAS f32x4*)lds + rg * (16 * 64) + lane;
    if (c == 1) {
#pragma unroll
        for (int db = 0; db < 4; ++db)
#pragma unroll
            for (int r4 = 0; r4 < 4; ++r4) xb[(db * 4 + r4) * 64] = (f32x4){o[db][4 * r4], o[db][4 * r4 + 1], o[db][4 * r4 + 2], o[db][4 * r4 + 3]} * inv;
    }
    __syncthreads();
    if (c == 0) {
        float ss = 0.f;
#pragma unroll
        for (int db = 0; db < 4; ++db)
#pragma unroll
            for (int r4 = 0; r4 < 4; ++r4) { const f32x4 ot = xb[(db * 4 + r4) * 64];
#pragma unroll
                for (int e = 0; e < 4; ++e) { const float d = o[db][4 * r4 + e] * inv - lam * ot[e]; o[db][4 * r4 + e] = d; ss += d * d; } }
        ss += __shfl_xor(ss, 32);
        const float rs = rsqrtf(ss * (1.f / 128.f) + EPS) * outscale;
        bf16* yp = Y + rowQ * D + 512 + 128 * h + 4 * hi;
#pragma unroll
        for (int db = 0; db < 4; ++db)
#pragma unroll
            for (int r4 = 0; r4 < 4; ++r4) { const f32x4 gw = *(const f32x4*)(subln + 32 * db + 8 * r4 + 4 * hi);
                u32x2 wv; wv.x = cvt_pk_bf16(o[db][4 * r4] * rs * gw[0], o[db][4 * r4 + 1] * rs * gw[1]); wv.y = cvt_pk_bf16(o[db][4 * r4 + 2] * rs * gw[2], o[db][4 * r4 + 3] * rs * gw[3]);
                *(u32x2*)(yp + 32 * db + 8 * r4) = wv; }
    }
    __syncthreads();
}

__device__ __forceinline__ void swa_unit(LAS char* lds, const bf16* __restrict__ QKV, bf16* __restrict__ Y, int b, int kvh, int n, float Mb, const float* __restrict__ sink) {
    int tid = threadIdx.x; asm volatile("" : "+v"(tid)); const int lane = tid & 63, w = __builtin_amdgcn_readfirstlane(tid >> 6), q = lane & 31, hi = lane >> 5;
    const int head = kvh * 4 + (w >> 1), rb = (w & 1) * 64;
    const size_t rowQ = (size_t)b * S + n * 128 + rb + q;
    bf16x8 qf[2][4];
#pragma unroll
    for (int rg = 0; rg < 2; ++rg)
#pragma unroll
        for (int ds = 0; ds < 4; ++ds) qf[rg][ds] = *(const bf16x8*)(QKV + (rowQ + 32 * rg) * NIN + head * 64 + hi * 8 + ds * 16);
    const int lrow = tid >> 3, lcc = tid & 7;
    const long kp0 = (long)b * S + (long)(n - 1) * 128 + lrow;
    const bf16* kg = QKV + kp0 * NIN + 512 + kvh * 64 + lcc * 8;
    const bf16* vg = QKV + kp0 * NIN + 640 + kvh * 64 + lcc * 8;
    const int kdst = lrow * KROW + lcc * 16, vdst = 64 * KROW + lrow * VROWA + lcc * 16;
    u32x4 st0, st1;
#define ALOAD(t) do { const long o_ = (long)(t) * 64 * NIN; st0 = *(const u32x4*)(kg + o_); st1 = *(const u32x4*)(vg + o_); } while (0)
#define ASTORE(bo) do { *(LAS u32x4*)(lds + (bo) + kdst) = st0; *(LAS u32x4*)(lds + (bo) + vdst) = st1; } while (0)
    f32x16 o[2][2];
#pragma unroll
    for (int i = 0; i < 2; ++i)
#pragma unroll
        for (int j = 0; j < 2; ++j) o[i][j] = (f32x16){0.f};
    float l[2] = {0.f, 0.f};
    const int t0 = (n == 0) ? 2 : 0, t1 = (n == S / 128 - 1) ? 4 : 6;
    ALOAD(t0); ASTORE((t0 & 1) * ASTG); __syncthreads();
    const int koff = q * KROW + hi * 16;
    const int voff = 64 * KROW + (4 * hi + ((lane & 15) >> 2)) * VROWA + ((lane >> 4) & 1) * 32 + (lane & 3) * 8;
    const unsigned lbase = (unsigned)(size_t)lds;
    for (int t = t0; t < t1; ++t) {
        const int cur = (t & 1) * ASTG, nxt = ASTG - cur;
        if (t + 1 < t1) ALOAD(t + 1);
        const unsigned ka = lbase + cur + koff, va = lbase + cur + voff;
        bf16x8 kf[8];
#pragma unroll
        for (int ds = 0; ds < 4; ++ds) { kf[2 * ds] = rd128(ka, ds * 32); kf[2 * ds + 1] = rd128(ka, 32 * KROW + ds * 32); }
        s16x4 vl[4][2], vh[4][2];
#pragma unroll
        for (int ks = 0; ks < 4; ++ks)
#pragma unroll
            for (int db = 0; db < 2; ++db) { vl[ks][db] = rdtr(va, ks * 16 * VROWA + db * 64); vh[ks][db] = rdtr(va, ks * 16 * VROWA + 8 * VROWA + db * 64); }
        LGKM_WAIT(0); SCHED_FENCE();
#pragma unroll
        for (int rg = 0; rg < 2; ++rg) {
            const int i0 = rb + 32 * rg;
            if (64 * t + 63 >= i0 && 64 * t <= i0 + 31 + 256) {
                f32x16 s0 = (f32x16){0.f}, s1 = (f32x16){0.f};
#pragma unroll
                for (int ds = 0; ds < 4; ++ds) { s0 = MFMA32(kf[2 * ds], qf[rg][ds], s0); s1 = MFMA32(kf[2 * ds + 1], qf[rg][ds], s1); }
                const int jb = 64 * t + 4 * hi - (i0 + q);
                float ls = 0.f;
#pragma unroll
                for (int r = 0; r < 16; ++r) {
                    const int d0 = jb + (r & 3) + 8 * (r >> 2), d1 = d0 + 32;
                    const float p0 = __builtin_amdgcn_exp2f(s0[r] - Mb), p1 = __builtin_amdgcn_exp2f(s1[r] - Mb);
                    s0[r] = ((unsigned)d0 <= 256u) ? p0 : 0.f; s1[r] = ((unsigned)d1 <= 256u) ? p1 : 0.f; ls += s0[r] + s1[r];
                }
                l[rg] += ls;
                bf16x8 pf[4]; pf[0] = pack8(s0, 0); pf[1] = pack8(s0, 8); pf[2] = pack8(s1, 0); pf[3] = pack8(s1, 8);
#pragma unroll
                for (int ks = 0; ks < 4; ++ks)
#pragma unroll
                    for (int db = 0; db < 2; ++db) o[rg][db] = MFMA32(VFRAG(vl[ks][db], vh[ks][db]), pf[ks], o[rg][db]);
            }
        }
        SCHED_FENCE();
        if (t + 1 < t1) ASTORE(nxt);
        __syncthreads();
    }
#undef ALOAD
#undef ASTORE
    const float sk = __builtin_amdgcn_exp2f(sink[head] * LOG2E - Mb);
#pragma unroll
    for (int rg = 0; rg < 2; ++rg) {
        float lt = l[rg]; lt += __shfl_xor(lt, 32);
        const float inv = 1.f / (lt + sk);
        bf16* yp = Y + (rowQ + 32 * rg) * D + head * 64 + 4 * hi;
#pragma unroll
        for (int db = 0; db < 2; ++db)
#pragma unroll
            for (int r4 = 0; r4 < 4; ++r4) { u32x2 wv; wv.x = cvt_pk_bf16(o[rg][db][4 * r4] * inv, o[rg][db][4 * r4 + 1] * inv); wv.y = cvt_pk_bf16(o[rg][db][4 * r4 + 2] * inv, o[rg][db][4 * r4 + 3] * inv);
                *(u32x2*)(yp + 32 * db + 8 * r4) = wv; }
    }
}
}
constexpr size_t MiB = 1u << 20;
constexpr size_t WS_CTL = 0, CTL_BYTES = 65536 + 4 * 65536;
constexpr size_t WS_ROWSQ = 65536;
constexpr int MISC_OFF = 131072 + 4096;
constexpr size_t WS_ROPE = 1 * MiB;
constexpr size_t WS_W = 2 * MiB, W_LAYER = 23 * MiB;
constexpr size_t W_IN = 0, W_OUT = (size_t)NIN * D * 2, W_UP = W_OUT + (size_t)D * D * 2, W_DOWN = W_UP + (size_t)NUP * D * 2;
static_assert(W_DOWN + (size_t)D * FF * 2 <= W_LAYER, "weights");
constexpr size_t WS_H = 48 * MiB;
constexpr size_t WS_QKV = 80 * MiB;
constexpr size_t WS_Y = 152 * MiB;
constexpr size_t WS_ACT = 80 * MiB;
constexpr size_t WS_EDGE = 184 * MiB;
constexpr size_t WS_PART = 186 * MiB;
constexpr size_t WS_END = 190 * MiB;
static_assert(WS_ACT + (size_t)M * FF * 2 <= WS_EDGE && WS_QKV + (size_t)M * NIN * 2 <= WS_Y && WS_Y + (size_t)M * D * 2 <= WS_EDGE, "ws map");

#ifndef REP_P0
#define REP_P0 1
#endif
#ifndef REP_P1
#define REP_P1 1
#endif
#ifndef REP_P3B
#define REP_P3B 1
#endif
#ifndef REP_P4
#define REP_P4 1
#endif
#ifndef ATT_REP
#define ATT_REP 1
#endif
#ifndef REP_P5
#define REP_P5 1
#endif
#ifndef REP_P3
#define REP_P3 1
#endif
#ifndef REP_SYNC
#define REP_SYNC 1
#endif
struct Args {
    const float *x, *g_attn, *w_in, *qn_a, *kn_a, *sink, *qn_b, *kn_b, *lq1, *lk1, *lq2, *lk2, *subln, *w_out, *g_ffn, *w_up, *conv_w, *conv_b, *w_down;
    float* out; unsigned char* ws;
};

__device__ __forceinline__ float wave_sum(float v) {
#pragma unroll
    for (int o = 1; o < 64; o <<= 1) v += __shfl_xor(v, o);
    return v;
}
__device__ __forceinline__ float uniform_f(float v) { return __uint_as_float(__builtin_amdgcn_readfirstlane(__float_as_uint(v))); }
__device__ __forceinline__ float wave_max(float v) {
#pragma unroll
    for (int o = 1; o < 64; o <<= 1) v = fmaxf(v, __shfl_xor(v, o));
    return v;
}
__device__ __forceinline__ unsigned f2bf(float f) { unsigned u = __builtin_bit_cast(unsigned, f); return (u + 0x7fffu + ((u >> 16) & 1u)) >> 16; }
__device__ __forceinline__ unsigned pk2(float lo, float hi) { return f2bf(lo) | (f2bf(hi) << 16); }

__device__ __forceinline__ void transpose_item(const float* __restrict__ W, int K, int N, bf16* __restrict__ WT, LAS float* scr, int kb, int nb, int dnb, int lane, const float* __restrict__ g) {
    const int k0 = 64 * kb, n0 = 32 * nb;
#pragma unroll 8
    for (int i = 0; i < 32; ++i) { const int kk = 2 * i + (lane >> 5); scr[kk * 33 + (lane & 31)] = W[(size_t)(k0 + kk) * N + n0 + (lane & 31)] * (g ? g[k0 + kk] : 1.f); }
    asm volatile("s_waitcnt lgkmcnt(0)" ::: "memory");
    const int c = lane & 7;
#pragma unroll
    for (int j = 0; j < 4; ++j) { const int n = (lane >> 3) + 8 * j; const LAS float* s = scr + (8 * c) * 33 + n;
        u32x4 o; o.x = pk2(s[0 * 33], s[1 * 33]); o.y = pk2(s[2 * 33], s[3 * 33]); o.z = pk2(s[4 * 33], s[5 * 33]); o.w = pk2(s[6 * 33], s[7 * 33]);
        *(u32x4*)(WT + (size_t)(32 * dnb + n) * K + k0 + 8 * c) = o; }
    asm volatile("s_waitcnt lgkmcnt(0)" ::: "memory");
}

__device__ __forceinline__ void convert_rows(const float* __restrict__ x, bf16* __restrict__ out, float* __restrict__ rowsq, int gw, int ngw, int lane) {
    for (int m = gw; m < M; m += ngw) {
        const f32x4* xr = (const f32x4*)(x + (size_t)m * D) + lane; f32x4 v[4]; float s = 0.f;
#pragma unroll
        for (int j = 0; j < 4; ++j) { v[j] = xr[64 * j]; s += dot4(v[j]); }
        s = wave_sum(s);
        if (lane == 0) rowsq[m] = s;
        u32x2* o8 = (u32x2*)(out + (size_t)m * D) + lane;
#pragma unroll
        for (int j = 0; j < 4; ++j) { u32x2 wv; wv.x = pk2(v[j][0], v[j][1]); wv.y = pk2(v[j][2], v[j][3]); o8[64 * j] = wv; }
    }
}

#define XB_TMO      128
#define XB_XCNT(j)  (256  + 64 * (j))
#define XB_XSUB(j)  (1280 + 64 * (j))
#define XB_XGEN(j)  (2304 + 64 * (j))
#define XB_TOP      3328
#define XB_TOPGEN   3392
#define XCD_BAR_WORDS 3456
#define XB_SPIN_CAP (1u << 18)

__device__ __forceinline__ unsigned xb_ld(unsigned* p)              { return __hip_atomic_load(p, __ATOMIC_RELAXED, __HIP_MEMORY_SCOPE_AGENT); }
__device__ __forceinline__ unsigned xb_add(unsigned* p, unsigned v) { return __hip_atomic_fetch_add(p, v, __ATOMIC_RELAXED, __HIP_MEMORY_SCOPE_AGENT); }
__device__ __forceinline__ unsigned xb_xcc_id() { return (unsigned)__builtin_amdgcn_s_getreg((3 << 11) | 20) & 0xFu; }
#define XB_SPIN(cond, bar) do { unsigned _sp = 0; while (cond) { __builtin_amdgcn_s_sleep(1); \
    if ((++_sp & 255u) == 0u) { if (xb_ld(&(bar)[XB_TMO])) break; if (_sp > XB_SPIN_CAP) { atomicAdd(&(bar)[XB_TMO], 1u); break; } } } } while (0)

struct XcdBarrier {
    unsigned* bar; unsigned x;
    volatile LAS unsigned* st;
};

__device__ __forceinline__ XcdBarrier xcd_barrier_post(unsigned* bar, volatile LAS unsigned* st) {
    XcdBarrier b; b.bar = bar; b.x = xb_xcc_id(); b.st = st;
    if (threadIdx.x == 0) (void)xb_add(&bar[XB_XCNT(b.x)], 1u);
    return b;
}
__device__ __forceinline__ void xcd_barrier_complete(unsigned* bar, unsigned x, unsigned& nloc, unsigned& nx) {
    const unsigned G = gridDim.x * gridDim.y * gridDim.z;
    unsigned sum, cnt, mine, sp = 0u;
    for (;;) {
        sum = 0u; cnt = 0u; mine = 0u;
#pragma unroll
        for (unsigned j = 0; j < 16; ++j) { const unsigned c = xb_ld(&bar[XB_XCNT(j)]); sum += c; cnt += (c > 0u) ? 1u : 0u; mine = (j == x) ? c : mine; }
        if (sum == G) break;
        __builtin_amdgcn_s_sleep(1);
        if ((++sp & 255u) == 0u) { if (xb_ld(&bar[XB_TMO])) break; if (sp > XB_SPIN_CAP) { atomicAdd(&bar[XB_TMO], 1u); break; } }
    }
    nloc = mine > 0u ? mine : 1u; nx = cnt > 0u ? cnt : 1u;
}

__device__ __forceinline__ void xcd_barrier(const XcdBarrier& b) {
    asm volatile("s_waitcnt vmcnt(0)" ::: "memory");
    __syncthreads();
    if (threadIdx.x == 0) {
        unsigned* bar = b.bar;
        __builtin_amdgcn_s_waitcnt(0);
        unsigned nloc = b.st[0], nx = b.st[1];
        if (nloc == 0u) { xcd_barrier_complete(bar, b.x, nloc, nx); b.st[0] = nloc; b.st[1] = nx; }
        const unsigned old = xb_add(&bar[XB_XSUB(b.x)], 1u);
        const unsigned gen = old / nloc;
        if (old + 1u == (gen + 1u) * nloc) {
            __builtin_amdgcn_fence(__ATOMIC_RELEASE, "agent");
            asm volatile("s_waitcnt vmcnt(0)" ::: "memory");
            const unsigned og = xb_add(&bar[XB_TOP], 1u);
            const unsigned tg = og / nx;
            if (og + 1u == (tg + 1u) * nx) xb_add(&bar[XB_TOPGEN], 1u);
            else XB_SPIN(xb_ld(&bar[XB_TOPGEN]) == tg, bar);
            __builtin_amdgcn_fence(__ATOMIC_ACQUIRE, "agent");
            xb_add(&bar[XB_XGEN(b.x)], 1u);
            asm volatile("s_waitcnt vmcnt(0)" ::: "memory");
        } else {
            XB_SPIN(xb_ld(&bar[XB_XGEN(b.x)]) == gen, bar);
            __builtin_amdgcn_fence(__ATOMIC_ACQUIRE, "agent");
            asm volatile("s_waitcnt vmcnt(0)" ::: "memory");
        }
    }
    __syncthreads();
}

__global__ void __launch_bounds__(512, 2) mega_fwd(Args a) {
    extern __shared__ __attribute__((aligned(16))) unsigned char lds_raw[];
    LAS unsigned char* lds = (LAS unsigned char*)lds_raw;
    cg::grid_group grid = cg::this_grid();
    const int tid = threadIdx.x, lane = tid & 63, wave = __builtin_amdgcn_readfirstlane(tid >> 6);
    const int G = gridDim.x, bx = blockIdx.x;
    const int vcu = (G % 8 == 0) ? (bx % 8) * (G / 8) + bx / 8 : bx;
    const int gw = vcu * 8 + wave, ngw = G * 8;
    typedef const __attribute__((address_space(4))) Args* kargs_t;
    const kargs_t kap = (kargs_t)__builtin_amdgcn_kernarg_segment_ptr();
#define PHASE_ARGS() kargs_t ap = kap; asm volatile("" : "+s"(ap)); unsigned char* const ws = ap->ws; \
    float* const cosT = (float*)(ws + WS_ROPE); float* const sinT = cosT + S * 32; \
    bf16* const Hb = (bf16*)(ws + WS_H); bf16* const QKV = (bf16*)(ws + WS_QKV); bf16* const Yb = (bf16*)(ws + WS_Y); bf16* const ACT = (bf16*)(ws + WS_ACT); \
    float* const edge = (float*)(ws + WS_EDGE); float* const part = (float*)(ws + WS_PART); float* const rowsq = (float*)(ws + WS_ROWSQ); \
    (void)cosT; (void)sinT; (void)Hb; (void)QKV; (void)Yb; (void)ACT; (void)edge; (void)part; (void)rowsq
    volatile LAS unsigned* misc = (volatile LAS unsigned*)(lds + MISC_OFF);
    if (tid < 16) misc[tid] = 0u;
    __syncthreads();
    XcdBarrier xbar; { PHASE_ARGS(); xbar = xcd_barrier_post((unsigned*)(ws + WS_CTL) + 1024, misc); }

#define CONVERT_WEIGHTS(L, wv, nwv) do { \
        int lane = threadIdx.x & 63; asm volatile("" : "+v"(lane)); \
        LAS float* scr = (LAS float*)(lds + wave * 16384); \
        constexpr int I_IN = 16 * 72, I_OUT = 16 * 32, I_UP = 16 * 176, I_DOWN = 44 * 32, I_L = I_IN + I_OUT + I_UP + I_DOWN; \
        unsigned char* wl_ = ws + WS_W + (size_t)(L) * W_LAYER; \
        for (int it = (wv); it < I_L; it += (nwv)) { \
            int r = it; \
            if (r < I_IN) { const int kb = r / 72, nb = r % 72; const int pn = nb >> 3, wc = (nb >> 1) & 3, bj = nb & 1; \
                transpose_item(ap->w_in + (size_t)(L) * D * NIN, D, NIN, (bf16*)(wl_ + W_IN), scr, kb, nb, 8 * pn + 4 * bj + wc, lane, ap->g_attn + (L) * D); continue; } \
            r -= I_IN; \
            if (r < I_OUT) { const int kb = r / 32, nb = r % 32; transpose_item(ap->w_out + (size_t)(L) * D * D, D, D, (bf16*)(wl_ + W_OUT), scr, kb, nb, nb, lane, nullptr); continue; } \
            r -= I_OUT; \
            if (r < I_UP) { const int kb = r / 176, nb = r % 176; const int isv = nb >= 88, nn = isv ? nb - 88 : nb; const int dnb = 8 * (nn >> 2) + 4 * isv + (nn & 3); \
                transpose_item(ap->w_up + (size_t)(L) * D * NUP, D, NUP, (bf16*)(wl_ + W_UP), scr, kb, nb, dnb, lane, ap->g_ffn + (L) * D); continue; } \
            r -= I_UP; \
            { const int kb = r / 32, nb = r % 32; transpose_item(ap->w_down + (size_t)(L) * FF * D, FF, D, (bf16*)(wl_ + W_DOWN), scr, kb, nb, nb, lane, nullptr); } \
        } } while (0)
    {
        PHASE_ARGS();
        CONVERT_WEIGHTS(0, gw, ngw);
        for (int i = vcu * 512 + tid; i < S * 32; i += G * 512) {
            const int pos = i >> 5, j = i & 31;
            double inv = 1.0; for (int k = 0; k < j; ++k) inv *= 0.74989420933245582730;
            const double ang = (double)pos * inv;
            const double kq = __builtin_rint(ang * 0.15915494309189533577);
            const double rr = (ang - kq * 6.283185307179586232) - kq * 2.4492935982947064e-16;
            const double r2 = rr * rr;
            double sn = 1.0, cs = 1.0;
#pragma unroll
            for (int k = 12; k >= 1; --k) { sn = 1.0 - sn * r2 / (double)((2 * k) * (2 * k + 1)); cs = 1.0 - cs * r2 / (double)((2 * k - 1) * (2 * k)); }
            cosT[i] = (float)cs; sinT[i] = (float)(sn * rr);
        }
        convert_rows(ap->x, Hb, rowsq, gw, ngw, lane);
    }
    asm volatile("s_waitcnt vmcnt(0)" ::: "memory");
    __syncthreads();
    if (tid == 0) { __builtin_amdgcn_fence(__ATOMIC_RELEASE, "agent"); asm volatile("s_waitcnt vmcnt(0)" ::: "memory"); }
    grid.sync();
    if (tid == 0) { __builtin_amdgcn_fence(__ATOMIC_ACQUIRE, "agent"); asm volatile("s_waitcnt vmcnt(0)" ::: "memory"); }
    __syncthreads();

    for (int l = 0; l < DEPTH; ++l) {
        const float lambda_init = 0.8f - 0.6f * __expf(-0.3f * (float)l);
        {
            PHASE_ARGS(); unsigned char* const wl = ws + WS_W + (size_t)l * W_LAYER; (void)wl;
            pg8::Gemm g{Hb, (const bf16*)(wl + W_IN), M, NIN, D}; pg8::StaticOrder So; So.init(M, NIN, G, bx);
            EpiInProj E{QKV, ap->qn_a + l * 64, ap->kn_a + l * 64, ap->qn_b + l * 64, ap->kn_b + l * 64, cosT, sinT, rowsq + (size_t)(2 * l) * M};
            pg8::gemm_phase<EpiInProj, pg8::StaticOrder, true, true>(lds, g, So, E);
            if (l == 0 && DEPTH > 1) {
                const int nidle = G - 64;
                if (nidle >= 64) { if (bx >= 64) CONVERT_WEIGHTS(1, (bx - 64) * 8 + wave, nidle * 8); }
                else CONVERT_WEIGHTS(1, gw, ngw);
            }
        }
        xcd_barrier(xbar);
        {
            PHASE_ARGS(); unsigned char* const wl = ws + WS_W + (size_t)l * W_LAYER; (void)wl;
            int lane = threadIdx.x & 63; asm volatile("" : "+v"(lane));
            const float mqa = wave_max(fabsf(ap->qn_a[l * 64 + lane])), mka = wave_max(fabsf(ap->kn_a[l * 64 + lane]));
            const float mqb = wave_max(fabsf(ap->qn_b[l * 64 + lane])), mkb = wave_max(fabsf(ap->kn_b[l * 64 + lane]));
            const float MbA = uniform_f(8.f * mqa * mka * LOG2E * 1.02f), MbB = uniform_f(8.f * mqb * mkb * LOG2E * 1.02f);
            const float s1 = wave_sum(ap->lq1[l * 64 + lane] * ap->lk1[l * 64 + lane]), s2 = wave_sum(ap->lq2[l * 64 + lane] * ap->lk2[l * 64 + lane]);
            const float lam = uniform_f(__expf(s1) - __expf(s2) + lambda_init);
            {
            for (int uidx = vcu; uidx < NB * 4 * 16; uidx += G) {
                const int bh = uidx >> 4, qb = uidx & 15;
                att::diff_unit((LAS char*)lds, QKV, Yb, bh >> 2, bh & 3, qb, MbB, lam, ap->subln + l * 128, 1.f - lambda_init);
            }
            for (int uidx = vcu; uidx < NB * 2 * 16; uidx += G) {
                const int bk = uidx >> 4, n = uidx & 15;
                att::swa_unit((LAS char*)lds, QKV, Yb, bk >> 1, bk & 1, n, MbA, ap->sink + l * 8);
            }
            __syncthreads();
            }
        }
        xcd_barrier(xbar);
        {
            PHASE_ARGS(); unsigned char* const wl = ws + WS_W + (size_t)l * W_LAYER; (void)wl;
            pg8::Gemm g{Yb, (const bf16*)(wl + W_OUT), M, D, D}; pg8::StaticOrder So; So.init(M, D, G, bx);
            EpiResid E{Hb, rowsq + (size_t)(2 * l + 1) * M, nullptr};
            pg8::gemm_phase<EpiResid, pg8::StaticOrder, true, true>(lds, g, So, E);
        }
        xcd_barrier(xbar);
        {
            PHASE_ARGS(); unsigned char* const wl = ws + WS_W + (size_t)l * W_LAYER; (void)wl;
            pg8::Gemm g{Hb, (const bf16*)(wl + W_UP), M, NUP, D}; pg8::StaticOrder So; So.init(M, NUP, G, bx);
            EpiUpConv E{ACT, ap->conv_w + (size_t)l * 3 * FF, ap->conv_b + (size_t)l * FF, edge, part, (LAS float*)(lds + XL_OFF), rowsq + (size_t)(2 * l + 1) * M};
            pg8::gemm_phase<EpiUpConv, pg8::StaticOrder, true, true>(lds, g, So, E);
        }
        xcd_barrier(xbar);
        {
            PHASE_ARGS(); unsigned char* const wl = ws + WS_W + (size_t)l * W_LAYER; (void)wl;
            pg8::Gemm g{ACT, (const bf16*)(wl + W_DOWN), M, D, FF}; pg8::StaticOrder So; So.init(M, D, G, bx);
            { const float* cw = ap->conv_w + (size_t)l * 3 * FF; pg8::Unit uu; int tid = threadIdx.x; asm volatile("" : "+v"(tid));
              for (int ui = 0; So.next(ui, uu); ++ui) { const int pm = uu.pm;
                for (int i = tid; i < 2 * FF; i += 512) { const int which = i / FF, ch = i % FF;
                    if (which == 0 && (pm & 7) != 0) { const float* pp = part + (((size_t)pm * 2 + 0) * FF + ch) * 2;
                        const float pre = pp[0] + cw[ch] * edge[((size_t)(pm - 1) * 2 + 1) * FF + ch];
                        ACT[(size_t)(pm * 256) * FF + ch] = (bf16)f2bf(silu_f(pre) * pp[1]); }
                    if (which == 1 && (pm & 7) != 7) { const float* pp = part + (((size_t)pm * 2 + 1) * FF + ch) * 2;
                        const float pre = pp[0] + cw[2 * FF + ch] * edge[((size_t)(pm + 1) * 2 + 0) * FF + ch];
                        ACT[(size_t)(pm * 256 + 255) * FF + ch] = (bf16)f2bf(silu_f(pre) * pp[1]); } } }
              asm volatile("s_waitcnt vmcnt(0)" ::: "memory"); __syncthreads(); }
            const bool lastl = (l + 1 == DEPTH);
            EpiResid E{Hb, lastl ? nullptr : rowsq + (size_t)(2 * l + 2) * M, lastl ? ap->out : nullptr};
            pg8::gemm_phase<EpiResid, pg8::StaticOrder, true, true>(lds, g, So, E);
        }
        if (l + 1 < DEPTH) xcd_barrier(xbar);
    }
}

extern "C" void kernel_launch(void* const* d_in, const int* in_sizes, int n_in, void* d_out, int out_size, void* d_ws, size_t ws_size, hipStream_t stream) {
    static int grid = 0;
    if (grid == 0) {
        if (n_in != 19 || ws_size < WS_END) { fprintf(stderr, "kernel_launch: unexpected inputs (n_in %d, ws %zu)\n", n_in, ws_size); grid = -1; return; }
        int dev = 0, cus = 0, per_cu = 0;
        hipGetDevice(&dev);
        hipDeviceGetAttribute(&cus, hipDeviceAttributeMultiprocessorCount, dev);
        hipFuncSetAttribute((const void*)mega_fwd, hipFuncAttributeMaxDynamicSharedMemorySize, LDS_BYTES);
        hipOccupancyMaxActiveBlocksPerMultiprocessor(&per_cu, (const void*)mega_fwd, 512, LDS_BYTES);
        if (per_cu < 1) { fprintf(stderr, "kernel_launch: occupancy query reports %d blocks per CU\n", per_cu); per_cu = 1; }
        grid = cus;
        (void)hipGetLastError();
    }
    if (grid < 0) return;
    if (hipMemsetAsync((char*)d_ws + WS_CTL, 0, CTL_BYTES, stream) != hipSuccess) { fprintf(stderr, "kernel_launch: memset failed\n"); return; }
    Args a{};
    const float** p = (const float**)&a;
    for (int i = 0; i < 19; ++i) p[i] = (const float*)d_in[i];
    a.out = (float*)d_out; a.ws = (unsigned char*)d_ws;
    void* args[] = {&a};
    hipError_t e = hipLaunchCooperativeKernel((const void*)mega_fwd, dim3(grid), dim3(512), args, LDS_BYTES, stream);
    if (e != hipSuccess) fprintf(stderr, "cooperative launch failed: %s (grid %d)\n", hipGetErrorString(e), grid);
}
```

```cpp
#include <hip/hip_runtime.h>
#include <hip/hip_cooperative_groups.h>
#include <cstdio>
#include <cstdint>
namespace cg = cooperative_groups;
namespace pg8 {
#define PG8_LAS __attribute__((address_space(3)))
typedef unsigned short bf16_t;
typedef short bf16x8 __attribute__((ext_vector_type(8)));
typedef float f32x4 __attribute__((ext_vector_type(4)));
typedef unsigned u32x4 __attribute__((ext_vector_type(4)));
constexpr int BM = 256, BK = 64, HALF = 128, HTB = HALF * BK * 2  , STAGE_BYTES = 8 * HTB, NXCD = 8, WGM = 8;

__host__ __device__ __forceinline__ int lds_byte(int r, int c) { const int st = (r >> 4) * 2 + (c >> 5), rr = r & 15, cc = c & 31, ob = rr * 64 + cc * 2; return st * 1024 + (ob ^ (((ob >> 9) & 1) << 5)); }
__host__ __device__ __forceinline__ void stage_rc(int b, int& R, int& C) { const int st = b / 1024, sb = b % 1024, swz = sb ^ (((sb >> 9) & 1) << 5); R = (st >> 1) * 16 + swz / 64; C = (st & 1) * 32 + (swz % 64) / 2; }
__host__ __device__ __forceinline__ int perm32(int rho) { const int n = rho >> 4, i = rho & 15; return 8 * (i >> 2) + 4 * n + (i & 3); }

struct Unit { int pm, pn; };
struct Gemm { const bf16_t* A; const bf16_t* Bt; int M, N, K; };

struct StaticOrder {
    int nM, nN, nwg, G, c;
    __host__ __device__ void init(int M, int N, int G_, int c_) { nM = M / BM; nN = N / BM; nwg = nM * nN; G = G_; c = c_; }
    __host__ __device__ bool next(int i, Unit& u) const {
        const long L = (long)i * G + c; if (L >= nwg) return false;
        int wgid = (int)L; { const int q = nwg / NXCD, r = nwg % NXCD, xcd = wgid % NXCD, off = wgid / NXCD; wgid = (xcd < r ? xcd * (q + 1) : r * (q + 1) + (xcd - r) * q) + off; }
        const int nig = WGM * nN, gid = wgid / nig, fm = gid * WGM, gsz = (nM - fm) < WGM ? (nM - fm) : WGM;
        u.pm = fm + ((wgid % nig) % gsz); u.pn = (wgid % nig) / gsz; return true;
    }
    __device__ __forceinline__ void a_ready(const Unit&) const {}
    __device__ __forceinline__ void done(const Unit&) const {}
};

__device__ __forceinline__ unsigned cvt_pk_bf16(float lo, float hi) { unsigned r; asm volatile("v_cvt_pk_bf16_f32 %0, %1, %2" : "=v"(r) : "v"(lo), "v"(hi)); return r; }
template <class Epi, class Sched, bool ALIGN_EPI = false, bool SP2 = false>
__device__ __forceinline__ void gemm_phase(PG8_LAS unsigned char* lds, const Gemm g, const Sched& S, const Epi& E) {
    int tid = threadIdx.x; asm volatile("" : "+v"(tid)); const int wid = __builtin_amdgcn_readfirstlane(tid >> 6), lane = tid & 63, wr = wid >> 2, wc = wid & 3, fr = lane & 15, fq = lane >> 4;
    const int K = g.K, nt = K / BK;
    unsigned voffA[2], voffB[2];
#pragma unroll
    for (int i = 0; i < 2; ++i) { int R, C; stage_rc(tid * 16 + i * 8192, R, C); const int Rb = Epi::PERM ? ((R & ~31) + perm32(R & 31)) : R;
        voffA[i] = (unsigned)(R * K + C) * 2u; voffB[i] = (unsigned)(Rb * K + C) * 2u; }
    const size_t kstep = (size_t)(BK * 2);
    const size_t hstep = (size_t)HALF * K * 2;
    const size_t tstep = 2 * hstep;
    const unsigned ldsw = (unsigned)wid * 1024u;
    const int aoff = lds_byte(wr * 64 + fr, fq * 8), boff = lds_byte(wc * 32 + fr, fq * 8);
#define PG8_SA(b, h) (((b) * 2 + (h)) * HTB)
#define PG8_SB(b, h) ((4 + (b) * 2 + (h)) * HTB)
#define PG8_STAGE(bufoff, gbase, voff) do { _Pragma("unroll") for (int _i = 0; _i < 2; ++_i) \
        __builtin_amdgcn_global_load_lds((const unsigned*)((const char*)(gbase) + (voff)[_i]), (PG8_LAS unsigned*)(lds + (bufoff) + ldsw + _i * 8192), 16, 0, 0); } while (0)
#define PG8_LDA(dst, b, h) do { _Pragma("unroll") for (int m = 0; m < 4; ++m) _Pragma("unroll") for (int k = 0; k < 2; ++k) dst[m][k] = *(const PG8_LAS bf16x8*)(lds + PG8_SA(b, h) + aoff + m * 2048 + k * 1024); } while (0)
#define PG8_LDB(dst, b, h) do { _Pragma("unroll") for (int n = 0; n < 2; ++n) _Pragma("unroll") for (int k = 0; k < 2; ++k) dst[n][k] = *(const PG8_LAS bf16x8*)(lds + PG8_SB(b, h) + boff + n * 2048 + k * 1024); } while (0)
#define PG8_MMA(ai, bj, At, Bt) do { __builtin_amdgcn_s_setprio(1); _Pragma("unroll") for (int m = 0; m < 4; ++m) _Pragma("unroll") for (int n = 0; n < 2; ++n) _Pragma("unroll") for (int k = 0; k < 2; ++k) \
        acc[ai][bj][m][n] = __builtin_amdgcn_mfma_f32_16x16x32_bf16(Bt[n][k], At[m][k], acc[ai][bj][m][n], 0, 0, 0); __builtin_amdgcn_s_setprio(0); } while (0)
#define PG8_WAIT_V(n) asm volatile("s_waitcnt vmcnt(" #n ")" ::: "memory")
#define PG8_WAIT_L(n) asm volatile("s_waitcnt lgkmcnt(" #n ")" ::: "memory")
#define PG8_BAR __builtin_amdgcn_s_barrier()
#define PG8_SCHED __builtin_amdgcn_sched_barrier(0)
    Unit cur, nxt; int ui = 0;
    if (!S.next(0, cur)) return;
    f32x4 acc[2][2][4][2];
#pragma unroll
    for (int a = 0; a < 2; ++a)
#pragma unroll
        for (int b = 0; b < 2; ++b)
#pragma unroll
            for (int m = 0; m < 4; ++m)
#pragma unroll
                for (int n = 0; n < 2; ++n) acc[a][b][m][n] = (f32x4){0.f, 0.f, 0.f, 0.f};
    bf16x8 At[4][2], B0[2][2], B1[2][2];
    const char* cA = (const char*)g.A + (size_t)cur.pm * tstep; const char* cB = (const char*)g.Bt + (size_t)cur.pn * tstep;
    S.a_ready(cur);
    if constexpr (SP2) {
        PG8_STAGE(PG8_SB(0, 0), cB, voffB); PG8_STAGE(PG8_SB(0, 1), cB + hstep, voffB); PG8_STAGE(PG8_SA(0, 0), cA, voffA); PG8_STAGE(PG8_SA(0, 1), cA + hstep, voffA);
        if (wr == 1) PG8_BAR;
        PG8_WAIT_V(2); PG8_BAR;
        PG8_STAGE(PG8_SB(1, 0), cB + kstep, voffB); PG8_STAGE(PG8_SA(1, 0), cA + kstep, voffA); PG8_STAGE(PG8_SB(1, 1), cB + hstep + kstep, voffB);
        PG8_WAIT_V(6); PG8_BAR;
    } else {
        PG8_STAGE(PG8_SB(0, 0), cB, voffB); PG8_STAGE(PG8_SA(0, 0), cA, voffA); PG8_STAGE(PG8_SB(0, 1), cB + hstep, voffB); PG8_STAGE(PG8_SA(0, 1), cA + hstep, voffA);
        if (wr == 1) PG8_BAR;
        PG8_WAIT_V(4); PG8_BAR;
        PG8_STAGE(PG8_SB(1, 0), cB + kstep, voffB); PG8_STAGE(PG8_SA(1, 0), cA + kstep, voffA); PG8_STAGE(PG8_SB(1, 1), cB + hstep + kstep, voffB);
        PG8_WAIT_V(6); PG8_BAR;
    }
    for (;;) {
        const bool has_next = S.next(ui + 1, nxt);
        const char* nA = has_next ? (const char*)g.A + (size_t)nxt.pm * tstep : cA; const char* nB = has_next ? (const char*)g.Bt + (size_t)nxt.pn * tstep : cB;
        for (int t = 0; t < nt; t += 2) {
            const bool last = (t == nt - 2);
            const char* a1 = cA + (size_t)(t + 1) * kstep;
            const char* a2 = last ? nA : cA + (size_t)(t + 2) * kstep; const char* b2 = last ? nB : cB + (size_t)(t + 2) * kstep;
            const char* a3 = a2 + kstep; const char* b3 = b2 + kstep;
            if (last && has_next) S.a_ready(nxt);
            if constexpr (SP2) {
            PG8_LDB(B0, 0, 0); PG8_LDB(B1, 0, 1); PG8_SCHED; PG8_LDA(At, 0, 0); PG8_STAGE(PG8_SA(1, 1), a1 + hstep, voffA);
            PG8_WAIT_V(8); PG8_WAIT_L(0); PG8_BAR; PG8_MMA(0, 0, At, B0); PG8_MMA(0, 1, At, B1); PG8_BAR; PG8_SCHED;
            PG8_LDA(At, 0, 1); PG8_STAGE(PG8_SB(0, 0), b2, voffB); PG8_STAGE(PG8_SB(0, 1), b2 + hstep, voffB); PG8_STAGE(PG8_SA(0, 0), a2, voffA);
            PG8_WAIT_V(8); PG8_WAIT_L(0); PG8_BAR; PG8_MMA(1, 0, At, B0); PG8_MMA(1, 1, At, B1); PG8_BAR; PG8_SCHED;
            PG8_LDB(B0, 1, 0); PG8_LDB(B1, 1, 1); PG8_SCHED; PG8_LDA(At, 1, 0); PG8_STAGE(PG8_SA(0, 1), a2 + hstep, voffA);
            PG8_WAIT_V(8); PG8_WAIT_L(0); PG8_BAR; PG8_MMA(0, 0, At, B0); PG8_MMA(0, 1, At, B1); PG8_BAR; PG8_SCHED;
            PG8_LDA(At, 1, 1); PG8_STAGE(PG8_SB(1, 0), b3, voffB); PG8_STAGE(PG8_SB(1, 1), b3 + hstep, voffB); PG8_STAGE(PG8_SA(1, 0), a3, voffA);
            PG8_WAIT_V(8); PG8_WAIT_L(0); PG8_BAR; PG8_MMA(1, 0, At, B0); PG8_MMA(1, 1, At, B1); PG8_BAR; PG8_SCHED;
            } else {
            PG8_LDB(B0, 0, 0); PG8_SCHED; PG8_LDA(At, 0, 0); PG8_STAGE(PG8_SA(1, 1), a1 + hstep, voffA);
            PG8_WAIT_L(8); PG8_BAR; PG8_WAIT_L(0); PG8_MMA(0, 0, At, B0); PG8_BAR; PG8_SCHED;
            PG8_LDB(B1, 0, 1); PG8_STAGE(PG8_SB(0, 0), b2, voffB);
            PG8_BAR; PG8_WAIT_L(0); PG8_MMA(0, 1, At, B1); PG8_BAR;
            PG8_LDA(At, 0, 1); PG8_STAGE(PG8_SA(0, 0), a2, voffA);
            PG8_BAR; PG8_WAIT_L(0); PG8_MMA(1, 0, At, B0); PG8_BAR; PG8_SCHED;
            PG8_STAGE(PG8_SB(0, 1), b2 + hstep, voffB);
            PG8_WAIT_V(6); PG8_BAR; PG8_MMA(1, 1, At, B1); PG8_BAR;
            PG8_LDB(B0, 1, 0); PG8_SCHED; PG8_LDA(At, 1, 0); PG8_STAGE(PG8_SA(0, 1), a2 + hstep, voffA);
            PG8_WAIT_L(8); PG8_BAR; PG8_WAIT_L(0); PG8_MMA(0, 0, At, B0); PG8_BAR; PG8_SCHED;
            PG8_LDB(B1, 1, 1); PG8_STAGE(PG8_SB(1, 0), b3, voffB);
            PG8_BAR; PG8_WAIT_L(0); PG8_MMA(0, 1, At, B1); PG8_BAR;
            PG8_LDA(At, 1, 1); PG8_STAGE(PG8_SA(1, 0), a3, voffA);
            PG8_BAR; PG8_WAIT_L(0); PG8_MMA(1, 0, At, B0); PG8_BAR; PG8_SCHED;
            PG8_STAGE(PG8_SB(1, 1), b3 + hstep, voffB);
            PG8_WAIT_V(6); PG8_BAR; PG8_MMA(1, 1, At, B1); PG8_BAR;
            }
        }
        if constexpr (ALIGN_EPI) { if (wr == 0) PG8_BAR; }
        if constexpr (!Epi::AFTER_DRAIN) { E(acc, cur, wr, wc, fr, fq); S.done(cur); }
        if (!has_next) break;
#pragma unroll
        for (int a = 0; a < 2; ++a)
#pragma unroll
            for (int b = 0; b < 2; ++b)
#pragma unroll
                for (int m = 0; m < 4; ++m)
#pragma unroll
                    for (int n = 0; n < 2; ++n) acc[a][b][m][n] = (f32x4){0.f, 0.f, 0.f, 0.f};
        cur = nxt; cA = nA; cB = nB; ++ui;
        if constexpr (ALIGN_EPI) { if (wr == 1) PG8_BAR; }
    }
    PG8_WAIT_V(0);
    if constexpr (!ALIGN_EPI) { if (wr == 0) PG8_BAR; }
    PG8_BAR;
    if constexpr (Epi::AFTER_DRAIN) { E.fused(acc, cur, wr, wc, fr, fq, lds, wid, lane); S.done(cur); }
#undef PG8_SA
#undef PG8_SB
#undef PG8_STAGE
#undef PG8_LDA
#undef PG8_LDB
#undef PG8_MMA
#undef PG8_WAIT_V
#undef PG8_WAIT_L
#undef PG8_BAR
#undef PG8_SCHED
}
}
#define LAS __attribute__((address_space(3)))
typedef unsigned short bf16;
using pg8::f32x4; using pg8::u32x4; using pg8::Unit; using pg8::cvt_pk_bf16; using pg8::bf16x8;
typedef unsigned u32x2 __attribute__((ext_vector_type(2)));

constexpr int NB = 8, S = 2048, D = 1024, M = NB * S, NIN = 2304, FF = 2816, NUP = 2 * FF, DEPTH = 2;
constexpr float EPS = 1e-6f;
constexpr float LOG2E = 1.4426950408889634f;
constexpr float QSCALE = 0.125f * LOG2E;
constexpr int XL_OFF = 131072;
constexpr int LDS_BYTES = 131072 + 8192;

__device__ __forceinline__ float dot4(f32x4 a) { return (a[0] * a[0] + a[1] * a[1]) + (a[2] * a[2] + a[3] * a[3]); }
__device__ __forceinline__ float silu_f(float v) { return v * __builtin_amdgcn_rcpf(1.f + __expf(-v)); }

struct EpiInProj {
    static constexpr bool PERM = true, AFTER_DRAIN = false;
    bf16* O; const float* qn_a; const float* kn_a; const float* qn_b; const float* kn_b; const float* cosT; const float* sinT; const float* rowsq;
    __device__ __forceinline__ void operator()(const f32x4 (&acc)[2][2][4][2], const Unit& u, int wr, int wc, int fr, int fq) const {
        asm volatile("" : "+v"(fr), "+v"(fq));
        const int pn = u.pn;
        const float* g = nullptr; float sc = 1.f;
        if (pn < 2) { g = qn_a; sc = QSCALE; }
        else if (pn == 2) { if (wc < 2) g = kn_a; }
        else if (pn < 5) { g = qn_b; sc = QSCALE; }
        else if (pn < 7) { g = kn_b; }
        const int colb = pn * 256 + wc * 64 + 8 * fq;
        const int row0 = u.pm * 256 + wr * 64 + fr;
        if (g) {
            f32x4 g1[2], g2[2];
#pragma unroll
            for (int n = 0; n < 2; ++n) { g1[n] = *(const f32x4*)(g + 8 * fq + 4 * n); g2[n] = *(const f32x4*)(g + 32 + 8 * fq + 4 * n); }
#pragma unroll
            for (int ai = 0; ai < 2; ++ai)
#pragma unroll
                for (int m = 0; m < 4; ++m) {
                    const int row = row0 + ai * 128 + m * 16;
                    const f32x4 a0 = acc[ai][0][m][0], a1 = acc[ai][0][m][1], b0 = acc[ai][1][m][0], b1 = acc[ai][1][m][1];
                    float ss = (dot4(a0) + dot4(a1)) + (dot4(b0) + dot4(b1));
                    ss += __shfl_xor(ss, 16); ss += __shfl_xor(ss, 32);
                    const float rx = rsqrtf(rowsq[row] * (1.f / D) + EPS);
                    const float rs = rsqrtf(ss * rx * rx * (1.f / 64.f) + EPS) * rx * sc;
                    const size_t ro = (size_t)(row & (S - 1)) * 32 + 8 * fq;
                    const f32x4 c0 = *(const f32x4*)(cosT + ro), c1 = *(const f32x4*)(cosT + ro + 4), s0 = *(const f32x4*)(sinT + ro), s1 = *(const f32x4*)(sinT + ro + 4);
                    const f32x4 y10 = a0 * rs * g1[0], y11 = a1 * rs * g1[1], y20 = b0 * rs * g2[0], y21 = b1 * rs * g2[1];
                    const f32x4 o10 = y10 * c0 - y20 * s0, o11 = y11 * c1 - y21 * s1, o20 = y20 * c0 + y10 * s0, o21 = y21 * c1 + y11 * s1;
                    u32x4 w1, w2;
                    w1.x = cvt_pk_bf16(o10[0], o10[1]); w1.y = cvt_pk_bf16(o10[2], o10[3]); w1.z = cvt_pk_bf16(o11[0], o11[1]); w1.w = cvt_pk_bf16(o11[2], o11[3]);
                    w2.x = cvt_pk_bf16(o20[0], o20[1]); w2.y = cvt_pk_bf16(o20[2], o20[3]); w2.z = cvt_pk_bf16(o21[0], o21[1]); w2.w = cvt_pk_bf16(o21[2], o21[3]);
                    bf16* op = O + (size_t)row * NIN + colb;
                    *(u32x4*)op = w1; *(u32x4*)(op + 32) = w2;
                }
        } else {
#pragma unroll
            for (int ai = 0; ai < 2; ++ai)
#pragma unroll
                for (int m = 0; m < 4; ++m) {
                    const int row = row0 + ai * 128 + m * 16;
                    bf16* op = O + (size_t)row * NIN + colb;
                    const float rx = rsqrtf(rowsq[row] * (1.f / D) + EPS);
#pragma unroll
                    for (int bj = 0; bj < 2; ++bj) { const f32x4 v0 = acc[ai][bj][m][0] * rx, v1 = acc[ai][bj][m][1] * rx; u32x4 w;
                        w.x = cvt_pk_bf16(v0[0], v0[1]); w.y = cvt_pk_bf16(v0[2], v0[3]); w.z = cvt_pk_bf16(v1[0], v1[1]); w.w = cvt_pk_bf16(v1[2], v1[3]);
                        *(u32x4*)(op + 32 * bj) = w; }
                }
        }
    }
};

__device__ __forceinline__ f32x4 bf2f_lo(unsigned a, unsigned b) { return (f32x4){__uint_as_float(a << 16), __uint_as_float(a & 0xffff0000u), __uint_as_float(b << 16), __uint_as_float(b & 0xffff0000u)}; }
struct EpiResid {
    static constexpr bool PERM = true, AFTER_DRAIN = false;
    bf16* XB; float* rowsq; float* outf;
    __device__ __forceinline__ void operator()(const f32x4 (&acc)[2][2][4][2], const Unit& u, int wr, int wc, int fr, int fq) const {
        asm volatile("" : "+v"(fr), "+v"(fq));
        const int col0 = u.pn * 256 + wc * 32 + 8 * fq, row0 = u.pm * 256 + wr * 64 + fr;
#pragma unroll
        for (int ai = 0; ai < 2; ++ai) {
            u32x4 xr[4][2];
#pragma unroll
            for (int m = 0; m < 4; ++m) { const size_t off = (size_t)(row0 + ai * 128 + m * 16) * D + col0;
#pragma unroll
                for (int bj = 0; bj < 2; ++bj) xr[m][bj] = *(const u32x4*)(XB + off + bj * 128); }
            asm volatile("" ::: "memory");
#pragma unroll
            for (int m = 0; m < 4; ++m) { const int row = row0 + ai * 128 + m * 16; const size_t off = (size_t)row * D + col0; float ss = 0.f;
#pragma unroll
                for (int bj = 0; bj < 2; ++bj) {
                    const f32x4 y0 = bf2f_lo(xr[m][bj].x, xr[m][bj].y) + acc[ai][bj][m][0], y1 = bf2f_lo(xr[m][bj].z, xr[m][bj].w) + acc[ai][bj][m][1];
                    ss += dot4(y0) + dot4(y1);
                    if (outf) { *(f32x4*)(outf + off + bj * 128) = y0; *(f32x4*)(outf + off + bj * 128 + 4) = y1; }
                    else { u32x4 w; w.x = cvt_pk_bf16(y0[0], y0[1]); w.y = cvt_pk_bf16(y0[2], y0[3]); w.z = cvt_pk_bf16(y1[0], y1[1]); w.w = cvt_pk_bf16(y1[2], y1[3]); *(u32x4*)(XB + off + bj * 128) = w; }
                }
                if (rowsq) { ss += __shfl_xor(ss, 16); ss += __shfl_xor(ss, 32); if (fq == 0) atomicAdd(rowsq + row, ss); }
            }
            asm volatile("" ::: "memory");
        }
    }
};

struct EpiUpConv {
    static constexpr bool PERM = true, AFTER_DRAIN = false;
    bf16* ACT; const float* cw; const float* cb; float* edge; float* part; LAS float* xl; const float* rowsq;
    __device__ __forceinline__ void operator()(f32x4 (&acc)[2][2][4][2], const Unit& u, int wr, int wc, int fr, int fq) const {
        asm volatile("" : "+v"(fr), "+v"(fq));
        const int lane = 16 * fq + fr;
        const int cl0 = 32 * wc + 8 * fq, ch0 = 128 * u.pn + cl0;
#pragma unroll
        for (int ai = 0; ai < 2; ++ai)
#pragma unroll
            for (int m = 0; m < 4; ++m) { const float rx = rsqrtf(rowsq[u.pm * 256 + ai * 128 + wr * 64 + m * 16 + fr] * (1.f / D) + EPS);
#pragma unroll
                for (int bj = 0; bj < 2; ++bj) { acc[ai][bj][m][0] *= rx; acc[ai][bj][m][1] *= rx; } }
#pragma unroll
        for (int ai = 0; ai < 2; ++ai) {
            const int chunk = 2 * ai + wr;
            if (fr == 0) { *(LAS f32x4*)(xl + (chunk * 2 + 0) * 128 + cl0) = acc[ai][0][0][0]; *(LAS f32x4*)(xl + (chunk * 2 + 0) * 128 + cl0 + 4) = acc[ai][0][0][1]; }
            if (fr == 15) { *(LAS f32x4*)(xl + (chunk * 2 + 1) * 128 + cl0) = acc[ai][0][3][0]; *(LAS f32x4*)(xl + (chunk * 2 + 1) * 128 + cl0 + 4) = acc[ai][0][3][1]; }
        }
        asm volatile("s_waitcnt lgkmcnt(0)" ::: "memory"); __builtin_amdgcn_s_barrier(); asm volatile("" ::: "memory");
        const int lup = (lane & ~15) | ((fr + 15) & 15), ldn = (lane & ~15) | ((fr + 1) & 15);
        const bool seq_first = (u.pm & 7) == 0, seq_last = (u.pm & 7) == 7;
#pragma unroll
        for (int ai = 0; ai < 2; ++ai) {
            const int chunk = 2 * ai + wr;
#pragma unroll
            for (int n = 0; n < 2; ++n) {
                const int ch = ch0 + 4 * n;
                const f32x4 w0 = *(const f32x4*)(cw + ch), w1 = *(const f32x4*)(cw + FF + ch), w2 = *(const f32x4*)(cw + 2 * FF + ch), bb = *(const f32x4*)(cb + ch);
                const f32x4 above = (chunk > 0) ? *(const LAS f32x4*)(xl + ((chunk - 1) * 2 + 1) * 128 + cl0 + 4 * n) : (f32x4){0.f, 0.f, 0.f, 0.f};
                const f32x4 below = (chunk < 3) ? *(const LAS f32x4*)(xl + ((chunk + 1) * 2 + 0) * 128 + cl0 + 4 * n) : (f32x4){0.f, 0.f, 0.f, 0.f};
                f32x4 Rprev = above, Lcur;
#pragma unroll
                for (int e = 0; e < 4; ++e) Lcur[e] = __shfl(acc[ai][0][0][n][e], ldn);
#pragma unroll
                for (int m = 0; m < 4; ++m) {
                    const int rt = ai * 128 + wr * 64 + m * 16 + fr;
                    const size_t row = (size_t)u.pm * 256 + rt;
                    const f32x4 cur = acc[ai][0][m][n], val = acc[ai][1][m][n];
                    f32x4 Rm, Lnext = below;
#pragma unroll
                    for (int e = 0; e < 4; ++e) { Rm[e] = __shfl(cur[e], lup); if (m < 3) Lnext[e] = __shfl(acc[ai][0][m < 3 ? m + 1 : 3][n][e], ldn); }
                    const f32x4 up = (fr == 0) ? Rprev : Rm, dn = (fr == 15) ? Lnext : Lcur;
                    Rprev = Rm; Lcur = Lnext;
                    const f32x4 pre = bb + w0 * up + w1 * cur + w2 * dn;
                    f32x4 res;
#pragma unroll
                    for (int e = 0; e < 4; ++e) res[e] = silu_f(pre[e]) * val[e];
                    if (rt == 0) {
                        *(f32x4*)(edge + ((size_t)u.pm * 2 + 0) * FF + ch) = cur;
                        if (!seq_first) { float* pp = part + (((size_t)u.pm * 2 + 0) * FF + ch) * 2;
                            *(f32x4*)pp = (f32x4){pre[0], val[0], pre[1], val[1]}; *(f32x4*)(pp + 4) = (f32x4){pre[2], val[2], pre[3], val[3]}; }
                    }
                    if (rt == 255) {
                        *(f32x4*)(edge + ((size_t)u.pm * 2 + 1) * FF + ch) = cur;
                        if (!seq_last) { float* pp = part + (((size_t)u.pm * 2 + 1) * FF + ch) * 2;
                            *(f32x4*)pp = (f32x4){pre[0], val[0], pre[1], val[1]}; *(f32x4*)(pp + 4) = (f32x4){pre[2], val[2], pre[3], val[3]}; }
                    }
                    u32x2 w; w.x = cvt_pk_bf16(res[0], res[1]); w.y = cvt_pk_bf16(res[2], res[3]);
                    *(u32x2*)(ACT + row * FF + ch) = w;
                }
            }
        }
    }
};
namespace att {
typedef __attribute__((ext_vector_type(16))) float f32x16;
typedef __attribute__((ext_vector_type(4))) short s16x4;
typedef short v4i16_t __attribute__((ext_vector_type(4)));
typedef LAS const char* lptr;
__device__ __forceinline__ s16x4 vtr(lptr p) { return __builtin_bit_cast(s16x4, __builtin_amdgcn_ds_read_tr16_b64_v4i16((LAS v4i16_t*)p)); }
typedef float f32x2_t __attribute__((ext_vector_type(2))); typedef __bf16 bf16x2_t __attribute__((ext_vector_type(2)));
__device__ __forceinline__ unsigned cvtpk_s(float lo, float hi) { f32x2_t v = {lo, hi}; bf16x2_t b = __builtin_convertvector(v, bf16x2_t); return __builtin_bit_cast(unsigned, b); }
__device__ __forceinline__ bf16x8 pack8(const f32x16& s, int b) {
    u32x4 w; w.x = cvtpk_s(s[b], s[b + 1]); w.y = cvtpk_s(s[b + 2], s[b + 3]); w.z = cvtpk_s(s[b + 4], s[b + 5]); w.w = cvtpk_s(s[b + 6], s[b + 7]);
    return __builtin_bit_cast(bf16x8, w);
}
#define MFMA32(a, b, c) __builtin_amdgcn_mfma_f32_32x32x16_bf16((a), (b), (c), 0, 0, 0)

#define LGKM_WAIT(n) asm volatile("s_waitcnt lgkmcnt(" #n ")" ::: "memory")
#define SCHED_FENCE() __builtin_amdgcn_sched_barrier(0)
__device__ __forceinline__ bf16x8 rd128(unsigned addr, int off) { bf16x8 r; asm volatile("ds_read_b128 %0, %1 offset:%c2" : "=&v"(r) : "v"(addr), "i"(off) : "memory"); return r; }
__device__ __forceinline__ s16x4 rdtr(unsigned addr, int off) { s16x4 r; asm volatile("ds_read_b64_tr_b16 %0, %1 offset:%c2" : "=&v"(r) : "v"(addr), "i"(off) : "memory"); return r; }
#define VFRAG(lo, hh) ((bf16x8){lo[0], lo[1], lo[2], lo[3], hh[0], hh[1], hh[2], hh[3]})
constexpr int KROW = 144, VROWD = 320, VROWA = 192;
constexpr int DSTG = 2 * 64 * KROW + 64 * VROWD;
constexpr int ASTG = 64 * KROW + 64 * VROWA;

constexpr int DST3 = 32768;
#define SGB(mask, n) __builtin_amdgcn_sched_group_barrier((mask), (n), 0)
__device__ __forceinline__ void diff_unit(LAS char* lds, const bf16* __restrict__ QKV, bf16* __restrict__ Y, int b, int h, int qb, float Mb, float lam, const float* __restrict__ subln, float outscale) {
    int tid = threadIdx.x; asm volatile("" : "+v"(tid)); const int lane = tid & 63, w = __builtin_amdgcn_readfirstlane(tid >> 6), q = lane & 31, hi = lane >> 5;
    const int rg = w >> 1, c = w & 1;
    const size_t rowQ = (size_t)b * S + qb * 128 + rg * 32 + q;
    const bf16* qp = QKV + rowQ * NIN + 768 + (2 * h + c) * 64 + hi * 8;
    bf16x8 qf[4];
#pragma unroll
    for (int ds = 0; ds < 4; ++ds) qf[ds] = *(const bf16x8*)(qp + ds * 16);
    const int krow = 8 * w + (lane >> 3), kch = (lane & 7) ^ ((krow >> 1) & 7);
    const int vrow = 4 * w + (lane >> 4), vch = (lane & 15) ^ ((vrow & 3) << 2);
    const bf16* kg = QKV + ((size_t)b * S + krow) * NIN + 1280 + 128 * h + kch * 8;
    const bf16* vg = QKV + ((size_t)b * S + vrow) * NIN + 1792 + 128 * h + vch * 8;
#define DDMA(t, so) do { const size_t o_ = (size_t)(t) * 64 * NIN; LAS unsigned char* d_ = (LAS unsigned char*)lds + (so) + w * 1024; \
        __builtin_amdgcn_global_load_lds((const unsigned*)(kg + o_), (LAS unsigned*)(d_), 16, 0, 0); \
        __builtin_amdgcn_global_load_lds((const unsigned*)(kg + o_ + 64), (LAS unsigned*)(d_ + 8192), 16, 0, 0); \
        __builtin_amdgcn_global_load_lds((const unsigned*)(vg + o_), (LAS unsigned*)(d_ + 16384), 16, 0, 0); \
        __builtin_amdgcn_global_load_lds((const unsigned*)(vg + o_ + 32 * NIN), (LAS unsigned*)(d_ + 16384 + 8192), 16, 0, 0); } while (0)
    f32x16 o[4];
#pragma unroll
    for (int i = 0; i < 4; ++i) o[i] = (f32x16){0.f};
    float l = 0.f;
    constexpr int NT = S / 64;
    DDMA(0, 0); DDMA(1, DST3); DDMA(2, 2 * DST3);
    const unsigned lbase = (unsigned)(size_t)lds;
    unsigned kofs[4], vofs[4];
    { const int sw = (q >> 1) & 7, vq = (lane & 15) >> 2;
#pragma unroll
      for (int ds = 0; ds < 4; ++ds) kofs[ds] = (unsigned)(c * 8192 + q * 128 + (((2 * ds + hi) ^ sw) << 4));
#pragma unroll
      for (int db = 0; db < 4; ++db) vofs[db] = (unsigned)(16384 + (4 * hi + vq) * 256 + ((db ^ vq) << 6) + ((lane >> 4) & 1) * 32 + (lane & 3) * 8); }
    f32x16 negm;
#pragma unroll
    for (int r = 0; r < 16; ++r) negm[r] = -Mb;
    f32x16 s0, s1;
    { asm volatile("s_waitcnt vmcnt(8)" ::: "memory"); __builtin_amdgcn_s_barrier(); asm volatile("" ::: "memory");
      bf16x8 kf[8];
#pragma unroll
      for (int ds = 0; ds < 4; ++ds) { kf[2 * ds] = rd128(lbase + kofs[ds], 0); kf[2 * ds + 1] = rd128(lbase + kofs[ds], 32 * 128); }
      LGKM_WAIT(0); SCHED_FENCE();
      s0 = negm; s1 = negm;
#pragma unroll
      for (int ds = 0; ds < 4; ++ds) { s0 = MFMA32(kf[2 * ds], qf[ds], s0); s1 = MFMA32(kf[2 * ds + 1], qf[ds], s1); }
      SCHED_FENCE(); }
    int so_cur = 0, so_n1 = DST3, so_n3 = 3 * DST3;
    for (int t = 0; t < NT; ++t) {
        asm volatile("s_waitcnt vmcnt(4)" ::: "memory");
        __builtin_amdgcn_s_barrier();
        asm volatile("" ::: "memory");
        { const int tn = (t + 3 < NT) ? t + 3 : NT - 1; DDMA(tn, so_n3); }
        const unsigned sb = lbase + so_cur, sn = lbase + so_n1;
        bf16x8 kf[8];
#pragma unroll
        for (int ds = 0; ds < 4; ++ds) { kf[2 * ds] = rd128(sn + kofs[ds], 0); kf[2 * ds + 1] = rd128(sn + kofs[ds], 32 * 128); }
        s16x4 vl[2][4], vh[2][4];
#pragma unroll
        for (int db = 0; db < 4; ++db) { vl[0][db] = rdtr(sb + vofs[db], 0); vh[0][db] = rdtr(sb + vofs[db], 8 * 256); }
        LGKM_WAIT(0); SCHED_FENCE();
        __builtin_amdgcn_s_setprio(1);
        f32x16 n0 = negm, n1 = negm;
#pragma unroll
        for (int ds = 0; ds < 4; ++ds) { n0 = MFMA32(kf[2 * ds], qf[ds], n0); n1 = MFMA32(kf[2 * ds + 1], qf[ds], n1); }
        float ls = 0.f;
#pragma unroll
        for (int r = 0; r < 16; ++r) { s0[r] = __builtin_amdgcn_exp2f(s0[r]); ls += s0[r]; }
        bf16x8 pf[4]; pf[0] = pack8(s0, 0); pf[1] = pack8(s0, 8);
#pragma unroll
        for (int i = 0; i < 8; ++i) { SGB(0x008, 1); SGB(0x400, 2); SGB(0x002, 3); }
        SCHED_FENCE();
        __builtin_amdgcn_s_setprio(0);
#pragma unroll
        for (int db = 0; db < 4; ++db) { vl[1][db] = rdtr(sb + vofs[db], 16 * 256); vh[1][db] = rdtr(sb + vofs[db], 16 * 256 + 8 * 256); }
        s16x4 wl[2][4], wh[2][4];
#pragma unroll
        for (int ks = 0; ks < 2; ++ks)
#pragma unroll
            for (int db = 0; db < 4; ++db) { wl[ks][db] = rdtr(sb + vofs[db], (ks + 2) * 16 * 256); wh[ks][db] = rdtr(sb + vofs[db], (ks + 2) * 16 * 256 + 8 * 256); }
        LGKM_WAIT(15); SCHED_FENCE();
        __builtin_amdgcn_s_setprio(1);
#pragma unroll
        for (int ks = 0; ks < 2; ++ks)
#pragma unroll
            for (int db = 0; db < 4; ++db) o[db] = MFMA32(VFRAG(vl[ks][db], vh[ks][db]), pf[ks], o[db]);
#pragma unroll
        for (int r = 0; r < 16; ++r) { s1[r] = __builtin_amdgcn_exp2f(s1[r]); ls += s1[r]; }
        l += ls;
        pf[2] = pack8(s1, 0); pf[3] = pack8(s1, 8);
#pragma unroll
        for (int i = 0; i < 8; ++i) { SGB(0x008, 1); SGB(0x400, 2); SGB(0x002, 3); }
        SCHED_FENCE();
        LGKM_WAIT(0); SCHED_FENCE();
#pragma unroll
        for (int ks = 0; ks < 2; ++ks)
#pragma unroll
            for (int db = 0; db < 4; ++db) o[db] = MFMA32(VFRAG(wl[ks][db], wh[ks][db]), pf[2 + ks], o[db]);
        SCHED_FENCE();
        __builtin_amdgcn_s_setprio(0);
        s0 = n0; s1 = n1;
        so_cur = so_n1; so_n1 = (so_n1 == 3 * DST3) ? 0 : so_n1 + DST3; so_n3 = (so_n3 == 3 * DST3) ? 0 : so_n3 + DST3;
    }
#undef DDMA
    asm volatile("s_waitcnt vmcnt(0)" ::: "memory");
    __syncthreads();
    l += __shfl_xor(l, 32);
    const float inv = 1.f / l;
    LAS f32x4* xb = (LAS f32x4*)lds + rg * (16 * 64) + lane;
    if (c == 1) {
#pragma unroll
        for (int db = 0; db < 4; ++db)
#pragma unroll
            for (int r4 = 0; r4 < 4; ++r4) xb[(db * 4 + r4) * 64] = (f32x4){o[db][4 * r4], o[db][4 * r4 + 1], o[db][4 * r4 + 2], o[db][4 * r4 + 3]} * inv;
    }
    __syncthreads();
    if (c == 0) {
        float ss = 0.f;
#pragma unroll
        for (int db = 0; db < 4; ++db)
#pragma unroll
            for (int r4 = 0; r4 < 4; ++r4) { const f32x4 ot = xb[(db * 4 + r4) * 64];
#pragma unroll
                for (int e = 0; e < 4; ++e) { const float d = o[db][4 * r4 + e] * inv - lam * ot[e]; o[db][4 * r4 + e] = d; ss += d * d; } }
        ss += __shfl_xor(ss, 32);
        const float rs = rsqrtf(ss * (1.f / 128.f) + EPS) * outscale;
        bf16* yp = Y + rowQ * D + 512 + 128 * h + 4 * hi;
#pragma unroll
        for (int db = 0; db < 4; ++db)
#pragma unroll
            for (int r4 = 0; r4 < 4; ++r4) { const f32x4 gw = *(const f32x4*)(subln + 32 * db + 8 * r4 + 4 * hi);
                u32x2 wv; wv.x = cvt_pk_bf16(o[db][4 * r4] * rs * gw[0], o[db][4 * r4 + 1] * rs * gw[1]); wv.y = cvt_pk_bf16(o[db][4 * r4 + 2] * rs * gw[2], o[db][4 * r4 + 3] * rs * gw[3]);
                *(u32x2*)(yp + 32 * db + 8 * r4) = wv; }
    }
    __syncthreads();
}

__device__ __forceinline__ void swa_unit(LAS char* lds, const bf16* __restrict__ QKV, bf16* __restrict__ Y, int b, int kvh, int n, float Mb, const float* __restrict__ sink) {
    int tid = threadIdx.x; asm volatile("" : "+v"(tid)); const int lane = tid & 63, w = __builtin_amdgcn_readfirstlane(tid >> 6), q = lane & 31, hi = lane >> 5;
    const int head = kvh * 4 + (w >> 1), rb = (w & 1) * 64;
    const size_t rowQ = (size_t)b * S + n * 128 + rb + q;
    bf16x8 qf[2][4];
#pragma unroll
    for (int rg = 0; rg < 2; ++rg)
#pragma unroll
        for (int ds = 0; ds < 4; ++ds) qf[rg][ds] = *(const bf16x8*)(QKV + (rowQ + 32 * rg) * NIN + head * 64 + hi * 8 + ds * 16);
    const int lrow = tid >> 3, lcc = tid & 7;
    const long kp0 = (long)b * S + (long)(n - 1) * 128 + lrow;
    const bf16* kg = QKV + kp0 * NIN + 512 + kvh * 64 + lcc * 8;
    const bf16* vg = QKV + kp0 * NIN + 640 + kvh * 64 + lcc * 8;
    const int kdst = lrow * KROW + lcc * 16, vdst = 64 * KROW + lrow * VROWA + lcc * 16;
    u32x4 st0, st1;
#define ALOAD(t) do { const long o_ = (long)(t) * 64 * NIN; st0 = *(const u32x4*)(kg + o_); st1 = *(const u32x4*)(vg + o_); } while (0)
#define ASTORE(bo) do { *(LAS u32x4*)(lds + (bo) + kdst) = st0; *(LAS u32x4*)(lds + (bo) + vdst) = st1; } while (0)
    f32x16 o[2][2];
#pragma unroll
    for (int i = 0; i < 2; ++i)
#pragma unroll
        for (int j = 0; j < 2; ++j) o[i][j] = (f32x16){0.f};
    float l[2] = {0.f, 0.f};
    const int t0 = (n == 0) ? 2 : 0, t1 = (n == S / 128 - 1) ? 4 : 6;
    ALOAD(t0); ASTORE((t0 & 1) * ASTG); __syncthreads();
    const int koff = q * KROW + hi * 16;
    const int voff = 64 * KROW + (4 * hi + ((lane & 15) >> 2)) * VROWA + ((lane >> 4) & 1) * 32 + (lane & 3) * 8;
    const unsigned lbase = (unsigned)(size_t)lds;
    for (int t = t0; t < t1; ++t) {
        const int cur = (t & 1) * ASTG, nxt = ASTG - cur;
        if (t + 1 < t1) ALOAD(t + 1);
        const unsigned ka = lbase + cur + koff, va = lbase + cur + voff;
        bf16x8 kf[8];
#pragma unroll
        for (int ds = 0; ds < 4; ++ds) { kf[2 * ds] = rd128(ka, ds * 32); kf[2 * ds + 1] = rd128(ka, 32 * KROW + ds * 32); }
        s16x4 vl[4][2], vh[4][2];
#pragma unroll
        for (int ks = 0; ks < 4; ++ks)
#pragma unroll
            for (int db = 0; db < 2; ++db) { vl[ks][db] = rdtr(va, ks * 16 * VROWA + db * 64); vh[ks][db] = rdtr(va, ks * 16 * VROWA + 8 * VROWA + db * 64); }
        LGKM_WAIT(0); SCHED_FENCE();
#pragma unroll
        for (int rg = 0; rg < 2; ++rg) {
            const int i0 = rb + 32 * rg;
            if (64 * t + 63 >= i0 && 64 * t <= i0 + 31 + 256) {
                f32x16 s0 = (f32x16){0.f}, s1 = (f32x16){0.f};
#pragma unroll
                for (int ds = 0; ds < 4; ++ds) { s0 = MFMA32(kf[2 * ds], qf[rg][ds], s0); s1 = MFMA32(kf[2 * ds + 1], qf[rg][ds], s1); }
                const int jb = 64 * t + 4 * hi - (i0 + q);
                float ls = 0.f;
#pragma unroll
                for (int r = 0; r < 16; ++r) {
                    const int d0 = jb + (r & 3) + 8 * (r >> 2), d1 = d0 + 32;
                    const float p0 = __builtin_amdgcn_exp2f(s0[r] - Mb), p1 = __builtin_amdgcn_exp2f(s1[r] - Mb);
                    s0[r] = ((unsigned)d0 <= 256u) ? p0 : 0.f; s1[r] = ((unsigned)d1 <= 256u) ? p1 : 0.f; ls += s0[r] + s1[r];
                }
                l[rg] += ls;
                bf16x8 pf[4]; pf[0] = pack8(s0, 0); pf[1] = pack8(s0, 8); pf[2] = pack8(s1, 0); pf[3] = pack8(s1, 8);
#pragma unroll
                for (int ks = 0; ks < 4; ++ks)
#pragma unroll
                    for (int db = 0; db < 2; ++db) o[rg][db] = MFMA32(VFRAG(vl[ks][db], vh[ks][db]), pf[ks], o[rg][db]);
            }
        }
        SCHED_FENCE();
        if (t + 1 < t1) ASTORE(nxt);
        __syncthreads();
    }
#undef ALOAD
#undef ASTORE
    const float sk = __builtin_amdgcn_exp2f(sink[head] * LOG2E - Mb);
#pragma unroll
    for (int rg = 0; rg < 2; ++rg) {
        float lt = l[rg]; lt += __shfl_xor(lt, 32);
        const float inv = 1.f / (lt + sk);
        bf16* yp = Y + (rowQ + 32 * rg) * D + head * 64 + 4 * hi;
#pragma unroll
        for (int db = 0; db < 2; ++db)
#pragma unroll
            for (int r4 = 0; r4 < 4; ++r4) { u32x2 wv; wv.x = cvt_pk_bf16(o[rg][db][4 * r4] * inv, o[rg][db][4 * r4 + 1] * inv); wv.y = cvt_pk_bf16(o[rg][db][4 * r4 + 2] * inv, o[rg][db][4 * r4 + 3] * inv);
                *(u32x2*)(yp + 32 * db + 8 * r4) = wv; }
    }
}
}
constexpr size_t MiB = 1u << 20;
constexpr size_t WS_CTL = 0, CTL_BYTES = 65536 + 4 * 65536;
constexpr size_t WS_ROWSQ = 65536;
constexpr int MISC_OFF = 131072 + 4096;
constexpr size_t WS_ROPE = 1 * MiB;
constexpr size_t WS_W = 2 * MiB, W_LAYER = 23 * MiB;
constexpr size_t W_IN = 0, W_OUT = (size_t)NIN * D * 2, W_UP = W_OUT + (size_t)D * D * 2, W_DOWN = W_UP + (size_t)NUP * D * 2;
static_assert(W_DOWN + (size_t)D * FF * 2 <= W_LAYER, "weights");
constexpr size_t WS_H = 48 * MiB;
constexpr size_t WS_QKV = 80 * MiB;
constexpr size_t WS_Y = 152 * MiB;
constexpr size_t WS_ACT = 80 * MiB;
constexpr size_t WS_EDGE = 184 * MiB;
constexpr size_t WS_PART = 186 * MiB;
constexpr size_t WS_END = 190 * MiB;
static_assert(WS_ACT + (size_t)M * FF * 2 <= WS_EDGE && WS_QKV + (size_t)M * NIN * 2 <= WS_Y && WS_Y + (size_t)M * D * 2 <= WS_EDGE, "ws map");

#ifndef REP_P0
#define REP_P0 1
#endif
#ifndef REP_P1
#define REP_P1 1
#endif
#ifndef REP_P3B
#define REP_P3B 1
#endif
#ifndef REP_P4
#define REP_P4 1
#endif
#ifndef ATT_REP
#define ATT_REP 1
#endif
#ifndef REP_P5
#define REP_P5 1
#endif
#ifndef REP_P3
#define REP_P3 1
#endif
#ifndef REP_SYNC
#define REP_SYNC 1
#endif
struct Args {
    const float *x, *g_attn, *w_in, *qn_a, *kn_a, *sink, *qn_b, *kn_b, *lq1, *lk1, *lq2, *lk2, *subln, *w_out, *g_ffn, *w_up, *conv_w, *conv_b, *w_down;
    float* out; unsigned char* ws;
};

__device__ __forceinline__ float wave_sum(float v) {
#pragma unroll
    for (int o = 1; o < 64; o <<= 1) v += __shfl_xor(v, o);
    return v;
}
__device__ __forceinline__ float uniform_f(float v) { return __uint_as_float(__builtin_amdgcn_readfirstlane(__float_as_uint(v))); }
__device__ __forceinline__ float wave_max(float v) {
#pragma unroll
    for (int o = 1; o < 64; o <<= 1) v = fmaxf(v, __shfl_xor(v, o));
    return v;
}
__device__ __forceinline__ unsigned f2bf(float f) { unsigned u = __builtin_bit_cast(unsigned, f); return (u + 0x7fffu + ((u >> 16) & 1u)) >> 16; }
__device__ __forceinline__ unsigned pk2(float lo, float hi) { return f2bf(lo) | (f2bf(hi) << 16); }

__device__ __forceinline__ void transpose_item(const float* __restrict__ W, int K, int N, bf16* __restrict__ WT, LAS float* scr, int kb, int nb, int dnb, int lane, const float* __restrict__ g) {
    const int k0 = 64 * kb, n0 = 32 * nb;
#pragma unroll 8
    for (int i = 0; i < 32; ++i) { const int kk = 2 * i + (lane >> 5); scr[kk * 33 + (lane & 31)] = W[(size_t)(k0 + kk) * N + n0 + (lane & 31)] * (g ? g[k0 + kk] : 1.f); }
    asm volatile("s_waitcnt lgkmcnt(0)" ::: "memory");
    const int c = lane & 7;
#pragma unroll
    for (int j = 0; j < 4; ++j) { const int n = (lane >> 3) + 8 * j; const LAS float* s = scr + (8 * c) * 33 + n;
        u32x4 o; o.x = pk2(s[0 * 33], s[1 * 33]); o.y = pk2(s[2 * 33], s[3 * 33]); o.z = pk2(s[4 * 33], s[5 * 33]); o.w = pk2(s[6 * 33], s[7 * 33]);
        *(u32x4*)(WT + (size_t)(32 * dnb + n) * K + k0 + 8 * c) = o; }
    asm volatile("s_waitcnt lgkmcnt(0)" ::: "memory");
}

__device__ __forceinline__ void convert_rows(const float* __restrict__ x, bf16* __restrict__ out, float* __restrict__ rowsq, int gw, int ngw, int lane) {
    for (int m = gw; m < M; m += ngw) {
        const f32x4* xr = (const f32x4*)(x + (size_t)m * D) + lane; f32x4 v[4]; float s = 0.f;
#pragma unroll
        for (int j = 0; j < 4; ++j) { v[j] = xr[64 * j]; s += dot4(v[j]); }
        s = wave_sum(s);
        if (lane == 0) rowsq[m] = s;
        u32x2* o8 = (u32x2*)(out + (size_t)m * D) + lane;
#pragma unroll
        for (int j = 0; j < 4; ++j) { u32x2 wv; wv.x = pk2(v[j][0], v[j][1]); wv.y = pk2(v[j][2], v[j][3]); o8[64 * j] = wv; }
    }
}

#define XB_TMO      128
#define XB_XCNT(j)  (256  + 64 * (j))
#define XB_XSUB(j)  (1280 + 64 * (j))
#define XB_XGEN(j)  (2304 + 64 * (j))
#define XB_TOP      3328
#define XB_TOPGEN   3392
#define XCD_BAR_WORDS 3456
#define XB_SPIN_CAP (1u << 18)

__device__ __forceinline__ unsigned xb_ld(unsigned* p)              { return __hip_atomic_load(p, __ATOMIC_RELAXED, __HIP_MEMORY_SCOPE_AGENT); }
__device__ __forceinline__ unsigned xb_add(unsigned* p, unsigned v) { return __hip_atomic_fetch_add(p, v, __ATOMIC_RELAXED, __HIP_MEMORY_SCOPE_AGENT); }
__device__ __forceinline__ unsigned xb_xcc_id() { return (unsigned)__builtin_amdgcn_s_getreg((3 << 11) | 20) & 0xFu; }
#define XB_SPIN(cond, bar) do { unsigned _sp = 0; while (cond) { __builtin_amdgcn_s_sleep(1); \
    if ((++_sp & 255u) == 0u) { if (xb_ld(&(bar)[XB_TMO])) break; if (_sp > XB_SPIN_CAP) { atomicAdd(&(bar)[XB_TMO], 1u); break; } } } } while (0)

struct XcdBarrier {
    unsigned* bar; unsigned x;
    volatile LAS unsigned* st;
};

__device__ __forceinline__ XcdBarrier xcd_barrier_post(unsigned* bar, volatile LAS unsigned* st) {
    XcdBarrier b; b.bar = bar; b.x = xb_xcc_id(); b.st = st;
    if (threadIdx.x == 0) (void)xb_add(&bar[XB_XCNT(b.x)], 1u);
    return b;
}
__device__ __forceinline__ void xcd_barrier_complete(unsigned* bar, unsigned x, unsigned& nloc, unsigned& nx) {
    const unsigned G = gridDim.x * gridDim.y * gridDim.z;
    unsigned sum, cnt, mine, sp = 0u;
    for (;;) {
        sum = 0u; cnt = 0u; mine = 0u;
#pragma unroll
        for (unsigned j = 0; j < 16; ++j) { const unsigned c = xb_ld(&bar[XB_XCNT(j)]); sum += c; cnt += (c > 0u) ? 1u : 0u; mine = (j == x) ? c : mine; }
        if (sum == G) break;
        __builtin_amdgcn_s_sleep(1);
        if ((++sp & 255u) == 0u) { if (xb_ld(&bar[XB_TMO])) break; if (sp > XB_SPIN_CAP) { atomicAdd(&bar[XB_TMO], 1u); break; } }
    }
    nloc = mine > 0u ? mine : 1u; nx = cnt > 0u ? cnt : 1u;
}

__device__ __forceinline__ void xcd_barrier(const XcdBarrier& b) {
    asm volatile("s_waitcnt vmcnt(0)" ::: "memory");
    __syncthreads();
    if (threadIdx.x == 0) {
        unsigned* bar = b.bar;
        __builtin_amdgcn_s_waitcnt(0);
        unsigned nloc = b.st[0], nx = b.st[1];
        if (nloc == 0u) { xcd_barrier_complete(bar, b.x, nloc, nx); b.st[0] = nloc; b.st[1] = nx; }
        const unsigned old = xb_add(&bar[XB_XSUB(b.x)], 1u);
        const unsigned gen = old / nloc;
        if (old + 1u == (gen + 1u) * nloc) {
            __builtin_amdgcn_fence(__ATOMIC_RELEASE, "agent");
            asm volatile("s_waitcnt vmcnt(0)" ::: "memory");
            const unsigned og = xb_add(&bar[XB_TOP], 1u);
            const unsigned tg = og / nx;
            if (og + 1u == (tg + 1u) * nx) xb_add(&bar[XB_TOPGEN], 1u);
            else XB_SPIN(xb_ld(&bar[XB_TOPGEN]) == tg, bar);
            __builtin_amdgcn_fence(__ATOMIC_ACQUIRE, "agent");
            xb_add(&bar[XB_XGEN(b.x)], 1u);
            asm volatile("s_waitcnt vmcnt(0)" ::: "memory");
        } else {
            XB_SPIN(xb_ld(&bar[XB_XGEN(b.x)]) == gen, bar);
            __builtin_amdgcn_fence(__ATOMIC_ACQUIRE, "agent");
            asm volatile("s_waitcnt vmcnt(0)" ::: "memory");
        }
    }
    __syncthreads();
}

__global__ void __launch_bounds__(512, 2) mega_fwd(Args a) {
    extern __shared__ __attribute__((aligned(16))) unsigned char lds_raw[];
    LAS unsigned char* lds = (LAS unsigned char*)lds_raw;
    cg::grid_group grid = cg::this_grid();
    const int tid = threadIdx.x, lane = tid & 63, wave = __builtin_amdgcn_readfirstlane(tid >> 6);
    const int G = gridDim.x, bx = blockIdx.x;
    const int vcu = (G % 8 == 0) ? (bx % 8) * (G / 8) + bx / 8 : bx;
    const int gw = vcu * 8 + wave, ngw = G * 8;
    typedef const __attribute__((address_space(4))) Args* kargs_t;
    const kargs_t kap = (kargs_t)__builtin_amdgcn_kernarg_segment_ptr();
#define PHASE_ARGS() kargs_t ap = kap; asm volatile("" : "+s"(ap)); unsigned char* const ws = ap->ws; \
    float* const cosT = (float*)(ws + WS_ROPE); float* const sinT = cosT + S * 32; \
    bf16* const Hb = (bf16*)(ws + WS_H); bf16* const QKV = (bf16*)(ws + WS_QKV); bf16* const Yb = (bf16*)(ws + WS_Y); bf16* const ACT = (bf16*)(ws + WS_ACT); \
    float* const edge = (float*)(ws + WS_EDGE); float* const part = (float*)(ws + WS_PART); float* const rowsq = (float*)(ws + WS_ROWSQ); \
    (void)cosT; (void)sinT; (void)Hb; (void)QKV; (void)Yb; (void)ACT; (void)edge; (void)part; (void)rowsq
    volatile LAS unsigned* misc = (volatile LAS unsigned*)(lds + MISC_OFF);
    if (tid < 16) misc[tid] = 0u;
    __syncthreads();
    XcdBarrier xbar; { PHASE_ARGS(); xbar = xcd_barrier_post((unsigned*)(ws + WS_CTL) + 1024, misc); }

#define CONVERT_WEIGHTS(L, wv, nwv) do { \
        int lane = threadIdx.x & 63; asm volatile("" : "+v"(lane)); \
        LAS float* scr = (LAS float*)(lds + wave * 16384); \
        constexpr int I_IN = 16 * 72, I_OUT = 16 * 32, I_UP = 16 * 176, I_DOWN = 44 * 32, I_L = I_IN + I_OUT + I_UP + I_DOWN; \
        unsigned char* wl_ = ws + WS_W + (size_t)(L) * W_LAYER; \
        for (int it = (wv); it < I_L; it += (nwv)) { \
            int r = it; \
            if (r < I_IN) { const int kb = r / 72, nb = r % 72; const int pn = nb >> 3, wc = (nb >> 1) & 3, bj = nb & 1; \
                transpose_item(ap->w_in + (size_t)(L) * D * NIN, D, NIN, (bf16*)(wl_ + W_IN), scr, kb, nb, 8 * pn + 4 * bj + wc, lane, ap->g_attn + (L) * D); continue; } \
            r -= I_IN; \
            if (r < I_OUT) { const int kb = r / 32, nb = r % 32; transpose_item(ap->w_out + (size_t)(L) * D * D, D, D, (bf16*)(wl_ + W_OUT), scr, kb, nb, nb, lane, nullptr); continue; } \
            r -= I_OUT; \
            if (r < I_UP) { const int kb = r / 176, nb = r % 176; const int isv = nb >= 88, nn = isv ? nb - 88 : nb; const int dnb = 8 * (nn >> 2) + 4 * isv + (nn & 3); \
                transpose_item(ap->w_up + (size_t)(L) * D * NUP, D, NUP, (bf16*)(wl_ + W_UP), scr, kb, nb, dnb, lane, ap->g_ffn + (L) * D); continue; } \
            r -= I_UP; \
            { const int kb = r / 32, nb = r % 32; transpose_item(ap->w_down + (size_t)(L) * FF * D, FF, D, (bf16*)(wl_ + W_DOWN), scr, kb, nb, nb, lane, nullptr); } \
        } } while (0)
    {
        PHASE_ARGS();
        CONVERT_WEIGHTS(0, gw, ngw);
        for (int i = vcu * 512 + tid; i < S * 32; i += G * 512) {
            const int pos = i >> 5, j = i & 31;
            double inv = 1.0; for (int k = 0; k < j; ++k) inv *= 0.74989420933245582730;
            const double ang = (double)pos * inv;
            const double kq = __builtin_rint(ang * 0.15915494309189533577);
            const double rr = (ang - kq * 6.283185307179586232) - kq * 2.4492935982947064e-16;
            const double r2 = rr * rr;
            double sn = 1.0, cs = 1.0;
#pragma unroll
            for (int k = 12; k >= 1; --k) { sn = 1.0 - sn * r2 / (double)((2 * k) * (2 * k + 1)); cs = 1.0 - cs * r2 / (double)((2 * k - 1) * (2 * k)); }
            cosT[i] = (float)cs; sinT[i] = (float)(sn * rr);
        }
        convert_rows(ap->x, Hb, rowsq, gw, ngw, lane);
    }
    asm volatile("s_waitcnt vmcnt(0)" ::: "memory");
    __syncthreads();
    if (tid == 0) { __builtin_amdgcn_fence(__ATOMIC_RELEASE, "agent"); asm volatile("s_waitcnt vmcnt(0)" ::: "memory"); }
    grid.sync();
    if (tid == 0) { __builtin_amdgcn_fence(__ATOMIC_ACQUIRE, "agent"); asm volatile("s_waitcnt vmcnt(0)" ::: "memory"); }
    __syncthreads();

    for (int l = 0; l < DEPTH; ++l) {
        const float lambda_init = 0.8f - 0.6f * __expf(-0.3f * (float)l);
        {
            PHASE_ARGS(); unsigned char* const wl = ws + WS_W + (size_t)l * W_LAYER; (void)wl;
            pg8::Gemm g{Hb, (const bf16*)(wl + W_IN), M, NIN, D}; pg8::StaticOrder So; So.init(M, NIN, G, bx);
            EpiInProj E{QKV, ap->qn_a + l * 64, ap->kn_a + l * 64, ap->qn_b + l * 64, ap->kn_b + l * 64, cosT, sinT, rowsq + (size_t)(2 * l) * M};
            pg8::gemm_phase<EpiInProj, pg8::StaticOrder, true, true>(lds, g, So, E);
            if (l == 0 && DEPTH > 1) {
                const int nidle = G - 64;
                if (nidle >= 64) { if (bx >= 64) CONVERT_WEIGHTS(1, (bx - 64) * 8 + wave, nidle * 8); }
                else CONVERT_WEIGHTS(1, gw, ngw);
            }
        }
        xcd_barrier(xbar);
        {
            PHASE_ARGS(); unsigned char* const wl = ws + WS_W + (size_t)l * W_LAYER; (void)wl;
            int lane = threadIdx.x & 63; asm volatile("" : "+v"(lane));
            const float mqa = wave_max(fabsf(ap->qn_a[l * 64 + lane])), mka = wave_max(fabsf(ap->kn_a[l * 64 + lane]));
            const float mqb = wave_max(fabsf(ap->qn_b[l * 64 + lane])), mkb = wave_max(fabsf(ap->kn_b[l * 64 + lane]));
            const float MbA = uniform_f(8.f * mqa * mka * LOG2E * 1.02f), MbB = uniform_f(8.f * mqb * mkb * LOG2E * 1.02f);
            const float s1 = wave_sum(ap->lq1[l * 64 + lane] * ap->lk1[l * 64 + lane]), s2 = wave_sum(ap->lq2[l * 64 + lane] * ap->lk2[l * 64 + lane]);
            const float lam = uniform_f(__expf(s1) - __expf(s2) + lambda_init);
            {
            for (int uidx = vcu; uidx < NB * 4 * 16; uidx += G) {
                const int bh = uidx >> 4, qb = uidx & 15;
                att::diff_unit((LAS char*)lds, QKV, Yb, bh >> 2, bh & 3, qb, MbB, lam, ap->subln + l * 128, 1.f - lambda_init);
            }
            for (int uidx = vcu; uidx < NB * 2 * 16; uidx += G) {
                const int bk = uidx >> 4, n = uidx & 15;
                att::swa_unit((LAS char*)lds, QKV, Yb, bk >> 1, bk & 1, n, MbA, ap->sink + l * 8);
            }
            __syncthreads();
            }
        }
        xcd_barrier(xbar);
        {
            PHASE_ARGS(); unsigned char* const wl = ws + WS_W + (size_t)l * W_LAYER; (void)wl;
            pg8::Gemm g{Yb, (const bf16*)(wl + W_OUT), M, D, D}; pg8::StaticOrder So; So.init(M, D, G, bx);
            EpiResid E{Hb, rowsq + (size_t)(2 * l + 1) * M, nullptr};
            pg8::gemm_phase<EpiResid, pg8::StaticOrder, true, true>(lds, g, So, E);
        }
        xcd_barrier(xbar);
        {
            PHASE_ARGS(); unsigned char* const wl = ws + WS_W + (size_t)l * W_LAYER; (void)wl;
            pg8::Gemm g{Hb, (const bf16*)(wl + W_UP), M, NUP, D}; pg8::StaticOrder So; So.init(M, NUP, G, bx);
            EpiUpConv E{ACT, ap->conv_w + (size_t)l * 3 * FF, ap->conv_b + (size_t)l * FF, edge, part, (LAS float*)(lds + XL_OFF), rowsq + (size_t)(2 * l + 1) * M};
            pg8::gemm_phase<EpiUpConv, pg8::StaticOrder, true, true>(lds, g, So, E);
        }
        xcd_barrier(xbar);
        {
            PHASE_ARGS(); unsigned char* const wl = ws + WS_W + (size_t)l * W_LAYER; (void)wl;
            pg8::Gemm g{ACT, (const bf16*)(wl + W_DOWN), M, D, FF}; pg8::StaticOrder So; So.init(M, D, G, bx);
            { const float* cw = ap->conv_w + (size_t)l * 3 * FF; pg8::Unit uu; int tid = threadIdx.x; asm volatile("" : "+v"(tid));
              for (int ui = 0; So.next(ui, uu); ++ui) { const int pm = uu.pm;
                for (int i = tid; i < 2 * FF; i += 512) { const int which = i / FF, ch = i % FF;
                    if (which == 0 && (pm & 7) != 0) { const float* pp = part + (((size_t)pm * 2 + 0) * FF + ch) * 2;
                        const float pre = pp[0] + cw[ch] * edge[((size_t)(pm - 1) * 2 + 1) * FF + ch];
                        ACT[(size_t)(pm * 256) * FF + ch] = (bf16)f2bf(silu_f(pre) * pp[1]); }
                    if (which == 1 && (pm & 7) != 7) { const float* pp = part + (((size_t)pm * 2 + 1) * FF + ch) * 2;
                        const float pre = pp[0] + cw[2 * FF + ch] * edge[((size_t)(pm + 1) * 2 + 0) * FF + ch];
                        ACT[(size_t)(pm * 256 + 255) * FF + ch] = (bf16)f2bf(silu_f(pre) * pp[1]); } } }
              asm volatile("s_waitcnt vmcnt(0)" ::: "memory"); __syncthreads(); }
            const bool lastl = (l + 1 == DEPTH);
            EpiResid E{Hb, lastl ? nullptr : rowsq + (size_t)(2 * l + 2) * M, lastl ? ap->out : nullptr};
            pg8::gemm_phase<EpiResid, pg8::StaticOrder, true, true>(lds, g, So, E);
        }
        if (l + 1 < DEPTH) xcd_barrier(xbar);
    }
}

extern "C" void kernel_launch(void* const* d_in, const int* in_sizes, int n_in, void* d_out, int out_size, void* d_ws, size_t ws_size, hipStream_t stream) {
    static int grid = 0;
    if (grid == 0) {
        if (n_in != 19 || ws_size < WS_END) { fprintf(stderr, "kernel_launch: unexpected inputs (n_in %d, ws %zu)\n", n_in, ws_size); grid = -1; return; }
        int dev = 0, cus = 0, per_cu = 0;
        hipGetDevice(&dev);
        hipDeviceGetAttribute(&cus, hipDeviceAttributeMultiprocessorCount, dev);
        hipFuncSetAttribute((const void*)mega_fwd, hipFuncAttributeMaxDynamicSharedMemorySize, LDS_BYTES);
        hipOccupancyMaxActiveBlocksPerMultiprocessor(&per_cu, (const void*)mega_fwd, 512, LDS_BYTES);
        if (per_cu < 1) { fprintf(stderr, "kernel_launch: occupancy query reports %d blocks per CU\n", per_cu); per_cu = 1; }
        grid = cus;
        (void)hipGetLastError();
    }
    if (grid < 0) return;
    if (hipMemsetAsync((char*)d_ws + WS_CTL, 0, CTL_BYTES, stream) != hipSuccess) { fprintf(stderr, "kernel_launch: memset failed\n"); return; }
    Args a{};
    const float** p = (const float**)&a;
    for (int i = 0; i < 19; ++i) p[i] = (const float*)d_in[i];
    a.out = (float*)d_out; a.ws = (unsigned char*)d_ws;
    void* args[] = {&a};
    hipError_t e = hipLaunchCooperativeKernel((const void*)mega_fwd, dim3(grid), dim3(512), args, LDS_BYTES, stream);
    if (e != hipSuccess) fprintf(stderr, "cooperative launch failed: %s (grid %d)\n", hipGetErrorString(e), grid);
}
```

```cpp
#include <hip/hip_runtime.h>
#include <hip/hip_cooperative_groups.h>
#include <cstdio>
#include <cstdint>
namespace cg = cooperative_groups;
namespace pg8 {
#define PG8_LAS __attribute__((address_space(3)))
typedef unsigned short bf16_t;
typedef short bf16x8 __attribute__((ext_vector_type(8)));
typedef float f32x4 __attribute__((ext_vector_type(4)));
typedef unsigned u32x4 __attribute__((ext_vector_type(4)));
constexpr int BM = 256, BK = 64, HALF = 128, HTB = HALF * BK * 2  , STAGE_BYTES = 8 * HTB, NXCD = 8, WGM = 4;

__host__ __device__ __forceinline__ int lds_byte(int r, int c) { const int st = (r >> 4) * 2 + (c >> 5), rr = r & 15, cc = c & 31, ob = rr * 64 + cc * 2; return st * 1024 + (ob ^ (((ob >> 9) & 1) << 5)); }
__host__ __device__ __forceinline__ void stage_rc(int b, int& R, int& C) { const int st = b / 1024, sb = b % 1024, swz = sb ^ (((sb >> 9) & 1) << 5); R = (st >> 1) * 16 + swz / 64; C = (st & 1) * 32 + (swz % 64) / 2; }
__host__ __device__ __forceinline__ int perm32(int rho) { const int n = rho >> 4, i = rho & 15; return 8 * (i >> 2) + 4 * n + (i & 3); }

struct Unit { int pm, pn; };
struct Gemm { const bf16_t* A; const bf16_t* Bt; int M, N, K; };

struct StaticOrder {
    int nM, nN, nwg, G, c;
    __host__ __device__ void init(int M, int N, int G_, int c_) { nM = M / BM; nN = N / BM; nwg = nM * nN; G = G_; c = c_; }
    __host__ __device__ bool next(int i, Unit& u) const {
        const long L = (long)i * G + c; if (L >= nwg) return false;
        int wgid = (int)L; { const int q = nwg / NXCD, r = nwg % NXCD, xcd = wgid % NXCD, off = wgid / NXCD; wgid = (xcd < r ? xcd * (q + 1) : r * (q + 1) + (xcd - r) * q) + off; }
        const int nig = WGM * nN, gid = wgid / nig, fm = gid * WGM, gsz = (nM - fm) < WGM ? (nM - fm) : WGM;
        u.pm = fm + ((wgid % nig) % gsz); u.pn = (wgid % nig) / gsz; return true;
    }
    __device__ __forceinline__ void a_ready(const Unit&) const {}
    __device__ __forceinline__ void done(const Unit&) const {}
};

__device__ __forceinline__ unsigned cvt_pk_bf16(float lo, float hi) { unsigned r; asm volatile("v_cvt_pk_bf16_f32 %0, %1, %2" : "=v"(r) : "v"(lo), "v"(hi)); return r; }
template <class Epi, class Sched, bool ALIGN_EPI = false, bool SP2 = false>
__device__ __forceinline__ void gemm_phase(PG8_LAS unsigned char* lds, const Gemm g, const Sched& S, const Epi& E) {
    int tid = threadIdx.x; asm volatile("" : "+v"(tid)); const int wid = __builtin_amdgcn_readfirstlane(tid >> 6), lane = tid & 63, wr = wid >> 2, wc = wid & 3, fr = lane & 15, fq = lane >> 4;
    const int K = g.K, nt = K / BK;
    unsigned voffA[2], voffB[2];
#pragma unroll
    for (int i = 0; i < 2; ++i) { int R, C; stage_rc(tid * 16 + i * 8192, R, C); const int Rb = Epi::PERM ? ((R & ~31) + perm32(R & 31)) : R;
        voffA[i] = (unsigned)(R * K + C) * 2u; voffB[i] = (unsigned)(Rb * K + C) * 2u; }
    const size_t kstep = (size_t)(BK * 2);
    const size_t hstep = (size_t)HALF * K * 2;
    const size_t tstep = 2 * hstep;
    const unsigned ldsw = (unsigned)wid * 1024u;
    const int aoff = lds_byte(wr * 64 + fr, fq * 8), boff = lds_byte(wc * 32 + fr, fq * 8);
#define PG8_SA(b, h) (((b) * 2 + (h)) * HTB)
#define PG8_SB(b, h) ((4 + (b) * 2 + (h)) * HTB)
#define PG8_STAGE(bufoff, gbase, voff) do { _Pragma("unroll") for (int _i = 0; _i < 2; ++_i) \
        __builtin_amdgcn_global_load_lds((const unsigned*)((const char*)(gbase) + (voff)[_i]), (PG8_LAS unsigned*)(lds + (bufoff) + ldsw + _i * 8192), 16, 0, 0); } while (0)
#define PG8_LDA(dst, b, h) do { _Pragma("unroll") for (int m = 0; m < 4; ++m) _Pragma("unroll") for (int k = 0; k < 2; ++k) dst[m][k] = *(const PG8_LAS bf16x8*)(lds + PG8_SA(b, h) + aoff + m * 2048 + k * 1024); } while (0)
#define PG8_LDB(dst, b, h) do { _Pragma("unroll") for (int n = 0; n < 2; ++n) _Pragma("unroll") for (int k = 0; k < 2; ++k) dst[n][k] = *(const PG8_LAS bf16x8*)(lds + PG8_SB(b, h) + boff + n * 2048 + k * 1024); } while (0)
#define PG8_MMA(ai, bj, At, Bt) do { __builtin_amdgcn_s_setprio(1); _Pragma("unroll") for (int m = 0; m < 4; ++m) _Pragma("unroll") for (int n = 0; n < 2; ++n) _Pragma("unroll") for (int k = 0; k < 2; ++k) \
        acc[ai][bj][m][n] = __builtin_amdgcn_mfma_f32_16x16x32_bf16(Bt[n][k], At[m][k], acc[ai][bj][m][n], 0, 0, 0); __builtin_amdgcn_s_setprio(0); } while (0)
#define PG8_WAIT_V(n) asm volatile("s_waitcnt vmcnt(" #n ")" ::: "memory")
#define PG8_WAIT_L(n) asm volatile("s_waitcnt lgkmcnt(" #n ")" ::: "memory")
#define PG8_BAR __builtin_amdgcn_s_barrier()
#define PG8_SCHED __builtin_amdgcn_sched_barrier(0)
    Unit cur, nxt; int ui = 0;
    if (!S.next(0, cur)) return;
    f32x4 acc[2][2][4][2];
#pragma unroll
    for (int a = 0; a < 2; ++a)
#pragma unroll
        for (int b = 0; b < 2; ++b)
#pragma unroll
            for (int m = 0; m < 4; ++m)
#pragma unroll
                for (int n = 0; n < 2; ++n) acc[a][b][m][n] = (f32x4){0.f, 0.f, 0.f, 0.f};
    bf16x8 At[4][2], B0[2][2], B1[2][2];
    const char* cA = (const char*)g.A + (size_t)cur.pm * tstep; const char* cB = (const char*)g.Bt + (size_t)cur.pn * tstep;
    S.a_ready(cur);
    if constexpr (SP2) {
        PG8_STAGE(PG8_SB(0, 0), cB, voffB); PG8_STAGE(PG8_SB(0, 1), cB + hstep, voffB); PG8_STAGE(PG8_SA(0, 0), cA, voffA); PG8_STAGE(PG8_SA(0, 1), cA + hstep, voffA);
        if (wr == 1) PG8_BAR;
        PG8_WAIT_V(2); PG8_BAR;
        PG8_STAGE(PG8_SB(1, 0), cB + kstep, voffB); PG8_STAGE(PG8_SA(1, 0), cA + kstep, voffA); PG8_STAGE(PG8_SB(1, 1), cB + hstep + kstep, voffB);
        PG8_WAIT_V(6); PG8_BAR;
    } else {
        PG8_STAGE(PG8_SB(0, 0), cB, voffB); PG8_STAGE(PG8_SA(0, 0), cA, voffA); PG8_STAGE(PG8_SB(0, 1), cB + hstep, voffB); PG8_STAGE(PG8_SA(0, 1), cA + hstep, voffA);
        if (wr == 1) PG8_BAR;
        PG8_WAIT_V(4); PG8_BAR;
        PG8_STAGE(PG8_SB(1, 0), cB + kstep, voffB); PG8_STAGE(PG8_SA(1, 0), cA + kstep, voffA); PG8_STAGE(PG8_SB(1, 1), cB + hstep + kstep, voffB);
        PG8_WAIT_V(6); PG8_BAR;
    }
    for (;;) {
        const bool has_next = S.next(ui + 1, nxt);
        const char* nA = has_next ? (const char*)g.A + (size_t)nxt.pm * tstep : cA; const char* nB = has_next ? (const char*)g.Bt + (size_t)nxt.pn * tstep : cB;
        for (int t = 0; t < nt; t += 2) {
            const bool last = (t == nt - 2);
            const char* a1 = cA + (size_t)(t + 1) * kstep;
            const char* a2 = last ? nA : cA + (size_t)(t + 2) * kstep; const char* b2 = last ? nB : cB + (size_t)(t + 2) * kstep;
            const char* a3 = a2 + kstep; const char* b3 = b2 + kstep;
            if (last && has_next) S.a_ready(nxt);
            if constexpr (SP2) {
            PG8_LDB(B0, 0, 0); PG8_LDB(B1, 0, 1); PG8_SCHED; PG8_LDA(At, 0, 0); PG8_STAGE(PG8_SA(1, 1), a1 + hstep, voffA);
            PG8_WAIT_V(8); PG8_WAIT_L(0); PG8_BAR; PG8_MMA(0, 0, At, B0); PG8_MMA(0, 1, At, B1); PG8_BAR; PG8_SCHED;
            PG8_LDA(At, 0, 1); PG8_STAGE(PG8_SB(0, 0), b2, voffB); PG8_STAGE(PG8_SB(0, 1), b2 + hstep, voffB); PG8_STAGE(PG8_SA(0, 0), a2, voffA);
            PG8_WAIT_V(8); PG8_WAIT_L(0); PG8_BAR; PG8_MMA(1, 0, At, B0); PG8_MMA(1, 1, At, B1); PG8_BAR; PG8_SCHED;
            PG8_LDB(B0, 1, 0); PG8_LDB(B1, 1, 1); PG8_SCHED; PG8_LDA(At, 1, 0); PG8_STAGE(PG8_SA(0, 1), a2 + hstep, voffA);
            PG8_WAIT_V(8); PG8_WAIT_L(0); PG8_BAR; PG8_MMA(0, 0, At, B0); PG8_MMA(0, 1, At, B1); PG8_BAR; PG8_SCHED;
            PG8_LDA(At, 1, 1); PG8_STAGE(PG8_SB(1, 0), b3, voffB); PG8_STAGE(PG8_SB(1, 1), b3 + hstep, voffB); PG8_STAGE(PG8_SA(1, 0), a3, voffA);
            PG8_WAIT_V(8); PG8_WAIT_L(0); PG8_BAR; PG8_MMA(1, 0, At, B0); PG8_MMA(1, 1, At, B1); PG8_BAR; PG8_SCHED;
            } else {
            PG8_LDB(B0, 0, 0); PG8_SCHED; PG8_LDA(At, 0, 0); PG8_STAGE(PG8_SA(1, 1), a1 + hstep, voffA);
            PG8_WAIT_L(8); PG8_BAR; PG8_WAIT_L(0); PG8_MMA(0, 0, At, B0); PG8_BAR; PG8_SCHED;
            PG8_LDB(B1, 0, 1); PG8_STAGE(PG8_SB(0, 0), b2, voffB);
            PG8_BAR; PG8_WAIT_L(0); PG8_MMA(0, 1, At, B1); PG8_BAR;
            PG8_LDA(At, 0, 1); PG8_STAGE(PG8_SA(0, 0), a2, voffA);
            PG8_BAR; PG8_WAIT_L(0); PG8_MMA(1, 0, At, B0); PG8_BAR; PG8_SCHED;
            PG8_STAGE(PG8_SB(0, 1), b2 + hstep, voffB);
            PG8_WAIT_V(6); PG8_BAR; PG8_MMA(1, 1, At, B1); PG8_BAR;
            PG8_LDB(B0, 1, 0); PG8_SCHED; PG8_LDA(At, 1, 0); PG8_STAGE(PG8_SA(0, 1), a2 + hstep, voffA);
            PG8_WAIT_L(8); PG8_BAR; PG8_WAIT_L(0); PG8_MMA(0, 0, At, B0); PG8_BAR; PG8_SCHED;
            PG8_LDB(B1, 1, 1); PG8_STAGE(PG8_SB(1, 0), b3, voffB);
            PG8_BAR; PG8_WAIT_L(0); PG8_MMA(0, 1, At, B1); PG8_BAR;
            PG8_LDA(At, 1, 1); PG8_STAGE(PG8_SA(1, 0), a3, voffA);
            PG8_BAR; PG8_WAIT_L(0); PG8_MMA(1, 0, At, B0); PG8_BAR; PG8_SCHED;
            PG8_STAGE(PG8_SB(1, 1), b3 + hstep, voffB);
            PG8_WAIT_V(6); PG8_BAR; PG8_MMA(1, 1, At, B1); PG8_BAR;
            }
        }
        if constexpr (ALIGN_EPI) { if (wr == 0) PG8_BAR; }
        if constexpr (!Epi::AFTER_DRAIN) { E(acc, cur, wr, wc, fr, fq); S.done(cur); }
        if (!has_next) break;
#pragma unroll
        for (int a = 0; a < 2; ++a)
#pragma unroll
            for (int b = 0; b < 2; ++b)
#pragma unroll
                for (int m = 0; m < 4; ++m)
#pragma unroll
                    for (int n = 0; n < 2; ++n) acc[a][b][m][n] = (f32x4){0.f, 0.f, 0.f, 0.f};
        cur = nxt; cA = nA; cB = nB; ++ui;
        if constexpr (ALIGN_EPI) { if (wr == 1) PG8_BAR; }
    }
    PG8_WAIT_V(0);
    if constexpr (!ALIGN_EPI) { if (wr == 0) PG8_BAR; }
    PG8_BAR;
    if constexpr (Epi::AFTER_DRAIN) { E.fused(acc, cur, wr, wc, fr, fq, lds, wid, lane); S.done(cur); }
#undef PG8_SA
#undef PG8_SB
#undef PG8_STAGE
#undef PG8_LDA
#undef PG8_LDB
#undef PG8_MMA
#undef PG8_WAIT_V
#undef PG8_WAIT_L
#undef PG8_BAR
#undef PG8_SCHED
}
}
#define LAS __attribute__((address_space(3)))
typedef unsigned short bf16;
using pg8::f32x4; using pg8::u32x4; using pg8::Unit; using pg8::cvt_pk_bf16; using pg8::bf16x8;
typedef unsigned u32x2 __attribute__((ext_vector_type(2)));

constexpr int NB = 8, S = 2048, D = 1024, M = NB * S, NIN = 2304, FF = 2816, NUP = 2 * FF, DEPTH = 2;
constexpr float EPS = 1e-6f;
constexpr float LOG2E = 1.4426950408889634f;
constexpr float QSCALE = 0.125f * LOG2E;
constexpr int XL_OFF = 131072;
constexpr int LDS_BYTES = 131072 + 8192;

__device__ __forceinline__ float dot4(f32x4 a) { return (a[0] * a[0] + a[1] * a[1]) + (a[2] * a[2] + a[3] * a[3]); }
__device__ __forceinline__ float silu_f(float v) { return v * __builtin_amdgcn_rcpf(1.f + __expf(-v)); }

struct EpiInProj {
    static constexpr bool PERM = true, AFTER_DRAIN = false;
    bf16* O; const float* qn_a; const float* kn_a; const float* qn_b; const float* kn_b; const float* cosT; const float* sinT; const float* rowsq;
    __device__ __forceinline__ void operator()(const f32x4 (&acc)[2][2][4][2], const Unit& u, int wr, int wc, int fr, int fq) const {
        asm volatile("" : "+v"(fr), "+v"(fq));
        const int pn = u.pn;
        const float* g = nullptr; float sc = 1.f;
        if (pn < 2) { g = qn_a; sc = QSCALE; }
        else if (pn == 2) { if (wc < 2) g = kn_a; }
        else if (pn < 5) { g = qn_b; sc = QSCALE; }
        else if (pn < 7) { g = kn_b; }
        const int colb = pn * 256 + wc * 64 + 8 * fq;
        const int row0 = u.pm * 256 + wr * 64 + fr;
        if (g) {
            f32x4 g1[2], g2[2];
#pragma unroll
            for (int n = 0; n < 2; ++n) { g1[n] = *(const f32x4*)(g + 8 * fq + 4 * n); g2[n] = *(const f32x4*)(g + 32 + 8 * fq + 4 * n); }
#pragma unroll
            for (int ai = 0; ai < 2; ++ai)
#pragma unroll
                for (int m = 0; m < 4; ++m) {
                    const int row = row0 + ai * 128 + m * 16;
                    const f32x4 a0 = acc[ai][0][m][0], a1 = acc[ai][0][m][1], b0 = acc[ai][1][m][0], b1 = acc[ai][1][m][1];
                    float ss = (dot4(a0) + dot4(a1)) + (dot4(b0) + dot4(b1));
                    ss += __shfl_xor(ss, 16); ss += __shfl_xor(ss, 32);
                    const float rx = rsqrtf(rowsq[row] * (1.f / D) + EPS);
                    const float rs = rsqrtf(ss * rx * rx * (1.f / 64.f) + EPS) * rx * sc;
                    const size_t ro = (size_t)(row & (S - 1)) * 32 + 8 * fq;
                    const f32x4 c0 = *(const f32x4*)(cosT + ro), c1 = *(const f32x4*)(cosT + ro + 4), s0 = *(const f32x4*)(sinT + ro), s1 = *(const f32x4*)(sinT + ro + 4);
                    const f32x4 y10 = a0 * rs * g1[0], y11 = a1 * rs * g1[1], y20 = b0 * rs * g2[0], y21 = b1 * rs * g2[1];
                    const f32x4 o10 = y10 * c0 - y20 * s0, o11 = y11 * c1 - y21 * s1, o20 = y20 * c0 + y10 * s0, o21 = y21 * c1 + y11 * s1;
                    u32x4 w1, w2;
                    w1.x = cvt_pk_bf16(o10[0], o10[1]); w1.y = cvt_pk_bf16(o10[2], o10[3]); w1.z = cvt_pk_bf16(o11[0], o11[1]); w1.w = cvt_pk_bf16(o11[2], o11[3]);
                    w2.x = cvt_pk_bf16(o20[0], o20[1]); w2.y = cvt_pk_bf16(o20[2], o20[3]); w2.z = cvt_pk_bf16(o21[0], o21[1]); w2.w = cvt_pk_bf16(o21[2], o21[3]);
                    bf16* op = O + (size_t)row * NIN + colb;
                    *(u32x4*)op = w1; *(u32x4*)(op + 32) = w2;
                }
        } else {
#pragma unroll
            for (int ai = 0; ai < 2; ++ai)
#pragma unroll
                for (int m = 0; m < 4; ++m) {
                    const int row = row0 + ai * 128 + m * 16;
                    bf16* op = O + (size_t)row * NIN + colb;
                    const float rx = rsqrtf(rowsq[row] * (1.f / D) + EPS);
#pragma unroll
                    for (int bj = 0; bj < 2; ++bj) { const f32x4 v0 = acc[ai][bj][m][0] * rx, v1 = acc[ai][bj][m][1] * rx; u32x4 w;
                        w.x = cvt_pk_bf16(v0[0], v0[1]); w.y = cvt_pk_bf16(v0[2], v0[3]); w.z = cvt_pk_bf16(v1[0], v1[1]); w.w = cvt_pk_bf16(v1[2], v1[3]);
                        *(u32x4*)(op + 32 * bj) = w; }
                }
        }
    }
};

__device__ __forceinline__ f32x4 bf2f_lo(unsigned a, unsigned b) { return (f32x4){__uint_as_float(a << 16), __uint_as_float(a & 0xffff0000u), __uint_as_float(b << 16), __uint_as_float(b & 0xffff0000u)}; }
struct EpiResid {
    static constexpr bool PERM = true, AFTER_DRAIN = false;
    bf16* XB; float* rowsq; float* outf;
    __device__ __forceinline__ void operator()(const f32x4 (&acc)[2][2][4][2], const Unit& u, int wr, int wc, int fr, int fq) const {
        asm volatile("" : "+v"(fr), "+v"(fq));
        const int col0 = u.pn * 256 + wc * 32 + 8 * fq, row0 = u.pm * 256 + wr * 64 + fr;
#pragma unroll
        for (int ai = 0; ai < 2; ++ai) {
            u32x4 xr[4][2];
#pragma unroll
            for (int m = 0; m < 4; ++m) { const size_t off = (size_t)(row0 + ai * 128 + m * 16) * D + col0;
#pragma unroll
                for (int bj = 0; bj < 2; ++bj) xr[m][bj] = *(const u32x4*)(XB + off + bj * 128); }
            asm volatile("" ::: "memory");
#pragma unroll
            for (int m = 0; m < 4; ++m) { const int row = row0 + ai * 128 + m * 16; const size_t off = (size_t)row * D + col0; float ss = 0.f;
#pragma unroll
                for (int bj = 0; bj < 2; ++bj) {
                    const f32x4 y0 = bf2f_lo(xr[m][bj].x, xr[m][bj].y) + acc[ai][bj][m][0], y1 = bf2f_lo(xr[m][bj].z, xr[m][bj].w) + acc[ai][bj][m][1];
                    ss += dot4(y0) + dot4(y1);
                    if (outf) { *(f32x4*)(outf + off + bj * 128) = y0; *(f32x4*)(outf + off + bj * 128 + 4) = y1; }
                    else { u32x4 w; w.x = cvt_pk_bf16(y0[0], y0[1]); w.y = cvt_pk_bf16(y0[2], y0[3]); w.z = cvt_pk_bf16(y1[0], y1[1]); w.w = cvt_pk_bf16(y1[2], y1[3]); *(u32x4*)(XB + off + bj * 128) = w; }
                }
                if (rowsq) { ss += __shfl_xor(ss, 16); ss += __shfl_xor(ss, 32); if (fq == 0) atomicAdd(rowsq + row, ss); }
            }
            asm volatile("" ::: "memory");
        }
    }
};

struct EpiUpConv {
    static constexpr bool PERM = true, AFTER_DRAIN = false;
    bf16* ACT; const float* cw; const float* cb; float* edge; float* part; LAS float* xl; const float* rowsq;
    __device__ __forceinline__ void operator()(f32x4 (&acc)[2][2][4][2], const Unit& u, int wr, int wc, int fr, int fq) const {
        asm volatile("" : "+v"(fr), "+v"(fq));
        const int lane = 16 * fq + fr;
        const int cl0 = 32 * wc + 8 * fq, ch0 = 128 * u.pn + cl0;
#pragma unroll
        for (int ai = 0; ai < 2; ++ai)
#pragma unroll
            for (int m = 0; m < 4; ++m) { const float rx = rsqrtf(rowsq[u.pm * 256 + ai * 128 + wr * 64 + m * 16 + fr] * (1.f / D) + EPS);
#pragma unroll
                for (int bj = 0; bj < 2; ++bj) { acc[ai][bj][m][0] *= rx; acc[ai][bj][m][1] *= rx; } }
#pragma unroll
        for (int ai = 0; ai < 2; ++ai) {
            const int chunk = 2 * ai + wr;
            if (fr == 0) { *(LAS f32x4*)(xl + (chunk * 2 + 0) * 128 + cl0) = acc[ai][0][0][0]; *(LAS f32x4*)(xl + (chunk * 2 + 0) * 128 + cl0 + 4) = acc[ai][0][0][1]; }
            if (fr == 15) { *(LAS f32x4*)(xl + (chunk * 2 + 1) * 128 + cl0) = acc[ai][0][3][0]; *(LAS f32x4*)(xl + (chunk * 2 + 1) * 128 + cl0 + 4) = acc[ai][0][3][1]; }
        }
        asm volatile("s_waitcnt lgkmcnt(0)" ::: "memory"); __builtin_amdgcn_s_barrier(); asm volatile("" ::: "memory");
        const int lup = (lane & ~15) | ((fr + 15) & 15), ldn = (lane & ~15) | ((fr + 1) & 15);
        const bool seq_first = (u.pm & 7) == 0, seq_last = (u.pm & 7) == 7;
#pragma unroll
        for (int ai = 0; ai < 2; ++ai) {
            const int chunk = 2 * ai + wr;
#pragma unroll
            for (int n = 0; n < 2; ++n) {
                const int ch = ch0 + 4 * n;
                const f32x4 w0 = *(const f32x4*)(cw + ch), w1 = *(const f32x4*)(cw + FF + ch), w2 = *(const f32x4*)(cw + 2 * FF + ch), bb = *(const f32x4*)(cb + ch);
                const f32x4 above = (chunk > 0) ? *(const LAS f32x4*)(xl + ((chunk - 1) * 2 + 1) * 128 + cl0 + 4 * n) : (f32x4){0.f, 0.f, 0.f, 0.f};
                const f32x4 below = (chunk < 3) ? *(const LAS f32x4*)(xl + ((chunk + 1) * 2 + 0) * 128 + cl0 + 4 * n) : (f32x4){0.f, 0.f, 0.f, 0.f};
                f32x4 Rprev = above, Lcur;
#pragma unroll
                for (int e = 0; e < 4; ++e) Lcur[e] = __shfl(acc[ai][0][0][n][e], ldn);
#pragma unroll
                for (int m = 0; m < 4; ++m) {
                    const int rt = ai * 128 + wr * 64 + m * 16 + fr;
                    const size_t row = (size_t)u.pm * 256 + rt;
                    const f32x4 cur = acc[ai][0][m][n], val = acc[ai][1][m][n];
                    f32x4 Rm, Lnext = below;
#pragma unroll
                    for (int e = 0; e < 4; ++e) { Rm[e] = __shfl(cur[e], lup); if (m < 3) Lnext[e] = __shfl(acc[ai][0][m < 3 ? m + 1 : 3][n][e], ldn); }
                    const f32x4 up = (fr == 0) ? Rprev : Rm, dn = (fr == 15) ? Lnext : Lcur;
                    Rprev = Rm; Lcur = Lnext;
                    const f32x4 pre = bb + w0 * up + w1 * cur + w2 * dn;
                    f32x4 res;
#pragma unroll
                    for (int e = 0; e < 4; ++e) res[e] = silu_f(pre[e]) * val[e];
                    if (rt == 0) {
                        *(f32x4*)(edge + ((size_t)u.pm * 2 + 0) * FF + ch) = cur;
                        if (!seq_first) { float* pp = part + (((size_t)u.pm * 2 + 0) * FF + ch) * 2;
                            *(f32x4*)pp = (f32x4){pre[0], val[0], pre[1], val[1]}; *(f32x4*)(pp + 4) = (f32x4){pre[2], val[2], pre[3], val[3]}; }
                    }
                    if (rt == 255) {
                        *(f32x4*)(edge + ((size_t)u.pm * 2 + 1) * FF + ch) = cur;
                        if (!seq_last) { float* pp = part + (((size_t)u.pm * 2 + 1) * FF + ch) * 2;
                            *(f32x4*)pp = (f32x4){pre[0], val[0], pre[1], val[1]}; *(f32x4*)(pp + 4) = (f32x4){pre[2], val[2], pre[3], val[3]}; }
                    }
                    u32x2 w; w.x = cvt_pk_bf16(res[0], res[1]); w.y = cvt_pk_bf16(res[2], res[3]);
                    *(u32x2*)(ACT + row * FF + ch) = w;
                }
            }
        }
    }
};
namespace att {
typedef __attribute__((ext_vector_type(16))) float f32x16;
typedef __attribute__((ext_vector_type(4))) short s16x4;
typedef short v4i16_t __attribute__((ext_vector_type(4)));
typedef LAS const char* lptr;
__device__ __forceinline__ s16x4 vtr(lptr p) { return __builtin_bit_cast(s16x4, __builtin_amdgcn_ds_read_tr16_b64_v4i16((LAS v4i16_t*)p)); }
typedef float f32x2_t __attribute__((ext_vector_type(2))); typedef __bf16 bf16x2_t __attribute__((ext_vector_type(2)));
__device__ __forceinline__ unsigned cvtpk_s(float lo, float hi) { f32x2_t v = {lo, hi}; bf16x2_t b = __builtin_convertvector(v, bf16x2_t); return __builtin_bit_cast(unsigned, b); }
__device__ __forceinline__ bf16x8 pack8(const f32x16& s, int b) {
    u32x4 w; w.x = cvtpk_s(s[b], s[b + 1]); w.y = cvtpk_s(s[b + 2], s[b + 3]); w.z = cvtpk_s(s[b + 4], s[b + 5]); w.w = cvtpk_s(s[b + 6], s[b + 7]);
    return __builtin_bit_cast(bf16x8, w);
}
#define MFMA32(a, b, c) __builtin_amdgcn_mfma_f32_32x32x16_bf16((a), (b), (c), 0, 0, 0)

#define LGKM_WAIT(n) asm volatile("s_waitcnt lgkmcnt(" #n ")" ::: "memory")
#define SCHED_FENCE() __builtin_amdgcn_sched_barrier(0)
__device__ __forceinline__ bf16x8 rd128(unsigned addr, int off) { bf16x8 r; asm volatile("ds_read_b128 %0, %1 offset:%c2" : "=&v"(r) : "v"(addr), "i"(off) : "memory"); return r; }
__device__ __forceinline__ s16x4 rdtr(unsigned addr, int off) { s16x4 r; asm volatile("ds_read_b64_tr_b16 %0, %1 offset:%c2" : "=&v"(r) : "v"(addr), "i"(off) : "memory"); return r; }
#define VFRAG(lo, hh) ((bf16x8){lo[0], lo[1], lo[2], lo[3], hh[0], hh[1], hh[2], hh[3]})
constexpr int KROW = 144, VROWD = 320, VROWA = 192;
constexpr int DSTG = 2 * 64 * KROW + 64 * VROWD;
constexpr int ASTG = 64 * KROW + 64 * VROWA;

constexpr int DST3 = 32768;
#define SGB(mask, n) __builtin_amdgcn_sched_group_barrier((mask), (n), 0)
__device__ __forceinline__ void diff_unit(LAS char* lds, const bf16* __restrict__ QKV, bf16* __restrict__ Y, int b, int h, int qb, float Mb, float lam, const float* __restrict__ subln, float outscale) {
    int tid = threadIdx.x; asm volatile("" : "+v"(tid)); const int lane = tid & 63, w = __builtin_amdgcn_readfirstlane(tid >> 6), q = lane & 31, hi = lane >> 5;
    const int rg = w >> 1, c = w & 1;
    const size_t rowQ = (size_t)b * S + qb * 128 + rg * 32 + q;
    const bf16* qp = QKV + rowQ * NIN + 768 + (2 * h + c) * 64 + hi * 8;
    bf16x8 qf[4];
#pragma unroll
    for (int ds = 0; ds < 4; ++ds) qf[ds] = *(const bf16x8*)(qp + ds * 16);
    const int krow = 8 * w + (lane >> 3), kch = (lane & 7) ^ ((krow >> 1) & 7);
    const int vrow = 4 * w + (lane >> 4), vch = (lane & 15) ^ ((vrow & 3) << 2);
    const bf16* kg = QKV + ((size_t)b * S + krow) * NIN + 1280 + 128 * h + kch * 8;
    const bf16* vg = QKV + ((size_t)b * S + vrow) * NIN + 1792 + 128 * h + vch * 8;
#define DDMA(t, so) do { const size_t o_ = (size_t)(t) * 64 * NIN; LAS unsigned char* d_ = (LAS unsigned char*)lds + (so) + w * 1024; \
        __builtin_amdgcn_global_load_lds((const unsigned*)(kg + o_), (LAS unsigned*)(d_), 16, 0, 0); \
        __builtin_amdgcn_global_load_lds((const unsigned*)(kg + o_ + 64), (LAS unsigned*)(d_ + 8192), 16, 0, 0); \
        __builtin_amdgcn_global_load_lds((const unsigned*)(vg + o_), (LAS unsigned*)(d_ + 16384), 16, 0, 0); \
        __builtin_amdgcn_global_load_lds((const unsigned*)(vg + o_ + 32 * NIN), (LAS unsigned*)(d_ + 16384 + 8192), 16, 0, 0); } while (0)
    f32x16 o[4];
#pragma unroll
    for (int i = 0; i < 4; ++i) o[i] = (f32x16){0.f};
    float l = 0.f;
    constexpr int NT = S / 64;
    DDMA(0, 0); DDMA(1, DST3); DDMA(2, 2 * DST3);
    const unsigned lbase = (unsigned)(size_t)lds;
    unsigned kofs[4], vofs[4];
    { const int sw = (q >> 1) & 7, vq = (lane & 15) >> 2;
#pragma unroll
      for (int ds = 0; ds < 4; ++ds) kofs[ds] = (unsigned)(c * 8192 + q * 128 + (((2 * ds + hi) ^ sw) << 4));
#pragma unroll
      for (int db = 0; db < 4; ++db) vofs[db] = (unsigned)(16384 + (4 * hi + vq) * 256 + ((db ^ vq) << 6) + ((lane >> 4) & 1) * 32 + (lane & 3) * 8); }
    f32x16 negm;
#pragma unroll
    for (int r = 0; r < 16; ++r) negm[r] = -Mb;
    f32x16 s0, s1;
    { asm volatile("s_waitcnt vmcnt(8)" ::: "memory"); __builtin_amdgcn_s_barrier(); asm volatile("" ::: "memory");
      bf16x8 kf[8];
#pragma unroll
      for (int ds = 0; ds < 4; ++ds) { kf[2 * ds] = rd128(lbase + kofs[ds], 0); kf[2 * ds + 1] = rd128(lbase + kofs[ds], 32 * 128); }
      LGKM_WAIT(0); SCHED_FENCE();
      s0 = negm; s1 = negm;
#pragma unroll
      for (int ds = 0; ds < 4; ++ds) { s0 = MFMA32(kf[2 * ds], qf[ds], s0); s1 = MFMA32(kf[2 * ds + 1], qf[ds], s1); }
      SCHED_FENCE(); }
    int so_cur = 0, so_n1 = DST3, so_n3 = 3 * DST3;
    for (int t = 0; t < NT; ++t) {
        asm volatile("s_waitcnt vmcnt(4)" ::: "memory");
        __builtin_amdgcn_s_barrier();
        asm volatile("" ::: "memory");
        { const int tn = (t + 3 < NT) ? t + 3 : NT - 1; DDMA(tn, so_n3); }
        const unsigned sb = lbase + so_cur, sn = lbase + so_n1;
        bf16x8 kf[8];
#pragma unroll
        for (int ds = 0; ds < 4; ++ds) { kf[2 * ds] = rd128(sn + kofs[ds], 0); kf[2 * ds + 1] = rd128(sn + kofs[ds], 32 * 128); }
        s16x4 vl[2][4], vh[2][4];
#pragma unroll
        for (int db = 0; db < 4; ++db) { vl[0][db] = rdtr(sb + vofs[db], 0); vh[0][db] = rdtr(sb + vofs[db], 8 * 256); }
        LGKM_WAIT(0); SCHED_FENCE();
        __builtin_amdgcn_s_setprio(1);
        f32x16 n0 = negm, n1 = negm;
#pragma unroll
        for (int ds = 0; ds < 4; ++ds) { n0 = MFMA32(kf[2 * ds], qf[ds], n0); n1 = MFMA32(kf[2 * ds + 1], qf[ds], n1); }
        float ls = 0.f;
#pragma unroll
        for (int r = 0; r < 16; ++r) { s0[r] = __builtin_amdgcn_exp2f(s0[r]); ls += s0[r]; }
        bf16x8 pf[4]; pf[0] = pack8(s0, 0); pf[1] = pack8(s0, 8);
#pragma unroll
        for (int i = 0; i < 8; ++i) { SGB(0x008, 1); SGB(0x400, 2); SGB(0x002, 3); }
        SCHED_FENCE();
        __builtin_amdgcn_s_setprio(0);
#pragma unroll
        for (int db = 0; db < 4; ++db) { vl[1][db] = rdtr(sb + vofs[db], 16 * 256); vh[1][db] = rdtr(sb + vofs[db], 16 * 256 + 8 * 256); }
        s16x4 wl[2][4], wh[2][4];
#pragma unroll
        for (int ks = 0; ks < 2; ++ks)
#pragma unroll
            for (int db = 0; db < 4; ++db) { wl[ks][db] = rdtr(sb + vofs[db], (ks + 2) * 16 * 256); wh[ks][db] = rdtr(sb + vofs[db], (ks + 2) * 16 * 256 + 8 * 256); }
        LGKM_WAIT(15); SCHED_FENCE();
        __builtin_amdgcn_s_setprio(1);
#pragma unroll
        for (int ks = 0; ks < 2; ++ks)
#pragma unroll
            for (int db = 0; db < 4; ++db) o[db] = MFMA32(VFRAG(vl[ks][db], vh[ks][db]), pf[ks], o[db]);
#pragma unroll
        for (int r = 0; r < 16; ++r) { s1[r] = __builtin_amdgcn_exp2f(s1[r]); ls += s1[r]; }
        l += ls;
        pf[2] = pack8(s1, 0); pf[3] = pack8(s1, 8);
#pragma unroll
        for (int i = 0; i < 8; ++i) { SGB(0x008, 1); SGB(0x400, 2); SGB(0x002, 3); }
        SCHED_FENCE();
        LGKM_WAIT(0); SCHED_FENCE();
#pragma unroll
        for (int ks = 0; ks < 2; ++ks)
#pragma unroll
            for (int db = 0; db < 4; ++db) o[db] = MFMA32(VFRAG(wl[ks][db], wh[ks][db]), pf[2 + ks], o[db]);
        SCHED_FENCE();
        __builtin_amdgcn_s_setprio(0);
        s0 = n0; s1 = n1;
        so_cur = so_n1; so_n1 = (so_n1 == 3 * DST3) ? 0 : so_n1 + DST3; so_n3 = (so_n3 == 3 * DST3) ? 0 : so_n3 + DST3;
    }
#undef DDMA
    asm volatile("s_waitcnt vmcnt(0)" ::: "memory");
    __syncthreads();
    l += __shfl_xor(l, 32);
    const float inv = 1.f / l;
    LAS f32x4* xb = (LAS f32x4*)lds + rg * (16 * 64) + lane;
    if (c == 1) {
#pragma unroll
        for (int db = 0; db < 4; ++db)
#pragma unroll
            for (int r4 = 0; r4 < 4; ++r4) xb[(db * 4 + r4) * 64] = (f32x4){o[db][4 * r4], o[db][4 * r4 + 1], o[db][4 * r4 + 2], o[db][4 * r4 + 3]} * inv;
    }
    __syncthreads();
    if (c == 0) {
        float ss = 0.f;
#pragma unroll
        for (int db = 0; db < 4; ++db)
#pragma unroll
            for (int r4 = 0; r4 < 4; ++r4) { const f32x4 ot = xb[(db * 4 + r4) * 64];
#pragma unroll
                for (int e = 0; e < 4; ++e) { const float d = o[db][4 * r4 + e] * inv - lam * ot[e]; o[db][4 * r4 + e] = d; ss += d * d; } }
        ss += __shfl_xor(ss, 32);
        const float rs = rsqrtf(ss * (1.f / 128.f) + EPS) * outscale;
        bf16* yp = Y + rowQ * D + 512 + 128 * h + 4 * hi;
#pragma unroll
        for (int db = 0; db < 4; ++db)
#pragma unroll
            for (int r4 = 0; r4 < 4; ++r4) { const f32x4 gw = *(const f32x4*)(subln + 32 * db + 8 * r4 + 4 * hi);
                u32x2 wv; wv.x = cvt_pk_bf16(o[db][4 * r4] * rs * gw[0], o[db][4 * r4 + 1] * rs * gw[1]); wv.y = cvt_pk_bf16(o[db][4 * r4 + 2] * rs * gw[2], o[db][4 * r4 + 3] * rs * gw[3]);
                *(u32x2*)(yp + 32 * db + 8 * r4) = wv; }
    }
    __syncthreads();
}

__device__ __forceinline__ void swa_unit(LAS char* lds, const bf16* __restrict__ QKV, bf16* __restrict__ Y, int b, int kvh, int n, float Mb, const float* __restrict__ sink) {
    int tid = threadIdx.x; asm volatile("" : "+v"(tid)); const int lane = tid & 63, w = __builtin_amdgcn_readfirstlane(tid >> 6), q = lane & 31, hi = lane >> 5;
    const int head = kvh * 4 + (w >> 1), rb = (w & 1) * 64;
    const size_t rowQ = (size_t)b * S + n * 128 + rb + q;
    bf16x8 qf[2][4];
#pragma unroll
    for (int rg = 0; rg < 2; ++rg)
#pragma unroll
        for (int ds = 0; ds < 4; ++ds) qf[rg][ds] = *(const bf16x8*)(QKV + (rowQ + 32 * rg) * NIN + head * 64 + hi * 8 + ds * 16);
    const int lrow = tid >> 3, lcc = tid & 7;
    const long kp0 = (long)b * S + (long)(n - 1) * 128 + lrow;
    const bf16* kg = QKV + kp0 * NIN + 512 + kvh * 64 + lcc * 8;
    const bf16* vg = QKV + kp0 * NIN + 640 + kvh * 64 + lcc * 8;
    const int kdst = lrow * KROW + lcc * 16, vdst = 64 * KROW + lrow * VROWA + lcc * 16;
    u32x4 st0, st1;
#define ALOAD(t) do { const long o_ = (long)(t) * 64 * NIN; st0 = *(const u32x4*)(kg + o_); st1 = *(const u32x4*)(vg + o_); } while (0)
#define ASTORE(bo) do { *(LAS u32x4*)(lds + (bo) + kdst) = st0; *(LAS u32x4*)(lds + (bo) + vdst) = st1; } while (0)
    f32x16 o[2][2];
#pragma unroll
    for (int i = 0; i < 2; ++i)
#pragma unroll
        for (int j = 0; j < 2; ++j) o[i][j] = (f32x16){0.f};
    float l[2] = {0.f, 0.f};
    const int t0 = (n == 0) ? 2 : 0, t1 = (n == S / 128 - 1) ? 4 : 6;
    ALOAD(t0); ASTORE((t0 & 1) * ASTG); __syncthreads();
    const int koff = q * KROW + hi * 16;
    const int voff = 64 * KROW + (4 * hi + ((lane & 15) >> 2)) * VROWA + ((lane >> 4) & 1) * 32 + (lane & 3) * 8;
    const unsigned lbase = (unsigned)(size_t)lds;
    for (int t = t0; t < t1; ++t) {
        const int cur = (t & 1) * ASTG, nxt = ASTG - cur;
        if (t + 1 < t1) ALOAD(t + 1);
        const unsigned ka = lbase + cur + koff, va = lbase + cur + voff;
        bf16x8 kf[8];
#pragma unroll
        for (int ds = 0; ds < 4; ++ds) { kf[2 * ds] = rd128(ka, ds * 32); kf[2 * ds + 1] = rd128(ka, 32 * KROW + ds * 32); }
        s16x4 vl[4][2], vh[4][2];
#pragma unroll
        for (int ks = 0; ks < 4; ++ks)
#pragma unroll
            for (int db = 0; db < 2; ++db) { vl[ks][db] = rdtr(va, ks * 16 * VROWA + db * 64); vh[ks][db] = rdtr(va, ks * 16 * VROWA + 8 * VROWA + db * 64); }
        LGKM_WAIT(0); SCHED_FENCE();
#pragma unroll
        for (int rg = 0; rg < 2; ++rg) {
            const int i0 = rb + 32 * rg;
            if (64 * t + 63 >= i0 && 64 * t <= i0 + 31 + 256) {
                f32x16 s0 = (f32x16){0.f}, s1 = (f32x16){0.f};
#pragma unroll
                for (int ds = 0; ds < 4; ++ds) { s0 = MFMA32(kf[2 * ds], qf[rg][ds], s0); s1 = MFMA32(kf[2 * ds + 1], qf[rg][ds], s1); }
                const int jb = 64 * t + 4 * hi - (i0 + q);
                float ls = 0.f;
#pragma unroll
                for (int r = 0; r < 16; ++r) {
                    const int d0 = jb + (r & 3) + 8 * (r >> 2), d1 = d0 + 32;
                    const float p0 = __builtin_amdgcn_exp2f(s0[r] - Mb), p1 = __builtin_amdgcn_exp2f(s1[r] - Mb);
                    s0[r] = ((unsigned)d0 <= 256u) ? p0 : 0.f; s1[r] = ((unsigned)d1 <= 256u) ? p1 : 0.f; ls += s0[r] + s1[r];
                }
                l[rg] += ls;
                bf16x8 pf[4]; pf[0] = pack8(s0, 0); pf[1] = pack8(s0, 8); pf[2] = pack8(s1, 0); pf[3] = pack8(s1, 8);
#pragma unroll
                for (int ks = 0; ks < 4; ++ks)
#pragma unroll
                    for (int db = 0; db < 2; ++db) o[rg][db] = MFMA32(VFRAG(vl[ks][db], vh[ks][db]), pf[ks], o[rg][db]);
            }
        }
        SCHED_FENCE();
        if (t + 1 < t1) ASTORE(nxt);
        __syncthreads();
    }
#undef ALOAD
#undef ASTORE
    const float sk = __builtin_amdgcn_exp2f(sink[head] * LOG2E - Mb);
#pragma unroll
    for (int rg = 0; rg < 2; ++rg) {
        float lt = l[rg]; lt += __shfl_xor(lt, 32);
        const float inv = 1.f / (lt + sk);
        bf16* yp = Y + (rowQ + 32 * rg) * D + head * 64 + 4 * hi;
#pragma unroll
        for (int db = 0; db < 2; ++db)
#pragma unroll
            for (int r4 = 0; r4 < 4; ++r4) { u32x2 wv; wv.x = cvt_pk_bf16(o[rg][db][4 * r4] * inv, o[rg][db][4 * r4 + 1] * inv); wv.y = cvt_pk_bf16(o[rg][db][4 * r4 + 2] * inv, o[rg][db][4 * r4 + 3] * inv);
                *(u32x2*)(yp + 32 * db + 8 * r4) = wv; }
    }
}
}
constexpr size_t MiB = 1u << 20;
constexpr size_t WS_CTL = 0, CTL_BYTES = 65536 + 4 * 65536;
constexpr size_t WS_ROWSQ = 65536;
constexpr int MISC_OFF = 131072 + 4096;
constexpr size_t WS_ROPE = 1 * MiB;
constexpr size_t WS_W = 2 * MiB, W_LAYER = 23 * MiB;
constexpr size_t W_IN = 0, W_OUT = (size_t)NIN * D * 2, W_UP = W_OUT + (size_t)D * D * 2, W_DOWN = W_UP + (size_t)NUP * D * 2;
static_assert(W_DOWN + (size_t)D * FF * 2 <= W_LAYER, "weights");
constexpr size_t WS_H = 48 * MiB;
constexpr size_t WS_QKV = 80 * MiB;
constexpr size_t WS_Y = 152 * MiB;
constexpr size_t WS_ACT = 80 * MiB;
constexpr size_t WS_EDGE = 184 * MiB;
constexpr size_t WS_PART = 186 * MiB;
constexpr size_t WS_END = 190 * MiB;
static_assert(WS_ACT + (size_t)M * FF * 2 <= WS_EDGE && WS_QKV + (size_t)M * NIN * 2 <= WS_Y && WS_Y + (size_t)M * D * 2 <= WS_EDGE, "ws map");

#ifndef REP_P0
#define REP_P0 1
#endif
#ifndef REP_P1
#define REP_P1 1
#endif
#ifndef REP_P3B
#define REP_P3B 1
#endif
#ifndef REP_P4
#define REP_P4 1
#endif
#ifndef ATT_REP
#define ATT_REP 1
#endif
#ifndef REP_P5
#define REP_P5 1
#endif
#ifndef REP_P3
#define REP_P3 1
#endif
#ifndef REP_SYNC
#define REP_SYNC 1
#endif
struct Args {
    const float *x, *g_attn, *w_in, *qn_a, *kn_a, *sink, *qn_b, *kn_b, *lq1, *lk1, *lq2, *lk2, *subln, *w_out, *g_ffn, *w_up, *conv_w, *conv_b, *w_down;
    float* out; unsigned char* ws;
};

__device__ __forceinline__ float wave_sum(float v) {
#pragma unroll
    for (int o = 1; o < 64; o <<= 1) v += __shfl_xor(v, o);
    return v;
}
__device__ __forceinline__ float uniform_f(float v) { return __uint_as_float(__builtin_amdgcn_readfirstlane(__float_as_uint(v))); }
__device__ __forceinline__ float wave_max(float v) {
#pragma unroll
    for (int o = 1; o < 64; o <<= 1) v = fmaxf(v, __shfl_xor(v, o));
    return v;
}
__device__ __forceinline__ unsigned f2bf(float f) { unsigned u = __builtin_bit_cast(unsigned, f); return (u + 0x7fffu + ((u >> 16) & 1u)) >> 16; }
__device__ __forceinline__ unsigned pk2(float lo, float hi) { return f2bf(lo) | (f2bf(hi) << 16); }

__device__ __forceinline__ void transpose_item(const float* __restrict__ W, int K, int N, bf16* __restrict__ WT, LAS float* scr, int kb, int nb, int dnb, int lane, const float* __restrict__ g) {
    const int k0 = 64 * kb, n0 = 32 * nb;
#pragma unroll 8
    for (int i = 0; i < 32; ++i) { const int kk = 2 * i + (lane >> 5); scr[kk * 33 + (lane & 31)] = W[(size_t)(k0 + kk) * N + n0 + (lane & 31)] * (g ? g[k0 + kk] : 1.f); }
    asm volatile("s_waitcnt lgkmcnt(0)" ::: "memory");
    const int c = lane & 7;
#pragma unroll
    for (int j = 0; j < 4; ++j) { const int n = (lane >> 3) + 8 * j; const LAS float* s = scr + (8 * c) * 33 + n;
        u32x4 o; o.x = pk2(s[0 * 33], s[1 * 33]); o.y = pk2(s[2 * 33], s[3 * 33]); o.z = pk2(s[4 * 33], s[5 * 33]); o.w = pk2(s[6 * 33], s[7 * 33]);
        *(u32x4*)(WT + (size_t)(32 * dnb + n) * K + k0 + 8 * c) = o; }
    asm volatile("s_waitcnt lgkmcnt(0)" ::: "memory");
}

__device__ __forceinline__ void convert_rows(const float* __restrict__ x, bf16* __restrict__ out, float* __restrict__ rowsq, int gw, int ngw, int lane) {
    for (int m = gw; m < M; m += ngw) {
        const f32x4* xr = (const f32x4*)(x + (size_t)m * D) + lane; f32x4 v[4]; float s = 0.f;
#pragma unroll
        for (int j = 0; j < 4; ++j) { v[j] = xr[64 * j]; s += dot4(v[j]); }
        s = wave_sum(s);
        if (lane == 0) rowsq[m] = s;
        u32x2* o8 = (u32x2*)(out + (size_t)m * D) + lane;
#pragma unroll
        for (int j = 0; j < 4; ++j) { u32x2 wv; wv.x = pk2(v[j][0], v[j][1]); wv.y = pk2(v[j][2], v[j][3]); o8[64 * j] = wv; }
    }
}

#define XB_TMO      128
#define XB_XCNT(j)  (256  + 64 * (j))
#define XB_XSUB(j)  (1280 + 64 * (j))
#define XB_XGEN(j)  (2304 + 64 * (j))
#define XB_TOP      3328
#define XB_TOPGEN   3392
#define XCD_BAR_WORDS 3456
#define XB_SPIN_CAP (1u << 18)

__device__ __forceinline__ unsigned xb_ld(unsigned* p)              { return __hip_atomic_load(p, __ATOMIC_RELAXED, __HIP_MEMORY_SCOPE_AGENT); }
__device__ __forceinline__ unsigned xb_add(unsigned* p, unsigned v) { return __hip_atomic_fetch_add(p, v, __ATOMIC_RELAXED, __HIP_MEMORY_SCOPE_AGENT); }
__device__ __forceinline__ unsigned xb_xcc_id() { return (unsigned)__builtin_amdgcn_s_getreg((3 << 11) | 20) & 0xFu; }
#define XB_SPIN(cond, bar) do { unsigned _sp = 0; while (cond) { __builtin_amdgcn_s_sleep(1); \
    if ((++_sp & 255u) == 0u) { if (xb_ld(&(bar)[XB_TMO])) break; if (_sp > XB_SPIN_CAP) { atomicAdd(&(bar)[XB_TMO], 1u); break; } } } } while (0)

struct XcdBarrier {
    unsigned* bar; unsigned x;
    volatile LAS unsigned* st;
};

__device__ __forceinline__ XcdBarrier xcd_barrier_post(unsigned* bar, volatile LAS unsigned* st) {
    XcdBarrier b; b.bar = bar; b.x = xb_xcc_id(); b.st = st;
    if (threadIdx.x == 0) (void)xb_add(&bar[XB_XCNT(b.x)], 1u);
    return b;
}
__device__ __forceinline__ void xcd_barrier_complete(unsigned* bar, unsigned x, unsigned& nloc, unsigned& nx) {
    const unsigned G = gridDim.x * gridDim.y * gridDim.z;
    unsigned sum, cnt, mine, sp = 0u;
    for (;;) {
        sum = 0u; cnt = 0u; mine = 0u;
#pragma unroll
        for (unsigned j = 0; j < 16; ++j) { const unsigned c = xb_ld(&bar[XB_XCNT(j)]); sum += c; cnt += (c > 0u) ? 1u : 0u; mine = (j == x) ? c : mine; }
        if (sum == G) break;
        __builtin_amdgcn_s_sleep(1);
        if ((++sp & 255u) == 0u) { if (xb_ld(&bar[XB_TMO])) break; if (sp > XB_SPIN_CAP) { atomicAdd(&bar[XB_TMO], 1u); break; } }
    }
    nloc = mine > 0u ? mine : 1u; nx = cnt > 0u ? cnt : 1u;
}

__device__ __forceinline__ void xcd_barrier(const XcdBarrier& b) {
    asm volatile("s_waitcnt vmcnt(0)" ::: "memory");
    __syncthreads();
    if (threadIdx.x == 0) {
        unsigned* bar = b.bar;
        __builtin_amdgcn_s_waitcnt(0);
        unsigned nloc = b.st[0], nx = b.st[1];
        if (nloc == 0u) { xcd_barrier_complete(bar, b.x, nloc, nx); b.st[0] = nloc; b.st[1] = nx; }
        const unsigned old = xb_add(&bar[XB_XSUB(b.x)], 1u);
        const unsigned gen = old / nloc;
        if (old + 1u == (gen + 1u) * nloc) {
            __builtin_amdgcn_fence(__ATOMIC_RELEASE, "agent");
            asm volatile("s_waitcnt vmcnt(0)" ::: "memory");
            const unsigned og = xb_add(&bar[XB_TOP], 1u);
            const unsigned tg = og / nx;
            if (og + 1u == (tg + 1u) * nx) xb_add(&bar[XB_TOPGEN], 1u);
            else XB_SPIN(xb_ld(&bar[XB_TOPGEN]) == tg, bar);
            __builtin_amdgcn_fence(__ATOMIC_ACQUIRE, "agent");
            xb_add(&bar[XB_XGEN(b.x)], 1u);
            asm volatile("s_waitcnt vmcnt(0)" ::: "memory");
        } else {
            XB_SPIN(xb_ld(&bar[XB_XGEN(b.x)]) == gen, bar);
            __builtin_amdgcn_fence(__ATOMIC_ACQUIRE, "agent");
            asm volatile("s_waitcnt vmcnt(0)" ::: "memory");
        }
    }
    __syncthreads();
}

__global__ void __launch_bounds__(512, 2) mega_fwd(Args a) {
    extern __shared__ __attribute__((aligned(16))) unsigned char lds_raw[];
    LAS unsigned char* lds = (LAS unsigned char*)lds_raw;
    cg::grid_group grid = cg::this_grid();
    const int tid = threadIdx.x, lane = tid & 63, wave = __builtin_amdgcn_readfirstlane(tid >> 6);
    const int G = gridDim.x, bx = blockIdx.x;
    const int vcu = (G % 8 == 0) ? (bx % 8) * (G / 8) + bx / 8 : bx;
    const int gw = vcu * 8 + wave, ngw = G * 8;
    typedef const __attribute__((address_space(4))) Args* kargs_t;
    const kargs_t kap = (kargs_t)__builtin_amdgcn_kernarg_segment_ptr();
#define PHASE_ARGS() kargs_t ap = kap; asm volatile("" : "+s"(ap)); unsigned char* const ws = ap->ws; \
    float* const cosT = (float*)(ws + WS_ROPE); float* const sinT = cosT + S * 32; \
    bf16* const Hb = (bf16*)(ws + WS_H); bf16* const QKV = (bf16*)(ws + WS_QKV); bf16* const Yb = (bf16*)(ws + WS_Y); bf16* const ACT = (bf16*)(ws + WS_ACT); \
    float* const edge = (float*)(ws + WS_EDGE); float* const part = (float*)(ws + WS_PART); float* const rowsq = (float*)(ws + WS_ROWSQ); \
    (void)cosT; (void)sinT; (void)Hb; (void)QKV; (void)Yb; (void)ACT; (void)edge; (void)part; (void)rowsq
    volatile LAS unsigned* misc = (volatile LAS unsigned*)(lds + MISC_OFF);
    if (tid < 16) misc[tid] = 0u;
    __syncthreads();
    XcdBarrier xbar; { PHASE_ARGS(); xbar = xcd_barrier_post((unsigned*)(ws + WS_CTL) + 1024, misc); }

#define CONVERT_WEIGHTS(L, wv, nwv) do { \
        int lane = threadIdx.x & 63; asm volatile("" : "+v"(lane)); \
        LAS float* scr = (LAS float*)(lds + wave * 16384); \
        constexpr int I_IN = 16 * 72, I_OUT = 16 * 32, I_UP = 16 * 176, I_DOWN = 44 * 32, I_L = I_IN + I_OUT + I_UP + I_DOWN; \
        unsigned char* wl_ = ws + WS_W + (size_t)(L) * W_LAYER; \
        for (int it = (wv); it < I_L; it += (nwv)) { \
            int r = it; \
            if (r < I_IN) { const int kb = r / 72, nb = r % 72; const int pn = nb >> 3, wc = (nb >> 1) & 3, bj = nb & 1; \
                transpose_item(ap->w_in + (size_t)(L) * D * NIN, D, NIN, (bf16*)(wl_ + W_IN), scr, kb, nb, 8 * pn + 4 * bj + wc, lane, ap->g_attn + (L) * D); continue; } \
            r -= I_IN; \
            if (r < I_OUT) { const int kb = r / 32, nb = r % 32; transpose_item(ap->w_out + (size_t)(L) * D * D, D, D, (bf16*)(wl_ + W_OUT), scr, kb, nb, nb, lane, nullptr); continue; } \
            r -= I_OUT; \
            if (r < I_UP) { const int kb = r / 176, nb = r % 176; const int isv = nb >= 88, nn = isv ? nb - 88 : nb; const int dnb = 8 * (nn >> 2) + 4 * isv + (nn & 3); \
                transpose_item(ap->w_up + (size_t)(L) * D * NUP, D, NUP, (bf16*)(wl_ + W_UP), scr, kb, nb, dnb, lane, ap->g_ffn + (L) * D); continue; } \
            r -= I_UP; \
            { const int kb = r / 32, nb = r % 32; transpose_item(ap->w_down + (size_t)(L) * FF * D, FF, D, (bf16*)(wl_ + W_DOWN), scr, kb, nb, nb, lane, nullptr); } \
        } } while (0)
    {
        PHASE_ARGS();
        CONVERT_WEIGHTS(0, gw, ngw);
        for (int i = vcu * 512 + tid; i < S * 32; i += G * 512) {
            const int pos = i >> 5, j = i & 31;
            double inv = 1.0; for (int k = 0; k < j; ++k) inv *= 0.74989420933245582730;
            const double ang = (double)pos * inv;
            const double kq = __builtin_rint(ang * 0.15915494309189533577);
            const double rr = (ang - kq * 6.283185307179586232) - kq * 2.4492935982947064e-16;
            const double r2 = rr * rr;
            double sn = 1.0, cs = 1.0;
#pragma unroll
            for (int k = 12; k >= 1; --k) { sn = 1.0 - sn * r2 / (double)((2 * k) * (2 * k + 1)); cs = 1.0 - cs * r2 / (double)((2 * k - 1) * (2 * k)); }
            cosT[i] = (float)cs; sinT[i] = (float)(sn * rr);
        }
        convert_rows(ap->x, Hb, rowsq, gw, ngw, lane);
    }
    asm volatile("s_waitcnt vmcnt(0)" ::: "memory");
    __syncthreads();
    if (tid == 0) { __builtin_amdgcn_fence(__ATOMIC_RELEASE, "agent"); asm volatile("s_waitcnt vmcnt(0)" ::: "memory"); }
    grid.sync();
    if (tid == 0) { __builtin_amdgcn_fence(__ATOMIC_ACQUIRE, "agent"); asm volatile("s_waitcnt vmcnt(0)" ::: "memory"); }
    __syncthreads();

    for (int l = 0; l < DEPTH; ++l) {
        const float lambda_init = 0.8f - 0.6f * __expf(-0.3f * (float)l);
        {
            PHASE_ARGS(); unsigned char* const wl = ws + WS_W + (size_t)l * W_LAYER; (void)wl;
            pg8::Gemm g{Hb, (const bf16*)(wl + W_IN), M, NIN, D}; pg8::StaticOrder So; So.init(M, NIN, G, bx);
            EpiInProj E{QKV, ap->qn_a + l * 64, ap->kn_a + l * 64, ap->qn_b + l * 64, ap->kn_b + l * 64, cosT, sinT, rowsq + (size_t)(2 * l) * M};
            pg8::gemm_phase<EpiInProj, pg8::StaticOrder, true, true>(lds, g, So, E);
            if (l == 0 && DEPTH > 1) {
                const int nidle = G - 64;
                if (nidle >= 64) { if (bx >= 64) CONVERT_WEIGHTS(1, (bx - 64) * 8 + wave, nidle * 8); }
                else CONVERT_WEIGHTS(1, gw, ngw);
            }
        }
        xcd_barrier(xbar);
        {
            PHASE_ARGS(); unsigned char* const wl = ws + WS_W + (size_t)l * W_LAYER; (void)wl;
            int lane = threadIdx.x & 63; asm volatile("" : "+v"(lane));
            const float mqa = wave_max(fabsf(ap->qn_a[l * 64 + lane])), mka = wave_max(fabsf(ap->kn_a[l * 64 + lane]));
            const float mqb = wave_max(fabsf(ap->qn_b[l * 64 + lane])), mkb = wave_max(fabsf(ap->kn_b[l * 64 + lane]));
            const float MbA = uniform_f(8.f * mqa * mka * LOG2E * 1.02f), MbB = uniform_f(8.f * mqb * mkb * LOG2E * 1.02f);
            const float s1 = wave_sum(ap->lq1[l * 64 + lane] * ap->lk1[l * 64 + lane]), s2 = wave_sum(ap->lq2[l * 64 + lane] * ap->lk2[l * 64 + lane]);
            const float lam = uniform_f(__expf(s1) - __expf(s2) + lambda_init);
            {
            for (int uidx = vcu; uidx < NB * 4 * 16; uidx += G) {
                const int bh = uidx >> 4, qb = uidx & 15;
                att::diff_unit((LAS char*)lds, QKV, Yb, bh >> 2, bh & 3, qb, MbB, lam, ap->subln + l * 128, 1.f - lambda_init);
            }
            for (int uidx = vcu; uidx < NB * 2 * 16; uidx += G) {
                const int bk = uidx >> 4, n = uidx & 15;
                att::swa_unit((LAS char*)lds, QKV, Yb, bk >> 1, bk & 1, n, MbA, ap->sink + l * 8);
            }
            __syncthreads();
            }
        }
        xcd_barrier(xbar);
        {
            PHASE_ARGS(); unsigned char* const wl = ws + WS_W + (size_t)l * W_LAYER; (void)wl;
            pg8::Gemm g{Yb, (const bf16*)(wl + W_OUT), M, D, D}; pg8::StaticOrder So; So.init(M, D, G, bx);
            EpiResid E{Hb, rowsq + (size_t)(2 * l + 1) * M, nullptr};
            pg8::gemm_phase<EpiResid, pg8::StaticOrder, true, true>(lds, g, So, E);
        }
        xcd_barrier(xbar);
        {
            PHASE_ARGS(); unsigned char* const wl = ws + WS_W + (size_t)l * W_LAYER; (void)wl;
            pg8::Gemm g{Hb, (const bf16*)(wl + W_UP), M, NUP, D}; pg8::StaticOrder So; So.init(M, NUP, G, bx);
            EpiUpConv E{ACT, ap->conv_w + (size_t)l * 3 * FF, ap->conv_b + (size_t)l * FF, edge, part, (LAS float*)(lds + XL_OFF), rowsq + (size_t)(2 * l + 1) * M};
            pg8::gemm_phase<EpiUpConv, pg8::StaticOrder, true, true>(lds, g, So, E);
        }
        xcd_barrier(xbar);
        {
            PHASE_ARGS(); unsigned char* const wl = ws + WS_W + (size_t)l * W_LAYER; (void)wl;
            pg8::Gemm g{ACT, (const bf16*)(wl + W_DOWN), M, D, FF}; pg8::StaticOrder So; So.init(M, D, G, bx);
            { const float* cw = ap->conv_w + (size_t)l * 3 * FF; pg8::Unit uu; int tid = threadIdx.x; asm volatile("" : "+v"(tid));
              for (int ui = 0; So.next(ui, uu); ++ui) { const int pm = uu.pm;
                for (int i = tid; i < 2 * FF; i += 512) { const int which = i / FF, ch = i % FF;
                    if (which == 0 && (pm & 7) != 0) { const float* pp = part + (((size_t)pm * 2 + 0) * FF + ch) * 2;
                        const float pre = pp[0] + cw[ch] * edge[((size_t)(pm - 1) * 2 + 1) * FF + ch];
                        ACT[(size_t)(pm * 256) * FF + ch] = (bf16)f2bf(silu_f(pre) * pp[1]); }
                    if (which == 1 && (pm & 7) != 7) { const float* pp = part + (((size_t)pm * 2 + 1) * FF + ch) * 2;
                        const float pre = pp[0] + cw[2 * FF + ch] * edge[((size_t)(pm + 1) * 2 + 0) * FF + ch];
                        ACT[(size_t)(pm * 256 + 255) * FF + ch] = (bf16)f2bf(silu_f(pre) * pp[1]); } } }
              asm volatile("s_waitcnt vmcnt(0)" ::: "memory"); __syncthreads(); }
            const bool lastl = (l + 1 == DEPTH);
            EpiResid E{Hb, lastl ? nullptr : rowsq + (size_t)(2 * l + 2) * M, lastl ? ap->out : nullptr};
            pg8::gemm_phase<EpiResid, pg8::StaticOrder, true, true>(lds, g, So, E);
        }
        if (l + 1 < DEPTH) xcd_barrier(xbar);
    }
}

extern "C" void kernel_launch(void* const* d_in, const int* in_sizes, int n_in, void* d_out, int out_size, void* d_ws, size_t ws_size, hipStream_t stream) {
    static int grid = 0;
    if (grid == 0) {
        if (n_in != 19 || ws_size < WS_END) { fprintf(stderr, "kernel_launch: unexpected inputs (n_in %d, ws %zu)\n", n_in, ws_size); grid = -1; return; }
        int dev = 0, cus = 0, per_cu = 0;
        hipGetDevice(&dev);
        hipDeviceGetAttribute(&cus, hipDeviceAttributeMultiprocessorCount, dev);
        hipFuncSetAttribute((const void*)mega_fwd, hipFuncAttributeMaxDynamicSharedMemorySize, LDS_BYTES);
        hipOccupancyMaxActiveBlocksPerMultiprocessor(&per_cu, (const void*)mega_fwd, 512, LDS_BYTES);
        if (per_cu < 1) { fprintf(stderr, "kernel_launch: occupancy query reports %d blocks per CU\n", per_cu); per_cu = 1; }
        grid = cus;
        (void)hipGetLastError();
    }
    if (grid < 0) return;
    if (hipMemsetAsync((char*)d_ws + WS_CTL, 0, CTL_BYTES, stream) != hipSuccess) { fprintf(stderr, "kernel_launch: memset failed\n"); return; }
    Args a{};
    const float** p = (const float**)&a;
    for (int i = 0; i < 19; ++i) p[i] = (const float*)d_in[i];
    a.out = (float*)d_out; a.ws = (unsigned char*)d_ws;
    void* args[] = {&a};
    hipError_t e = hipLaunchCooperativeKernel((const void*)mega_fwd, dim3(grid), dim3(512), args, LDS_BYTES, stream);
    if (e != hipSuccess) fprintf(stderr, "cooperative launch failed: %s (grid %d)\n", hipGetErrorString(e), grid);
}
```

```cpp
#include <hip/hip_runtime.h>
#include <hip/hip_cooperative_groups.h>
#include <cstdio>
#include <cstdint>
namespace cg = cooperative_groups;
namespace pg8 {
#define PG8_LAS __attribute__((address_space(3)))
typedef unsigned short bf16_t;
typedef short bf16x8 __attribute__((ext_vector_type(8)));
typedef float f32x4 __attribute__((ext_vector_type(4)));
typedef unsigned u32x4 __attribute__((ext_vector_type(4)));
constexpr int BM = 256, BK = 64, HALF = 128, HTB = HALF * BK * 2  , STAGE_BYTES = 8 * HTB, NXCD = 8, WGM = 4;

__host__ __device__ __forceinline__ int lds_byte(int r, int c) { const int st = (r >> 4) * 2 + (c >> 5), rr = r & 15, cc = c & 31, ob = rr * 64 + cc * 2; return st * 1024 + (ob ^ (((ob >> 9) & 1) << 5)); }
__host__ __device__ __forceinline__ void stage_rc(int b, int& R, int& C) { const int st = b / 1024, sb = b % 1024, swz = sb ^ (((sb >> 9) & 1) << 5); R = (st >> 1) * 16 + swz / 64; C = (st & 1) * 32 + (swz % 64) / 2; }
__host__ __device__ __forceinline__ int perm32(int rho) { const int n = rho >> 4, i = rho & 15; return 8 * (i >> 2) + 4 * n + (i & 3); }

struct Unit { int pm, pn; };
struct Gemm { const bf16_t* A; const bf16_t* Bt; int M, N, K; };

struct StaticOrder {
    int nM, nN, nwg, G, c;
    __host__ __device__ void init(int M, int N, int G_, int c_) { nM = M / BM; nN = N / BM; nwg = nM * nN; G = G_; c = c_; }
    __host__ __device__ bool next(int i, Unit& u) const {
        const long L = (long)i * G + c; if (L >= nwg) return false;
        int wgid = (int)L; { const int q = nwg / NXCD, r = nwg % NXCD, xcd = wgid % NXCD, off = wgid / NXCD; wgid = (xcd < r ? xcd * (q + 1) : r * (q + 1) + (xcd - r) * q) + off; }
        const int nig = WGM * nN, gid = wgid / nig, fm = gid * WGM, gsz = (nM - fm) < WGM ? (nM - fm) : WGM;
        u.pm = fm + ((wgid % nig) % gsz); u.pn = (wgid % nig) / gsz; return true;
    }
    __device__ __forceinline__ void a_ready(const Unit&) const {}
    __device__ __forceinline__ void done(const Unit&) const {}
};

__device__ __forceinline__ unsigned cvt_pk_bf16(float lo, float hi) { unsigned r; asm volatile("v_cvt_pk_bf16_f32 %0, %1, %2" : "=v"(r) : "v"(lo), "v"(hi)); return r; }
template <class Epi, class Sched, bool ALIGN_EPI = false, bool SP2 = false>
__device__ __forceinline__ void gemm_phase(PG8_LAS unsigned char* lds, const Gemm g, const Sched& S, const Epi& E) {
    int tid = threadIdx.x; asm volatile("" : "+v"(tid)); const int wid = __builtin_amdgcn_readfirstlane(tid >> 6), lane = tid & 63, wr = wid >> 2, wc = wid & 3, fr = lane & 15, fq = lane >> 4;
    const int K = g.K, nt = K / BK;
    unsigned voffA[2], voffB[2];
#pragma unroll
    for (int i = 0; i < 2; ++i) { int R, C; stage_rc(tid * 16 + i * 8192, R, C); const int Rb = Epi::PERM ? ((R & ~31) + perm32(R & 31)) : R;
        voffA[i] = (unsigned)(R * K + C) * 2u; voffB[i] = (unsigned)(Rb * K + C) * 2u; }
    const size_t kstep = (size_t)(BK * 2);
    const size_t hstep = (size_t)HALF * K * 2;
    const size_t tstep = 2 * hstep;
    const unsigned ldsw = (unsigned)wid * 1024u;
    const int aoff = lds_byte(wr * 64 + fr, fq * 8), boff = lds_byte(wc * 32 + fr, fq * 8);
#define PG8_SA(b, h) (((b) * 2 + (h)) * HTB)
#define PG8_SB(b, h) ((4 + (b) * 2 + (h)) * HTB)
#define PG8_STAGE(bufoff, gbase, voff) do { _Pragma("unroll") for (int _i = 0; _i < 2; ++_i) \
        __builtin_amdgcn_global_load_lds((const unsigned*)((const char*)(gbase) + (voff)[_i]), (PG8_LAS unsigned*)(lds + (bufoff) + ldsw + _i * 8192), 16, 0, 0); } while (0)
#define PG8_LDA(dst, b, h) do { _Pragma("unroll") for (int m = 0; m < 4; ++m) _Pragma("unroll") for (int k = 0; k < 2; ++k) dst[m][k] = *(const PG8_LAS bf16x8*)(lds + PG8_SA(b, h) + aoff + m * 2048 + k * 1024); } while (0)
#define PG8_LDB(dst, b, h) do { _Pragma("unroll") for (int n = 0; n < 2; ++n) _Pragma("unroll") for (int k = 0; k < 2; ++k) dst[n][k] = *(const PG8_LAS bf16x8*)(lds + PG8_SB(b, h) + boff + n * 2048 + k * 1024); } while (0)
#define PG8_MMA(ai, bj, At, Bt) do { __builtin_amdgcn_s_setprio(1); _Pragma("unroll") for (int m = 0; m < 4; ++m) _Pragma("unroll") for (int n = 0; n < 2; ++n) _Pragma("unroll") for (int k = 0; k < 2; ++k) \
        acc[ai][bj][m][n] = __builtin_amdgcn_mfma_f32_16x16x32_bf16(Bt[n][k], At[m][k], acc[ai][bj][m][n], 0, 0, 0); __builtin_amdgcn_s_setprio(0); } while (0)
#define PG8_WAIT_V(n) asm volatile("s_waitcnt vmcnt(" #n ")" ::: "memory")
#define PG8_WAIT_L(n) asm volatile("s_waitcnt lgkmcnt(" #n ")" ::: "memory")
#define PG8_BAR __builtin_amdgcn_s_barrier()
#define PG8_SCHED __builtin_amdgcn_sched_barrier(0)
    Unit cur, nxt; int ui = 0;
    if (!S.next(0, cur)) return;
    f32x4 acc[2][2][4][2];
#pragma unroll
    for (int a = 0; a < 2; ++a)
#pragma unroll
        for (int b = 0; b < 2; ++b)
#pragma unroll
            for (int m = 0; m < 4; ++m)
#pragma unroll
                for (int n = 0; n < 2; ++n) acc[a][b][m][n] = (f32x4){0.f, 0.f, 0.f, 0.f};
    bf16x8 At[4][2], B0[2][2], B1[2][2];
    const char* cA = (const char*)g.A + (size_t)cur.pm * tstep; const char* cB = (const char*)g.Bt + (size_t)cur.pn * tstep;
    S.a_ready(cur);
    if constexpr (SP2) {
        PG8_STAGE(PG8_SB(0, 0), cB, voffB); PG8_STAGE(PG8_SB(0, 1), cB + hstep, voffB); PG8_STAGE(PG8_SA(0, 0), cA, voffA); PG8_STAGE(PG8_SA(0, 1), cA + hstep, voffA);
        if (wr == 1) PG8_BAR;
        PG8_WAIT_V(2); PG8_BAR;
        PG8_STAGE(PG8_SB(1, 0), cB + kstep, voffB); PG8_STAGE(PG8_SA(1, 0), cA + kstep, voffA); PG8_STAGE(PG8_SB(1, 1), cB + hstep + kstep, voffB);
        PG8_WAIT_V(6); PG8_BAR;
    } else {
        PG8_STAGE(PG8_SB(0, 0), cB, voffB); PG8_STAGE(PG8_SA(0, 0), cA, voffA); PG8_STAGE(PG8_SB(0, 1), cB + hstep, voffB); PG8_STAGE(PG8_SA(0, 1), cA + hstep, voffA);
        if (wr == 1) PG8_BAR;
        PG8_WAIT_V(4); PG8_BAR;
        PG8_STAGE(PG8_SB(1, 0), cB + kstep, voffB); PG8_STAGE(PG8_SA(1, 0), cA + kstep, voffA); PG8_STAGE(PG8_SB(1, 1), cB + hstep + kstep, voffB);
        PG8_WAIT_V(6); PG8_BAR;
    }
    for (;;) {
        const bool has_next = S.next(ui + 1, nxt);
        const char* nA = has_next ? (const char*)g.A + (size_t)nxt.pm * tstep : cA; const char* nB = has_next ? (const char*)g.Bt + (size_t)nxt.pn * tstep : cB;
        for (int t = 0; t < nt; t += 2) {
            const bool last = (t == nt - 2);
            const char* a1 = cA + (size_t)(t + 1) * kstep;
            const char* a2 = last ? nA : cA + (size_t)(t + 2) * kstep; const char* b2 = last ? nB : cB + (size_t)(t + 2) * kstep;
            const char* a3 = a2 + kstep; const char* b3 = b2 + kstep;
            if (last && has_next) S.a_ready(nxt);
            if constexpr (SP2) {
            PG8_LDB(B0, 0, 0); PG8_LDB(B1, 0, 1); PG8_SCHED; PG8_LDA(At, 0, 0); PG8_STAGE(PG8_SA(1, 1), a1 + hstep, voffA);
            PG8_WAIT_V(8); PG8_WAIT_L(0); PG8_BAR; PG8_MMA(0, 0, At, B0); PG8_MMA(0, 1, At, B1); PG8_BAR; PG8_SCHED;
            PG8_LDA(At, 0, 1); PG8_STAGE(PG8_SB(0, 0), b2, voffB); PG8_STAGE(PG8_SB(0, 1), b2 + hstep, voffB); PG8_STAGE(PG8_SA(0, 0), a2, voffA);
            PG8_WAIT_V(8); PG8_WAIT_L(0); PG8_BAR; PG8_MMA(1, 0, At, B0); PG8_MMA(1, 1, At, B1); PG8_BAR; PG8_SCHED;
            PG8_LDB(B0, 1, 0); PG8_LDB(B1, 1, 1); PG8_SCHED; PG8_LDA(At, 1, 0); PG8_STAGE(PG8_SA(0, 1), a2 + hstep, voffA);
            PG8_WAIT_V(8); PG8_WAIT_L(0); PG8_BAR; PG8_MMA(0, 0, At, B0); PG8_MMA(0, 1, At, B1); PG8_BAR; PG8_SCHED;
            PG8_LDA(At, 1, 1); PG8_STAGE(PG8_SB(1, 0), b3, voffB); PG8_STAGE(PG8_SB(1, 1), b3 + hstep, voffB); PG8_STAGE(PG8_SA(1, 0), a3, voffA);
            PG8_WAIT_V(8); PG8_WAIT_L(0); PG8_BAR; PG8_MMA(1, 0, At, B0); PG8_MMA(1, 1, At, B1); PG8_BAR; PG8_SCHED;
            } else {
            PG8_LDB(B0, 0, 0); PG8_SCHED; PG8_LDA(At, 0, 0); PG8_STAGE(PG8_SA(1, 1), a1 + hstep, voffA);
            PG8_WAIT_L(8); PG8_BAR; PG8_WAIT_L(0); PG8_MMA(0, 0, At, B0); PG8_BAR; PG8_SCHED;
            PG8_LDB(B1, 0, 1); PG8_STAGE(PG8_SB(0, 0), b2, voffB);
            PG8_BAR; PG8_WAIT_L(0); PG8_MMA(0, 1, At, B1); PG8_BAR;
            PG8_LDA(At, 0, 1); PG8_STAGE(PG8_SA(0, 0), a2, voffA);
            PG8_BAR; PG8_WAIT_L(0); PG8_MMA(1, 0, At, B0); PG8_BAR; PG8_SCHED;
            PG8_STAGE(PG8_SB(0, 1), b2 + hstep, voffB);
            PG8_WAIT_V(6); PG8_BAR; PG8_MMA(1, 1, At, B1); PG8_BAR;
            PG8_LDB(B0, 1, 0); PG8_SCHED; PG8_LDA(At, 1, 0); PG8_STAGE(PG8_SA(0, 1), a2 + hstep, voffA);
            PG8_WAIT_L(8); PG8_BAR; PG8_WAIT_L(0); PG8_MMA(0, 0, At, B0); PG8_BAR; PG8_SCHED;
            PG8_LDB(B1, 1, 1); PG8_STAGE(PG8_SB(1, 0), b3, voffB);
            PG8_BAR; PG8_WAIT_L(0); PG8_MMA(0, 1, At, B1); PG8_BAR;
            PG8_LDA(At, 1, 1); PG8_STAGE(PG8_SA(1, 0), a3, voffA);
            PG8_BAR; PG8_WAIT_L(0); PG8_MMA(1, 0, At, B0); PG8_BAR; PG8_SCHED;
            PG8_STAGE(PG8_SB(1, 1), b3 + hstep, voffB);
            PG8_WAIT_V(6); PG8_BAR; PG8_MMA(1, 1, At, B1); PG8_BAR;
            }
        }
        if constexpr (ALIGN_EPI) { if (wr == 0) PG8_BAR; }
        if constexpr (!Epi::AFTER_DRAIN) { E(acc, cur, wr, wc, fr, fq); S.done(cur); }
        if (!has_next) break;
#pragma unroll
        for (int a = 0; a < 2; ++a)
#pragma unroll
            for (int b = 0; b < 2; ++b)
#pragma unroll
                for (int m = 0; m < 4; ++m)
#pragma unroll
                    for (int n = 0; n < 2; ++n) acc[a][b][m][n] = (f32x4){0.f, 0.f, 0.f, 0.f};
        cur = nxt; cA = nA; cB = nB; ++ui;
        if constexpr (ALIGN_EPI) { if (wr == 1) PG8_BAR; }
    }
    PG8_WAIT_V(0);
    if constexpr (!ALIGN_EPI) { if (wr == 0) PG8_BAR; }
    PG8_BAR;
    if constexpr (Epi::AFTER_DRAIN) { E.fused(acc, cur, wr, wc, fr, fq, lds, wid, lane); S.done(cur); }
#undef PG8_SA
#undef PG8_SB
#undef PG8_STAGE
#undef PG8_LDA
#undef PG8_LDB
#undef PG8_MMA
#undef PG8_WAIT_V
#undef PG8_WAIT_L
#undef PG8_BAR
#undef PG8_SCHED
}
}
#define LAS __attribute__((address_space(3)))
typedef unsigned short bf16;
using pg8::f32x4; using pg8::u32x4; using pg8::Unit; using pg8::cvt_pk_bf16; using pg8::bf16x8;
typedef unsigned u32x2 __attribute__((ext_vector_type(2)));

constexpr int NB = 8, S = 2048, D = 1024, M = NB * S, NIN = 2304, FF = 2816, NUP = 2 * FF, DEPTH = 2;
constexpr float EPS = 1e-6f;
constexpr float LOG2E = 1.4426950408889634f;
constexpr float QSCALE = 0.125f * LOG2E;
constexpr int XL_OFF = 131072;
constexpr int LDS_BYTES = 131072 + 8192;

__device__ __forceinline__ float dot4(f32x4 a) { return (a[0] * a[0] + a[1] * a[1]) + (a[2] * a[2] + a[3] * a[3]); }
__device__ __forceinline__ float silu_f(float v) { return v * __builtin_amdgcn_rcpf(1.f + __expf(-v)); }

struct EpiInProj {
    static constexpr bool PERM = true, AFTER_DRAIN = false;
    bf16* O; const float* qn_a; const float* kn_a; const float* qn_b; const float* kn_b; const float* cosT; const float* sinT; const float* rowsq;
    __device__ __forceinline__ void operator()(const f32x4 (&acc)[2][2][4][2], const Unit& u, int wr, int wc, int fr, int fq) const {
        asm volatile("" : "+v"(fr), "+v"(fq));
        const int pn = u.pn;
        const float* g = nullptr; float sc = 1.f;
        if (pn < 2) { g = qn_a; sc = QSCALE; }
        else if (pn == 2) { if (wc < 2) g = kn_a; }
        else if (pn < 5) { g = qn_b; sc = QSCALE; }
        else if (pn < 7) { g = kn_b; }
        const int colb = pn * 256 + wc * 64 + 8 * fq;
        const int row0 = u.pm * 256 + wr * 64 + fr;
        if (g) {
            f32x4 g1[2], g2[2];
#pragma unroll
            for (int n = 0; n < 2; ++n) { g1[n] = *(const f32x4*)(g + 8 * fq + 4 * n); g2[n] = *(const f32x4*)(g + 32 + 8 * fq + 4 * n); }
#pragma unroll
            for (int ai = 0; ai < 2; ++ai)
#pragma unroll
                for (int m = 0; m < 4; ++m) {
                    const int row = row0 + ai * 128 + m * 16;
                    const f32x4 a0 = acc[ai][0][m][0], a1 = acc[ai][0][m][1], b0 = acc[ai][1][m][0], b1 = acc[ai][1][m][1];
                    float ss = (dot4(a0) + dot4(a1)) + (dot4(b0) + dot4(b1));
                    ss += __shfl_xor(ss, 16); ss += __shfl_xor(ss, 32);
                    const float rx = rsqrtf(rowsq[row] * (1.f / D) + EPS);
                    const float rs = rsqrtf(ss * rx * rx * (1.f / 64.f) + EPS) * rx * sc;
                    const size_t ro = (size_t)(row & (S - 1)) * 32 + 8 * fq;
                    const f32x4 c0 = *(const f32x4*)(cosT + ro), c1 = *(const f32x4*)(cosT + ro + 4), s0 = *(const f32x4*)(sinT + ro), s1 = *(const f32x4*)(sinT + ro + 4);
                    const f32x4 y10 = a0 * rs * g1[0], y11 = a1 * rs * g1[1], y20 = b0 * rs * g2[0], y21 = b1 * rs * g2[1];
                    const f32x4 o10 = y10 * c0 - y20 * s0, o11 = y11 * c1 - y21 * s1, o20 = y20 * c0 + y10 * s0, o21 = y21 * c1 + y11 * s1;
                    u32x4 w1, w2;
                    w1.x = cvt_pk_bf16(o10[0], o10[1]); w1.y = cvt_pk_bf16(o10[2], o10[3]); w1.z = cvt_pk_bf16(o11[0], o11[1]); w1.w = cvt_pk_bf16(o11[2], o11[3]);
                    w2.x = cvt_pk_bf16(o20[0], o20[1]); w2.y = cvt_pk_bf16(o20[2], o20[3]); w2.z = cvt_pk_bf16(o21[0], o21[1]); w2.w = cvt_pk_bf16(o21[2], o21[3]);
                    bf16* op = O + (size_t)row * NIN + colb;
                    *(u32x4*)op = w1; *(u32x4*)(op + 32) = w2;
                }
        } else {
#pragma unroll
            for (int ai = 0; ai < 2; ++ai)
#pragma unroll
                for (int m = 0; m < 4; ++m) {
                    const int row = row0 + ai * 128 + m * 16;
                    bf16* op = O + (size_t)row * NIN + colb;
                    const float rx = rsqrtf(rowsq[row] * (1.f / D) + EPS);
#pragma unroll
                    for (int bj = 0; bj < 2; ++bj) { const f32x4 v0 = acc[ai][bj][m][0] * rx, v1 = acc[ai][bj][m][1] * rx; u32x4 w;
                        w.x = cvt_pk_bf16(v0[0], v0[1]); w.y = cvt_pk_bf16(v0[2], v0[3]); w.z = cvt_pk_bf16(v1[0], v1[1]); w.w = cvt_pk_bf16(v1[2], v1[3]);
                        *(u32x4*)(op + 32 * bj) = w; }
                }
        }
    }
};

__device__ __forceinline__ f32x4 bf2f_lo(unsigned a, unsigned b) { return (f32x4){__uint_as_float(a << 16), __uint_as_float(a & 0xffff0000u), __uint_as_float(b << 16), __uint_as_float(b & 0xffff0000u)}; }
struct EpiResid {
    static constexpr bool PERM = true, AFTER_DRAIN = false;
    bf16* XB; float* rowsq; float* outf;
    __device__ __forceinline__ void operator()(const f32x4 (&acc)[2][2][4][2], const Unit& u, int wr, int wc, int fr, int fq) const {
        asm volatile("" : "+v"(fr), "+v"(fq));
        const int col0 = u.pn * 256 + wc * 32 + 8 * fq, row0 = u.pm * 256 + wr * 64 + fr;
#pragma unroll
        for (int ai = 0; ai < 2; ++ai) {
            u32x4 xr[4][2];
#pragma unroll
            for (int m = 0; m < 4; ++m) { const size_t off = (size_t)(row0 + ai * 128 + m * 16) * D + col0;
#pragma unroll
                for (int bj = 0; bj < 2; ++bj) xr[m][bj] = *(const u32x4*)(XB + off + bj * 128); }
            asm volatile("" ::: "memory");
#pragma unroll
            for (int m = 0; m < 4; ++m) { const int row = row0 + ai * 128 + m * 16; const size_t off = (size_t)row * D + col0; float ss = 0.f;
#pragma unroll
                for (int bj = 0; bj < 2; ++bj) {
                    const f32x4 y0 = bf2f_lo(xr[m][bj].x, xr[m][bj].y) + acc[ai][bj][m][0], y1 = bf2f_lo(xr[m][bj].z, xr[m][bj].w) + acc[ai][bj][m][1];
                    ss += dot4(y0) + dot4(y1);
                    if (outf) { *(f32x4*)(outf + off + bj * 128) = y0; *(f32x4*)(outf + off + bj * 128 + 4) = y1; }
                    else { u32x4 w; w.x = cvt_pk_bf16(y0[0], y0[1]); w.y = cvt_pk_bf16(y0[2], y0[3]); w.z = cvt_pk_bf16(y1[0], y1[1]); w.w = cvt_pk_bf16(y1[2], y1[3]); *(u32x4*)(XB + off + bj * 128) = w; }
                }
                if (rowsq) { ss += __shfl_xor(ss, 16); ss += __shfl_xor(ss, 32); if (fq == 0) atomicAdd(rowsq + row, ss); }
            }
            asm volatile("" ::: "memory");
        }
    }
};

struct EpiUpConv {
    static constexpr bool PERM = true, AFTER_DRAIN = false;
    bf16* ACT; const float* cw; const float* cb; float* edge; float* part; LAS float* xl; const float* rowsq;
    __device__ __forceinline__ void operator()(f32x4 (&acc)[2][2][4][2], const Unit& u, int wr, int wc, int fr, int fq) const {
        asm volatile("" : "+v"(fr), "+v"(fq));
        const int lane = 16 * fq + fr;
        const int cl0 = 32 * wc + 8 * fq, ch0 = 128 * u.pn + cl0;
#pragma unroll
        for (int ai = 0; ai < 2; ++ai)
#pragma unroll
            for (int m = 0; m < 4; ++m) { const float rx = rsqrtf(rowsq[u.pm * 256 + ai * 128 + wr * 64 + m * 16 + fr] * (1.f / D) + EPS);
#pragma unroll
                for (int bj = 0; bj < 2; ++bj) { acc[ai][bj][m][0] *= rx; acc[ai][bj][m][1] *= rx; } }
#pragma unroll
        for (int ai = 0; ai < 2; ++ai) {
            const int chunk = 2 * ai + wr;
            if (fr == 0) { *(LAS f32x4*)(xl + (chunk * 2 + 0) * 128 + cl0) = acc[ai][0][0][0]; *(LAS f32x4*)(xl + (chunk * 2 + 0) * 128 + cl0 + 4) = acc[ai][0][0][1]; }
            if (fr == 15) { *(LAS f32x4*)(xl + (chunk * 2 + 1) * 128 + cl0) = acc[ai][0][3][0]; *(LAS f32x4*)(xl + (chunk * 2 + 1) * 128 + cl0 + 4) = acc[ai][0][3][1]; }
        }
        asm volatile("s_waitcnt lgkmcnt(0)" ::: "memory"); __builtin_amdgcn_s_barrier(); asm volatile("" ::: "memory");
        const int lup = (lane & ~15) | ((fr + 15) & 15), ldn = (lane & ~15) | ((fr + 1) & 15);
        const bool seq_first = (u.pm & 7) == 0, seq_last = (u.pm & 7) == 7;
#pragma unroll
        for (int ai = 0; ai < 2; ++ai) {
            const int chunk = 2 * ai + wr;
#pragma unroll
            for (int n = 0; n < 2; ++n) {
                const int ch = ch0 + 4 * n;
                const f32x4 w0 = *(const f32x4*)(cw + ch), w1 = *(const f32x4*)(cw + FF + ch), w2 = *(const f32x4*)(cw + 2 * FF + ch), bb = *(const f32x4*)(cb + ch);
                const f32x4 above = (chunk > 0) ? *(const LAS f32x4*)(xl + ((chunk - 1) * 2 + 1) * 128 + cl0 + 4 * n) : (f32x4){0.f, 0.f, 0.f, 0.f};
                const f32x4 below = (chunk < 3) ? *(const LAS f32x4*)(xl + ((chunk + 1) * 2 + 0) * 128 + cl0 + 4 * n) : (f32x4){0.f, 0.f, 0.f, 0.f};
                f32x4 Rprev = above, Lcur;
#pragma unroll
                for (int e = 0; e < 4; ++e) Lcur[e] = __shfl(acc[ai][0][0][n][e], ldn);
#pragma unroll
                for (int m = 0; m < 4; ++m) {
                    const int rt = ai * 128 + wr * 64 + m * 16 + fr;
                    const size_t row = (size_t)u.pm * 256 + rt;
                    const f32x4 cur = acc[ai][0][m][n], val = acc[ai][1][m][n];
                    f32x4 Rm, Lnext = below;
#pragma unroll
                    for (int e = 0; e < 4; ++e) { Rm[e] = __shfl(cur[e], lup); if (m < 3) Lnext[e] = __shfl(acc[ai][0][m < 3 ? m + 1 : 3][n][e], ldn); }
                    const f32x4 up = (fr == 0) ? Rprev : Rm, dn = (fr == 15) ? Lnext : Lcur;
                    Rprev = Rm; Lcur = Lnext;
                    const f32x4 pre = bb + w0 * up + w1 * cur + w2 * dn;
                    f32x4 res;
#pragma unroll
                    for (int e = 0; e < 4; ++e) res[e] = silu_f(pre[e]) * val[e];
                    if (rt == 0) {
                        *(f32x4*)(edge + ((size_t)u.pm * 2 + 0) * FF + ch) = cur;
                        if (!seq_first) { float* pp = part + (((size_t)u.pm * 2 + 0) * FF + ch) * 2;
                            *(f32x4*)pp = (f32x4){pre[0], val[0], pre[1], val[1]}; *(f32x4*)(pp + 4) = (f32x4){pre[2], val[2], pre[3], val[3]}; }
                    }
                    if (rt == 255) {
                        *(f32x4*)(edge + ((size_t)u.pm * 2 + 1) * FF + ch) = cur;
                        if (!seq_last) { float* pp = part + (((size_t)u.pm * 2 + 1) * FF + ch) * 2;
                            *(f32x4*)pp = (f32x4){pre[0], val[0], pre[1], val[1]}; *(f32x4*)(pp + 4) = (f32x4){pre[2], val[2], pre[3], val[3]}; }
                    }
                    u32x2 w; w.x = cvt_pk_bf16(res[0], res[1]); w.y = cvt_pk_bf16(res[2], res[3]);
                    *(u32x2*)(ACT + row * FF + ch) = w;
                }
            }
        }
    }
};
namespace att {
typedef __attribute__((ext_vector_type(16))) float f32x16;
typedef __attribute__((ext_vector_type(4))) short s16x4;
typedef short v4i16_t __attribute__((ext_vector_type(4)));
typedef LAS const char* lptr;
__device__ __forceinline__ s16x4 vtr(lptr p) { return __builtin_bit_cast(s16x4, __builtin_amdgcn_ds_read_tr16_b64_v4i16((LAS v4i16_t*)p)); }
typedef float f32x2_t __attribute__((ext_vector_type(2))); typedef __bf16 bf16x2_t __attribute__((ext_vector_type(2)));
__device__ __forceinline__ unsigned cvtpk_s(float lo, float hi) { f32x2_t v = {lo, hi}; bf16x2_t b = __builtin_convertvector(v, bf16x2_t); return __builtin_bit_cast(unsigned, b); }
__device__ __forceinline__ bf16x8 pack8(const f32x16& s, int b) {
    u32x4 w; w.x = cvtpk_s(s[b], s[b + 1]); w.y = cvtpk_s(s[b + 2], s[b + 3]); w.z = cvtpk_s(s[b + 4], s[b + 5]); w.w = cvtpk_s(s[b + 6], s[b + 7]);
    return __builtin_bit_cast(bf16x8, w);
}
#define MFMA32(a, b, c) __builtin_amdgcn_mfma_f32_32x32x16_bf16((a), (b), (c), 0, 0, 0)

#define LGKM_WAIT(n) asm volatile("s_waitcnt lgkmcnt(" #n ")" ::: "memory")
#define SCHED_FENCE() __builtin_amdgcn_sched_barrier(0)
__device__ __forceinline__ bf16x8 rd128(unsigned addr, int off) { bf16x8 r; asm volatile("ds_read_b128 %0, %1 offset:%c2" : "=&v"(r) : "v"(addr), "i"(off) : "memory"); return r; }
__device__ __forceinline__ s16x4 rdtr(unsigned addr, int off) { s16x4 r; asm volatile("ds_read_b64_tr_b16 %0, %1 offset:%c2" : "=&v"(r) : "v"(addr), "i"(off) : "memory"); return r; }
#define VFRAG(lo, hh) ((bf16x8){lo[0], lo[1], lo[2], lo[3], hh[0], hh[1], hh[2], hh[3]})
constexpr int KROW = 144, VROWD = 320, VROWA = 192;
constexpr int DSTG = 2 * 64 * KROW + 64 * VROWD;
constexpr int ASTG = 64 * KROW + 64 * VROWA;

constexpr int DST3 = 32768;
#define SGB(mask, n) __builtin_amdgcn_sched_group_barrier((mask), (n), 0)
__device__ __forceinline__ void diff_unit(LAS char* lds, const bf16* __restrict__ QKV, bf16* __restrict__ Y, int b, int h, int qb, float Mb, float lam, const float* __restrict__ subln, float outscale) {
    int tid = threadIdx.x; asm volatile("" : "+v"(tid)); const int lane = tid & 63, w = __builtin_amdgcn_readfirstlane(tid >> 6), q = lane & 31, hi = lane >> 5;
    const int rg = w >> 1, c = w & 1;
    const size_t rowQ = (size_t)b * S + qb * 128 + rg * 32 + q;
    const bf16* qp = QKV + rowQ * NIN + 768 + (2 * h + c) * 64 + hi * 8;
    bf16x8 qf[4];
#pragma unroll
    for (int ds = 0; ds < 4; ++ds) qf[ds] = *(const bf16x8*)(qp + ds * 16);
    const int krow = 8 * w + (lane >> 3), kch = (lane & 7) ^ ((krow >> 1) & 7);
    const int vrow = 4 * w + (lane >> 4), vch = (lane & 15) ^ ((vrow & 3) << 2);
    const bf16* kg = QKV + ((size_t)b * S + krow) * NIN + 1280 + 128 * h + kch * 8;
    const bf16* vg = QKV + ((size_t)b * S + vrow) * NIN + 1792 + 128 * h + vch * 8;
#define DDMA(t, so) do { const size_t o_ = (size_t)(t) * 64 * NIN; LAS unsigned char* d_ = (LAS unsigned char*)lds + (so) + w * 1024; \
        __builtin_amdgcn_global_load_lds((const unsigned*)(kg + o_), (LAS unsigned*)(d_), 16, 0, 0); \
        __builtin_amdgcn_global_load_lds((const unsigned*)(kg + o_ + 64), (LAS unsigned*)(d_ + 8192), 16, 0, 0); \
        __builtin_amdgcn_global_load_lds((const unsigned*)(vg + o_), (LAS unsigned*)(d_ + 16384), 16, 0, 0); \
        __builtin_amdgcn_global_load_lds((const unsigned*)(vg + o_ + 32 * NIN), (LAS unsigned*)(d_ + 16384 + 8192), 16, 0, 0); } while (0)
    f32x16 o[4];
#pragma unroll
    for (int i = 0; i < 4; ++i) o[i] = (f32x16){0.f};
    float l = 0.f;
    constexpr int NT = S / 64;
    DDMA(0, 0); DDMA(1, DST3); DDMA(2, 2 * DST3);
    const unsigned lbase = (unsigned)(size_t)lds;
    unsigned kofs[4], vofs[4];
    { const int sw = (q >> 1) & 7, vq = (lane & 15) >> 2;
#pragma unroll
      for (int ds = 0; ds < 4; ++ds) kofs[ds] = (unsigned)(c * 8192 + q * 128 + (((2 * ds + hi) ^ sw) << 4));
#pragma unroll
      for (int db = 0; db < 4; ++db) vofs[db] = (unsigned)(16384 + (4 * hi + vq) * 256 + ((db ^ vq) << 6) + ((lane >> 4) & 1) * 32 + (lane & 3) * 8); }
    f32x16 negm;
#pragma unroll
    for (int r = 0; r < 16; ++r) negm[r] = -Mb;
    f32x16 s0, s1;
    { asm volatile("s_waitcnt vmcnt(8)" ::: "memory"); __builtin_amdgcn_s_barrier(); asm volatile("" ::: "memory");
      bf16x8 kf[8];
#pragma unroll
      for (int ds = 0; ds < 4; ++ds) { kf[2 * ds] = rd128(lbase + kofs[ds], 0); kf[2 * ds + 1] = rd128(lbase + kofs[ds], 32 * 128); }
      LGKM_WAIT(0); SCHED_FENCE();
      s0 = negm; s1 = negm;
#pragma unroll
      for (int ds = 0; ds < 4; ++ds) { s0 = MFMA32(kf[2 * ds], qf[ds], s0); s1 = MFMA32(kf[2 * ds + 1], qf[ds], s1); }
      SCHED_FENCE(); }
    int so_cur = 0, so_n1 = DST3, so_n3 = 3 * DST3;
    for (int t = 0; t < NT; ++t) {
        asm volatile("s_waitcnt vmcnt(4)" ::: "memory");
        __builtin_amdgcn_s_barrier();
        asm volatile("" ::: "memory");
        { const int tn = (t + 3 < NT) ? t + 3 : NT - 1; DDMA(tn, so_n3); }
        const unsigned sb = lbase + so_cur, sn = lbase + so_n1;
        bf16x8 kf[8];
#pragma unroll
        for (int ds = 0; ds < 4; ++ds) { kf[2 * ds] = rd128(sn + kofs[ds], 0); kf[2 * ds + 1] = rd128(sn + kofs[ds], 32 * 128); }
        s16x4 vl[2][4], vh[2][4];
#pragma unroll
        for (int db = 0; db < 4; ++db) { vl[0][db] = rdtr(sb + vofs[db], 0); vh[0][db] = rdtr(sb + vofs[db], 8 * 256); }
        LGKM_WAIT(0); SCHED_FENCE();
        __builtin_amdgcn_s_setprio(1);
        f32x16 n0 = negm, n1 = negm;
#pragma unroll
        for (int ds = 0; ds < 4; ++ds) { n0 = MFMA32(kf[2 * ds], qf[ds], n0); n1 = MFMA32(kf[2 * ds + 1], qf[ds], n1); }
        float ls = 0.f;
#pragma unroll
        for (int r = 0; r < 16; ++r) { s0[r] = __builtin_amdgcn_exp2f(s0[r]); ls += s0[r]; }
        bf16x8 pf[4]; pf[0] = pack8(s0, 0); pf[1] = pack8(s0, 8);
#pragma unroll
        for (int i = 0; i < 8; ++i) { SGB(0x008, 1); SGB(0x400, 2); SGB(0x002, 3); }
        SCHED_FENCE();
        __builtin_amdgcn_s_setprio(0);
#pragma unroll
        for (int db = 0; db < 4; ++db) { vl[1][db] = rdtr(sb + vofs[db], 16 * 256); vh[1][db] = rdtr(sb + vofs[db], 16 * 256 + 8 * 256); }
        s16x4 wl[2][4], wh[2][4];
#pragma unroll
        for (int ks = 0; ks < 2; ++ks)
#pragma unroll
            for (int db = 0; db < 4; ++db) { wl[ks][db] = rdtr(sb + vofs[db], (ks + 2) * 16 * 256); wh[ks][db] = rdtr(sb + vofs[db], (ks + 2) * 16 * 256 + 8 * 256); }
        LGKM_WAIT(15); SCHED_FENCE();
        __builtin_amdgcn_s_setprio(1);
#pragma unroll
        for (int ks = 0; ks < 2; ++ks)
#pragma unroll
            for (int db = 0; db < 4; ++db) o[db] = MFMA32(VFRAG(vl[ks][db], vh[ks][db]), pf[ks], o[db]);
#pragma unroll
        for (int r = 0; r < 16; ++r) { s1[r] = __builtin_amdgcn_exp2f(s1[r]); ls += s1[r]; }
        l += ls;
        pf[2] = pack8(s1, 0); pf[3] = pack8(s1, 8);
#pragma unroll
        for (int i = 0; i < 8; ++i) { SGB(0x008, 1); SGB(0x400, 2); SGB(0x002, 3); }
        SCHED_FENCE();
        LGKM_WAIT(0); SCHED_FENCE();
#pragma unroll
        for (int ks = 0; ks < 2; ++ks)
#pragma unroll
            for (int db = 0; db < 4; ++db) o[db] = MFMA32(VFRAG(wl[ks][db], wh[ks][db]), pf[2 + ks], o[db]);
        SCHED_FENCE();
        __builtin_amdgcn_s_setprio(0);
        s0 = n0; s1 = n1;
        so_cur = so_n1; so_n1 = (so_n1 == 3 * DST3) ? 0 : so_n1 + DST3; so_n3 = (so_n3 == 3 * DST3) ? 0 : so_n3 + DST3;
    }
#undef DDMA
    asm volatile("s_waitcnt vmcnt(0)" ::: "memory");
    __syncthreads();
    l += __shfl_xor(l, 32);
    const float inv = 1.f / l;
    LAS f32x4* xb = (LAS f32x4*)lds + rg * (16 * 64) + lane;
    if (c == 1) {
#pragma unroll
        for (int db = 0; db < 4; ++db)
#pragma unroll
            for (int r4 = 0; r4 < 4; ++r4) xb[(db * 4 + r4) * 64] = (f32x4){o[db][4 * r4], o[db][4 * r4 + 1], o[db][4 * r4 + 2], o[db][4 * r4 + 3]} * inv;
    }
    __syncthreads();
    if (c == 0) {
        float ss = 0.f;
#pragma unroll
        for (int db = 0; db < 4; ++db)
#pragma unroll
            for (int r4 = 0; r4 < 4; ++r4) { const f32x4 ot = xb[(db * 4 + r4) * 64];
#pragma unroll
                for (int e = 0; e < 4; ++e) { const float d = o[db][4 * r4 + e] * inv - lam * ot[e]; o[db][4 * r4 + e] = d; ss += d * d; } }
        ss += __shfl_xor(ss, 32);
        const float rs = rsqrtf(ss * (1.f / 128.f) + EPS) * outscale;
        bf16* yp = Y + rowQ * D + 512 + 128 * h + 4 * hi;
#pragma unroll
        for (int db = 0; db < 4; ++db)
#pragma unroll
            for (int r4 = 0; r4 < 4; ++r4) { const f32x4 gw = *(const f32x4*)(subln + 32 * db + 8 * r4 + 4 * hi);
                u32x2 wv; wv.x = cvt_pk_bf16(o[db][4 * r4] * rs * gw[0], o[db][4 * r4 + 1] * rs * gw[1]); wv.y = cvt_pk_bf16(o[db][4 * r4 + 2] * rs * gw[2], o[db][4 * r4 + 3] * rs * gw[3]);
                *(u32x2*)(yp + 32 * db + 8 * r4) = wv; }
    }
    __syncthreads();
}

__device__ __forceinline__ void swa_unit(LAS char* lds, const bf16* __restrict__ QKV, bf16* __restrict__ Y, int b, int kvh, int n, float Mb, const float* __restrict__ sink) {
    int tid = threadIdx.x; asm volatile("" : "+v"(tid)); const int lane = tid & 63, w = __builtin_amdgcn_readfirstlane(tid >> 6), q = lane & 31, hi = lane >> 5;
    const int head = kvh * 4 + (w >> 1), rb = (w & 1) * 64;
    const size_t rowQ = (size_t)b * S + n * 128 + rb + q;
    bf16x8 qf[2][4];
#pragma unroll
    for (int rg = 0; rg < 2; ++rg)
#pragma unroll
        for (int ds = 0; ds < 4; ++ds) qf[rg][ds] = *(const bf16x8*)(QKV + (rowQ + 32 * rg) * NIN + head * 64 + hi * 8 + ds * 16);
    const int lrow = tid >> 3, lcc = tid & 7;
    const long kp0 = (long)b * S + (long)(n - 1) * 128 + lrow;
    const bf16* kg = QKV + kp0 * NIN + 512 + kvh * 64 + lcc * 8;
    const bf16* vg = QKV + kp0 * NIN + 640 + kvh * 64 + lcc * 8;
    const int kdst = lrow * KROW + lcc * 16, vdst = 64 * KROW + lrow * VROWA + lcc * 16;
    u32x4 st0, st1;
#define ALOAD(t) do { const long o_ = (long)(t) * 64 * NIN; st0 = *(const u32x4*)(kg + o_); st1 = *(const u32x4*)(vg + o_); } while (0)
#define ASTORE(bo) do { *(LAS u32x4*)(lds + (bo) + kdst) = st0; *(LAS u32x4*)(lds + (bo) + vdst) = st1; } while (0)
    f32x16 o[2][2];
#pragma unroll
    for (int i = 0; i < 2; ++i)
#pragma unroll
        for (int j = 0; j < 2; ++j) o[i][j] = (f32x16){0.f};
    float l[2] = {0.f, 0.f};
    const int t0 = (n == 0) ? 2 : 0, t1 = (n == S / 128 - 1) ? 4 : 6;
    ALOAD(t0); ASTORE((t0 & 1) * ASTG); __syncthreads();
    const int koff = q * KROW + hi * 16;
    const int voff = 64 * KROW + (4 * hi + ((lane & 15) >> 2)) * VROWA + ((lane >> 4) & 1) * 32 + (lane & 3) * 8;
    const unsigned lbase = (unsigned)(size_t)lds;
    for (int t = t0; t < t1; ++t) {
        const int cur = (t & 1) * ASTG, nxt = ASTG - cur;
        if (t + 1 < t1) ALOAD(t + 1);
        const unsigned ka = lbase + cur + koff, va = lbase + cur + voff;
        bf16x8 kf[8];
#pragma unroll
        for (int ds = 0; ds < 4; ++ds) { kf[2 * ds] = rd128(ka, ds * 32); kf[2 * ds + 1] = rd128(ka, 32 * KROW + ds * 32); }
        s16x4 vl[4][2], vh[4][2];
#pragma unroll
        for (int ks = 0; ks < 4; ++ks)
#pragma unroll
            for (int db = 0; db < 2; ++db) { vl[ks][db] = rdtr(va, ks * 16 * VROWA + db * 64); vh[ks][db] = rdtr(va, ks * 16 * VROWA + 8 * VROWA + db * 64); }
        LGKM_WAIT(0); SCHED_FENCE();
#pragma unroll
        for (int rg = 0; rg < 2; ++rg) {
            const int i0 = rb + 32 * rg;
            if (64 * t + 63 >= i0 && 64 * t <= i0 + 31 + 256) {
                f32x16 s0 = (f32x16){0.f}, s1 = (f32x16){0.f};
#pragma unroll
                for (int ds = 0; ds < 4; ++ds) { s0 = MFMA32(kf[2 * ds], qf[rg][ds], s0); s1 = MFMA32(kf[2 * ds + 1], qf[rg][ds], s1); }
                const int jb = 64 * t + 4 * hi - (i0 + q);
                float ls = 0.f;
#pragma unroll
                for (int r = 0; r < 16; ++r) {
                    const int d0 = jb + (r & 3) + 8 * (r >> 2), d1 = d0 + 32;
                    const float p0 = __builtin_amdgcn_exp2f(s0[r] - Mb), p1 = __builtin_amdgcn_exp2f(s1[r] - Mb);
                    s0[r] = ((unsigned)d0 <= 256u) ? p0 : 0.f; s1[r] = ((unsigned)d1 <= 256u) ? p1 : 0.f; ls += s0[r] + s1[r];
                }
                l[rg] += ls;
                bf16x8 pf[4]; pf[0] = pack8(s0, 0); pf[1] = pack8(s0, 8); pf[2] = pack8(s1, 0); pf[3] = pack8(s1, 8);
#pragma unroll
                for (int ks = 0; ks < 4; ++ks)
#pragma unroll
                    for (int db = 0; db < 2; ++db) o[rg][db] = MFMA32(VFRAG(vl[ks][db], vh[ks][db]), pf[ks], o[rg][db]);
            }
        }
        SCHED_FENCE();
        if (t + 1 < t1) ASTORE(nxt);
        __syncthreads();
    }
#undef ALOAD
#undef ASTORE
    const float sk = __builtin_amdgcn_exp2f(sink[head] * LOG2E - Mb);
#pragma unroll
    for (int rg = 0; rg < 2; ++rg) {
        float lt = l[rg]; lt += __shfl_xor(lt, 32);
        const float inv = 1.f / (lt + sk);
        bf16* yp = Y + (rowQ + 32 * rg) * D + head * 64 + 4 * hi;
#pragma unroll
        for (int db = 0; db < 2; ++db)
#pragma unroll
            for (int r4 = 0; r4 < 4; ++r4) { u32x2 wv; wv.x = cvt_pk_bf16(o[rg][db][4 * r4] * inv, o[rg][db][4 * r4 + 1] * inv); wv.y = cvt_pk_bf16(o[rg][db][4 * r4 + 2] * inv, o[rg][db][4 * r4 + 3] * inv);
                *(u32x2*)(yp + 32 * db + 8 * r4) = wv; }
    }
}
}
constexpr size_t MiB = 1u << 20;
constexpr size_t WS_CTL = 0, CTL_BYTES = 65536 + 4 * 65536;
constexpr size_t WS_ROWSQ = 65536;
constexpr int MISC_OFF = 131072 + 4096;
constexpr size_t WS_ROPE = 1 * MiB;
constexpr size_t WS_W = 2 * MiB, W_LAYER = 23 * MiB;
constexpr size_t W_IN = 0, W_OUT = (size_t)NIN * D * 2, W_UP = W_OUT + (size_t)D * D * 2, W_DOWN = W_UP + (size_t)NUP * D * 2;
static_assert(W_DOWN + (size_t)D * FF * 2 <= W_LAYER, "weights");
constexpr size_t WS_H = 48 * MiB;
constexpr size_t WS_QKV = 80 * MiB;
constexpr size_t WS_Y = 152 * MiB;
constexpr size_t WS_ACT = 80 * MiB;
constexpr size_t WS_EDGE = 184 * MiB;
constexpr size_t WS_PART = 186 * MiB;
constexpr size_t WS_END = 190 * MiB;
static_assert(WS_ACT + (size_t)M * FF * 2 <= WS_EDGE && WS_QKV + (size_t)M * NIN * 2 <= WS_Y && WS_Y + (size_t)M * D * 2 <= WS_EDGE, "ws map");

#ifndef REP_P0
#define REP_P0 1
#endif
#ifndef REP_P1
#define REP_P1 1
#endif
#ifndef REP_P3B
#define REP_P3B 1
#endif
#ifndef REP_P4
#define REP_P4 1
#endif
#ifndef ATT_REP
#define ATT_REP 1
#endif
#ifndef REP_P5
#define REP_P5 1
#endif
#ifndef REP_P3
#define REP_P3 1
#endif
#ifndef REP_SYNC
#define REP_SYNC 1
#endif
struct Args {
    const float *x, *g_attn, *w_in, *qn_a, *kn_a, *sink, *qn_b, *kn_b, *lq1, *lk1, *lq2, *lk2, *subln, *w_out, *g_ffn, *w_up, *conv_w, *conv_b, *w_down;
    float* out; unsigned char* ws;
};

__device__ __forceinline__ float wave_sum(float v) {
#pragma unroll
    for (int o = 1; o < 64; o <<= 1) v += __shfl_xor(v, o);
    return v;
}
__device__ __forceinline__ float uniform_f(float v) { return __uint_as_float(__builtin_amdgcn_readfirstlane(__float_as_uint(v))); }
__device__ __forceinline__ float wave_max(float v) {
#pragma unroll
    for (int o = 1; o < 64; o <<= 1) v = fmaxf(v, __shfl_xor(v, o));
    return v;
}
__device__ __forceinline__ unsigned f2bf(float f) { unsigned u = __builtin_bit_cast(unsigned, f); return (u + 0x7fffu + ((u >> 16) & 1u)) >> 16; }
__device__ __forceinline__ unsigned pk2(float lo, float hi) { return f2bf(lo) | (f2bf(hi) << 16); }

__device__ __forceinline__ void transpose_item(const float* __restrict__ W, int K, int N, bf16* __restrict__ WT, LAS float* scr, int kb, int nb, int dnb, int lane, const float* __restrict__ g) {
    const int k0 = 64 * kb, n0 = 32 * nb;
#pragma unroll 8
    for (int i = 0; i < 32; ++i) { const int kk = 2 * i + (lane >> 5); scr[kk * 33 + (lane & 31)] = W[(size_t)(k0 + kk) * N + n0 + (lane & 31)] * (g ? g[k0 + kk] : 1.f); }
    asm volatile("s_waitcnt lgkmcnt(0)" ::: "memory");
    const int c = lane & 7;
#pragma unroll
    for (int j = 0; j < 4; ++j) { const int n = (lane >> 3) + 8 * j; const LAS float* s = scr + (8 * c) * 33 + n;
        u32x4 o; o.x = pk2(s[0 * 33], s[1 * 33]); o.y = pk2(s[2 * 33], s[3 * 33]); o.z = pk2(s[4 * 33], s[5 * 33]); o.w = pk2(s[6 * 33], s[7 * 33]);
        *(u32x4*)(WT + (size_t)(32 * dnb + n) * K + k0 + 8 * c) = o; }
    asm volatile("s_waitcnt lgkmcnt(0)" ::: "memory");
}

__device__ __forceinline__ void convert_rows(const float* __restrict__ x, bf16* __restrict__ out, float* __restrict__ rowsq, int gw, int ngw, int lane) {
    for (int m = gw; m < M; m += ngw) {
        const f32x4* xr = (const f32x4*)(x + (size_t)m * D) + lane; f32x4 v[4]; float s = 0.f;
#pragma unroll
        for (int j = 0; j < 4; ++j) { v[j] = xr[64 * j]; s += dot4(v[j]); }
        s = wave_sum(s);
        if (lane == 0) rowsq[m] = s;
        u32x2* o8 = (u32x2*)(out + (size_t)m * D) + lane;
#pragma unroll
        for (int j = 0; j < 4; ++j) { u32x2 wv; wv.x = pk2(v[j][0], v[j][1]); wv.y = pk2(v[j][2], v[j][3]); o8[64 * j] = wv; }
    }
}

#define XB_TMO      128
#define XB_XCNT(j)  (256  + 64 * (j))
#define XB_XSUB(j)  (1280 + 64 * (j))
#define XB_XGEN(j)  (2304 + 64 * (j))
#define XB_TOP      3328
#define XB_TOPGEN   3392
#define XCD_BAR_WORDS 3456
#define XB_SPIN_CAP (1u << 18)

__device__ __forceinline__ unsigned xb_ld(unsigned* p)              { return __hip_atomic_load(p, __ATOMIC_RELAXED, __HIP_MEMORY_SCOPE_AGENT); }
__device__ __forceinline__ unsigned xb_add(unsigned* p, unsigned v) { return __hip_atomic_fetch_add(p, v, __ATOMIC_RELAXED, __HIP_MEMORY_SCOPE_AGENT); }
__device__ __forceinline__ unsigned xb_xcc_id() { return (unsigned)__builtin_amdgcn_s_getreg((3 << 11) | 20) & 0xFu; }
#define XB_SPIN(cond, bar) do { unsigned _sp = 0; while (cond) { __builtin_amdgcn_s_sleep(1); \
    if ((++_sp & 255u) == 0u) { if (xb_ld(&(bar)[XB_TMO])) break; if (_sp > XB_SPIN_CAP) { atomicAdd(&(bar)[XB_TMO], 1u); break; } } } } while (0)

struct XcdBarrier {
    unsigned* bar; unsigned x;
    volatile LAS unsigned* st;
};

__device__ __forceinline__ XcdBarrier xcd_barrier_post(unsigned* bar, volatile LAS unsigned* st) {
    XcdBarrier b; b.bar = bar; b.x = xb_xcc_id(); b.st = st;
    if (threadIdx.x == 0) (void)xb_add(&bar[XB_XCNT(b.x)], 1u);
    return b;
}
__device__ __forceinline__ void xcd_barrier_complete(unsigned* bar, unsigned x, unsigned& nloc, unsigned& nx) {
    const unsigned G = gridDim.x * gridDim.y * gridDim.z;
    unsigned sum, cnt, mine, sp = 0u;
    for (;;) {
        sum = 0u; cnt = 0u; mine = 0u;
#pragma unroll
        for (unsigned j = 0; j < 16; ++j) { const unsigned c = xb_ld(&bar[XB_XCNT(j)]); sum += c; cnt += (c > 0u) ? 1u : 0u; mine = (j == x) ? c : mine; }
        if (sum == G) break;
        __builtin_amdgcn_s_sleep(1);
        if ((++sp & 255u) == 0u) { if (xb_ld(&bar[XB_TMO])) break; if (sp > XB_SPIN_CAP) { atomicAdd(&bar[XB_TMO], 1u); break; } }
    }
    nloc = mine > 0u ? mine : 1u; nx = cnt > 0u ? cnt : 1u;
}

__device__ __forceinline__ void xcd_barrier(const XcdBarrier& b) {
    asm volatile("s_waitcnt vmcnt(0)" ::: "memory");
    __syncthreads();
    if (threadIdx.x == 0) {
        unsigned* bar = b.bar;
        __builtin_amdgcn_s_waitcnt(0);
        unsigned nloc = b.st[0], nx = b.st[1];
        if (nloc == 0u) { xcd_barrier_complete(bar, b.x, nloc, nx); b.st[0] = nloc; b.st[1] = nx; }
        const unsigned old = xb_add(&bar[XB_XSUB(b.x)], 1u);
        const unsigned gen = old / nloc;
        if (old + 1u == (gen + 1u) * nloc) {
            __builtin_amdgcn_fence(__ATOMIC_RELEASE, "agent");
            asm volatile("s_waitcnt vmcnt(0)" ::: "memory");
            const unsigned og = xb_add(&bar[XB_TOP], 1u);
            const unsigned tg = og / nx;
            if (og + 1u == (tg + 1u) * nx) xb_add(&bar[XB_TOPGEN], 1u);
            else XB_SPIN(xb_ld(&bar[XB_TOPGEN]) == tg, bar);
            __builtin_amdgcn_fence(__ATOMIC_ACQUIRE, "agent");
            xb_add(&bar[XB_XGEN(b.x)], 1u);
            asm volatile("s_waitcnt vmcnt(0)" ::: "memory");
        } else {
            XB_SPIN(xb_ld(&bar[XB_XGEN(b.x)]) == gen, bar);
            __builtin_amdgcn_fence(__ATOMIC_ACQUIRE, "agent");
            asm volatile("s_waitcnt vmcnt(0)" ::: "memory");
        }
    }
    __syncthreads();
}

__global__ void __launch_bounds__(512, 2) mega_fwd(Args a) {
    extern __shared__ __attribute__((aligned(16))) unsigned char lds_raw[];
    LAS unsigned char* lds = (LAS unsigned char*)lds_raw;
    cg::grid_group grid = cg::this_grid();
    const int tid = threadIdx.x, lane = tid & 63, wave = __builtin_amdgcn_readfirstlane(tid >> 6);
    const int G = gridDim.x, bx = blockIdx.x;
    const int vcu = (G % 8 == 0) ? (bx % 8) * (G / 8) + bx / 8 : bx;
    const int gw = vcu * 8 + wave, ngw = G * 8;
    typedef const __attribute__((address_space(4))) Args* kargs_t;
    const kargs_t kap = (kargs_t)__builtin_amdgcn_kernarg_segment_ptr();
#define PHASE_ARGS() kargs_t ap = kap; asm volatile("" : "+s"(ap)); unsigned char* const ws = ap->ws; \
    float* const cosT = (float*)(ws + WS_ROPE); float* const sinT = cosT + S * 32; \
    bf16* const Hb = (bf16*)(ws + WS_H); bf16* const QKV = (bf16*)(ws + WS_QKV); bf16* const Yb = (bf16*)(ws + WS_Y); bf16* const ACT = (bf16*)(ws + WS_ACT); \
    float* const edge = (float*)(ws + WS_EDGE); float* const part = (float*)(ws + WS_PART); float* const rowsq = (float*)(ws + WS_ROWSQ); \
    (void)cosT; (void)sinT; (void)Hb; (void)QKV; (void)Yb; (void)ACT; (void)edge; (void)part; (void)rowsq
    volatile LAS unsigned* misc = (volatile LAS unsigned*)(lds + MISC_OFF);
    if (tid < 16) misc[tid] = 0u;
    __syncthreads();

#define CONVERT_WEIGHTS(L, wv, nwv) do { \
        int lane = threadIdx.x & 63; asm volatile("" : "+v"(lane)); \
        LAS float* scr = (LAS float*)(lds + wave * 16384); \
        constexpr int I_IN = 16 * 72, I_OUT = 16 * 32, I_UP = 16 * 176, I_DOWN = 44 * 32, I_L = I_IN + I_OUT + I_UP + I_DOWN; \
        unsigned char* wl_ = ws + WS_W + (size_t)(L) * W_LAYER; \
        for (int it = (wv); it < I_L; it += (nwv)) { \
            int r = it; \
            if (r < I_IN) { const int kb = r / 72, nb = r % 72; const int pn = nb >> 3, wc = (nb >> 1) & 3, bj = nb & 1; \
                transpose_item(ap->w_in + (size_t)(L) * D * NIN, D, NIN, (bf16*)(wl_ + W_IN), scr, kb, nb, 8 * pn + 4 * bj + wc, lane, ap->g_attn + (L) * D); continue; } \
            r -= I_IN; \
            if (r < I_OUT) { const int kb = r / 32, nb = r % 32; transpose_item(ap->w_out + (size_t)(L) * D * D, D, D, (bf16*)(wl_ + W_OUT), scr, kb, nb, nb, lane, nullptr); continue; } \
            r -= I_OUT; \
            if (r < I_UP) { const int kb = r / 176, nb = r % 176; const int isv = nb >= 88, nn = isv ? nb - 88 : nb; const int dnb = 8 * (nn >> 2) + 4 * isv + (nn & 3); \
                transpose_item(ap->w_up + (size_t)(L) * D * NUP, D, NUP, (bf16*)(wl_ + W_UP), scr, kb, nb, dnb, lane, ap->g_ffn + (L) * D); continue; } \
            r -= I_UP; \
            { const int kb = r / 32, nb = r % 32; transpose_item(ap->w_down + (size_t)(L) * FF * D, FF, D, (bf16*)(wl_ + W_DOWN), scr, kb, nb, nb, lane, nullptr); } \
        } } while (0)
    {
        PHASE_ARGS();
        CONVERT_WEIGHTS(0, gw, ngw);
        for (int i = vcu * 512 + tid; i < S * 32; i += G * 512) {
            const int pos = i >> 5, j = i & 31;
            double inv = 1.0; for (int k = 0; k < j; ++k) inv *= 0.74989420933245582730;
            const double ang = (double)pos * inv;
            const double kq = __builtin_rint(ang * 0.15915494309189533577);
            const double rr = (ang - kq * 6.283185307179586232) - kq * 2.4492935982947064e-16;
            const double r2 = rr * rr;
            double sn = 1.0, cs = 1.0;
#pragma unroll
            for (int k = 12; k >= 1; --k) { sn = 1.0 - sn * r2 * (1.0 / (double)((2 * k) * (2 * k + 1))); cs = 1.0 - cs * r2 * (1.0 / (double)((2 * k - 1) * (2 * k))); }
            cosT[i] = (float)cs; sinT[i] = (float)(sn * rr);
        }
        for (int i = vcu * 512 + tid; i < (int)(CTL_BYTES / 16); i += G * 512) { const size_t off = (size_t)i * 16;
            if (off < WS_ROWSQ || off >= WS_ROWSQ + (size_t)M * 4) *(u32x4*)(ws + WS_CTL + off) = (u32x4){0u, 0u, 0u, 0u}; }
        convert_rows(ap->x, Hb, rowsq, gw, ngw, lane);
    }
    asm volatile("s_waitcnt vmcnt(0)" ::: "memory");
    __syncthreads();
    if (tid == 0) { __builtin_amdgcn_fence(__ATOMIC_RELEASE, "agent"); asm volatile("s_waitcnt vmcnt(0)" ::: "memory"); }
    grid.sync();
    if (tid == 0) { __builtin_amdgcn_fence(__ATOMIC_ACQUIRE, "agent"); asm volatile("s_waitcnt vmcnt(0)" ::: "memory"); }
    __syncthreads();
    XcdBarrier xbar; { PHASE_ARGS(); xbar = xcd_barrier_post((unsigned*)(ws + WS_CTL) + 1024, misc); }

    for (int l = 0; l < DEPTH; ++l) {
        const float lambda_init = 0.8f - 0.6f * __expf(-0.3f * (float)l);
        {
            PHASE_ARGS(); unsigned char* const wl = ws + WS_W + (size_t)l * W_LAYER; (void)wl;
            pg8::Gemm g{Hb, (const bf16*)(wl + W_IN), M, NIN, D}; pg8::StaticOrder So; So.init(M, NIN, G, bx);
            EpiInProj E{QKV, ap->qn_a + l * 64, ap->kn_a + l * 64, ap->qn_b + l * 64, ap->kn_b + l * 64, cosT, sinT, rowsq + (size_t)(2 * l) * M};
            pg8::gemm_phase<EpiInProj, pg8::StaticOrder, true, true>(lds, g, So, E);
            if (l == 0 && DEPTH > 1) {
                const int nidle = G - 64;
                if (nidle >= 64) { if (bx >= 64) CONVERT_WEIGHTS(1, (bx - 64) * 8 + wave, nidle * 8); }
                else CONVERT_WEIGHTS(1, gw, ngw);
            }
        }
        xcd_barrier(xbar);
        {
            PHASE_ARGS(); unsigned char* const wl = ws + WS_W + (size_t)l * W_LAYER; (void)wl;
            int lane = threadIdx.x & 63; asm volatile("" : "+v"(lane));
            const float mqa = wave_max(fabsf(ap->qn_a[l * 64 + lane])), mka = wave_max(fabsf(ap->kn_a[l * 64 + lane]));
            const float mqb = wave_max(fabsf(ap->qn_b[l * 64 + lane])), mkb = wave_max(fabsf(ap->kn_b[l * 64 + lane]));
            const float MbA = uniform_f(8.f * mqa * mka * LOG2E * 1.02f), MbB = uniform_f(8.f * mqb * mkb * LOG2E * 1.02f);
            const float s1 = wave_sum(ap->lq1[l * 64 + lane] * ap->lk1[l * 64 + lane]), s2 = wave_sum(ap->lq2[l * 64 + lane] * ap->lk2[l * 64 + lane]);
            const float lam = uniform_f(__expf(s1) - __expf(s2) + lambda_init);
            {
            for (int uidx = vcu; uidx < NB * 4 * 16; uidx += G) {
                const int bh = uidx >> 4, qb = uidx & 15;
                att::diff_unit((LAS char*)lds, QKV, Yb, bh >> 2, bh & 3, qb, MbB, lam, ap->subln + l * 128, 1.f - lambda_init);
            }
            for (int uidx = vcu; uidx < NB * 2 * 16; uidx += G) {
                const int bk = uidx >> 4, n = uidx & 15;
                att::swa_unit((LAS char*)lds, QKV, Yb, bk >> 1, bk & 1, n, MbA, ap->sink + l * 8);
            }
            __syncthreads();
            }
        }
        xcd_barrier(xbar);
        {
            PHASE_ARGS(); unsigned char* const wl = ws + WS_W + (size_t)l * W_LAYER; (void)wl;
            pg8::Gemm g{Yb, (const bf16*)(wl + W_OUT), M, D, D}; pg8::StaticOrder So; So.init(M, D, G, bx);
            EpiResid E{Hb, rowsq + (size_t)(2 * l + 1) * M, nullptr};
            pg8::gemm_phase<EpiResid, pg8::StaticOrder, true, true>(lds, g, So, E);
        }
        xcd_barrier(xbar);
        {
            PHASE_ARGS(); unsigned char* const wl = ws + WS_W + (size_t)l * W_LAYER; (void)wl;
            pg8::Gemm g{Hb, (const bf16*)(wl + W_UP), M, NUP, D}; pg8::StaticOrder So; So.init(M, NUP, G, bx);
            EpiUpConv E{ACT, ap->conv_w + (size_t)l * 3 * FF, ap->conv_b + (size_t)l * FF, edge, part, (LAS float*)(lds + XL_OFF), rowsq + (size_t)(2 * l + 1) * M};
            pg8::gemm_phase<EpiUpConv, pg8::StaticOrder, true, true>(lds, g, So, E);
        }
        xcd_barrier(xbar);
        {
            PHASE_ARGS(); unsigned char* const wl = ws + WS_W + (size_t)l * W_LAYER; (void)wl;
            pg8::Gemm g{ACT, (const bf16*)(wl + W_DOWN), M, D, FF}; pg8::StaticOrder So; So.init(M, D, G, bx);
            { const float* cw = ap->conv_w + (size_t)l * 3 * FF; pg8::Unit uu; int tid = threadIdx.x; asm volatile("" : "+v"(tid));
              for (int ui = 0; So.next(ui, uu); ++ui) { const int pm = uu.pm;
                for (int i = tid; i < 2 * FF; i += 512) { const int which = i / FF, ch = i % FF;
                    if (which == 0 && (pm & 7) != 0) { const float* pp = part + (((size_t)pm * 2 + 0) * FF + ch) * 2;
                        const float pre = pp[0] + cw[ch] * edge[((size_t)(pm - 1) * 2 + 1) * FF + ch];
                        ACT[(size_t)(pm * 256) * FF + ch] = (bf16)f2bf(silu_f(pre) * pp[1]); }
                    if (which == 1 && (pm & 7) != 7) { const float* pp = part + (((size_t)pm * 2 + 1) * FF + ch) * 2;
                        const float pre = pp[0] + cw[2 * FF + ch] * edge[((size_t)(pm + 1) * 2 + 0) * FF + ch];
                        ACT[(size_t)(pm * 256 + 255) * FF + ch] = (bf16)f2bf(silu_f(pre) * pp[1]); } } }
              asm volatile("s_waitcnt vmcnt(0)" ::: "memory"); __syncthreads(); }
            const bool lastl = (l + 1 == DEPTH);
            EpiResid E{Hb, lastl ? nullptr : rowsq + (size_t)(2 * l + 2) * M, lastl ? ap->out : nullptr};
            pg8::gemm_phase<EpiResid, pg8::StaticOrder, true, true>(lds, g, So, E);
        }
        if (l + 1 < DEPTH) xcd_barrier(xbar);
    }
}

extern "C" void kernel_launch(void* const* d_in, const int* in_sizes, int n_in, void* d_out, int out_size, void* d_ws, size_t ws_size, hipStream_t stream) {
    static int grid = 0;
    if (grid == 0) {
        if (n_in != 19 || ws_size < WS_END) { fprintf(stderr, "kernel_launch: unexpected inputs (n_in %d, ws %zu)\n", n_in, ws_size); grid = -1; return; }
        int dev = 0, cus = 0, per_cu = 0;
        hipGetDevice(&dev);
        hipDeviceGetAttribute(&cus, hipDeviceAttributeMultiprocessorCount, dev);
        hipFuncSetAttribute((const void*)mega_fwd, hipFuncAttributeMaxDynamicSharedMemorySize, LDS_BYTES);
        hipOccupancyMaxActiveBlocksPerMultiprocessor(&per_cu, (const void*)mega_fwd, 512, LDS_BYTES);
        if (per_cu < 1) { fprintf(stderr, "kernel_launch: occupancy query reports %d blocks per CU\n", per_cu); per_cu = 1; }
        grid = cus;
        (void)hipGetLastError();
    }
    if (grid < 0) return;
    Args a{};
    const float** p = (const float**)&a;
    for (int i = 0; i < 19; ++i) p[i] = (const float*)d_in[i];
    a.out = (float*)d_out; a.ws = (unsigned char*)d_ws;
    void* args[] = {&a};
    hipError_t e = hipLaunchCooperativeKernel((const void*)mega_fwd, dim3(grid), dim3(512), args, LDS_BYTES, stream);
    if (e != hipSuccess) fprintf(stderr, "cooperative launch failed: %s (grid %d)\n", hipGetErrorString(e), grid);
}
```

```cpp
#include <hip/hip_runtime.h>
#include <hip/hip_cooperative_groups.h>
#include <cstdio>
#include <cstdint>
namespace cg = cooperative_groups;
namespace pg8 {
#define PG8_LAS __attribute__((address_space(3)))
typedef unsigned short bf16_t;
typedef short bf16x8 __attribute__((ext_vector_type(8)));
typedef float f32x4 __attribute__((ext_vector_type(4)));
typedef unsigned u32x4 __attribute__((ext_vector_type(4)));
constexpr int BM = 256, BK = 64, HALF = 128, HTB = HALF * BK * 2  , STAGE_BYTES = 8 * HTB, NXCD = 8, WGM = 4;

__host__ __device__ __forceinline__ int lds_byte(int r, int c) { const int st = (r >> 4) * 2 + (c >> 5), rr = r & 15, cc = c & 31, ob = rr * 64 + cc * 2; return st * 1024 + (ob ^ (((ob >> 9) & 1) << 5)); }
__host__ __device__ __forceinline__ void stage_rc(int b, int& R, int& C) { const int st = b / 1024, sb = b % 1024, swz = sb ^ (((sb >> 9) & 1) << 5); R = (st >> 1) * 16 + swz / 64; C = (st & 1) * 32 + (swz % 64) / 2; }
__host__ __device__ __forceinline__ int perm32(int rho) { const int n = rho >> 4, i = rho & 15; return 8 * (i >> 2) + 4 * n + (i & 3); }

struct Unit { int pm, pn; };
struct Gemm { const bf16_t* A; const bf16_t* Bt; int M, N, K; };

struct StaticOrder {
    int nM, nN, nwg, G, c;
    __host__ __device__ void init(int M, int N, int G_, int c_) { nM = M / BM; nN = N / BM; nwg = nM * nN; G = G_; c = c_; }
    __host__ __device__ bool next(int i, Unit& u) const {
        const long L = (long)i * G + c; if (L >= nwg) return false;
        int wgid = (int)L; { const int q = nwg / NXCD, r = nwg % NXCD, xcd = wgid % NXCD, off = wgid / NXCD; wgid = (xcd < r ? xcd * (q + 1) : r * (q + 1) + (xcd - r) * q) + off; }
        const int nig = WGM * nN, gid = wgid / nig, fm = gid * WGM, gsz = (nM - fm) < WGM ? (nM - fm) : WGM;
        u.pm = fm + ((wgid % nig) % gsz); u.pn = (wgid % nig) / gsz; return true;
    }
    __device__ __forceinline__ void a_ready(const Unit&) const {}
    __device__ __forceinline__ void done(const Unit&) const {}
};

__device__ __forceinline__ unsigned cvt_pk_bf16(float lo, float hi) { unsigned r; asm volatile("v_cvt_pk_bf16_f32 %0, %1, %2" : "=v"(r) : "v"(lo), "v"(hi)); return r; }
template <class Epi, class Sched, bool ALIGN_EPI = false, bool SP2 = false>
__device__ __forceinline__ void gemm_phase(PG8_LAS unsigned char* lds, const Gemm g, const Sched& S, const Epi& E) {
    int tid = threadIdx.x; asm volatile("" : "+v"(tid)); const int wid = __builtin_amdgcn_readfirstlane(tid >> 6), lane = tid & 63, wr = wid >> 2, wc = wid & 3, fr = lane & 15, fq = lane >> 4;
    const int K = g.K, nt = K / BK;
    unsigned voffA[2], voffB[2];
#pragma unroll
    for (int i = 0; i < 2; ++i) { int R, C; stage_rc(tid * 16 + i * 8192, R, C); const int Rb = Epi::PERM ? ((R & ~31) + perm32(R & 31)) : R;
        voffA[i] = (unsigned)(R * K + C) * 2u; voffB[i] = (unsigned)(Rb * K + C) * 2u; }
    const size_t kstep = (size_t)(BK * 2);
    const size_t hstep = (size_t)HALF * K * 2;
    const size_t tstep = 2 * hstep;
    const unsigned ldsw = (unsigned)wid * 1024u;
    const int aoff = lds_byte(wr * 64 + fr, fq * 8), boff = lds_byte(wc * 32 + fr, fq * 8);
#define PG8_SA(b, h) (((b) * 2 + (h)) * HTB)
#define PG8_SB(b, h) ((4 + (b) * 2 + (h)) * HTB)
#define PG8_STAGE(bufoff, gbase, voff) do { _Pragma("unroll") for (int _i = 0; _i < 2; ++_i) \
        __builtin_amdgcn_global_load_lds((const unsigned*)((const char*)(gbase) + (voff)[_i]), (PG8_LAS unsigned*)(lds + (bufoff) + ldsw + _i * 8192), 16, 0, 0); } while (0)
#define PG8_LDA(dst, b, h) do { _Pragma("unroll") for (int m = 0; m < 4; ++m) _Pragma("unroll") for (int k = 0; k < 2; ++k) dst[m][k] = *(const PG8_LAS bf16x8*)(lds + PG8_SA(b, h) + aoff + m * 2048 + k * 1024); } while (0)
#define PG8_LDB(dst, b, h) do { _Pragma("unroll") for (int n = 0; n < 2; ++n) _Pragma("unroll") for (int k = 0; k < 2; ++k) dst[n][k] = *(const PG8_LAS bf16x8*)(lds + PG8_SB(b, h) + boff + n * 2048 + k * 1024); } while (0)
#define PG8_MMA(ai, bj, At, Bt) do { __builtin_amdgcn_s_setprio(1); _Pragma("unroll") for (int m = 0; m < 4; ++m) _Pragma("unroll") for (int n = 0; n < 2; ++n) _Pragma("unroll") for (int k = 0; k < 2; ++k) \
        acc[ai][bj][m][n] = __builtin_amdgcn_mfma_f32_16x16x32_bf16(Bt[n][k], At[m][k], acc[ai][bj][m][n], 0, 0, 0); __builtin_amdgcn_s_setprio(0); } while (0)
#define PG8_WAIT_V(n) asm volatile("s_waitcnt vmcnt(" #n ")" ::: "memory")
#define PG8_WAIT_L(n) asm volatile("s_waitcnt lgkmcnt(" #n ")" ::: "memory")
#define PG8_BAR __builtin_amdgcn_s_barrier()
#define PG8_SCHED __builtin_amdgcn_sched_barrier(0)
    Unit cur, nxt; int ui = 0;
    if (!S.next(0, cur)) return;
    f32x4 acc[2][2][4][2];
#pragma unroll
    for (int a = 0; a < 2; ++a)
#pragma unroll
        for (int b = 0; b < 2; ++b)
#pragma unroll
            for (int m = 0; m < 4; ++m)
#pragma unroll
                for (int n = 0; n < 2; ++n) acc[a][b][m][n] = (f32x4){0.f, 0.f, 0.f, 0.f};
    bf16x8 At[4][2], B0[2][2], B1[2][2];
    const char* cA = (const char*)g.A + (size_t)cur.pm * tstep; const char* cB = (const char*)g.Bt + (size_t)cur.pn * tstep;
    S.a_ready(cur);
    if constexpr (SP2) {
        PG8_STAGE(PG8_SB(0, 0), cB, voffB); PG8_STAGE(PG8_SB(0, 1), cB + hstep, voffB); PG8_STAGE(PG8_SA(0, 0), cA, voffA); PG8_STAGE(PG8_SA(0, 1), cA + hstep, voffA);
        if (wr == 1) PG8_BAR;
        PG8_WAIT_V(2); PG8_BAR;
        PG8_STAGE(PG8_SB(1, 0), cB + kstep, voffB); PG8_STAGE(PG8_SA(1, 0), cA + kstep, voffA); PG8_STAGE(PG8_SB(1, 1), cB + hstep + kstep, voffB);
        PG8_WAIT_V(6); PG8_BAR;
    } else {
        PG8_STAGE(PG8_SB(0, 0), cB, voffB); PG8_STAGE(PG8_SA(0, 0), cA, voffA); PG8_STAGE(PG8_SB(0, 1), cB + hstep, voffB); PG8_STAGE(PG8_SA(0, 1), cA + hstep, voffA);
        if (wr == 1) PG8_BAR;
        PG8_WAIT_V(4); PG8_BAR;
        PG8_STAGE(PG8_SB(1, 0), cB + kstep, voffB); PG8_STAGE(PG8_SA(1, 0), cA + kstep, voffA); PG8_STAGE(PG8_SB(1, 1), cB + hstep + kstep, voffB);
        PG8_WAIT_V(6); PG8_BAR;
    }
    for (;;) {
        const bool has_next = S.next(ui + 1, nxt);
        const char* nA = has_next ? (const char*)g.A + (size_t)nxt.pm * tstep : cA; const char* nB = has_next ? (const char*)g.Bt + (size_t)nxt.pn * tstep : cB;
        for (int t = 0; t < nt; t += 2) {
            const bool last = (t == nt - 2);
            const char* a1 = cA + (size_t)(t + 1) * kstep;
            const char* a2 = last ? nA : cA + (size_t)(t + 2) * kstep; const char* b2 = last ? nB : cB + (size_t)(t + 2) * kstep;
            const char* a3 = a2 + kstep; const char* b3 = b2 + kstep;
            if (last && has_next) S.a_ready(nxt);
            if constexpr (SP2) {
            PG8_LDB(B0, 0, 0); PG8_LDB(B1, 0, 1); PG8_SCHED; PG8_LDA(At, 0, 0); PG8_STAGE(PG8_SA(1, 1), a1 + hstep, voffA);
            PG8_WAIT_V(8); PG8_WAIT_L(0); PG8_BAR; PG8_MMA(0, 0, At, B0); PG8_MMA(0, 1, At, B1); PG8_BAR; PG8_SCHED;
            PG8_LDA(At, 0, 1); PG8_STAGE(PG8_SB(0, 0), b2, voffB); PG8_STAGE(PG8_SB(0, 1), b2 + hstep, voffB); PG8_STAGE(PG8_SA(0, 0), a2, voffA);
            PG8_WAIT_V(8); PG8_WAIT_L(0); PG8_BAR; PG8_MMA(1, 0, At, B0); PG8_MMA(1, 1, At, B1); PG8_BAR; PG8_SCHED;
            PG8_LDB(B0, 1, 0); PG8_LDB(B1, 1, 1); PG8_SCHED; PG8_LDA(At, 1, 0); PG8_STAGE(PG8_SA(0, 1), a2 + hstep, voffA);
            PG8_WAIT_V(8); PG8_WAIT_L(0); PG8_BAR; PG8_MMA(0, 0, At, B0); PG8_MMA(0, 1, At, B1); PG8_BAR; PG8_SCHED;
            PG8_LDA(At, 1, 1); PG8_STAGE(PG8_SB(1, 0), b3, voffB); PG8_STAGE(PG8_SB(1, 1), b3 + hstep, voffB); PG8_STAGE(PG8_SA(1, 0), a3, voffA);
            PG8_WAIT_V(8); PG8_WAIT_L(0); PG8_BAR; PG8_MMA(1, 0, At, B0); PG8_MMA(1, 1, At, B1); PG8_BAR; PG8_SCHED;
            } else {
            PG8_LDB(B0, 0, 0); PG8_SCHED; PG8_LDA(At, 0, 0); PG8_STAGE(PG8_SA(1, 1), a1 + hstep, voffA);
            PG8_WAIT_L(8); PG8_BAR; PG8_WAIT_L(0); PG8_MMA(0, 0, At, B0); PG8_BAR; PG8_SCHED;
            PG8_LDB(B1, 0, 1); PG8_STAGE(PG8_SB(0, 0), b2, voffB);
            PG8_BAR; PG8_WAIT_L(0); PG8_MMA(0, 1, At, B1); PG8_BAR;
            PG8_LDA(At, 0, 1); PG8_STAGE(PG8_SA(0, 0), a2, voffA);
            PG8_BAR; PG8_WAIT_L(0); PG8_MMA(1, 0, At, B0); PG8_BAR; PG8_SCHED;
            PG8_STAGE(PG8_SB(0, 1), b2 + hstep, voffB);
            PG8_WAIT_V(6); PG8_BAR; PG8_MMA(1, 1, At, B1); PG8_BAR;
            PG8_LDB(B0, 1, 0); PG8_SCHED; PG8_LDA(At, 1, 0); PG8_STAGE(PG8_SA(0, 1), a2 + hstep, voffA);
            PG8_WAIT_L(8); PG8_BAR; PG8_WAIT_L(0); PG8_MMA(0, 0, At, B0); PG8_BAR; PG8_SCHED;
            PG8_LDB(B1, 1, 1); PG8_STAGE(PG8_SB(1, 0), b3, voffB);
            PG8_BAR; PG8_WAIT_L(0); PG8_MMA(0, 1, At, B1); PG8_BAR;
            PG8_LDA(At, 1, 1); PG8_STAGE(PG8_SA(1, 0), a3, voffA);
            PG8_BAR; PG8_WAIT_L(0); PG8_MMA(1, 0, At, B0); PG8_BAR; PG8_SCHED;
            PG8_STAGE(PG8_SB(1, 1), b3 + hstep, voffB);
            PG8_WAIT_V(6); PG8_BAR; PG8_MMA(1, 1, At, B1); PG8_BAR;
            }
        }
        if constexpr (ALIGN_EPI) { if (wr == 0) PG8_BAR; }
        if constexpr (!Epi::AFTER_DRAIN) { E(acc, cur, wr, wc, fr, fq); S.done(cur); }
        if (!has_next) break;
#pragma unroll
        for (int a = 0; a < 2; ++a)
#pragma unroll
            for (int b = 0; b < 2; ++b)
#pragma unroll
                for (int m = 0; m < 4; ++m)
#pragma unroll
                    for (int n = 0; n < 2; ++n) acc[a][b][m][n] = (f32x4){0.f, 0.f, 0.f, 0.f};
        cur = nxt; cA = nA; cB = nB; ++ui;
        if constexpr (ALIGN_EPI) { if (wr == 1) PG8_BAR; }
    }
    PG8_WAIT_V(0);
    if constexpr (!ALIGN_EPI) { if (wr == 0) PG8_BAR; }
    PG8_BAR;
    if constexpr (Epi::AFTER_DRAIN) { E.fused(acc, cur, wr, wc, fr, fq, lds, wid, lane); S.done(cur); }
#undef PG8_SA
#undef PG8_SB
#undef PG8_STAGE
#undef PG8_LDA
#undef PG8_LDB
#undef PG8_MMA
#undef PG8_WAIT_V
#undef PG8_WAIT_L
#undef PG8_BAR
#undef PG8_SCHED
}
}
#define LAS __attribute__((address_space(3)))
typedef unsigned short bf16;
using pg8::f32x4; using pg8::u32x4; using pg8::Unit; using pg8::cvt_pk_bf16; using pg8::bf16x8;
typedef unsigned u32x2 __attribute__((ext_vector_type(2)));

constexpr int NB = 8, S = 2048, D = 1024, M = NB * S, NIN = 2304, FF = 2816, NUP = 2 * FF, DEPTH = 2;
constexpr float EPS = 1e-6f;
constexpr float LOG2E = 1.4426950408889634f;
constexpr float QSCALE = 0.125f * LOG2E;
constexpr int XL_OFF = 131072;
constexpr int LDS_BYTES = 131072 + 8192;

__device__ __forceinline__ float dot4(f32x4 a) { return (a[0] * a[0] + a[1] * a[1]) + (a[2] * a[2] + a[3] * a[3]); }
__device__ __forceinline__ float silu_f(float v) { return v * __builtin_amdgcn_rcpf(1.f + __expf(-v)); }

struct EpiInProj {
    static constexpr bool PERM = true, AFTER_DRAIN = false;
    bf16* O; const float* qn_a; const float* kn_a; const float* qn_b; const float* kn_b; const float* cosT; const float* sinT; const float* rowsq;
    __device__ __forceinline__ void operator()(const f32x4 (&acc)[2][2][4][2], const Unit& u, int wr, int wc, int fr, int fq) const {
        asm volatile("" : "+v"(fr), "+v"(fq));
        const int pn = u.pn;
        const float* g = nullptr; float sc = 1.f;
        if (pn < 2) { g = qn_a; sc = QSCALE; }
        else if (pn == 2) { if (wc < 2) g = kn_a; }
        else if (pn < 5) { g = qn_b; sc = QSCALE; }
        else if (pn < 7) { g = kn_b; }
        const int colb = pn * 256 + wc * 64 + 8 * fq;
        const int row0 = u.pm * 256 + wr * 64 + fr;
        if (g) {
            f32x4 g1[2], g2[2];
#pragma unroll
            for (int n = 0; n < 2; ++n) { g1[n] = *(const f32x4*)(g + 8 * fq + 4 * n); g2[n] = *(const f32x4*)(g + 32 + 8 * fq + 4 * n); }
#pragma unroll
            for (int ai = 0; ai < 2; ++ai)
#pragma unroll
                for (int m = 0; m < 4; ++m) {
                    const int row = row0 + ai * 128 + m * 16;
                    const f32x4 a0 = acc[ai][0][m][0], a1 = acc[ai][0][m][1], b0 = acc[ai][1][m][0], b1 = acc[ai][1][m][1];
                    float ss = (dot4(a0) + dot4(a1)) + (dot4(b0) + dot4(b1));
                    ss += __shfl_xor(ss, 16); ss += __shfl_xor(ss, 32);
                    const float rx = rsqrtf(rowsq[row] * (1.f / D) + EPS);
                    const float rs = rsqrtf(ss * rx * rx * (1.f / 64.f) + EPS) * rx * sc;
                    const size_t ro = (size_t)(row & (S - 1)) * 32 + 8 * fq;
                    const f32x4 c0 = *(const f32x4*)(cosT + ro), c1 = *(const f32x4*)(cosT + ro + 4), s0 = *(const f32x4*)(sinT + ro), s1 = *(const f32x4*)(sinT + ro + 4);
                    const f32x4 y10 = a0 * rs * g1[0], y11 = a1 * rs * g1[1], y20 = b0 * rs * g2[0], y21 = b1 * rs * g2[1];
                    const f32x4 o10 = y10 * c0 - y20 * s0, o11 = y11 * c1 - y21 * s1, o20 = y20 * c0 + y10 * s0, o21 = y21 * c1 + y11 * s1;
                    u32x4 w1, w2;
                    w1.x = cvt_pk_bf16(o10[0], o10[1]); w1.y = cvt_pk_bf16(o10[2], o10[3]); w1.z = cvt_pk_bf16(o11[0], o11[1]); w1.w = cvt_pk_bf16(o11[2], o11[3]);
                    w2.x = cvt_pk_bf16(o20[0], o20[1]); w2.y = cvt_pk_bf16(o20[2], o20[3]); w2.z = cvt_pk_bf16(o21[0], o21[1]); w2.w = cvt_pk_bf16(o21[2], o21[3]);
                    bf16* op = O + (size_t)row * NIN + colb;
                    *(u32x4*)op = w1; *(u32x4*)(op + 32) = w2;
                }
        } else {
#pragma unroll
            for (int ai = 0; ai < 2; ++ai)
#pragma unroll
                for (int m = 0; m < 4; ++m) {
                    const int row = row0 + ai * 128 + m * 16;
                    bf16* op = O + (size_t)row * NIN + colb;
                    const float rx = rsqrtf(rowsq[row] * (1.f / D) + EPS);
#pragma unroll
                    for (int bj = 0; bj < 2; ++bj) { const f32x4 v0 = acc[ai][bj][m][0] * rx, v1 = acc[ai][bj][m][1] * rx; u32x4 w;
                        w.x = cvt_pk_bf16(v0[0], v0[1]); w.y = cvt_pk_bf16(v0[2], v0[3]); w.z = cvt_pk_bf16(v1[0], v1[1]); w.w = cvt_pk_bf16(v1[2], v1[3]);
                        *(u32x4*)(op + 32 * bj) = w; }
                }
        }
    }
};

__device__ __forceinline__ f32x4 bf2f_lo(unsigned a, unsigned b) { return (f32x4){__uint_as_float(a << 16), __uint_as_float(a & 0xffff0000u), __uint_as_float(b << 16), __uint_as_float(b & 0xffff0000u)}; }
struct EpiResid {
    static constexpr bool PERM = true, AFTER_DRAIN = false;
    bf16* XB; float* rowsq; float* outf;
    __device__ __forceinline__ void operator()(const f32x4 (&acc)[2][2][4][2], const Unit& u, int wr, int wc, int fr, int fq) const {
        asm volatile("" : "+v"(fr), "+v"(fq));
        const int col0 = u.pn * 256 + wc * 32 + 8 * fq, row0 = u.pm * 256 + wr * 64 + fr;
#pragma unroll
        for (int ai = 0; ai < 2; ++ai) {
            u32x4 xr[4][2];
#pragma unroll
            for (int m = 0; m < 4; ++m) { const size_t off = (size_t)(row0 + ai * 128 + m * 16) * D + col0;
#pragma unroll
                for (int bj = 0; bj < 2; ++bj) xr[m][bj] = *(const u32x4*)(XB + off + bj * 128); }
            asm volatile("" ::: "memory");
#pragma unroll
            for (int m = 0; m < 4; ++m) { const int row = row0 + ai * 128 + m * 16; const size_t off = (size_t)row * D + col0; float ss = 0.f;
#pragma unroll
                for (int bj = 0; bj < 2; ++bj) {
                    const f32x4 y0 = bf2f_lo(xr[m][bj].x, xr[m][bj].y) + acc[ai][bj][m][0], y1 = bf2f_lo(xr[m][bj].z, xr[m][bj].w) + acc[ai][bj][m][1];
                    ss += dot4(y0) + dot4(y1);
                    if (outf) { __builtin_nontemporal_store(y0, (f32x4*)(outf + off + bj * 128)); __builtin_nontemporal_store(y1, (f32x4*)(outf + off + bj * 128 + 4)); }
                    else { u32x4 w; w.x = cvt_pk_bf16(y0[0], y0[1]); w.y = cvt_pk_bf16(y0[2], y0[3]); w.z = cvt_pk_bf16(y1[0], y1[1]); w.w = cvt_pk_bf16(y1[2], y1[3]); *(u32x4*)(XB + off + bj * 128) = w; }
                }
                if (rowsq) { ss += __shfl_xor(ss, 16); ss += __shfl_xor(ss, 32); if (fq == 0) atomicAdd(rowsq + row, ss); }
            }
            asm volatile("" ::: "memory");
        }
    }
};

struct EpiUpConv {
    static constexpr bool PERM = true, AFTER_DRAIN = false;
    bf16* ACT; const float* cw; const float* cb; float* edge; float* part; LAS float* xl; const float* rowsq;
    __device__ __forceinline__ void operator()(f32x4 (&acc)[2][2][4][2], const Unit& u, int wr, int wc, int fr, int fq) const {
        asm volatile("" : "+v"(fr), "+v"(fq));
        const int lane = 16 * fq + fr;
        const int cl0 = 32 * wc + 8 * fq, ch0 = 128 * u.pn + cl0;
#pragma unroll
        for (int ai = 0; ai < 2; ++ai)
#pragma unroll
            for (int m = 0; m < 4; ++m) { const float rx = rsqrtf(rowsq[u.pm * 256 + ai * 128 + wr * 64 + m * 16 + fr] * (1.f / D) + EPS);
#pragma unroll
                for (int bj = 0; bj < 2; ++bj) { acc[ai][bj][m][0] *= rx; acc[ai][bj][m][1] *= rx; } }
#pragma unroll
        for (int ai = 0; ai < 2; ++ai) {
            const int chunk = 2 * ai + wr;
            if (fr == 0) { *(LAS f32x4*)(xl + (chunk * 2 + 0) * 128 + cl0) = acc[ai][0][0][0]; *(LAS f32x4*)(xl + (chunk * 2 + 0) * 128 + cl0 + 4) = acc[ai][0][0][1]; }
            if (fr == 15) { *(LAS f32x4*)(xl + (chunk * 2 + 1) * 128 + cl0) = acc[ai][0][3][0]; *(LAS f32x4*)(xl + (chunk * 2 + 1) * 128 + cl0 + 4) = acc[ai][0][3][1]; }
        }
        asm volatile("s_waitcnt lgkmcnt(0)" ::: "memory"); __builtin_amdgcn_s_barrier(); asm volatile("" ::: "memory");
        const int lup = (lane & ~15) | ((fr + 15) & 15), ldn = (lane & ~15) | ((fr + 1) & 15);
        const bool seq_first = (u.pm & 7) == 0, seq_last = (u.pm & 7) == 7;
#pragma unroll
        for (int ai = 0; ai < 2; ++ai) {
            const int chunk = 2 * ai + wr;
#pragma unroll
            for (int n = 0; n < 2; ++n) {
                const int ch = ch0 + 4 * n;
                const f32x4 w0 = *(const f32x4*)(cw + ch), w1 = *(const f32x4*)(cw + FF + ch), w2 = *(const f32x4*)(cw + 2 * FF + ch), bb = *(const f32x4*)(cb + ch);
                const f32x4 above = (chunk > 0) ? *(const LAS f32x4*)(xl + ((chunk - 1) * 2 + 1) * 128 + cl0 + 4 * n) : (f32x4){0.f, 0.f, 0.f, 0.f};
                const f32x4 below = (chunk < 3) ? *(const LAS f32x4*)(xl + ((chunk + 1) * 2 + 0) * 128 + cl0 + 4 * n) : (f32x4){0.f, 0.f, 0.f, 0.f};
                f32x4 Rprev = above, Lcur;
#pragma unroll
                for (int e = 0; e < 4; ++e) Lcur[e] = __shfl(acc[ai][0][0][n][e], ldn);
#pragma unroll
                for (int m = 0; m < 4; ++m) {
                    const int rt = ai * 128 + wr * 64 + m * 16 + fr;
                    const size_t row = (size_t)u.pm * 256 + rt;
                    const f32x4 cur = acc[ai][0][m][n], val = acc[ai][1][m][n];
                    f32x4 Rm, Lnext = below;
#pragma unroll
                    for (int e = 0; e < 4; ++e) { Rm[e] = __shfl(cur[e], lup); if (m < 3) Lnext[e] = __shfl(acc[ai][0][m < 3 ? m + 1 : 3][n][e], ldn); }
                    const f32x4 up = (fr == 0) ? Rprev : Rm, dn = (fr == 15) ? Lnext : Lcur;
                    Rprev = Rm; Lcur = Lnext;
                    const f32x4 pre = bb + w0 * up + w1 * cur + w2 * dn;
                    f32x4 res;
#pragma unroll
                    for (int e = 0; e < 4; ++e) res[e] = silu_f(pre[e]) * val[e];
                    if (rt == 0) {
                        *(f32x4*)(edge + ((size_t)u.pm * 2 + 0) * FF + ch) = cur;
                        if (!seq_first) { float* pp = part + (((size_t)u.pm * 2 + 0) * FF + ch) * 2;
                            *(f32x4*)pp = (f32x4){pre[0], val[0], pre[1], val[1]}; *(f32x4*)(pp + 4) = (f32x4){pre[2], val[2], pre[3], val[3]}; }
                    }
                    if (rt == 255) {
                        *(f32x4*)(edge + ((size_t)u.pm * 2 + 1) * FF + ch) = cur;
                        if (!seq_last) { float* pp = part + (((size_t)u.pm * 2 + 1) * FF + ch) * 2;
                            *(f32x4*)pp = (f32x4){pre[0], val[0], pre[1], val[1]}; *(f32x4*)(pp + 4) = (f32x4){pre[2], val[2], pre[3], val[3]}; }
                    }
                    u32x2 w; w.x = cvt_pk_bf16(res[0], res[1]); w.y = cvt_pk_bf16(res[2], res[3]);
                    *(u32x2*)(ACT + row * FF + ch) = w;
                }
            }
        }
    }
};
namespace att {
typedef __attribute__((ext_vector_type(16))) float f32x16;
typedef __attribute__((ext_vector_type(4))) short s16x4;
typedef short v4i16_t __attribute__((ext_vector_type(4)));
typedef LAS const char* lptr;
__device__ __forceinline__ s16x4 vtr(lptr p) { return __builtin_bit_cast(s16x4, __builtin_amdgcn_ds_read_tr16_b64_v4i16((LAS v4i16_t*)p)); }
typedef float f32x2_t __attribute__((ext_vector_type(2))); typedef __bf16 bf16x2_t __attribute__((ext_vector_type(2)));
__device__ __forceinline__ unsigned cvtpk_s(float lo, float hi) { f32x2_t v = {lo, hi}; bf16x2_t b = __builtin_convertvector(v, bf16x2_t); return __builtin_bit_cast(unsigned, b); }
__device__ __forceinline__ bf16x8 pack8(const f32x16& s, int b) {
    u32x4 w; w.x = cvtpk_s(s[b], s[b + 1]); w.y = cvtpk_s(s[b + 2], s[b + 3]); w.z = cvtpk_s(s[b + 4], s[b + 5]); w.w = cvtpk_s(s[b + 6], s[b + 7]);
    return __builtin_bit_cast(bf16x8, w);
}
#define MFMA32(a, b, c) __builtin_amdgcn_mfma_f32_32x32x16_bf16((a), (b), (c), 0, 0, 0)

#define LGKM_WAIT(n) asm volatile("s_waitcnt lgkmcnt(" #n ")" ::: "memory")
#define SCHED_FENCE() __builtin_amdgcn_sched_barrier(0)
__device__ __forceinline__ bf16x8 rd128(unsigned addr, int off) { bf16x8 r; asm volatile("ds_read_b128 %0, %1 offset:%c2" : "=&v"(r) : "v"(addr), "i"(off) : "memory"); return r; }
__device__ __forceinline__ s16x4 rdtr(unsigned addr, int off) { s16x4 r; asm volatile("ds_read_b64_tr_b16 %0, %1 offset:%c2" : "=&v"(r) : "v"(addr), "i"(off) : "memory"); return r; }
#define VFRAG(lo, hh) ((bf16x8){lo[0], lo[1], lo[2], lo[3], hh[0], hh[1], hh[2], hh[3]})
constexpr int KROW = 144, VROWD = 320, VROWA = 192;
constexpr int DSTG = 2 * 64 * KROW + 64 * VROWD;
constexpr int ASTG = 64 * KROW + 64 * VROWA;

constexpr int DST3 = 32768;
#define SGB(mask, n) __builtin_amdgcn_sched_group_barrier((mask), (n), 0)
__device__ __forceinline__ void diff_unit(LAS char* lds, const bf16* __restrict__ QKV, bf16* __restrict__ Y, int b, int h, int qb, float Mb, float lam, const float* __restrict__ subln, float outscale) {
    int tid = threadIdx.x; asm volatile("" : "+v"(tid)); const int lane = tid & 63, w = __builtin_amdgcn_readfirstlane(tid >> 6), q = lane & 31, hi = lane >> 5;
    const int rg = w >> 1, c = w & 1;
    const size_t rowQ = (size_t)b * S + qb * 128 + rg * 32 + q;
    const bf16* qp = QKV + rowQ * NIN + 768 + (2 * h + c) * 64 + hi * 8;
    bf16x8 qf[4];
#pragma unroll
    for (int ds = 0; ds < 4; ++ds) qf[ds] = *(const bf16x8*)(qp + ds * 16);
    const int krow = 8 * w + (lane >> 3), kch = (lane & 7) ^ ((krow >> 1) & 7);
    const int vrow = 4 * w + (lane >> 4), vch = (lane & 15) ^ ((vrow & 3) << 2);
    const bf16* kg = QKV + ((size_t)b * S + krow) * NIN + 1280 + 128 * h + kch * 8;
    const bf16* vg = QKV + ((size_t)b * S + vrow) * NIN + 1792 + 128 * h + vch * 8;
#define DDMA(t, so) do { const size_t o_ = (size_t)(t) * 64 * NIN; LAS unsigned char* d_ = (LAS unsigned char*)lds + (so) + w * 1024; \
        __builtin_amdgcn_global_load_lds((const unsigned*)(kg + o_), (LAS unsigned*)(d_), 16, 0, 0); \
        __builtin_amdgcn_global_load_lds((const unsigned*)(kg + o_ + 64), (LAS unsigned*)(d_ + 8192), 16, 0, 0); \
        __builtin_amdgcn_global_load_lds((const unsigned*)(vg + o_), (LAS unsigned*)(d_ + 16384), 16, 0, 0); \
        __builtin_amdgcn_global_load_lds((const unsigned*)(vg + o_ + 32 * NIN), (LAS unsigned*)(d_ + 16384 + 8192), 16, 0, 0); } while (0)
    f32x16 o[4];
#pragma unroll
    for (int i = 0; i < 4; ++i) o[i] = (f32x16){0.f};
    float l = 0.f;
    constexpr int NT = S / 64;
    DDMA(0, 0); DDMA(1, DST3); DDMA(2, 2 * DST3);
    const unsigned lbase = (unsigned)(size_t)lds;
    unsigned kofs[4], vofs[4];
    { const int sw = (q >> 1) & 7, vq = (lane & 15) >> 2;
#pragma unroll
      for (int ds = 0; ds < 4; ++ds) kofs[ds] = (unsigned)(c * 8192 + q * 128 + (((2 * ds + hi) ^ sw) << 4));
#pragma unroll
      for (int db = 0; db < 4; ++db) vofs[db] = (unsigned)(16384 + (4 * hi + vq) * 256 + ((db ^ vq) << 6) + ((lane >> 4) & 1) * 32 + (lane & 3) * 8); }
    f32x16 negm;
#pragma unroll
    for (int r = 0; r < 16; ++r) negm[r] = -Mb;
    f32x16 s0, s1;
    { asm volatile("s_waitcnt vmcnt(8)" ::: "memory"); __builtin_amdgcn_s_barrier(); asm volatile("" ::: "memory");
      bf16x8 kf[8];
#pragma unroll
      for (int ds = 0; ds < 4; ++ds) { kf[2 * ds] = rd128(lbase + kofs[ds], 0); kf[2 * ds + 1] = rd128(lbase + kofs[ds], 32 * 128); }
      LGKM_WAIT(0); SCHED_FENCE();
      s0 = negm; s1 = negm;
#pragma unroll
      for (int ds = 0; ds < 4; ++ds) { s0 = MFMA32(kf[2 * ds], qf[ds], s0); s1 = MFMA32(kf[2 * ds + 1], qf[ds], s1); }
      SCHED_FENCE(); }
    int so_cur = 0, so_n1 = DST3, so_n3 = 3 * DST3;
    for (int t = 0; t < NT; ++t) {
        asm volatile("s_waitcnt vmcnt(4)" ::: "memory");
        __builtin_amdgcn_s_barrier();
        asm volatile("" ::: "memory");
        { const int tn = (t + 3 < NT) ? t + 3 : NT - 1; DDMA(tn, so_n3); }
        const unsigned sb = lbase + so_cur, sn = lbase + so_n1;
        bf16x8 kf[8];
#pragma unroll
        for (int ds = 0; ds < 4; ++ds) { kf[2 * ds] = rd128(sn + kofs[ds], 0); kf[2 * ds + 1] = rd128(sn + kofs[ds], 32 * 128); }
        s16x4 vl[2][4], vh[2][4];
#pragma unroll
        for (int db = 0; db < 4; ++db) { vl[0][db] = rdtr(sb + vofs[db], 0); vh[0][db] = rdtr(sb + vofs[db], 8 * 256); }
        LGKM_WAIT(0); SCHED_FENCE();
        __builtin_amdgcn_s_setprio(1);
        f32x16 n0 = negm, n1 = negm;
#pragma unroll
        for (int ds = 0; ds < 4; ++ds) { n0 = MFMA32(kf[2 * ds], qf[ds], n0); n1 = MFMA32(kf[2 * ds + 1], qf[ds], n1); }
        float ls = 0.f;
#pragma unroll
        for (int r = 0; r < 16; ++r) { s0[r] = __builtin_amdgcn_exp2f(s0[r]); ls += s0[r]; }
        bf16x8 pf[4]; pf[0] = pack8(s0, 0); pf[1] = pack8(s0, 8);
#pragma unroll
        for (int i = 0; i < 8; ++i) { SGB(0x008, 1); SGB(0x400, 2); SGB(0x002, 3); }
        SCHED_FENCE();
        __builtin_amdgcn_s_setprio(0);
#pragma unroll
        for (int db = 0; db < 4; ++db) { vl[1][db] = rdtr(sb + vofs[db], 16 * 256); vh[1][db] = rdtr(sb + vofs[db], 16 * 256 + 8 * 256); }
        s16x4 wl[2][4], wh[2][4];
#pragma unroll
        for (int ks = 0; ks < 2; ++ks)
#pragma unroll
            for (int db = 0; db < 4; ++db) { wl[ks][db] = rdtr(sb + vofs[db], (ks + 2) * 16 * 256); wh[ks][db] = rdtr(sb + vofs[db], (ks + 2) * 16 * 256 + 8 * 256); }
        LGKM_WAIT(15); SCHED_FENCE();
        __builtin_amdgcn_s_setprio(1);
#pragma unroll
        for (int ks = 0; ks < 2; ++ks)
#pragma unroll
            for (int db = 0; db < 4; ++db) o[db] = MFMA32(VFRAG(vl[ks][db], vh[ks][db]), pf[ks], o[db]);
#pragma unroll
        for (int r = 0; r < 16; ++r) { s1[r] = __builtin_amdgcn_exp2f(s1[r]); ls += s1[r]; }
        l += ls;
        pf[2] = pack8(s1, 0); pf[3] = pack8(s1, 8);
#pragma unroll
        for (int i = 0; i < 8; ++i) { SGB(0x008, 1); SGB(0x400, 2); SGB(0x002, 3); }
        SCHED_FENCE();
        LGKM_WAIT(0); SCHED_FENCE();
#pragma unroll
        for (int ks = 0; ks < 2; ++ks)
#pragma unroll
            for (int db = 0; db < 4; ++db) o[db] = MFMA32(VFRAG(wl[ks][db], wh[ks][db]), pf[2 + ks], o[db]);
        SCHED_FENCE();
        __builtin_amdgcn_s_setprio(0);
        s0 = n0; s1 = n1;
        so_cur = so_n1; so_n1 = (so_n1 == 3 * DST3) ? 0 : so_n1 + DST3; so_n3 = (so_n3 == 3 * DST3) ? 0 : so_n3 + DST3;
    }
#undef DDMA
    asm volatile("s_waitcnt vmcnt(0)" ::: "memory");
    __syncthreads();
    l += __shfl_xor(l, 32);
    const float inv = 1.f / l;
    LAS f32x4* xb = (LAS f32x4*)lds + rg * (16 * 64) + lane;
    if (c == 1) {
#pragma unroll
        for (int db = 0; db < 4; ++db)
#pragma unroll
            for (int r4 = 0; r4 < 4; ++r4) xb[(db * 4 + r4) * 64] = (f32x4){o[db][4 * r4], o[db][4 * r4 + 1], o[db][4 * r4 + 2], o[db][4 * r4 + 3]} * inv;
    }
    __syncthreads();
    if (c == 0) {
        float ss = 0.f;
#pragma unroll
        for (int db = 0; db < 4; ++db)
#pragma unroll
            for (int r4 = 0; r4 < 4; ++r4) { const f32x4 ot = xb[(db * 4 + r4) * 64];
#pragma unroll
                for (int e = 0; e < 4; ++e) { const float d = o[db][4 * r4 + e] * inv - lam * ot[e]; o[db][4 * r4 + e] = d; ss += d * d; } }
        ss += __shfl_xor(ss, 32);
        const float rs = rsqrtf(ss * (1.f / 128.f) + EPS) * outscale;
        bf16* yp = Y + rowQ * D + 512 + 128 * h + 4 * hi;
#pragma unroll
        for (int db = 0; db < 4; ++db)
#pragma unroll
            for (int r4 = 0; r4 < 4; ++r4) { const f32x4 gw = *(const f32x4*)(subln + 32 * db + 8 * r4 + 4 * hi);
                u32x2 wv; wv.x = cvt_pk_bf16(o[db][4 * r4] * rs * gw[0], o[db][4 * r4 + 1] * rs * gw[1]); wv.y = cvt_pk_bf16(o[db][4 * r4 + 2] * rs * gw[2], o[db][4 * r4 + 3] * rs * gw[3]);
                *(u32x2*)(yp + 32 * db + 8 * r4) = wv; }
    }
    __syncthreads();
}

__device__ __forceinline__ void swa_unit(LAS char* lds, const bf16* __restrict__ QKV, bf16* __restrict__ Y, int b, int kvh, int n, float Mb, const float* __restrict__ sink) {
    int tid = threadIdx.x; asm volatile("" : "+v"(tid)); const int lane = tid & 63, w = __builtin_amdgcn_readfirstlane(tid >> 6), q = lane & 31, hi = lane >> 5;
    const int head = kvh * 4 + (w >> 1), rb = (w & 1) * 64;
    const size_t rowQ = (size_t)b * S + n * 128 + rb + q;
    bf16x8 qf[2][4];
#pragma unroll
    for (int rg = 0; rg < 2; ++rg)
#pragma unroll
        for (int ds = 0; ds < 4; ++ds) qf[rg][ds] = *(const bf16x8*)(QKV + (rowQ + 32 * rg) * NIN + head * 64 + hi * 8 + ds * 16);
    const int lrow = tid >> 3, lcc = tid & 7;
    const long kp0 = (long)b * S + (long)(n - 1) * 128 + lrow;
    const bf16* kg = QKV + kp0 * NIN + 512 + kvh * 64 + lcc * 8;
    const bf16* vg = QKV + kp0 * NIN + 640 + kvh * 64 + lcc * 8;
    const int kdst = lrow * KROW + lcc * 16, vdst = 64 * KROW + lrow * VROWA + lcc * 16;
    u32x4 st0, st1;
#define ALOAD(t) do { const long o_ = (long)(t) * 64 * NIN; st0 = *(const u32x4*)(kg + o_); st1 = *(const u32x4*)(vg + o_); } while (0)
#define ASTORE(bo) do { *(LAS u32x4*)(lds + (bo) + kdst) = st0; *(LAS u32x4*)(lds + (bo) + vdst) = st1; } while (0)
    f32x16 o[2][2];
#pragma unroll
    for (int i = 0; i < 2; ++i)
#pragma unroll
        for (int j = 0; j < 2; ++j) o[i][j] = (f32x16){0.f};
    float l[2] = {0.f, 0.f};
    const int t0 = (n == 0) ? 2 : 0, t1 = (n == S / 128 - 1) ? 4 : 6;
    ALOAD(t0); ASTORE((t0 & 1) * ASTG); __syncthreads();
    const int koff = q * KROW + hi * 16;
    const int voff = 64 * KROW + (4 * hi + ((lane & 15) >> 2)) * VROWA + ((lane >> 4) & 1) * 32 + (lane & 3) * 8;
    const unsigned lbase = (unsigned)(size_t)lds;
    for (int t = t0; t < t1; ++t) {
        const int cur = (t & 1) * ASTG, nxt = ASTG - cur;
        if (t + 1 < t1) ALOAD(t + 1);
        const unsigned ka = lbase + cur + koff, va = lbase + cur + voff;
        bf16x8 kf[8];
#pragma unroll
        for (int ds = 0; ds < 4; ++ds) { kf[2 * ds] = rd128(ka, ds * 32); kf[2 * ds + 1] = rd128(ka, 32 * KROW + ds * 32); }
        s16x4 vl[4][2], vh[4][2];
#pragma unroll
        for (int ks = 0; ks < 4; ++ks)
#pragma unroll
            for (int db = 0; db < 2; ++db) { vl[ks][db] = rdtr(va, ks * 16 * VROWA + db * 64); vh[ks][db] = rdtr(va, ks * 16 * VROWA + 8 * VROWA + db * 64); }
        LGKM_WAIT(0); SCHED_FENCE();
#pragma unroll
        for (int rg = 0; rg < 2; ++rg) {
            const int i0 = rb + 32 * rg;
            if (64 * t + 63 >= i0 && 64 * t <= i0 + 31 + 256) {
                f32x16 s0 = (f32x16){0.f}, s1 = (f32x16){0.f};
#pragma unroll
                for (int ds = 0; ds < 4; ++ds) { s0 = MFMA32(kf[2 * ds], qf[rg][ds], s0); s1 = MFMA32(kf[2 * ds + 1], qf[rg][ds], s1); }
                const int jb = 64 * t + 4 * hi - (i0 + q);
                float ls = 0.f;
#pragma unroll
                for (int r = 0; r < 16; ++r) {
                    const int d0 = jb + (r & 3) + 8 * (r >> 2), d1 = d0 + 32;
                    const float p0 = __builtin_amdgcn_exp2f(s0[r] - Mb), p1 = __builtin_amdgcn_exp2f(s1[r] - Mb);
                    s0[r] = ((unsigned)d0 <= 256u) ? p0 : 0.f; s1[r] = ((unsigned)d1 <= 256u) ? p1 : 0.f; ls += s0[r] + s1[r];
                }
                l[rg] += ls;
                bf16x8 pf[4]; pf[0] = pack8(s0, 0); pf[1] = pack8(s0, 8); pf[2] = pack8(s1, 0); pf[3] = pack8(s1, 8);
#pragma unroll
                for (int ks = 0; ks < 4; ++ks)
#pragma unroll
                    for (int db = 0; db < 2; ++db) o[rg][db] = MFMA32(VFRAG(vl[ks][db], vh[ks][db]), pf[ks], o[rg][db]);
            }
        }
        SCHED_FENCE();
        if (t + 1 < t1) ASTORE(nxt);
        __syncthreads();
    }
#undef ALOAD
#undef ASTORE
    const float sk = __builtin_amdgcn_exp2f(sink[head] * LOG2E - Mb);
#pragma unroll
    for (int rg = 0; rg < 2; ++rg) {
        float lt = l[rg]; lt += __shfl_xor(lt, 32);
        const float inv = 1.f / (lt + sk);
        bf16* yp = Y + (rowQ + 32 * rg) * D + head * 64 + 4 * hi;
#pragma unroll
        for (int db = 0; db < 2; ++db)
#pragma unroll
            for (int r4 = 0; r4 < 4; ++r4) { u32x2 wv; wv.x = cvt_pk_bf16(o[rg][db][4 * r4] * inv, o[rg][db][4 * r4 + 1] * inv); wv.y = cvt_pk_bf16(o[rg][db][4 * r4 + 2] * inv, o[rg][db][4 * r4 + 3] * inv);
                *(u32x2*)(yp + 32 * db + 8 * r4) = wv; }
    }
}
}
constexpr size_t MiB = 1u << 20;
constexpr size_t WS_CTL = 0, CTL_BYTES = 65536 + 4 * 65536;
constexpr size_t WS_ROWSQ = 65536;
constexpr int MISC_OFF = 131072 + 4096;
constexpr size_t WS_ROPE = 1 * MiB;
constexpr size_t WS_W = 2 * MiB, W_LAYER = 23 * MiB;
constexpr size_t W_IN = 0, W_OUT = (size_t)NIN * D * 2, W_UP = W_OUT + (size_t)D * D * 2, W_DOWN = W_UP + (size_t)NUP * D * 2;
static_assert(W_DOWN + (size_t)D * FF * 2 <= W_LAYER, "weights");
constexpr size_t WS_H = 48 * MiB;
constexpr size_t WS_QKV = 80 * MiB;
constexpr size_t WS_Y = 152 * MiB;
constexpr size_t WS_ACT = 80 * MiB;
constexpr size_t WS_EDGE = 184 * MiB;
constexpr size_t WS_PART = 186 * MiB;
constexpr size_t WS_END = 190 * MiB;
static_assert(WS_ACT + (size_t)M * FF * 2 <= WS_EDGE && WS_QKV + (size_t)M * NIN * 2 <= WS_Y && WS_Y + (size_t)M * D * 2 <= WS_EDGE, "ws map");

#ifndef REP_P0
#define REP_P0 1
#endif
#ifndef REP_P1
#define REP_P1 1
#endif
#ifndef REP_P3B
#define REP_P3B 1
#endif
#ifndef REP_P4
#define REP_P4 1
#endif
#ifndef ATT_REP
#define ATT_REP 1
#endif
#ifndef REP_P5
#define REP_P5 1
#endif
#ifndef REP_P3
#define REP_P3 1
#endif
#ifndef REP_SYNC
#define REP_SYNC 1
#endif
struct Args {
    const float *x, *g_attn, *w_in, *qn_a, *kn_a, *sink, *qn_b, *kn_b, *lq1, *lk1, *lq2, *lk2, *subln, *w_out, *g_ffn, *w_up, *conv_w, *conv_b, *w_down;
    float* out; unsigned char* ws;
};

__device__ __forceinline__ float wave_sum(float v) {
#pragma unroll
    for (int o = 1; o < 64; o <<= 1) v += __shfl_xor(v, o);
    return v;
}
__device__ __forceinline__ float uniform_f(float v) { return __uint_as_float(__builtin_amdgcn_readfirstlane(__float_as_uint(v))); }
__device__ __forceinline__ float wave_max(float v) {
#pragma unroll
    for (int o = 1; o < 64; o <<= 1) v = fmaxf(v, __shfl_xor(v, o));
    return v;
}
__device__ __forceinline__ unsigned f2bf(float f) { unsigned u = __builtin_bit_cast(unsigned, f); return (u + 0x7fffu + ((u >> 16) & 1u)) >> 16; }
__device__ __forceinline__ unsigned pk2(float lo, float hi) { return f2bf(lo) | (f2bf(hi) << 16); }

__device__ __forceinline__ void transpose_item(const float* __restrict__ W, int K, int N, bf16* __restrict__ WT, LAS float* scr, int kb, int nb, int dnb, int lane, const float* __restrict__ g) {
    const int k0 = 64 * kb, n0 = 32 * nb;
#pragma unroll 8
    for (int i = 0; i < 32; ++i) { const int kk = 2 * i + (lane >> 5); scr[kk * 33 + (lane & 31)] = __builtin_nontemporal_load(&W[(size_t)(k0 + kk) * N + n0 + (lane & 31)]) * (g ? g[k0 + kk] : 1.f); }
    asm volatile("s_waitcnt lgkmcnt(0)" ::: "memory");
    const int c = lane & 7;
#pragma unroll
    for (int j = 0; j < 4; ++j) { const int n = (lane >> 3) + 8 * j; const LAS float* s = scr + (8 * c) * 33 + n;
        u32x4 o; o.x = pk2(s[0 * 33], s[1 * 33]); o.y = pk2(s[2 * 33], s[3 * 33]); o.z = pk2(s[4 * 33], s[5 * 33]); o.w = pk2(s[6 * 33], s[7 * 33]);
        *(u32x4*)(WT + (size_t)(32 * dnb + n) * K + k0 + 8 * c) = o; }
    asm volatile("s_waitcnt lgkmcnt(0)" ::: "memory");
}

__device__ __forceinline__ void convert_rows(const float* __restrict__ x, bf16* __restrict__ out, float* __restrict__ rowsq, int gw, int ngw, int lane) {
    for (int m = gw; m < M; m += ngw) {
        const f32x4* xr = (const f32x4*)(x + (size_t)m * D) + lane; f32x4 v[4]; float s = 0.f;
#pragma unroll
        for (int j = 0; j < 4; ++j) { v[j] = __builtin_nontemporal_load(&xr[64 * j]); s += dot4(v[j]); }
        s = wave_sum(s);
        if (lane == 0) rowsq[m] = s;
        u32x2* o8 = (u32x2*)(out + (size_t)m * D) + lane;
#pragma unroll
        for (int j = 0; j < 4; ++j) { u32x2 wv; wv.x = pk2(v[j][0], v[j][1]); wv.y = pk2(v[j][2], v[j][3]); o8[64 * j] = wv; }
    }
}

#define XB_TMO      128
#define XB_XCNT(j)  (256  + 64 * (j))
#define XB_XSUB(j)  (1280 + 64 * (j))
#define XB_XGEN(j)  (2304 + 64 * (j))
#define XB_TOP      3328
#define XB_TOPGEN   3392
#define XCD_BAR_WORDS 3456
#define XB_SPIN_CAP (1u << 18)

__device__ __forceinline__ unsigned xb_ld(unsigned* p)              { return __hip_atomic_load(p, __ATOMIC_RELAXED, __HIP_MEMORY_SCOPE_AGENT); }
__device__ __forceinline__ unsigned xb_add(unsigned* p, unsigned v) { return __hip_atomic_fetch_add(p, v, __ATOMIC_RELAXED, __HIP_MEMORY_SCOPE_AGENT); }
__device__ __forceinline__ unsigned xb_xcc_id() { return (unsigned)__builtin_amdgcn_s_getreg((3 << 11) | 20) & 0xFu; }
#define XB_SPIN(cond, bar) do { unsigned _sp = 0; while (cond) { __builtin_amdgcn_s_sleep(1); \
    if ((++_sp & 255u) == 0u) { if (xb_ld(&(bar)[XB_TMO])) break; if (_sp > XB_SPIN_CAP) { atomicAdd(&(bar)[XB_TMO], 1u); break; } } } } while (0)

struct XcdBarrier {
    unsigned* bar; unsigned x;
    volatile LAS unsigned* st;
};

__device__ __forceinline__ XcdBarrier xcd_barrier_post(unsigned* bar, volatile LAS unsigned* st) {
    XcdBarrier b; b.bar = bar; b.x = xb_xcc_id(); b.st = st;
    if (threadIdx.x == 0) (void)xb_add(&bar[XB_XCNT(b.x)], 1u);
    return b;
}
__device__ __forceinline__ void xcd_barrier_complete(unsigned* bar, unsigned x, unsigned& nloc, unsigned& nx) {
    const unsigned G = gridDim.x * gridDim.y * gridDim.z;
    unsigned sum, cnt, mine, sp = 0u;
    for (;;) {
        sum = 0u; cnt = 0u; mine = 0u;
#pragma unroll
        for (unsigned j = 0; j < 16; ++j) { const unsigned c = xb_ld(&bar[XB_XCNT(j)]); sum += c; cnt += (c > 0u) ? 1u : 0u; mine = (j == x) ? c : mine; }
        if (sum == G) break;
        __builtin_amdgcn_s_sleep(1);
        if ((++sp & 255u) == 0u) { if (xb_ld(&bar[XB_TMO])) break; if (sp > XB_SPIN_CAP) { atomicAdd(&bar[XB_TMO], 1u); break; } }
    }
    nloc = mine > 0u ? mine : 1u; nx = cnt > 0u ? cnt : 1u;
}

__device__ __forceinline__ void xcd_barrier(const XcdBarrier& b) {
    asm volatile("s_waitcnt vmcnt(0)" ::: "memory");
    __syncthreads();
    if (threadIdx.x == 0) {
        unsigned* bar = b.bar;
        __builtin_amdgcn_s_waitcnt(0);
        unsigned nloc = b.st[0], nx = b.st[1];
        if (nloc == 0u) { xcd_barrier_complete(bar, b.x, nloc, nx); b.st[0] = nloc; b.st[1] = nx; }
        const unsigned old = xb_add(&bar[XB_XSUB(b.x)], 1u);
        const unsigned gen = old / nloc;
        if (old + 1u == (gen + 1u) * nloc) {
            __builtin_amdgcn_fence(__ATOMIC_RELEASE, "agent");
            asm volatile("s_waitcnt vmcnt(0)" ::: "memory");
            const unsigned og = xb_add(&bar[XB_TOP], 1u);
            const unsigned tg = og / nx;
            if (og + 1u == (tg + 1u) * nx) xb_add(&bar[XB_TOPGEN], 1u);
            else XB_SPIN(xb_ld(&bar[XB_TOPGEN]) == tg, bar);
            __builtin_amdgcn_fence(__ATOMIC_ACQUIRE, "agent");
            xb_add(&bar[XB_XGEN(b.x)], 1u);
            asm volatile("s_waitcnt vmcnt(0)" ::: "memory");
        } else {
            XB_SPIN(xb_ld(&bar[XB_XGEN(b.x)]) == gen, bar);
            __builtin_amdgcn_fence(__ATOMIC_ACQUIRE, "agent");
            asm volatile("s_waitcnt vmcnt(0)" ::: "memory");
        }
    }
    __syncthreads();
}

__global__ void __launch_bounds__(512, 2) mega_fwd(Args a) {
    extern __shared__ __attribute__((aligned(16))) unsigned char lds_raw[];
    LAS unsigned char* lds = (LAS unsigned char*)lds_raw;
    cg::grid_group grid = cg::this_grid();
    const int tid = threadIdx.x, lane = tid & 63, wave = __builtin_amdgcn_readfirstlane(tid >> 6);
    const int G = gridDim.x, bx = blockIdx.x;
    const int vcu = (G % 8 == 0) ? (bx % 8) * (G / 8) + bx / 8 : bx;
    const int gw = vcu * 8 + wave, ngw = G * 8;
    typedef const __attribute__((address_space(4))) Args* kargs_t;
    const kargs_t kap = (kargs_t)__builtin_amdgcn_kernarg_segment_ptr();
#define PHASE_ARGS() kargs_t ap = kap; asm volatile("" : "+s"(ap)); unsigned char* const ws = ap->ws; \
    float* const cosT = (float*)(ws + WS_ROPE); float* const sinT = cosT + S * 32; \
    bf16* const Hb = (bf16*)(ws + WS_H); bf16* const QKV = (bf16*)(ws + WS_QKV); bf16* const Yb = (bf16*)(ws + WS_Y); bf16* const ACT = (bf16*)(ws + WS_ACT); \
    float* const edge = (float*)(ws + WS_EDGE); float* const part = (float*)(ws + WS_PART); float* const rowsq = (float*)(ws + WS_ROWSQ); \
    (void)cosT; (void)sinT; (void)Hb; (void)QKV; (void)Yb; (void)ACT; (void)edge; (void)part; (void)rowsq
    volatile LAS unsigned* misc = (volatile LAS unsigned*)(lds + MISC_OFF);
    if (tid < 16) misc[tid] = 0u;
    __syncthreads();

#define CONVERT_WEIGHTS(L, wv, nwv) do { \
        int lane = threadIdx.x & 63; asm volatile("" : "+v"(lane)); \
        LAS float* scr = (LAS float*)(lds + wave * 16384); \
        constexpr int I_IN = 16 * 72, I_OUT = 16 * 32, I_UP = 16 * 176, I_DOWN = 44 * 32, I_L = I_IN + I_OUT + I_UP + I_DOWN; \
        unsigned char* wl_ = ws + WS_W + (size_t)(L) * W_LAYER; \
        for (int it = (wv); it < I_L; it += (nwv)) { \
            int r = it; \
            if (r < I_IN) { const int kb = r / 72, nb = r % 72; const int pn = nb >> 3, wc = (nb >> 1) & 3, bj = nb & 1; \
                transpose_item(ap->w_in + (size_t)(L) * D * NIN, D, NIN, (bf16*)(wl_ + W_IN), scr, kb, nb, 8 * pn + 4 * bj + wc, lane, ap->g_attn + (L) * D); continue; } \
            r -= I_IN; \
            if (r < I_OUT) { const int kb = r / 32, nb = r % 32; transpose_item(ap->w_out + (size_t)(L) * D * D, D, D, (bf16*)(wl_ + W_OUT), scr, kb, nb, nb, lane, nullptr); continue; } \
            r -= I_OUT; \
            if (r < I_UP) { const int kb = r / 176, nb = r % 176; const int isv = nb >= 88, nn = isv ? nb - 88 : nb; const int dnb = 8 * (nn >> 2) + 4 * isv + (nn & 3); \
                transpose_item(ap->w_up + (size_t)(L) * D * NUP, D, NUP, (bf16*)(wl_ + W_UP), scr, kb, nb, dnb, lane, ap->g_ffn + (L) * D); continue; } \
            r -= I_UP; \
            { const int kb = r / 32, nb = r % 32; transpose_item(ap->w_down + (size_t)(L) * FF * D, FF, D, (bf16*)(wl_ + W_DOWN), scr, kb, nb, nb, lane, nullptr); } \
        } } while (0)
    {
        PHASE_ARGS();
        CONVERT_WEIGHTS(0, gw, ngw);
        for (int i = vcu * 512 + tid; i < S * 32; i += G * 512) {
            const int pos = i >> 5, j = i & 31;
            double inv = 1.0; for (int k = 0; k < j; ++k) inv *= 0.74989420933245582730;
            const double ang = (double)pos * inv;
            const double kq = __builtin_rint(ang * 0.15915494309189533577);
            const double rr = (ang - kq * 6.283185307179586232) - kq * 2.4492935982947064e-16;
            const double r2 = rr * rr;
            double sn = 1.0, cs = 1.0;
#pragma unroll
            for (int k = 12; k >= 1; --k) { sn = 1.0 - sn * r2 * (1.0 / (double)((2 * k) * (2 * k + 1))); cs = 1.0 - cs * r2 * (1.0 / (double)((2 * k - 1) * (2 * k))); }
            cosT[i] = (float)cs; sinT[i] = (float)(sn * rr);
        }
        for (int i = vcu * 512 + tid; i < (int)(CTL_BYTES / 16); i += G * 512) { const size_t off = (size_t)i * 16;
            if (off < WS_ROWSQ || off >= WS_ROWSQ + (size_t)M * 4) *(u32x4*)(ws + WS_CTL + off) = (u32x4){0u, 0u, 0u, 0u}; }
        convert_rows(ap->x, Hb, rowsq, gw, ngw, lane);
    }
    asm volatile("s_waitcnt vmcnt(0)" ::: "memory");
    __syncthreads();
    if (tid == 0) { __builtin_amdgcn_fence(__ATOMIC_RELEASE, "agent"); asm volatile("s_waitcnt vmcnt(0)" ::: "memory"); }
    grid.sync();
    if (tid == 0) { __builtin_amdgcn_fence(__ATOMIC_ACQUIRE, "agent"); asm volatile("s_waitcnt vmcnt(0)" ::: "memory"); }
    __syncthreads();
    XcdBarrier xbar; { PHASE_ARGS(); xbar = xcd_barrier_post((unsigned*)(ws + WS_CTL) + 1024, misc); }

    for (int l = 0; l < DEPTH; ++l) {
        const float lambda_init = 0.8f - 0.6f * __expf(-0.3f * (float)l);
        {
            PHASE_ARGS(); unsigned char* const wl = ws + WS_W + (size_t)l * W_LAYER; (void)wl;
            pg8::Gemm g{Hb, (const bf16*)(wl + W_IN), M, NIN, D}; pg8::StaticOrder So; So.init(M, NIN, G, bx);
            EpiInProj E{QKV, ap->qn_a + l * 64, ap->kn_a + l * 64, ap->qn_b + l * 64, ap->kn_b + l * 64, cosT, sinT, rowsq + (size_t)(2 * l) * M};
            pg8::gemm_phase<EpiInProj, pg8::StaticOrder, true, true>(lds, g, So, E);
            if (l == 0 && DEPTH > 1) {
                const int nidle = G - 64;
                if (nidle >= 64) { if (bx >= 64) CONVERT_WEIGHTS(1, (bx - 64) * 8 + wave, nidle * 8); }
                else CONVERT_WEIGHTS(1, gw, ngw);
            }
        }
        xcd_barrier(xbar);
        {
            PHASE_ARGS(); unsigned char* const wl = ws + WS_W + (size_t)l * W_LAYER; (void)wl;
            int lane = threadIdx.x & 63; asm volatile("" : "+v"(lane));
            const float mqa = wave_max(fabsf(ap->qn_a[l * 64 + lane])), mka = wave_max(fabsf(ap->kn_a[l * 64 + lane]));
            const float mqb = wave_max(fabsf(ap->qn_b[l * 64 + lane])), mkb = wave_max(fabsf(ap->kn_b[l * 64 + lane]));
            const float MbA = uniform_f(8.f * mqa * mka * LOG2E * 1.02f), MbB = uniform_f(8.f * mqb * mkb * LOG2E * 1.02f);
            const float s1 = wave_sum(ap->lq1[l * 64 + lane] * ap->lk1[l * 64 + lane]), s2 = wave_sum(ap->lq2[l * 64 + lane] * ap->lk2[l * 64 + lane]);
            const float lam = uniform_f(__expf(s1) - __expf(s2) + lambda_init);
            {
            for (int uidx = vcu; uidx < NB * 4 * 16; uidx += G) {
                const int bh = uidx >> 4, qb = uidx & 15;
                att::diff_unit((LAS char*)lds, QKV, Yb, bh >> 2, bh & 3, qb, MbB, lam, ap->subln + l * 128, 1.f - lambda_init);
            }
            for (int uidx = vcu; uidx < NB * 2 * 16; uidx += G) {
                const int bk = uidx >> 4, n = uidx & 15;
                att::swa_unit((LAS char*)lds, QKV, Yb, bk >> 1, bk & 1, n, MbA, ap->sink + l * 8);
            }
            __syncthreads();
            }
        }
        xcd_barrier(xbar);
        {
            PHASE_ARGS(); unsigned char* const wl = ws + WS_W + (size_t)l * W_LAYER; (void)wl;
            pg8::Gemm g{Yb, (const bf16*)(wl + W_OUT), M, D, D}; pg8::StaticOrder So; So.init(M, D, G, bx);
            EpiResid E{Hb, rowsq + (size_t)(2 * l + 1) * M, nullptr};
            pg8::gemm_phase<EpiResid, pg8::StaticOrder, true, true>(lds, g, So, E);
        }
        xcd_barrier(xbar);
        {
            PHASE_ARGS(); unsigned char* const wl = ws + WS_W + (size_t)l * W_LAYER; (void)wl;
            pg8::Gemm g{Hb, (const bf16*)(wl + W_UP), M, NUP, D}; pg8::StaticOrder So; So.init(M, NUP, G, bx);
            EpiUpConv E{ACT, ap->conv_w + (size_t)l * 3 * FF, ap->conv_b + (size_t)l * FF, edge, part, (LAS float*)(lds + XL_OFF), rowsq + (size_t)(2 * l + 1) * M};
            pg8::gemm_phase<EpiUpConv, pg8::StaticOrder, true, true>(lds, g, So, E);
        }
        xcd_barrier(xbar);
        {
            PHASE_ARGS(); unsigned char* const wl = ws + WS_W + (size_t)l * W_LAYER; (void)wl;
            pg8::Gemm g{ACT, (const bf16*)(wl + W_DOWN), M, D, FF}; pg8::StaticOrder So; So.init(M, D, G, bx);
            { const float* cw = ap->conv_w + (size_t)l * 3 * FF; pg8::Unit uu; int tid = threadIdx.x; asm volatile("" : "+v"(tid));
              for (int ui = 0; So.next(ui, uu); ++ui) { const int pm = uu.pm;
                for (int i = tid; i < 2 * FF; i += 512) { const int which = i / FF, ch = i % FF;
                    if (which == 0 && (pm & 7) != 0) { const float* pp = part + (((size_t)pm * 2 + 0) * FF + ch) * 2;
                        const float pre = pp[0] + cw[ch] * edge[((size_t)(pm - 1) * 2 + 1) * FF + ch];
                        ACT[(size_t)(pm * 256) * FF + ch] = (bf16)f2bf(silu_f(pre) * pp[1]); }
                    if (which == 1 && (pm & 7) != 7) { const float* pp = part + (((size_t)pm * 2 + 1) * FF + ch) * 2;
                        const float pre = pp[0] + cw[2 * FF + ch] * edge[((size_t)(pm + 1) * 2 + 0) * FF + ch];
                        ACT[(size_t)(pm * 256 + 255) * FF + ch] = (bf16)f2bf(silu_f(pre) * pp[1]); } } }
              asm volatile("s_waitcnt vmcnt(0)" ::: "memory"); __syncthreads(); }
            const bool lastl = (l + 1 == DEPTH);
            EpiResid E{Hb, lastl ? nullptr : rowsq + (size_t)(2 * l + 2) * M, lastl ? ap->out : nullptr};
            pg8::gemm_phase<EpiResid, pg8::StaticOrder, true, true>(lds, g, So, E);
        }
        if (l + 1 < DEPTH) xcd_barrier(xbar);
    }
}

extern "C" void kernel_launch(void* const* d_in, const int* in_sizes, int n_in, void* d_out, int out_size, void* d_ws, size_t ws_size, hipStream_t stream) {
    static int grid = 0;
    if (grid == 0) {
        if (n_in != 19 || ws_size < WS_END) { fprintf(stderr, "kernel_launch: unexpected inputs (n_in %d, ws %zu)\n", n_in, ws_size); grid = -1; return; }
        int dev = 0, cus = 0, per_cu = 0;
        hipGetDevice(&dev);
        hipDeviceGetAttribute(&cus, hipDeviceAttributeMultiprocessorCount, dev);
        hipFuncSetAttribute((const void*)mega_fwd, hipFuncAttributeMaxDynamicSharedMemorySize, LDS_BYTES);
        hipOccupancyMaxActiveBlocksPerMultiprocessor(&per_cu, (const void*)mega_fwd, 512, LDS_BYTES);
        if (per_cu < 1) { fprintf(stderr, "kernel_launch: occupancy query reports %d blocks per CU\n", per_cu); per_cu = 1; }
        grid = cus;
        (void)hipGetLastError();
    }
    if (grid < 0) return;
    Args a{};
    const float** p = (const float**)&a;
    for (int i = 0; i < 19; ++i) p[i] = (const float*)d_in[i];
    a.out = (float*)d_out; a.ws = (unsigned char*)d_ws;
    void* args[] = {&a};
    hipError_t e = hipLaunchCooperativeKernel((const void*)mega_fwd, dim3(grid), dim3(512), args, LDS_BYTES, stream);
    if (e != hipSuccess) fprintf(stderr, "cooperative launch failed: %s (grid %d)\n", hipGetErrorString(e), grid);
}
```

```cpp
#include <hip/hip_runtime.h>
#include <hip/hip_cooperative_groups.h>
#include <cstdio>
#include <cstdint>
namespace cg = cooperative_groups;
namespace pg8 {
#define PG8_LAS __attribute__((address_space(3)))
typedef unsigned short bf16_t;
typedef short bf16x8 __attribute__((ext_vector_type(8)));
typedef float f32x4 __attribute__((ext_vector_type(4)));
typedef unsigned u32x4 __attribute__((ext_vector_type(4)));
constexpr int BM = 256, BK = 64, HALF = 128, HTB = HALF * BK * 2  , STAGE_BYTES = 8 * HTB, NXCD = 8, WGM = 4;

__host__ __device__ __forceinline__ int lds_byte(int r, int c) { const int st = (r >> 4) * 2 + (c >> 5), rr = r & 15, cc = c & 31, ob = rr * 64 + cc * 2; return st * 1024 + (ob ^ (((ob >> 9) & 1) << 5)); }
__host__ __device__ __forceinline__ void stage_rc(int b, int& R, int& C) { const int st = b / 1024, sb = b % 1024, swz = sb ^ (((sb >> 9) & 1) << 5); R = (st >> 1) * 16 + swz / 64; C = (st & 1) * 32 + (swz % 64) / 2; }
__host__ __device__ __forceinline__ int perm32(int rho) { const int n = rho >> 4, i = rho & 15; return 8 * (i >> 2) + 4 * n + (i & 3); }

struct Unit { int pm, pn; };
struct Gemm { const bf16_t* A; const bf16_t* Bt; int M, N, K; };

struct StaticOrder {
    int nM, nN, nwg, G, c;
    __host__ __device__ void init(int M, int N, int G_, int c_) { nM = M / BM; nN = N / BM; nwg = nM * nN; G = G_; c = c_; }
    __host__ __device__ bool next(int i, Unit& u) const {
        const long L = (long)i * G + c; if (L >= nwg) return false;
        int wgid = (int)L; { const int q = nwg / NXCD, r = nwg % NXCD, xcd = wgid % NXCD, off = wgid / NXCD; wgid = (xcd < r ? xcd * (q + 1) : r * (q + 1) + (xcd - r) * q) + off; }
        const int nig = WGM * nN, gid = wgid / nig, fm = gid * WGM, gsz = (nM - fm) < WGM ? (nM - fm) : WGM;
        u.pm = fm + ((wgid % nig) % gsz); u.pn = (wgid % nig) / gsz; return true;
    }
    __device__ __forceinline__ void a_ready(const Unit&) const {}
    __device__ __forceinline__ void done(const Unit&) const {}
};

__device__ __forceinline__ unsigned cvt_pk_bf16(float lo, float hi) { unsigned r; asm volatile("v_cvt_pk_bf16_f32 %0, %1, %2" : "=v"(r) : "v"(lo), "v"(hi)); return r; }
template <class Epi, class Sched, bool ALIGN_EPI = false, bool SP2 = false>
__device__ __forceinline__ void gemm_phase(PG8_LAS unsigned char* lds, const Gemm g, const Sched& S, const Epi& E) {
    int tid = threadIdx.x; asm volatile("" : "+v"(tid)); const int wid = __builtin_amdgcn_readfirstlane(tid >> 6), lane = tid & 63, wr = wid >> 2, wc = wid & 3, fr = lane & 15, fq = lane >> 4;
    const int K = g.K, nt = K / BK;
    unsigned voffA[2], voffB[2];
#pragma unroll
    for (int i = 0; i < 2; ++i) { int R, C; stage_rc(tid * 16 + i * 8192, R, C); const int Rb = Epi::PERM ? ((R & ~31) + perm32(R & 31)) : R;
        voffA[i] = (unsigned)(R * K + C) * 2u; voffB[i] = (unsigned)(Rb * K + C) * 2u; }
    const size_t kstep = (size_t)(BK * 2);
    const size_t hstep = (size_t)HALF * K * 2;
    const size_t tstep = 2 * hstep;
    const unsigned ldsw = (unsigned)wid * 1024u;
    const int aoff = lds_byte(wr * 64 + fr, fq * 8), boff = lds_byte(wc * 32 + fr, fq * 8);
#define PG8_SA(b, h) (((b) * 2 + (h)) * HTB)
#define PG8_SB(b, h) ((4 + (b) * 2 + (h)) * HTB)
#define PG8_STAGE(bufoff, gbase, voff) do { _Pragma("unroll") for (int _i = 0; _i < 2; ++_i) \
        __builtin_amdgcn_global_load_lds((const unsigned*)((const char*)(gbase) + (voff)[_i]), (PG8_LAS unsigned*)(lds + (bufoff) + ldsw + _i * 8192), 16, 0, 0); } while (0)
#define PG8_LDA(dst, b, h) do { _Pragma("unroll") for (int m = 0; m < 4; ++m) _Pragma("unroll") for (int k = 0; k < 2; ++k) dst[m][k] = *(const PG8_LAS bf16x8*)(lds + PG8_SA(b, h) + aoff + m * 2048 + k * 1024); } while (0)
#define PG8_LDB(dst, b, h) do { _Pragma("unroll") for (int n = 0; n < 2; ++n) _Pragma("unroll") for (int k = 0; k < 2; ++k) dst[n][k] = *(const PG8_LAS bf16x8*)(lds + PG8_SB(b, h) + boff + n * 2048 + k * 1024); } while (0)
#define PG8_MMA(ai, bj, At, Bt) do { __builtin_amdgcn_s_setprio(1); _Pragma("unroll") for (int m = 0; m < 4; ++m) _Pragma("unroll") for (int n = 0; n < 2; ++n) _Pragma("unroll") for (int k = 0; k < 2; ++k) \
        acc[ai][bj][m][n] = __builtin_amdgcn_mfma_f32_16x16x32_bf16(Bt[n][k], At[m][k], acc[ai][bj][m][n], 0, 0, 0); __builtin_amdgcn_s_setprio(0); } while (0)
#define PG8_WAIT_V(n) asm volatile("s_waitcnt vmcnt(" #n ")" ::: "memory")
#define PG8_WAIT_L(n) asm volatile("s_waitcnt lgkmcnt(" #n ")" ::: "memory")
#define PG8_BAR __builtin_amdgcn_s_barrier()
#define PG8_SCHED __builtin_amdgcn_sched_barrier(0)
    Unit cur, nxt; int ui = 0;
    if (!S.next(0, cur)) return;
    f32x4 acc[2][2][4][2];
#pragma unroll
    for (int a = 0; a < 2; ++a)
#pragma unroll
        for (int b = 0; b < 2; ++b)
#pragma unroll
            for (int m = 0; m < 4; ++m)
#pragma unroll
                for (int n = 0; n < 2; ++n) acc[a][b][m][n] = (f32x4){0.f, 0.f, 0.f, 0.f};
    bf16x8 At[4][2], B0[2][2], B1[2][2];
    const char* cA = (const char*)g.A + (size_t)cur.pm * tstep; const char* cB = (const char*)g.Bt + (size_t)cur.pn * tstep;
    S.a_ready(cur);
    if constexpr (SP2) {
        PG8_STAGE(PG8_SB(0, 0), cB, voffB); PG8_STAGE(PG8_SB(0, 1), cB + hstep, voffB); PG8_STAGE(PG8_SA(0, 0), cA, voffA); PG8_STAGE(PG8_SA(0, 1), cA + hstep, voffA);
        if (wr == 1) PG8_BAR;
        PG8_WAIT_V(2); PG8_BAR;
        PG8_STAGE(PG8_SB(1, 0), cB + kstep, voffB); PG8_STAGE(PG8_SA(1, 0), cA + kstep, voffA); PG8_STAGE(PG8_SB(1, 1), cB + hstep + kstep, voffB);
        PG8_WAIT_V(6); PG8_BAR;
    } else {
        PG8_STAGE(PG8_SB(0, 0), cB, voffB); PG8_STAGE(PG8_SA(0, 0), cA, voffA); PG8_STAGE(PG8_SB(0, 1), cB + hstep, voffB); PG8_STAGE(PG8_SA(0, 1), cA + hstep, voffA);
        if (wr == 1) PG8_BAR;
        PG8_WAIT_V(4); PG8_BAR;
        PG8_STAGE(PG8_SB(1, 0), cB + kstep, voffB); PG8_STAGE(PG8_SA(1, 0), cA + kstep, voffA); PG8_STAGE(PG8_SB(1, 1), cB + hstep + kstep, voffB);
        PG8_WAIT_V(6); PG8_BAR;
    }
    for (;;) {
        const bool has_next = S.next(ui + 1, nxt);
        const char* nA = has_next ? (const char*)g.A + (size_t)nxt.pm * tstep : cA; const char* nB = has_next ? (const char*)g.Bt + (size_t)nxt.pn * tstep : cB;
        for (int t = 0; t < nt; t += 2) {
            const bool last = (t == nt - 2);
            const char* a1 = cA + (size_t)(t + 1) * kstep;
            const char* a2 = last ? nA : cA + (size_t)(t + 2) * kstep; const char* b2 = last ? nB : cB + (size_t)(t + 2) * kstep;
            const char* a3 = a2 + kstep; const char* b3 = b2 + kstep;
            if (last && has_next) S.a_ready(nxt);
            if constexpr (SP2) {
            PG8_LDB(B0, 0, 0); PG8_LDB(B1, 0, 1); PG8_SCHED; PG8_LDA(At, 0, 0); PG8_STAGE(PG8_SA(1, 1), a1 + hstep, voffA);
            PG8_WAIT_V(8); PG8_WAIT_L(0); PG8_BAR; PG8_MMA(0, 0, At, B0); PG8_MMA(0, 1, At, B1); PG8_BAR; PG8_SCHED;
            PG8_LDA(At, 0, 1); PG8_STAGE(PG8_SB(0, 0), b2, voffB); PG8_STAGE(PG8_SB(0, 1), b2 + hstep, voffB); PG8_STAGE(PG8_SA(0, 0), a2, voffA);
            PG8_WAIT_V(8); PG8_WAIT_L(0); PG8_BAR; PG8_MMA(1, 0, At, B0); PG8_MMA(1, 1, At, B1); PG8_BAR; PG8_SCHED;
            PG8_LDB(B0, 1, 0); PG8_LDB(B1, 1, 1); PG8_SCHED; PG8_LDA(At, 1, 0); PG8_STAGE(PG8_SA(0, 1), a2 + hstep, voffA);
            PG8_WAIT_V(8); PG8_WAIT_L(0); PG8_BAR; PG8_MMA(0, 0, At, B0); PG8_MMA(0, 1, At, B1); PG8_BAR; PG8_SCHED;
            PG8_LDA(At, 1, 1); PG8_STAGE(PG8_SB(1, 0), b3, voffB); PG8_STAGE(PG8_SB(1, 1), b3 + hstep, voffB); PG8_STAGE(PG8_SA(1, 0), a3, voffA);
            PG8_WAIT_V(8); PG8_WAIT_L(0); PG8_BAR; PG8_MMA(1, 0, At, B0); PG8_MMA(1, 1, At, B1); PG8_BAR; PG8_SCHED;
            } else {
            PG8_LDB(B0, 0, 0); PG8_SCHED; PG8_LDA(At, 0, 0); PG8_STAGE(PG8_SA(1, 1), a1 + hstep, voffA);
            PG8_WAIT_L(8); PG8_BAR; PG8_WAIT_L(0); PG8_MMA(0, 0, At, B0); PG8_BAR; PG8_SCHED;
            PG8_LDB(B1, 0, 1); PG8_STAGE(PG8_SB(0, 0), b2, voffB);
            PG8_BAR; PG8_WAIT_L(0); PG8_MMA(0, 1, At, B1); PG8_BAR;
            PG8_LDA(At, 0, 1); PG8_STAGE(PG8_SA(0, 0), a2, voffA);
            PG8_BAR; PG8_WAIT_L(0); PG8_MMA(1, 0, At, B0); PG8_BAR; PG8_SCHED;
            PG8_STAGE(PG8_SB(0, 1), b2 + hstep, voffB);
            PG8_WAIT_V(6); PG8_BAR; PG8_MMA(1, 1, At, B1); PG8_BAR;
            PG8_LDB(B0, 1, 0); PG8_SCHED; PG8_LDA(At, 1, 0); PG8_STAGE(PG8_SA(0, 1), a2 + hstep, voffA);
            PG8_WAIT_L(8); PG8_BAR; PG8_WAIT_L(0); PG8_MMA(0, 0, At, B0); PG8_BAR; PG8_SCHED;
            PG8_LDB(B1, 1, 1); PG8_STAGE(PG8_SB(1, 0), b3, voffB);
            PG8_BAR; PG8_WAIT_L(0); PG8_MMA(0, 1, At, B1); PG8_BAR;
            PG8_LDA(At, 1, 1); PG8_STAGE(PG8_SA(1, 0), a3, voffA);
            PG8_BAR; PG8_WAIT_L(0); PG8_MMA(1, 0, At, B0); PG8_BAR; PG8_SCHED;
            PG8_STAGE(PG8_SB(1, 1), b3 + hstep, voffB);
            PG8_WAIT_V(6); PG8_BAR; PG8_MMA(1, 1, At, B1); PG8_BAR;
            }
        }
        if constexpr (ALIGN_EPI) { if (wr == 0) PG8_BAR; }
        if constexpr (!Epi::AFTER_DRAIN) { E(acc, cur, wr, wc, fr, fq); S.done(cur); }
        if (!has_next) break;
#pragma unroll
        for (int a = 0; a < 2; ++a)
#pragma unroll
            for (int b = 0; b < 2; ++b)
#pragma unroll
                for (int m = 0; m < 4; ++m)
#pragma unroll
                    for (int n = 0; n < 2; ++n) acc[a][b][m][n] = (f32x4){0.f, 0.f, 0.f, 0.f};
        cur = nxt; cA = nA; cB = nB; ++ui;
        if constexpr (ALIGN_EPI) { if (wr == 1) PG8_BAR; }
    }
    PG8_WAIT_V(0);
    if constexpr (!ALIGN_EPI) { if (wr == 0) PG8_BAR; }
    PG8_BAR;
    if constexpr (Epi::AFTER_DRAIN) { E.fused(acc, cur, wr, wc, fr, fq, lds, wid, lane); S.done(cur); }
#undef PG8_SA
#undef PG8_SB
#undef PG8_STAGE
#undef PG8_LDA
#undef PG8_LDB
#undef PG8_MMA
#undef PG8_WAIT_V
#undef PG8_WAIT_L
#undef PG8_BAR
#undef PG8_SCHED
}
}
#define LAS __attribute__((address_space(3)))
typedef unsigned short bf16;
using pg8::f32x4; using pg8::u32x4; using pg8::Unit; using pg8::cvt_pk_bf16; using pg8::bf16x8;
typedef unsigned u32x2 __attribute__((ext_vector_type(2)));

constexpr int NB = 8, S = 2048, D = 1024, M = NB * S, NIN = 2304, FF = 2816, NUP = 2 * FF, DEPTH = 2;
constexpr float EPS = 1e-6f;
constexpr float LOG2E = 1.4426950408889634f;
constexpr float QSCALE = 0.125f * LOG2E;
constexpr int XL_OFF = 131072;
constexpr int LDS_BYTES = 131072 + 8192;

__device__ __forceinline__ float dot4(f32x4 a) { return (a[0] * a[0] + a[1] * a[1]) + (a[2] * a[2] + a[3] * a[3]); }
__device__ __forceinline__ float silu_f(float v) { return v * __builtin_amdgcn_rcpf(1.f + __expf(-v)); }

struct EpiInProj {
    static constexpr bool PERM = true, AFTER_DRAIN = false;
    bf16* O; const float* qn_a; const float* kn_a; const float* qn_b; const float* kn_b; const float* cosT; const float* sinT; const float* rowsq;
    __device__ __forceinline__ void operator()(const f32x4 (&acc)[2][2][4][2], const Unit& u, int wr, int wc, int fr, int fq) const {
        asm volatile("" : "+v"(fr), "+v"(fq));
        const int pn = u.pn;
        const float* g = nullptr; float sc = 1.f;
        if (pn < 2) { g = qn_a; sc = QSCALE; }
        else if (pn == 2) { if (wc < 2) g = kn_a; }
        else if (pn < 5) { g = qn_b; sc = QSCALE; }
        else if (pn < 7) { g = kn_b; }
        const int colb = pn * 256 + wc * 64 + 8 * fq;
        const int row0 = u.pm * 256 + wr * 64 + fr;
        if (g) {
            f32x4 g1[2], g2[2];
#pragma unroll
            for (int n = 0; n < 2; ++n) { g1[n] = *(const f32x4*)(g + 8 * fq + 4 * n); g2[n] = *(const f32x4*)(g + 32 + 8 * fq + 4 * n); }
#pragma unroll
            for (int ai = 0; ai < 2; ++ai)
#pragma unroll
                for (int m = 0; m < 4; ++m) {
                    const int row = row0 + ai * 128 + m * 16;
                    const f32x4 a0 = acc[ai][0][m][0], a1 = acc[ai][0][m][1], b0 = acc[ai][1][m][0], b1 = acc[ai][1][m][1];
                    float ss = (dot4(a0) + dot4(a1)) + (dot4(b0) + dot4(b1));
                    ss += __shfl_xor(ss, 16); ss += __shfl_xor(ss, 32);
                    const float rx = rsqrtf(rowsq[row] * (1.f / D) + EPS);
                    const float rs = rsqrtf(ss * rx * rx * (1.f / 64.f) + EPS) * rx * sc;
                    const size_t ro = (size_t)(row & (S - 1)) * 32 + 8 * fq;
                    const f32x4 c0 = *(const f32x4*)(cosT + ro), c1 = *(const f32x4*)(cosT + ro + 4), s0 = *(const f32x4*)(sinT + ro), s1 = *(const f32x4*)(sinT + ro + 4);
                    const f32x4 y10 = a0 * rs * g1[0], y11 = a1 * rs * g1[1], y20 = b0 * rs * g2[0], y21 = b1 * rs * g2[1];
                    const f32x4 o10 = y10 * c0 - y20 * s0, o11 = y11 * c1 - y21 * s1, o20 = y20 * c0 + y10 * s0, o21 = y21 * c1 + y11 * s1;
                    u32x4 w1, w2;
                    w1.x = cvt_pk_bf16(o10[0], o10[1]); w1.y = cvt_pk_bf16(o10[2], o10[3]); w1.z = cvt_pk_bf16(o11[0], o11[1]); w1.w = cvt_pk_bf16(o11[2], o11[3]);
                    w2.x = cvt_pk_bf16(o20[0], o20[1]); w2.y = cvt_pk_bf16(o20[2], o20[3]); w2.z = cvt_pk_bf16(o21[0], o21[1]); w2.w = cvt_pk_bf16(o21[2], o21[3]);
                    bf16* op = O + (size_t)row * NIN + colb;
                    *(u32x4*)op = w1; *(u32x4*)(op + 32) = w2;
                }
        } else {
#pragma unroll
            for (int ai = 0; ai < 2; ++ai)
#pragma unroll
                for (int m = 0; m < 4; ++m) {
                    const int row = row0 + ai * 128 + m * 16;
                    bf16* op = O + (size_t)row * NIN + colb;
                    const float rx = rsqrtf(rowsq[row] * (1.f / D) + EPS);
#pragma unroll
                    for (int bj = 0; bj < 2; ++bj) { const f32x4 v0 = acc[ai][bj][m][0] * rx, v1 = acc[ai][bj][m][1] * rx; u32x4 w;
                        w.x = cvt_pk_bf16(v0[0], v0[1]); w.y = cvt_pk_bf16(v0[2], v0[3]); w.z = cvt_pk_bf16(v1[0], v1[1]); w.w = cvt_pk_bf16(v1[2], v1[3]);
                        *(u32x4*)(op + 32 * bj) = w; }
                }
        }
    }
};

__device__ __forceinline__ f32x4 bf2f_lo(unsigned a, unsigned b) { return (f32x4){__uint_as_float(a << 16), __uint_as_float(a & 0xffff0000u), __uint_as_float(b << 16), __uint_as_float(b & 0xffff0000u)}; }
struct EpiResid {
    static constexpr bool PERM = true, AFTER_DRAIN = false;
    bf16* XB; float* rowsq; float* outf;
    __device__ __forceinline__ void operator()(const f32x4 (&acc)[2][2][4][2], const Unit& u, int wr, int wc, int fr, int fq) const {
        asm volatile("" : "+v"(fr), "+v"(fq));
        const int col0 = u.pn * 256 + wc * 32 + 8 * fq, row0 = u.pm * 256 + wr * 64 + fr;
#pragma unroll
        for (int ai = 0; ai < 2; ++ai) {
            u32x4 xr[4][2];
#pragma unroll
            for (int m = 0; m < 4; ++m) { const size_t off = (size_t)(row0 + ai * 128 + m * 16) * D + col0;
#pragma unroll
                for (int bj = 0; bj < 2; ++bj) xr[m][bj] = *(const u32x4*)(XB + off + bj * 128); }
            asm volatile("" ::: "memory");
#pragma unroll
            for (int m = 0; m < 4; ++m) { const int row = row0 + ai * 128 + m * 16; const size_t off = (size_t)row * D + col0; float ss = 0.f;
#pragma unroll
                for (int bj = 0; bj < 2; ++bj) {
                    const f32x4 y0 = bf2f_lo(xr[m][bj].x, xr[m][bj].y) + acc[ai][bj][m][0], y1 = bf2f_lo(xr[m][bj].z, xr[m][bj].w) + acc[ai][bj][m][1];
                    ss += dot4(y0) + dot4(y1);
                    if (outf) { __builtin_nontemporal_store(y0, (f32x4*)(outf + off + bj * 128)); __builtin_nontemporal_store(y1, (f32x4*)(outf + off + bj * 128 + 4)); }
                    else { u32x4 w; w.x = cvt_pk_bf16(y0[0], y0[1]); w.y = cvt_pk_bf16(y0[2], y0[3]); w.z = cvt_pk_bf16(y1[0], y1[1]); w.w = cvt_pk_bf16(y1[2], y1[3]); *(u32x4*)(XB + off + bj * 128) = w; }
                }
                if (rowsq) { ss += __shfl_xor(ss, 16); ss += __shfl_xor(ss, 32); if (fq == 0) atomicAdd(rowsq + row, ss); }
            }
            asm volatile("" ::: "memory");
        }
    }
};

struct EpiUpConv {
    static constexpr bool PERM = true, AFTER_DRAIN = false;
    bf16* ACT; const float* cw; const float* cb; float* edge; float* part; LAS float* xl; const float* rowsq;
    __device__ __forceinline__ void operator()(f32x4 (&acc)[2][2][4][2], const Unit& u, int wr, int wc, int fr, int fq) const {
        asm volatile("" : "+v"(fr), "+v"(fq));
        const int lane = 16 * fq + fr;
        const int cl0 = 32 * wc + 8 * fq, ch0 = 128 * u.pn + cl0;
#pragma unroll
        for (int ai = 0; ai < 2; ++ai)
#pragma unroll
            for (int m = 0; m < 4; ++m) { const float rx = rsqrtf(rowsq[u.pm * 256 + ai * 128 + wr * 64 + m * 16 + fr] * (1.f / D) + EPS);
#pragma unroll
                for (int bj = 0; bj < 2; ++bj) { acc[ai][bj][m][0] *= rx; acc[ai][bj][m][1] *= rx; } }
#pragma unroll
        for (int ai = 0; ai < 2; ++ai) {
            const int chunk = 2 * ai + wr;
            if (fr == 0) { *(LAS f32x4*)(xl + (chunk * 2 + 0) * 128 + cl0) = acc[ai][0][0][0]; *(LAS f32x4*)(xl + (chunk * 2 + 0) * 128 + cl0 + 4) = acc[ai][0][0][1]; }
            if (fr == 15) { *(LAS f32x4*)(xl + (chunk * 2 + 1) * 128 + cl0) = acc[ai][0][3][0]; *(LAS f32x4*)(xl + (chunk * 2 + 1) * 128 + cl0 + 4) = acc[ai][0][3][1]; }
        }
        asm volatile("s_waitcnt lgkmcnt(0)" ::: "memory"); __builtin_amdgcn_s_barrier(); asm volatile("" ::: "memory");
        const int lup = (lane & ~15) | ((fr + 15) & 15), ldn = (lane & ~15) | ((fr + 1) & 15);
        const bool seq_first = (u.pm & 7) == 0, seq_last = (u.pm & 7) == 7;
#pragma unroll
        for (int ai = 0; ai < 2; ++ai) {
            const int chunk = 2 * ai + wr;
#pragma unroll
            for (int n = 0; n < 2; ++n) {
                const int ch = ch0 + 4 * n;
                const f32x4 w0 = *(const f32x4*)(cw + ch), w1 = *(const f32x4*)(cw + FF + ch), w2 = *(const f32x4*)(cw + 2 * FF + ch), bb = *(const f32x4*)(cb + ch);
                const f32x4 above = (chunk > 0) ? *(const LAS f32x4*)(xl + ((chunk - 1) * 2 + 1) * 128 + cl0 + 4 * n) : (f32x4){0.f, 0.f, 0.f, 0.f};
                const f32x4 below = (chunk < 3) ? *(const LAS f32x4*)(xl + ((chunk + 1) * 2 + 0) * 128 + cl0 + 4 * n) : (f32x4){0.f, 0.f, 0.f, 0.f};
                f32x4 Rprev = above, Lcur;
#pragma unroll
                for (int e = 0; e < 4; ++e) Lcur[e] = __shfl(acc[ai][0][0][n][e], ldn);
#pragma unroll
                for (int m = 0; m < 4; ++m) {
                    const int rt = ai * 128 + wr * 64 + m * 16 + fr;
                    const size_t row = (size_t)u.pm * 256 + rt;
                    const f32x4 cur = acc[ai][0][m][n], val = acc[ai][1][m][n];
                    f32x4 Rm, Lnext = below;
#pragma unroll
                    for (int e = 0; e < 4; ++e) { Rm[e] = __shfl(cur[e], lup); if (m < 3) Lnext[e] = __shfl(acc[ai][0][m < 3 ? m + 1 : 3][n][e], ldn); }
                    const f32x4 up = (fr == 0) ? Rprev : Rm, dn = (fr == 15) ? Lnext : Lcur;
                    Rprev = Rm; Lcur = Lnext;
                    const f32x4 pre = bb + w0 * up + w1 * cur + w2 * dn;
                    f32x4 res;
#pragma unroll
                    for (int e = 0; e < 4; ++e) res[e] = silu_f(pre[e]) * val[e];
                    if (rt == 0) {
                        *(f32x4*)(edge + ((size_t)u.pm * 2 + 0) * FF + ch) = cur;
                        if (!seq_first) { float* pp = part + (((size_t)u.pm * 2 + 0) * FF + ch) * 2;
                            *(f32x4*)pp = (f32x4){pre[0], val[0], pre[1], val[1]}; *(f32x4*)(pp + 4) = (f32x4){pre[2], val[2], pre[3], val[3]}; }
                    }
                    if (rt == 255) {
                        *(f32x4*)(edge + ((size_t)u.pm * 2 + 1) * FF + ch) = cur;
                        if (!seq_last) { float* pp = part + (((size_t)u.pm * 2 + 1) * FF + ch) * 2;
                            *(f32x4*)pp = (f32x4){pre[0], val[0], pre[1], val[1]}; *(f32x4*)(pp + 4) = (f32x4){pre[2], val[2], pre[3], val[3]}; }
                    }
                    u32x2 w; w.x = cvt_pk_bf16(res[0], res[1]); w.y = cvt_pk_bf16(res[2], res[3]);
                    *(u32x2*)(ACT + row * FF + ch) = w;
                }
            }
        }
    }
};
namespace att {
typedef __attribute__((ext_vector_type(16))) float f32x16;
typedef __attribute__((ext_vector_type(4))) short s16x4;
typedef short v4i16_t __attribute__((ext_vector_type(4)));
typedef LAS const char* lptr;
__device__ __forceinline__ s16x4 vtr(lptr p) { return __builtin_bit_cast(s16x4, __builtin_amdgcn_ds_read_tr16_b64_v4i16((LAS v4i16_t*)p)); }
typedef float f32x2_t __attribute__((ext_vector_type(2))); typedef __bf16 bf16x2_t __attribute__((ext_vector_type(2)));
__device__ __forceinline__ unsigned cvtpk_s(float lo, float hi) { f32x2_t v = {lo, hi}; bf16x2_t b = __builtin_convertvector(v, bf16x2_t); return __builtin_bit_cast(unsigned, b); }
__device__ __forceinline__ bf16x8 pack8(const f32x16& s, int b) {
    u32x4 w; w.x = cvtpk_s(s[b], s[b + 1]); w.y = cvtpk_s(s[b + 2], s[b + 3]); w.z = cvtpk_s(s[b + 4], s[b + 5]); w.w = cvtpk_s(s[b + 6], s[b + 7]);
    return __builtin_bit_cast(bf16x8, w);
}
#define MFMA32(a, b, c) __builtin_amdgcn_mfma_f32_32x32x16_bf16((a), (b), (c), 0, 0, 0)

#define LGKM_WAIT(n) asm volatile("s_waitcnt lgkmcnt(" #n ")" ::: "memory")
#define SCHED_FENCE() __builtin_amdgcn_sched_barrier(0)
__device__ __forceinline__ bf16x8 rd128(unsigned addr, int off) { bf16x8 r; asm volatile("ds_read_b128 %0, %1 offset:%c2" : "=&v"(r) : "v"(addr), "i"(off) : "memory"); return r; }
__device__ __forceinline__ s16x4 rdtr(unsigned addr, int off) { s16x4 r; asm volatile("ds_read_b64_tr_b16 %0, %1 offset:%c2" : "=&v"(r) : "v"(addr), "i"(off) : "memory"); return r; }
#define VFRAG(lo, hh) ((bf16x8){lo[0], lo[1], lo[2], lo[3], hh[0], hh[1], hh[2], hh[3]})
constexpr int KROW = 144, VROWD = 320, VROWA = 192;
constexpr int DSTG = 2 * 64 * KROW + 64 * VROWD;
constexpr int ASTG = 64 * KROW + 64 * VROWA;

constexpr int DST3 = 32768;
#define SGB(mask, n) __builtin_amdgcn_sched_group_barrier((mask), (n), 0)
__device__ __forceinline__ void diff_unit(LAS char* lds, const bf16* __restrict__ QKV, bf16* __restrict__ Y, int b, int h, int qb, float Mb, float lam, const float* __restrict__ subln, float outscale) {
    int tid = threadIdx.x; asm volatile("" : "+v"(tid)); const int lane = tid & 63, w = __builtin_amdgcn_readfirstlane(tid >> 6), q = lane & 31, hi = lane >> 5;
    const int rg = w >> 1, c = w & 1;
    const size_t rowQ = (size_t)b * S + qb * 128 + rg * 32 + q;
    const bf16* qp = QKV + rowQ * NIN + 768 + (2 * h + c) * 64 + hi * 8;
    bf16x8 qf[4];
#pragma unroll
    for (int ds = 0; ds < 4; ++ds) qf[ds] = *(const bf16x8*)(qp + ds * 16);
    const int krow = 8 * w + (lane >> 3), kch = (lane & 7) ^ ((krow >> 1) & 7);
    const int vrow = 4 * w + (lane >> 4), vch = (lane & 15) ^ ((vrow & 3) << 2);
    const bf16* kg = QKV + ((size_t)b * S + krow) * NIN + 1280 + 128 * h + kch * 8;
    const bf16* vg = QKV + ((size_t)b * S + vrow) * NIN + 1792 + 128 * h + vch * 8;
#define DDMA(t, so) do { const size_t o_ = (size_t)(t) * 64 * NIN; LAS unsigned char* d_ = (LAS unsigned char*)lds + (so) + w * 1024; \
        __builtin_amdgcn_global_load_lds((const unsigned*)(kg + o_), (LAS unsigned*)(d_), 16, 0, 0); \
        __builtin_amdgcn_global_load_lds((const unsigned*)(kg + o_ + 64), (LAS unsigned*)(d_ + 8192), 16, 0, 0); \
        __builtin_amdgcn_global_load_lds((const unsigned*)(vg + o_), (LAS unsigned*)(d_ + 16384), 16, 0, 0); \
        __builtin_amdgcn_global_load_lds((const unsigned*)(vg + o_ + 32 * NIN), (LAS unsigned*)(d_ + 16384 + 8192), 16, 0, 0); } while (0)
    f32x16 o[4];
#pragma unroll
    for (int i = 0; i < 4; ++i) o[i] = (f32x16){0.f};
    float l = 0.f;
    constexpr int NT = S / 64;
    DDMA(0, 0); DDMA(1, DST3); DDMA(2, 2 * DST3);
    const unsigned lbase = (unsigned)(size_t)lds;
    unsigned kofs[4], vofs[4];
    { const int sw = (q >> 1) & 7, vq = (lane & 15) >> 2;
#pragma unroll
      for (int ds = 0; ds < 4; ++ds) kofs[ds] = (unsigned)(c * 8192 + q * 128 + (((2 * ds + hi) ^ sw) << 4));
#pragma unroll
      for (int db = 0; db < 4; ++db) vofs[db] = (unsigned)(16384 + (4 * hi + vq) * 256 + ((db ^ vq) << 6) + ((lane >> 4) & 1) * 32 + (lane & 3) * 8); }
    f32x16 negm;
#pragma unroll
    for (int r = 0; r < 16; ++r) negm[r] = -Mb;
    f32x16 s0, s1;
    { asm volatile("s_waitcnt vmcnt(8)" ::: "memory"); __builtin_amdgcn_s_barrier(); asm volatile("" ::: "memory");
      bf16x8 kf[8];
#pragma unroll
      for (int ds = 0; ds < 4; ++ds) { kf[2 * ds] = rd128(lbase + kofs[ds], 0); kf[2 * ds + 1] = rd128(lbase + kofs[ds], 32 * 128); }
      LGKM_WAIT(0); SCHED_FENCE();
      s0 = negm; s1 = negm;
#pragma unroll
      for (int ds = 0; ds < 4; ++ds) { s0 = MFMA32(kf[2 * ds], qf[ds], s0); s1 = MFMA32(kf[2 * ds + 1], qf[ds], s1); }
      SCHED_FENCE(); }
    int so_cur = 0, so_n1 = DST3, so_n3 = 3 * DST3;
    for (int t = 0; t < NT; ++t) {
        asm volatile("s_waitcnt vmcnt(4)" ::: "memory");
        __builtin_amdgcn_s_barrier();
        asm volatile("" ::: "memory");
        { const int tn = (t + 3 < NT) ? t + 3 : NT - 1; DDMA(tn, so_n3); }
        const unsigned sb = lbase + so_cur, sn = lbase + so_n1;
        bf16x8 kf[8];
#pragma unroll
        for (int ds = 0; ds < 4; ++ds) { kf[2 * ds] = rd128(sn + kofs[ds], 0); kf[2 * ds + 1] = rd128(sn + kofs[ds], 32 * 128); }
        s16x4 vl[2][4], vh[2][4];
#pragma unroll
        for (int db = 0; db < 4; ++db) { vl[0][db] = rdtr(sb + vofs[db], 0); vh[0][db] = rdtr(sb + vofs[db], 8 * 256); }
        LGKM_WAIT(0); SCHED_FENCE();
        __builtin_amdgcn_s_setprio(1);
        f32x16 n0 = negm, n1 = negm;
#pragma unroll
        for (int ds = 0; ds < 4; ++ds) { n0 = MFMA32(kf[2 * ds], qf[ds], n0); n1 = MFMA32(kf[2 * ds + 1], qf[ds], n1); }
        float ls = 0.f;
#pragma unroll
        for (int r = 0; r < 16; ++r) { s0[r] = __builtin_amdgcn_exp2f(s0[r]); ls += s0[r]; }
        bf16x8 pf[4]; pf[0] = pack8(s0, 0); pf[1] = pack8(s0, 8);
#pragma unroll
        for (int i = 0; i < 8; ++i) { SGB(0x008, 1); SGB(0x400, 2); SGB(0x002, 3); }
        SCHED_FENCE();
        __builtin_amdgcn_s_setprio(0);
#pragma unroll
        for (int db = 0; db < 4; ++db) { vl[1][db] = rdtr(sb + vofs[db], 16 * 256); vh[1][db] = rdtr(sb + vofs[db], 16 * 256 + 8 * 256); }
        s16x4 wl[2][4], wh[2][4];
#pragma unroll
        for (int ks = 0; ks < 2; ++ks)
#pragma unroll
            for (int db = 0; db < 4; ++db) { wl[ks][db] = rdtr(sb + vofs[db], (ks + 2) * 16 * 256); wh[ks][db] = rdtr(sb + vofs[db], (ks + 2) * 16 * 256 + 8 * 256); }
        LGKM_WAIT(15); SCHED_FENCE();
        __builtin_amdgcn_s_setprio(1);
#pragma unroll
        for (int ks = 0; ks < 2; ++ks)
#pragma unroll
            for (int db = 0; db < 4; ++db) o[db] = MFMA32(VFRAG(vl[ks][db], vh[ks][db]), pf[ks], o[db]);
#pragma unroll
        for (int r = 0; r < 16; ++r) { s1[r] = __builtin_amdgcn_exp2f(s1[r]); ls += s1[r]; }
        l += ls;
        pf[2] = pack8(s1, 0); pf[3] = pack8(s1, 8);
#pragma unroll
        for (int i = 0; i < 8; ++i) { SGB(0x008, 1); SGB(0x400, 2); SGB(0x002, 3); }
        SCHED_FENCE();
        LGKM_WAIT(0); SCHED_FENCE();
#pragma unroll
        for (int ks = 0; ks < 2; ++ks)
#pragma unroll
            for (int db = 0; db < 4; ++db) o[db] = MFMA32(VFRAG(wl[ks][db], wh[ks][db]), pf[2 + ks], o[db]);
        SCHED_FENCE();
        __builtin_amdgcn_s_setprio(0);
        s0 = n0; s1 = n1;
        so_cur = so_n1; so_n1 = (so_n1 == 3 * DST3) ? 0 : so_n1 + DST3; so_n3 = (so_n3 == 3 * DST3) ? 0 : so_n3 + DST3;
    }
#undef DDMA
    asm volatile("s_waitcnt vmcnt(0)" ::: "memory");
    __syncthreads();
    l += __shfl_xor(l, 32);
    const float inv = 1.f / l;
    LAS f32x4* xb = (LAS f32x4*)lds + rg * (16 * 64) + lane;
    if (c == 1) {
#pragma unroll
        for (int db = 0; db < 4; ++db)
#pragma unroll
            for (int r4 = 0; r4 < 4; ++r4) xb[(db * 4 + r4) * 64] = (f32x4){o[db][4 * r4], o[db][4 * r4 + 1], o[db][4 * r4 + 2], o[db][4 * r4 + 3]} * inv;
    }
    __syncthreads();
    if (c == 0) {
        float ss = 0.f;
#pragma unroll
        for (int db = 0; db < 4; ++db)
#pragma unroll
            for (int r4 = 0; r4 < 4; ++r4) { const f32x4 ot = xb[(db * 4 + r4) * 64];
#pragma unroll
                for (int e = 0; e < 4; ++e) { const float d = o[db][4 * r4 + e] * inv - lam * ot[e]; o[db][4 * r4 + e] = d; ss += d * d; } }
        ss += __shfl_xor(ss, 32);
        const float rs = rsqrtf(ss * (1.f / 128.f) + EPS) * outscale;
        bf16* yp = Y + rowQ * D + 512 + 128 * h + 4 * hi;
#pragma unroll
        for (int db = 0; db < 4; ++db)
#pragma unroll
            for (int r4 = 0; r4 < 4; ++r4) { const f32x4 gw = *(const f32x4*)(subln + 32 * db + 8 * r4 + 4 * hi);
                u32x2 wv; wv.x = cvt_pk_bf16(o[db][4 * r4] * rs * gw[0], o[db][4 * r4 + 1] * rs * gw[1]); wv.y = cvt_pk_bf16(o[db][4 * r4 + 2] * rs * gw[2], o[db][4 * r4 + 3] * rs * gw[3]);
                *(u32x2*)(yp + 32 * db + 8 * r4) = wv; }
    }
    __syncthreads();
}

__device__ __forceinline__ void swa_unit(LAS char* lds, const bf16* __restrict__ QKV, bf16* __restrict__ Y, int b, int kvh, int n, float Mb, const float* __restrict__ sink) {
    int tid = threadIdx.x; asm volatile("" : "+v"(tid)); const int lane = tid & 63, w = __builtin_amdgcn_readfirstlane(tid >> 6), q = lane & 31, hi = lane >> 5;
    const int head = kvh * 4 + (w >> 1), rb = (w & 1) * 64;
    const size_t rowQ = (size_t)b * S + n * 128 + rb + q;
    bf16x8 qf[2][4];
#pragma unroll
    for (int rg = 0; rg < 2; ++rg)
#pragma unroll
        for (int ds = 0; ds < 4; ++ds) qf[rg][ds] = *(const bf16x8*)(QKV + (rowQ + 32 * rg) * NIN + head * 64 + hi * 8 + ds * 16);
    const int lrow = tid >> 3, lcc = tid & 7;
    const long kp0 = (long)b * S + (long)(n - 1) * 128 + lrow;
    const bf16* kg = QKV + kp0 * NIN + 512 + kvh * 64 + lcc * 8;
    const bf16* vg = QKV + kp0 * NIN + 640 + kvh * 64 + lcc * 8;
    const int kdst = lrow * KROW + lcc * 16, vdst = 64 * KROW + lrow * VROWA + lcc * 16;
    u32x4 st0, st1;
#define ALOAD(t) do { const long o_ = (long)(t) * 64 * NIN; st0 = *(const u32x4*)(kg + o_); st1 = *(const u32x4*)(vg + o_); } while (0)
#define ASTORE(bo) do { *(LAS u32x4*)(lds + (bo) + kdst) = st0; *(LAS u32x4*)(lds + (bo) + vdst) = st1; } while (0)
    f32x16 o[2][2];
#pragma unroll
    for (int i = 0; i < 2; ++i)
#pragma unroll
        for (int j = 0; j < 2; ++j) o[i][j] = (f32x16){0.f};
    float l[2] = {0.f, 0.f};
    const int t0 = (n == 0) ? 2 : 0, t1 = (n == S / 128 - 1) ? 4 : 6;
    ALOAD(t0); ASTORE((t0 & 1) * ASTG); __syncthreads();
    const int koff = q * KROW + hi * 16;
    const int voff = 64 * KROW + (4 * hi + ((lane & 15) >> 2)) * VROWA + ((lane >> 4) & 1) * 32 + (lane & 3) * 8;
    const unsigned lbase = (unsigned)(size_t)lds;
    for (int t = t0; t < t1; ++t) {
        const int cur = (t & 1) * ASTG, nxt = ASTG - cur;
        if (t + 1 < t1) ALOAD(t + 1);
        const unsigned ka = lbase + cur + koff, va = lbase + cur + voff;
        bf16x8 kf[8];
#pragma unroll
        for (int ds = 0; ds < 4; ++ds) { kf[2 * ds] = rd128(ka, ds * 32); kf[2 * ds + 1] = rd128(ka, 32 * KROW + ds * 32); }
        s16x4 vl[4][2], vh[4][2];
#pragma unroll
        for (int ks = 0; ks < 4; ++ks)
#pragma unroll
            for (int db = 0; db < 2; ++db) { vl[ks][db] = rdtr(va, ks * 16 * VROWA + db * 64); vh[ks][db] = rdtr(va, ks * 16 * VROWA + 8 * VROWA + db * 64); }
        LGKM_WAIT(0); SCHED_FENCE();
#pragma unroll
        for (int rg = 0; rg < 2; ++rg) {
            const int i0 = rb + 32 * rg;
            if (64 * t + 63 >= i0 && 64 * t <= i0 + 31 + 256) {
                f32x16 s0 = (f32x16){0.f}, s1 = (f32x16){0.f};
#pragma unroll
                for (int ds = 0; ds < 4; ++ds) { s0 = MFMA32(kf[2 * ds], qf[rg][ds], s0); s1 = MFMA32(kf[2 * ds + 1], qf[rg][ds], s1); }
                const int jb = 64 * t + 4 * hi - (i0 + q);
                float ls = 0.f;
#pragma unroll
                for (int r = 0; r < 16; ++r) {
                    const int d0 = jb + (r & 3) + 8 * (r >> 2), d1 = d0 + 32;
                    const float p0 = __builtin_amdgcn_exp2f(s0[r] - Mb), p1 = __builtin_amdgcn_exp2f(s1[r] - Mb);
                    s0[r] = ((unsigned)d0 <= 256u) ? p0 : 0.f; s1[r] = ((unsigned)d1 <= 256u) ? p1 : 0.f; ls += s0[r] + s1[r];
                }
                l[rg] += ls;
                bf16x8 pf[4]; pf[0] = pack8(s0, 0); pf[1] = pack8(s0, 8); pf[2] = pack8(s1, 0); pf[3] = pack8(s1, 8);
#pragma unroll
                for (int ks = 0; ks < 4; ++ks)
#pragma unroll
                    for (int db = 0; db < 2; ++db) o[rg][db] = MFMA32(VFRAG(vl[ks][db], vh[ks][db]), pf[ks], o[rg][db]);
            }
        }
        SCHED_FENCE();
        if (t + 1 < t1) ASTORE(nxt);
        __syncthreads();
    }
#undef ALOAD
#undef ASTORE
    const float sk = __builtin_amdgcn_exp2f(sink[head] * LOG2E - Mb);
#pragma unroll
    for (int rg = 0; rg < 2; ++rg) {
        float lt = l[rg]; lt += __shfl_xor(lt, 32);
        const float inv = 1.f / (lt + sk);
        bf16* yp = Y + (rowQ + 32 * rg) * D + head * 64 + 4 * hi;
#pragma unroll
        for (int db = 0; db < 2; ++db)
#pragma unroll
            for (int r4 = 0; r4 < 4; ++r4) { u32x2 wv; wv.x = cvt_pk_bf16(o[rg][db][4 * r4] * inv, o[rg][db][4 * r4 + 1] * inv); wv.y = cvt_pk_bf16(o[rg][db][4 * r4 + 2] * inv, o[rg][db][4 * r4 + 3] * inv);
                *(u32x2*)(yp + 32 * db + 8 * r4) = wv; }
    }
}
}
constexpr size_t MiB = 1u << 20;
constexpr size_t WS_CTL = 0, CTL_BYTES = 65536 + 4 * 65536;
constexpr size_t WS_ROWSQ = 65536;
constexpr int MISC_OFF = 131072 + 4096;
constexpr size_t WS_ROPE = 1 * MiB;
constexpr size_t WS_W = 2 * MiB, W_LAYER = 23 * MiB;
constexpr size_t W_IN = 0, W_OUT = (size_t)NIN * D * 2, W_UP = W_OUT + (size_t)D * D * 2, W_DOWN = W_UP + (size_t)NUP * D * 2;
static_assert(W_DOWN + (size_t)D * FF * 2 <= W_LAYER, "weights");
constexpr size_t WS_H = 48 * MiB;
constexpr size_t WS_QKV = 80 * MiB;
constexpr size_t WS_Y = 152 * MiB;
constexpr size_t WS_ACT = 80 * MiB;
constexpr size_t WS_EDGE = 184 * MiB;
constexpr size_t WS_PART = 186 * MiB;
constexpr size_t WS_END = 190 * MiB;
static_assert(WS_ACT + (size_t)M * FF * 2 <= WS_EDGE && WS_QKV + (size_t)M * NIN * 2 <= WS_Y && WS_Y + (size_t)M * D * 2 <= WS_EDGE, "ws map");

#ifndef REP_P0
#define REP_P0 1
#endif
#ifndef REP_P1
#define REP_P1 1
#endif
#ifndef REP_P3B
#define REP_P3B 1
#endif
#ifndef REP_P4
#define REP_P4 1
#endif
#ifndef ATT_REP
#define ATT_REP 1
#endif
#ifndef REP_P5
#define REP_P5 1
#endif
#ifndef REP_P3
#define REP_P3 1
#endif
#ifndef REP_SYNC
#define REP_SYNC 1
#endif
struct Args {
    const float *x, *g_attn, *w_in, *qn_a, *kn_a, *sink, *qn_b, *kn_b, *lq1, *lk1, *lq2, *lk2, *subln, *w_out, *g_ffn, *w_up, *conv_w, *conv_b, *w_down;
    float* out; unsigned char* ws;
};

__device__ __forceinline__ float wave_sum(float v) {
#pragma unroll
    for (int o = 1; o < 64; o <<= 1) v += __shfl_xor(v, o);
    return v;
}
__device__ __forceinline__ float uniform_f(float v) { return __uint_as_float(__builtin_amdgcn_readfirstlane(__float_as_uint(v))); }
__device__ __forceinline__ float wave_max(float v) {
#pragma unroll
    for (int o = 1; o < 64; o <<= 1) v = fmaxf(v, __shfl_xor(v, o));
    return v;
}
__device__ __forceinline__ unsigned f2bf(float f) { unsigned u = __builtin_bit_cast(unsigned, f); return (u + 0x7fffu + ((u >> 16) & 1u)) >> 16; }
__device__ __forceinline__ unsigned pk2(float lo, float hi) { return f2bf(lo) | (f2bf(hi) << 16); }

__device__ __forceinline__ void transpose_item(const float* __restrict__ W, int K, int N, bf16* __restrict__ WT, LAS float* scr, int kb, int nb, int dnb, int lane, const float* __restrict__ g) {
    const int k0 = 64 * kb, n0 = 32 * nb;
#pragma unroll 8
    for (int i = 0; i < 32; ++i) { const int kk = 2 * i + (lane >> 5); scr[kk * 33 + (lane & 31)] = __builtin_nontemporal_load(&W[(size_t)(k0 + kk) * N + n0 + (lane & 31)]) * (g ? g[k0 + kk] : 1.f); }
    asm volatile("s_waitcnt lgkmcnt(0)" ::: "memory");
    const int c = lane & 7;
#pragma unroll
    for (int j = 0; j < 4; ++j) { const int n = (lane >> 3) + 8 * j; const LAS float* s = scr + (8 * c) * 33 + n;
        u32x4 o; o.x = pk2(s[0 * 33], s[1 * 33]); o.y = pk2(s[2 * 33], s[3 * 33]); o.z = pk2(s[4 * 33], s[5 * 33]); o.w = pk2(s[6 * 33], s[7 * 33]);
        *(u32x4*)(WT + (size_t)(32 * dnb + n) * K + k0 + 8 * c) = o; }
    asm volatile("s_waitcnt lgkmcnt(0)" ::: "memory");
}

__device__ __forceinline__ void convert_rows(const float* __restrict__ x, bf16* __restrict__ out, float* __restrict__ rowsq, int gw, int ngw, int lane) {
    for (int m = gw; m < M; m += ngw) {
        const f32x4* xr = (const f32x4*)(x + (size_t)m * D) + lane; f32x4 v[4]; float s = 0.f;
#pragma unroll
        for (int j = 0; j < 4; ++j) { v[j] = __builtin_nontemporal_load(&xr[64 * j]); s += dot4(v[j]); }
        s = wave_sum(s);
        if (lane == 0) rowsq[m] = s;
        u32x2* o8 = (u32x2*)(out + (size_t)m * D) + lane;
#pragma unroll
        for (int j = 0; j < 4; ++j) { u32x2 wv; wv.x = pk2(v[j][0], v[j][1]); wv.y = pk2(v[j][2], v[j][3]); o8[64 * j] = wv; }
    }
}

#define XB_TMO      128
#define XB_XCNT(j)  (256  + 64 * (j))
#define XB_XSUB(j)  (1280 + 64 * (j))
#define XB_XGEN(j)  (2304 + 64 * (j))
#define XB_TOP      3328
#define XB_TOPGEN   3392
#define XCD_BAR_WORDS 3456
#define XB_SPIN_CAP (1u << 18)

__device__ __forceinline__ unsigned xb_ld(unsigned* p)              { return __hip_atomic_load(p, __ATOMIC_RELAXED, __HIP_MEMORY_SCOPE_AGENT); }
__device__ __forceinline__ unsigned xb_add(unsigned* p, unsigned v) { return __hip_atomic_fetch_add(p, v, __ATOMIC_RELAXED, __HIP_MEMORY_SCOPE_AGENT); }
__device__ __forceinline__ unsigned xb_xcc_id() { return (unsigned)__builtin_amdgcn_s_getreg((3 << 11) | 20) & 0xFu; }
#define XB_SPIN(cond, bar) do { unsigned _sp = 0; while (cond) { __builtin_amdgcn_s_sleep(0); \
    if ((++_sp & 255u) == 0u) { if (xb_ld(&(bar)[XB_TMO])) break; if (_sp > XB_SPIN_CAP) { atomicAdd(&(bar)[XB_TMO], 1u); break; } } } } while (0)

struct XcdBarrier {
    unsigned* bar; unsigned x;
    volatile LAS unsigned* st;
};

__device__ __forceinline__ XcdBarrier xcd_barrier_post(unsigned* bar, volatile LAS unsigned* st) {
    XcdBarrier b; b.bar = bar; b.x = xb_xcc_id(); b.st = st;
    if (threadIdx.x == 0) (void)xb_add(&bar[XB_XCNT(b.x)], 1u);
    return b;
}
__device__ __forceinline__ void xcd_barrier_complete(unsigned* bar, unsigned x, unsigned& nloc, unsigned& nx) {
    const unsigned G = gridDim.x * gridDim.y * gridDim.z;
    unsigned sum, cnt, mine, sp = 0u;
    for (;;) {
        sum = 0u; cnt = 0u; mine = 0u;
#pragma unroll
        for (unsigned j = 0; j < 16; ++j) { const unsigned c = xb_ld(&bar[XB_XCNT(j)]); sum += c; cnt += (c > 0u) ? 1u : 0u; mine = (j == x) ? c : mine; }
        if (sum == G) break;
        __builtin_amdgcn_s_sleep(1);
        if ((++sp & 255u) == 0u) { if (xb_ld(&bar[XB_TMO])) break; if (sp > XB_SPIN_CAP) { atomicAdd(&bar[XB_TMO], 1u); break; } }
    }
    nloc = mine > 0u ? mine : 1u; nx = cnt > 0u ? cnt : 1u;
}

__device__ __forceinline__ void xcd_barrier(const XcdBarrier& b) {
    asm volatile("s_waitcnt vmcnt(0)" ::: "memory");
    __syncthreads();
    if (threadIdx.x == 0) {
        unsigned* bar = b.bar;
        __builtin_amdgcn_s_waitcnt(0);
        unsigned nloc = b.st[0], nx = b.st[1];
        if (nloc == 0u) { xcd_barrier_complete(bar, b.x, nloc, nx); b.st[0] = nloc; b.st[1] = nx; }
        const unsigned old = xb_add(&bar[XB_XSUB(b.x)], 1u);
        const unsigned gen = old / nloc;
        if (old + 1u == (gen + 1u) * nloc) {
            __builtin_amdgcn_fence(__ATOMIC_RELEASE, "agent");
            asm volatile("s_waitcnt vmcnt(0)" ::: "memory");
            const unsigned og = xb_add(&bar[XB_TOP], 1u);
            const unsigned tg = og / nx;
            if (og + 1u == (tg + 1u) * nx) xb_add(&bar[XB_TOPGEN], 1u);
            else XB_SPIN(xb_ld(&bar[XB_TOPGEN]) == tg, bar);
            __builtin_amdgcn_fence(__ATOMIC_ACQUIRE, "agent");
            xb_add(&bar[XB_XGEN(b.x)], 1u);
            asm volatile("s_waitcnt vmcnt(0)" ::: "memory");
        } else {
            XB_SPIN(xb_ld(&bar[XB_XGEN(b.x)]) == gen, bar);
            __builtin_amdgcn_fence(__ATOMIC_ACQUIRE, "agent");
            asm volatile("s_waitcnt vmcnt(0)" ::: "memory");
        }
    }
    __syncthreads();
}

__global__ void __launch_bounds__(512, 2) mega_fwd(Args a) {
    extern __shared__ __attribute__((aligned(16))) unsigned char lds_raw[];
    LAS unsigned char* lds = (LAS unsigned char*)lds_raw;
    cg::grid_group grid = cg::this_grid();
    const int tid = threadIdx.x, lane = tid & 63, wave = __builtin_amdgcn_readfirstlane(tid >> 6);
    const int G = gridDim.x, bx = blockIdx.x;
    const int vcu = (G % 8 == 0) ? (bx % 8) * (G / 8) + bx / 8 : bx;
    const int gw = vcu * 8 + wave, ngw = G * 8;
    typedef const __attribute__((address_space(4))) Args* kargs_t;
    const kargs_t kap = (kargs_t)__builtin_amdgcn_kernarg_segment_ptr();
#define PHASE_ARGS() kargs_t ap = kap; asm volatile("" : "+s"(ap)); unsigned char* const ws = ap->ws; \
    float* const cosT = (float*)(ws + WS_ROPE); float* const sinT = cosT + S * 32; \
    bf16* const Hb = (bf16*)(ws + WS_H); bf16* const QKV = (bf16*)(ws + WS_QKV); bf16* const Yb = (bf16*)(ws + WS_Y); bf16* const ACT = (bf16*)(ws + WS_ACT); \
    float* const edge = (float*)(ws + WS_EDGE); float* const part = (float*)(ws + WS_PART); float* const rowsq = (float*)(ws + WS_ROWSQ); \
    (void)cosT; (void)sinT; (void)Hb; (void)QKV; (void)Yb; (void)ACT; (void)edge; (void)part; (void)rowsq
    volatile LAS unsigned* misc = (volatile LAS unsigned*)(lds + MISC_OFF);
    if (tid < 16) misc[tid] = 0u;
    __syncthreads();

#define CONVERT_WEIGHTS(L, wv, nwv) do { \
        int lane = threadIdx.x & 63; asm volatile("" : "+v"(lane)); \
        LAS float* scr = (LAS float*)(lds + wave * 16384); \
        constexpr int I_IN = 16 * 72, I_OUT = 16 * 32, I_UP = 16 * 176, I_DOWN = 44 * 32, I_L = I_IN + I_OUT + I_UP + I_DOWN; \
        unsigned char* wl_ = ws + WS_W + (size_t)(L) * W_LAYER; \
        for (int it = (wv); it < I_L; it += (nwv)) { \
            int r = it; \
            if (r < I_IN) { const int kb = r / 72, nb = r % 72; const int pn = nb >> 3, wc = (nb >> 1) & 3, bj = nb & 1; \
                transpose_item(ap->w_in + (size_t)(L) * D * NIN, D, NIN, (bf16*)(wl_ + W_IN), scr, kb, nb, 8 * pn + 4 * bj + wc, lane, ap->g_attn + (L) * D); continue; } \
            r -= I_IN; \
            if (r < I_OUT) { const int kb = r / 32, nb = r % 32; transpose_item(ap->w_out + (size_t)(L) * D * D, D, D, (bf16*)(wl_ + W_OUT), scr, kb, nb, nb, lane, nullptr); continue; } \
            r -= I_OUT; \
            if (r < I_UP) { const int kb = r / 176, nb = r % 176; const int isv = nb >= 88, nn = isv ? nb - 88 : nb; const int dnb = 8 * (nn >> 2) + 4 * isv + (nn & 3); \
                transpose_item(ap->w_up + (size_t)(L) * D * NUP, D, NUP, (bf16*)(wl_ + W_UP), scr, kb, nb, dnb, lane, ap->g_ffn + (L) * D); continue; } \
            r -= I_UP; \
            { const int kb = r / 32, nb = r % 32; transpose_item(ap->w_down + (size_t)(L) * FF * D, FF, D, (bf16*)(wl_ + W_DOWN), scr, kb, nb, nb, lane, nullptr); } \
        } } while (0)
    {
        PHASE_ARGS();
        CONVERT_WEIGHTS(0, gw, ngw);
        for (int i = vcu * 512 + tid; i < S * 32; i += G * 512) {
            const int pos = i >> 5, j = i & 31;
            double inv = 1.0; for (int k = 0; k < j; ++k) inv *= 0.74989420933245582730;
            const double ang = (double)pos * inv;
            const double kq = __builtin_rint(ang * 0.15915494309189533577);
            const double rr = (ang - kq * 6.283185307179586232) - kq * 2.4492935982947064e-16;
            const double r2 = rr * rr;
            double sn = 1.0, cs = 1.0;
#pragma unroll
            for (int k = 12; k >= 1; --k) { sn = 1.0 - sn * r2 * (1.0 / (double)((2 * k) * (2 * k + 1))); cs = 1.0 - cs * r2 * (1.0 / (double)((2 * k - 1) * (2 * k))); }
            cosT[i] = (float)cs; sinT[i] = (float)(sn * rr);
        }
        for (int i = vcu * 512 + tid; i < (int)(CTL_BYTES / 16); i += G * 512) { const size_t off = (size_t)i * 16;
            if (off < WS_ROWSQ || off >= WS_ROWSQ + (size_t)M * 4) *(u32x4*)(ws + WS_CTL + off) = (u32x4){0u, 0u, 0u, 0u}; }
        convert_rows(ap->x, Hb, rowsq, gw, ngw, lane);
    }
    asm volatile("s_waitcnt vmcnt(0)" ::: "memory");
    __syncthreads();
    if (tid == 0) { __builtin_amdgcn_fence(__ATOMIC_RELEASE, "agent"); asm volatile("s_waitcnt vmcnt(0)" ::: "memory"); }
    grid.sync();
    if (tid == 0) { __builtin_amdgcn_fence(__ATOMIC_ACQUIRE, "agent"); asm volatile("s_waitcnt vmcnt(0)" ::: "memory"); }
    __syncthreads();
    XcdBarrier xbar; { PHASE_ARGS(); xbar = xcd_barrier_post((unsigned*)(ws + WS_CTL) + 1024, misc); }

    for (int l = 0; l < DEPTH; ++l) {
        const float lambda_init = 0.8f - 0.6f * __expf(-0.3f * (float)l);
        {
            PHASE_ARGS(); unsigned char* const wl = ws + WS_W + (size_t)l * W_LAYER; (void)wl;
            pg8::Gemm g{Hb, (const bf16*)(wl + W_IN), M, NIN, D}; pg8::StaticOrder So; So.init(M, NIN, G, bx);
            EpiInProj E{QKV, ap->qn_a + l * 64, ap->kn_a + l * 64, ap->qn_b + l * 64, ap->kn_b + l * 64, cosT, sinT, rowsq + (size_t)(2 * l) * M};
            pg8::gemm_phase<EpiInProj, pg8::StaticOrder, true, true>(lds, g, So, E);
            if (l == 0 && DEPTH > 1) {
                const int nidle = G - 64;
                if (nidle >= 64) { if (bx >= 64) CONVERT_WEIGHTS(1, (bx - 64) * 8 + wave, nidle * 8); }
                else CONVERT_WEIGHTS(1, gw, ngw);
            }
        }
        xcd_barrier(xbar);
        {
            PHASE_ARGS(); unsigned char* const wl = ws + WS_W + (size_t)l * W_LAYER; (void)wl;
            int lane = threadIdx.x & 63; asm volatile("" : "+v"(lane));
            const float mqa = wave_max(fabsf(ap->qn_a[l * 64 + lane])), mka = wave_max(fabsf(ap->kn_a[l * 64 + lane]));
            const float mqb = wave_max(fabsf(ap->qn_b[l * 64 + lane])), mkb = wave_max(fabsf(ap->kn_b[l * 64 + lane]));
            const float MbA = uniform_f(8.f * mqa * mka * LOG2E * 1.02f), MbB = uniform_f(8.f * mqb * mkb * LOG2E * 1.02f);
            const float s1 = wave_sum(ap->lq1[l * 64 + lane] * ap->lk1[l * 64 + lane]), s2 = wave_sum(ap->lq2[l * 64 + lane] * ap->lk2[l * 64 + lane]);
            const float lam = uniform_f(__expf(s1) - __expf(s2) + lambda_init);
            {
            for (int uidx = vcu; uidx < NB * 4 * 16; uidx += G) {
                const int bh = uidx >> 4, qb = uidx & 15;
                att::diff_unit((LAS char*)lds, QKV, Yb, bh >> 2, bh & 3, qb, MbB, lam, ap->subln + l * 128, 1.f - lambda_init);
            }
            for (int uidx = vcu; uidx < NB * 2 * 16; uidx += G) {
                const int bk = uidx >> 4, n = uidx & 15;
                att::swa_unit((LAS char*)lds, QKV, Yb, bk >> 1, bk & 1, n, MbA, ap->sink + l * 8);
            }
            __syncthreads();
            }
        }
        xcd_barrier(xbar);
        {
            PHASE_ARGS(); unsigned char* const wl = ws + WS_W + (size_t)l * W_LAYER; (void)wl;
            pg8::Gemm g{Yb, (const bf16*)(wl + W_OUT), M, D, D}; pg8::StaticOrder So; So.init(M, D, G, bx);
            EpiResid E{Hb, rowsq + (size_t)(2 * l + 1) * M, nullptr};
            pg8::gemm_phase<EpiResid, pg8::StaticOrder, true, true>(lds, g, So, E);
        }
        xcd_barrier(xbar);
        {
            PHASE_ARGS(); unsigned char* const wl = ws + WS_W + (size_t)l * W_LAYER; (void)wl;
            pg8::Gemm g{Hb, (const bf16*)(wl + W_UP), M, NUP, D}; pg8::StaticOrder So; So.init(M, NUP, G, bx);
            EpiUpConv E{ACT, ap->conv_w + (size_t)l * 3 * FF, ap->conv_b + (size_t)l * FF, edge, part, (LAS float*)(lds + XL_OFF), rowsq + (size_t)(2 * l + 1) * M};
            pg8::gemm_phase<EpiUpConv, pg8::StaticOrder, true, true>(lds, g, So, E);
        }
        xcd_barrier(xbar);
        {
            PHASE_ARGS(); unsigned char* const wl = ws + WS_W + (size_t)l * W_LAYER; (void)wl;
            pg8::Gemm g{ACT, (const bf16*)(wl + W_DOWN), M, D, FF}; pg8::StaticOrder So; So.init(M, D, G, bx);
            { const float* cw = ap->conv_w + (size_t)l * 3 * FF; pg8::Unit uu; int tid = threadIdx.x; asm volatile("" : "+v"(tid));
              for (int ui = 0; So.next(ui, uu); ++ui) { const int pm = uu.pm;
                for (int i = tid; i < 2 * FF; i += 512) { const int which = i / FF, ch = i % FF;
                    if (which == 0 && (pm & 7) != 0) { const float* pp = part + (((size_t)pm * 2 + 0) * FF + ch) * 2;
                        const float pre = pp[0] + cw[ch] * edge[((size_t)(pm - 1) * 2 + 1) * FF + ch];
                        ACT[(size_t)(pm * 256) * FF + ch] = (bf16)f2bf(silu_f(pre) * pp[1]); }
                    if (which == 1 && (pm & 7) != 7) { const float* pp = part + (((size_t)pm * 2 + 1) * FF + ch) * 2;
                        const float pre = pp[0] + cw[2 * FF + ch] * edge[((size_t)(pm + 1) * 2 + 0) * FF + ch];
                        ACT[(size_t)(pm * 256 + 255) * FF + ch] = (bf16)f2bf(silu_f(pre) * pp[1]); } } }
              asm volatile("s_waitcnt vmcnt(0)" ::: "memory"); __syncthreads(); }
            const bool lastl = (l + 1 == DEPTH);
            EpiResid E{Hb, lastl ? nullptr : rowsq + (size_t)(2 * l + 2) * M, lastl ? ap->out : nullptr};
            pg8::gemm_phase<EpiResid, pg8::StaticOrder, true, true>(lds, g, So, E);
        }
        if (l + 1 < DEPTH) xcd_barrier(xbar);
    }
}

extern "C" void kernel_launch(void* const* d_in, const int* in_sizes, int n_in, void* d_out, int out_size, void* d_ws, size_t ws_size, hipStream_t stream) {
    static int grid = 0;
    if (grid == 0) {
        if (n_in != 19 || ws_size < WS_END) { fprintf(stderr, "kernel_launch: unexpected inputs (n_in %d, ws %zu)\n", n_in, ws_size); grid = -1; return; }
        int dev = 0, cus = 0, per_cu = 0;
        hipGetDevice(&dev);
        hipDeviceGetAttribute(&cus, hipDeviceAttributeMultiprocessorCount, dev);
        hipFuncSetAttribute((const void*)mega_fwd, hipFuncAttributeMaxDynamicSharedMemorySize, LDS_BYTES);
        hipOccupancyMaxActiveBlocksPerMultiprocessor(&per_cu, (const void*)mega_fwd, 512, LDS_BYTES);
        if (per_cu < 1) { fprintf(stderr, "kernel_launch: occupancy query reports %d blocks per CU\n", per_cu); per_cu = 1; }
        grid = cus;
        (void)hipGetLastError();
    }
    if (grid < 0) return;
    Args a{};
    const float** p = (const float**)&a;
    for (int i = 0; i < 19; ++i) p[i] = (const float*)d_in[i];
    a.out = (float*)d_out; a.ws = (unsigned char*)d_ws;
    void* args[] = {&a};
    hipError_t e = hipLaunchCooperativeKernel((const void*)mega_fwd, dim3(grid), dim3(512), args, LDS_BYTES, stream);
    if (e != hipSuccess) fprintf(stderr, "cooperative launch failed: %s (grid %d)\n", hipGetErrorString(e), grid);
}
```

```cpp
#include <hip/hip_runtime.h>
#include <hip/hip_cooperative_groups.h>
#include <cstdio>
#include <cstdint>
namespace cg = cooperative_groups;
namespace pg8 {
#define PG8_LAS __attribute__((address_space(3)))
typedef unsigned short bf16_t;
typedef short bf16x8 __attribute__((ext_vector_type(8)));
typedef float f32x4 __attribute__((ext_vector_type(4)));
typedef unsigned u32x4 __attribute__((ext_vector_type(4)));
constexpr int BM = 256, BK = 64, HALF = 128, HTB = HALF * BK * 2  , STAGE_BYTES = 8 * HTB, NXCD = 8, WGM = 4;

__host__ __device__ __forceinline__ int lds_byte(int r, int c) { const int st = (r >> 4) * 2 + (c >> 5), rr = r & 15, cc = c & 31, ob = rr * 64 + cc * 2; return st * 1024 + (ob ^ (((ob >> 9) & 1) << 5)); }
__host__ __device__ __forceinline__ void stage_rc(int b, int& R, int& C) { const int st = b / 1024, sb = b % 1024, swz = sb ^ (((sb >> 9) & 1) << 5); R = (st >> 1) * 16 + swz / 64; C = (st & 1) * 32 + (swz % 64) / 2; }
__host__ __device__ __forceinline__ int perm32(int rho) { const int n = rho >> 4, i = rho & 15; return 8 * (i >> 2) + 4 * n + (i & 3); }

struct Unit { int pm, pn; };
struct Gemm { const bf16_t* A; const bf16_t* Bt; int M, N, K; };

struct StaticOrder {
    int nM, nN, nwg, G, c;
    __host__ __device__ void init(int M, int N, int G_, int c_) { nM = M / BM; nN = N / BM; nwg = nM * nN; G = G_; c = c_; }
    __host__ __device__ bool next(int i, Unit& u) const {
        const long L = (long)i * G + c; if (L >= nwg) return false;
        int wgid = (int)L; { const int q = nwg / NXCD, r = nwg % NXCD, xcd = wgid % NXCD, off = wgid / NXCD; wgid = (xcd < r ? xcd * (q + 1) : r * (q + 1) + (xcd - r) * q) + off; }
        const int nig = WGM * nN, gid = wgid / nig, fm = gid * WGM, gsz = (nM - fm) < WGM ? (nM - fm) : WGM;
        u.pm = fm + ((wgid % nig) % gsz); u.pn = (wgid % nig) / gsz; return true;
    }
    __device__ __forceinline__ void a_ready(const Unit&) const {}
    __device__ __forceinline__ void done(const Unit&) const {}
};

__device__ __forceinline__ unsigned cvt_pk_bf16(float lo, float hi) { unsigned r; asm volatile("v_cvt_pk_bf16_f32 %0, %1, %2" : "=v"(r) : "v"(lo), "v"(hi)); return r; }
template <class Epi, class Sched, bool ALIGN_EPI = false, bool SP2 = false>
__device__ __forceinline__ void gemm_phase(PG8_LAS unsigned char* lds, const Gemm g, const Sched& S, const Epi& E) {
    int tid = threadIdx.x; asm volatile("" : "+v"(tid)); const int wid = __builtin_amdgcn_readfirstlane(tid >> 6), lane = tid & 63, wr = wid >> 2, wc = wid & 3, fr = lane & 15, fq = lane >> 4;
    const int K = g.K, nt = K / BK;
    unsigned voffA[2], voffB[2];
#pragma unroll
    for (int i = 0; i < 2; ++i) { int R, C; stage_rc(tid * 16 + i * 8192, R, C); const int Rb = Epi::PERM ? ((R & ~31) + perm32(R & 31)) : R;
        voffA[i] = (unsigned)(R * K + C) * 2u; voffB[i] = (unsigned)(Rb * K + C) * 2u; }
    const size_t kstep = (size_t)(BK * 2);
    const size_t hstep = (size_t)HALF * K * 2;
    const size_t tstep = 2 * hstep;
    const unsigned ldsw = (unsigned)wid * 1024u;
    const int aoff = lds_byte(wr * 64 + fr, fq * 8), boff = lds_byte(wc * 32 + fr, fq * 8);
#define PG8_SA(b, h) (((b) * 2 + (h)) * HTB)
#define PG8_SB(b, h) ((4 + (b) * 2 + (h)) * HTB)
#define PG8_STAGE(bufoff, gbase, voff) do { _Pragma("unroll") for (int _i = 0; _i < 2; ++_i) \
        __builtin_amdgcn_global_load_lds((const unsigned*)((const char*)(gbase) + (voff)[_i]), (PG8_LAS unsigned*)(lds + (bufoff) + ldsw + _i * 8192), 16, 0, 0); } while (0)
#define PG8_LDA(dst, b, h) do { _Pragma("unroll") for (int m = 0; m < 4; ++m) _Pragma("unroll") for (int k = 0; k < 2; ++k) dst[m][k] = *(const PG8_LAS bf16x8*)(lds + PG8_SA(b, h) + aoff + m * 2048 + k * 1024); } while (0)
#define PG8_LDB(dst, b, h) do { _Pragma("unroll") for (int n = 0; n < 2; ++n) _Pragma("unroll") for (int k = 0; k < 2; ++k) dst[n][k] = *(const PG8_LAS bf16x8*)(lds + PG8_SB(b, h) + boff + n * 2048 + k * 1024); } while (0)
#define PG8_MMA(ai, bj, At, Bt) do { __builtin_amdgcn_s_setprio(1); _Pragma("unroll") for (int m = 0; m < 4; ++m) _Pragma("unroll") for (int n = 0; n < 2; ++n) _Pragma("unroll") for (int k = 0; k < 2; ++k) \
        acc[ai][bj][m][n] = __builtin_amdgcn_mfma_f32_16x16x32_bf16(Bt[n][k], At[m][k], acc[ai][bj][m][n], 0, 0, 0); __builtin_amdgcn_s_setprio(0); } while (0)
#define PG8_WAIT_V(n) asm volatile("s_waitcnt vmcnt(" #n ")" ::: "memory")
#define PG8_WAIT_L(n) asm volatile("s_waitcnt lgkmcnt(" #n ")" ::: "memory")
#define PG8_BAR __builtin_amdgcn_s_barrier()
#define PG8_SCHED __builtin_amdgcn_sched_barrier(0)
    Unit cur, nxt; int ui = 0;
    if (!S.next(0, cur)) return;
    f32x4 acc[2][2][4][2];
#pragma unroll
    for (int a = 0; a < 2; ++a)
#pragma unroll
        for (int b = 0; b < 2; ++b)
#pragma unroll
            for (int m = 0; m < 4; ++m)
#pragma unroll
                for (int n = 0; n < 2; ++n) acc[a][b][m][n] = (f32x4){0.f, 0.f, 0.f, 0.f};
    bf16x8 At[4][2], B0[2][2], B1[2][2];
    const char* cA = (const char*)g.A + (size_t)cur.pm * tstep; const char* cB = (const char*)g.Bt + (size_t)cur.pn * tstep;
    S.a_ready(cur);
    if constexpr (SP2) {
        PG8_STAGE(PG8_SB(0, 0), cB, voffB); PG8_STAGE(PG8_SB(0, 1), cB + hstep, voffB); PG8_STAGE(PG8_SA(0, 0), cA, voffA); PG8_STAGE(PG8_SA(0, 1), cA + hstep, voffA);
        if (wr == 1) PG8_BAR;
        PG8_WAIT_V(2); PG8_BAR;
        PG8_STAGE(PG8_SB(1, 0), cB + kstep, voffB); PG8_STAGE(PG8_SA(1, 0), cA + kstep, voffA); PG8_STAGE(PG8_SB(1, 1), cB + hstep + kstep, voffB);
        PG8_WAIT_V(6); PG8_BAR;
    } else {
        PG8_STAGE(PG8_SB(0, 0), cB, voffB); PG8_STAGE(PG8_SA(0, 0), cA, voffA); PG8_STAGE(PG8_SB(0, 1), cB + hstep, voffB); PG8_STAGE(PG8_SA(0, 1), cA + hstep, voffA);
        if (wr == 1) PG8_BAR;
        PG8_WAIT_V(4); PG8_BAR;
        PG8_STAGE(PG8_SB(1, 0), cB + kstep, voffB); PG8_STAGE(PG8_SA(1, 0), cA + kstep, voffA); PG8_STAGE(PG8_SB(1, 1), cB + hstep + kstep, voffB);
        PG8_WAIT_V(6); PG8_BAR;
    }
    for (;;) {
        const bool has_next = S.next(ui + 1, nxt);
        const char* nA = has_next ? (const char*)g.A + (size_t)nxt.pm * tstep : cA; const char* nB = has_next ? (const char*)g.Bt + (size_t)nxt.pn * tstep : cB;
        for (int t = 0; t < nt; t += 2) {
            const bool last = (t == nt - 2);
            const char* a1 = cA + (size_t)(t + 1) * kstep;
            const char* a2 = last ? nA : cA + (size_t)(t + 2) * kstep; const char* b2 = last ? nB : cB + (size_t)(t + 2) * kstep;
            const char* a3 = a2 + kstep; const char* b3 = b2 + kstep;
            if (last && has_next) S.a_ready(nxt);
            if constexpr (SP2) {
            PG8_LDB(B0, 0, 0); PG8_LDB(B1, 0, 1); PG8_SCHED; PG8_LDA(At, 0, 0); PG8_STAGE(PG8_SA(1, 1), a1 + hstep, voffA);
            PG8_WAIT_V(8); PG8_WAIT_L(0); PG8_BAR; PG8_MMA(0, 0, At, B0); PG8_MMA(0, 1, At, B1); PG8_BAR; PG8_SCHED;
            PG8_LDA(At, 0, 1); PG8_STAGE(PG8_SB(0, 0), b2, voffB); PG8_STAGE(PG8_SB(0, 1), b2 + hstep, voffB); PG8_STAGE(PG8_SA(0, 0), a2, voffA);
            PG8_WAIT_V(8); PG8_WAIT_L(0); PG8_BAR; PG8_MMA(1, 0, At, B0); PG8_MMA(1, 1, At, B1); PG8_BAR; PG8_SCHED;
            PG8_LDB(B0, 1, 0); PG8_LDB(B1, 1, 1); PG8_SCHED; PG8_LDA(At, 1, 0); PG8_STAGE(PG8_SA(0, 1), a2 + hstep, voffA);
            PG8_WAIT_V(8); PG8_WAIT_L(0); PG8_BAR; PG8_MMA(0, 0, At, B0); PG8_MMA(0, 1, At, B1); PG8_BAR; PG8_SCHED;
            PG8_LDA(At, 1, 1); PG8_STAGE(PG8_SB(1, 0), b3, voffB); PG8_STAGE(PG8_SB(1, 1), b3 + hstep, voffB); PG8_STAGE(PG8_SA(1, 0), a3, voffA);
            PG8_WAIT_V(8); PG8_WAIT_L(0); PG8_BAR; PG8_MMA(1, 0, At, B0); PG8_MMA(1, 1, At, B1); PG8_BAR; PG8_SCHED;
            } else {
            PG8_LDB(B0, 0, 0); PG8_SCHED; PG8_LDA(At, 0, 0); PG8_STAGE(PG8_SA(1, 1), a1 + hstep, voffA);
            PG8_WAIT_L(8); PG8_BAR; PG8_WAIT_L(0); PG8_MMA(0, 0, At, B0); PG8_BAR; PG8_SCHED;
            PG8_LDB(B1, 0, 1); PG8_STAGE(PG8_SB(0, 0), b2, voffB);
            PG8_BAR; PG8_WAIT_L(0); PG8_MMA(0, 1, At, B1); PG8_BAR;
            PG8_LDA(At, 0, 1); PG8_STAGE(PG8_SA(0, 0), a2, voffA);
            PG8_BAR; PG8_WAIT_L(0); PG8_MMA(1, 0, At, B0); PG8_BAR; PG8_SCHED;
            PG8_STAGE(PG8_SB(0, 1), b2 + hstep, voffB);
            PG8_WAIT_V(6); PG8_BAR; PG8_MMA(1, 1, At, B1); PG8_BAR;
            PG8_LDB(B0, 1, 0); PG8_SCHED; PG8_LDA(At, 1, 0); PG8_STAGE(PG8_SA(0, 1), a2 + hstep, voffA);
            PG8_WAIT_L(8); PG8_BAR; PG8_WAIT_L(0); PG8_MMA(0, 0, At, B0); PG8_BAR; PG8_SCHED;
            PG8_LDB(B1, 1, 1); PG8_STAGE(PG8_SB(1, 0), b3, voffB);
            PG8_BAR; PG8_WAIT_L(0); PG8_MMA(0, 1, At, B1); PG8_BAR;
            PG8_LDA(At, 1, 1); PG8_STAGE(PG8_SA(1, 0), a3, voffA);
            PG8_BAR; PG8_WAIT_L(0); PG8_MMA(1, 0, At, B0); PG8_BAR; PG8_SCHED;
            PG8_STAGE(PG8_SB(1, 1), b3 + hstep, voffB);
            PG8_WAIT_V(6); PG8_BAR; PG8_MMA(1, 1, At, B1); PG8_BAR;
            }
        }
        if constexpr (ALIGN_EPI) { if (wr == 0) PG8_BAR; }
        if constexpr (!Epi::AFTER_DRAIN) { E(acc, cur, wr, wc, fr, fq); S.done(cur); }
        if (!has_next) break;
#pragma unroll
        for (int a = 0; a < 2; ++a)
#pragma unroll
            for (int b = 0; b < 2; ++b)
#pragma unroll
                for (int m = 0; m < 4; ++m)
#pragma unroll
                    for (int n = 0; n < 2; ++n) acc[a][b][m][n] = (f32x4){0.f, 0.f, 0.f, 0.f};
        cur = nxt; cA = nA; cB = nB; ++ui;
        if constexpr (ALIGN_EPI) { if (wr == 1) PG8_BAR; }
    }
    PG8_WAIT_V(0);
    if constexpr (!ALIGN_EPI) { if (wr == 0) PG8_BAR; }
    PG8_BAR;
    if constexpr (Epi::AFTER_DRAIN) { E.fused(acc, cur, wr, wc, fr, fq, lds, wid, lane); S.done(cur); }
#undef PG8_SA
#undef PG8_SB
#undef PG8_STAGE
#undef PG8_LDA
#undef PG8_LDB
#undef PG8_MMA
#undef PG8_WAIT_V
#undef PG8_WAIT_L
#undef PG8_BAR
#undef PG8_SCHED
}
}
#define LAS __attribute__((address_space(3)))
typedef unsigned short bf16;
using pg8::f32x4; using pg8::u32x4; using pg8::Unit; using pg8::cvt_pk_bf16; using pg8::bf16x8;
typedef unsigned u32x2 __attribute__((ext_vector_type(2)));

constexpr int NB = 8, S = 2048, D = 1024, M = NB * S, NIN = 2304, FF = 2816, NUP = 2 * FF, DEPTH = 2;
constexpr float EPS = 1e-6f;
constexpr float LOG2E = 1.4426950408889634f;
constexpr float QSCALE = 0.125f * LOG2E;
constexpr int XL_OFF = 131072;
constexpr int LDS_BYTES = 131072 + 8192;

__device__ __forceinline__ float dot4(f32x4 a) { return (a[0] * a[0] + a[1] * a[1]) + (a[2] * a[2] + a[3] * a[3]); }
__device__ __forceinline__ float silu_f(float v) { return v * __builtin_amdgcn_rcpf(1.f + __expf(-v)); }

struct EpiInProj {
    static constexpr bool PERM = true, AFTER_DRAIN = false;
    bf16* O; const float* qn_a; const float* kn_a; const float* qn_b; const float* kn_b; const float* cosT; const float* sinT; const float* rowsq;
    __device__ __forceinline__ void operator()(const f32x4 (&acc)[2][2][4][2], const Unit& u, int wr, int wc, int fr, int fq) const {
        asm volatile("" : "+v"(fr), "+v"(fq));
        const int pn = u.pn;
        const float* g = nullptr; float sc = 1.f;
        if (pn < 2) { g = qn_a; sc = QSCALE; }
        else if (pn == 2) { if (wc < 2) g = kn_a; }
        else if (pn < 5) { g = qn_b; sc = QSCALE; }
        else if (pn < 7) { g = kn_b; }
        const int colb = pn * 256 + wc * 64 + 8 * fq;
        const int row0 = u.pm * 256 + wr * 64 + fr;
        if (g) {
            f32x4 g1[2], g2[2];
#pragma unroll
            for (int n = 0; n < 2; ++n) { g1[n] = *(const f32x4*)(g + 8 * fq + 4 * n); g2[n] = *(const f32x4*)(g + 32 + 8 * fq + 4 * n); }
#pragma unroll
            for (int ai = 0; ai < 2; ++ai)
#pragma unroll
                for (int m = 0; m < 4; ++m) {
                    const int row = row0 + ai * 128 + m * 16;
                    const f32x4 a0 = acc[ai][0][m][0], a1 = acc[ai][0][m][1], b0 = acc[ai][1][m][0], b1 = acc[ai][1][m][1];
                    float ss = (dot4(a0) + dot4(a1)) + (dot4(b0) + dot4(b1));
                    ss += __shfl_xor(ss, 16); ss += __shfl_xor(ss, 32);
                    const float rx = rsqrtf(rowsq[row] * (1.f / D) + EPS);
                    const float rs = rsqrtf(ss * rx * rx * (1.f / 64.f) + EPS) * rx * sc;
                    const size_t ro = (size_t)(row & (S - 1)) * 32 + 8 * fq;
                    const f32x4 c0 = *(const f32x4*)(cosT + ro), c1 = *(const f32x4*)(cosT + ro + 4), s0 = *(const f32x4*)(sinT + ro), s1 = *(const f32x4*)(sinT + ro + 4);
                    const f32x4 y10 = a0 * rs * g1[0], y11 = a1 * rs * g1[1], y20 = b0 * rs * g2[0], y21 = b1 * rs * g2[1];
                    const f32x4 o10 = y10 * c0 - y20 * s0, o11 = y11 * c1 - y21 * s1, o20 = y20 * c0 + y10 * s0, o21 = y21 * c1 + y11 * s1;
                    u32x4 w1, w2;
                    w1.x = cvt_pk_bf16(o10[0], o10[1]); w1.y = cvt_pk_bf16(o10[2], o10[3]); w1.z = cvt_pk_bf16(o11[0], o11[1]); w1.w = cvt_pk_bf16(o11[2], o11[3]);
                    w2.x = cvt_pk_bf16(o20[0], o20[1]); w2.y = cvt_pk_bf16(o20[2], o20[3]); w2.z = cvt_pk_bf16(o21[0], o21[1]); w2.w = cvt_pk_bf16(o21[2], o21[3]);
                    bf16* op = O + (size_t)row * NIN + colb;
                    *(u32x4*)op = w1; *(u32x4*)(op + 32) = w2;
                }
        } else {
#pragma unroll
            for (int ai = 0; ai < 2; ++ai)
#pragma unroll
                for (int m = 0; m < 4; ++m) {
                    const int row = row0 + ai * 128 + m * 16;
                    bf16* op = O + (size_t)row * NIN + colb;
                    const float rx = rsqrtf(rowsq[row] * (1.f / D) + EPS);
#pragma unroll
                    for (int bj = 0; bj < 2; ++bj) { const f32x4 v0 = acc[ai][bj][m][0] * rx, v1 = acc[ai][bj][m][1] * rx; u32x4 w;
                        w.x = cvt_pk_bf16(v0[0], v0[1]); w.y = cvt_pk_bf16(v0[2], v0[3]); w.z = cvt_pk_bf16(v1[0], v1[1]); w.w = cvt_pk_bf16(v1[2], v1[3]);
                        *(u32x4*)(op + 32 * bj) = w; }
                }
        }
    }
};

__device__ __forceinline__ f32x4 bf2f_lo(unsigned a, unsigned b) { return (f32x4){__uint_as_float(a << 16), __uint_as_float(a & 0xffff0000u), __uint_as_float(b << 16), __uint_as_float(b & 0xffff0000u)}; }
struct EpiResid {
    static constexpr bool PERM = true, AFTER_DRAIN = false;
    bf16* XB; float* rowsq; float* outf;
    __device__ __forceinline__ void operator()(const f32x4 (&acc)[2][2][4][2], const Unit& u, int wr, int wc, int fr, int fq) const {
        asm volatile("" : "+v"(fr), "+v"(fq));
        const int col0 = u.pn * 256 + wc * 32 + 8 * fq, row0 = u.pm * 256 + wr * 64 + fr;
#pragma unroll
        for (int ai = 0; ai < 2; ++ai) {
            u32x4 xr[4][2];
#pragma unroll
            for (int m = 0; m < 4; ++m) { const size_t off = (size_t)(row0 + ai * 128 + m * 16) * D + col0;
#pragma unroll
                for (int bj = 0; bj < 2; ++bj) xr[m][bj] = *(const u32x4*)(XB + off + bj * 128); }
            asm volatile("" ::: "memory");
#pragma unroll
            for (int m = 0; m < 4; ++m) { const int row = row0 + ai * 128 + m * 16; const size_t off = (size_t)row * D + col0; float ss = 0.f;
#pragma unroll
                for (int bj = 0; bj < 2; ++bj) {
                    const f32x4 y0 = bf2f_lo(xr[m][bj].x, xr[m][bj].y) + acc[ai][bj][m][0], y1 = bf2f_lo(xr[m][bj].z, xr[m][bj].w) + acc[ai][bj][m][1];
                    ss += dot4(y0) + dot4(y1);
                    if (outf) { __builtin_nontemporal_store(y0, (f32x4*)(outf + off + bj * 128)); __builtin_nontemporal_store(y1, (f32x4*)(outf + off + bj * 128 + 4)); }
                    else { u32x4 w; w.x = cvt_pk_bf16(y0[0], y0[1]); w.y = cvt_pk_bf16(y0[2], y0[3]); w.z = cvt_pk_bf16(y1[0], y1[1]); w.w = cvt_pk_bf16(y1[2], y1[3]); *(u32x4*)(XB + off + bj * 128) = w; }
                }
                if (rowsq) { ss += __shfl_xor(ss, 16); ss += __shfl_xor(ss, 32); if (fq == 0) atomicAdd(rowsq + row, ss); }
            }
            asm volatile("" ::: "memory");
        }
    }
};

struct EpiUpConv {
    static constexpr bool PERM = true, AFTER_DRAIN = false;
    bf16* ACT; const float* cw; const float* cb; float* edge; float* part; LAS float* xl; const float* rowsq;
    __device__ __forceinline__ void operator()(f32x4 (&acc)[2][2][4][2], const Unit& u, int wr, int wc, int fr, int fq) const {
        asm volatile("" : "+v"(fr), "+v"(fq));
        const int lane = 16 * fq + fr;
        const int cl0 = 32 * wc + 8 * fq, ch0 = 128 * u.pn + cl0;
#pragma unroll
        for (int ai = 0; ai < 2; ++ai)
#pragma unroll
            for (int m = 0; m < 4; ++m) { const float rx = rsqrtf(rowsq[u.pm * 256 + ai * 128 + wr * 64 + m * 16 + fr] * (1.f / D) + EPS);
#pragma unroll
                for (int bj = 0; bj < 2; ++bj) { acc[ai][bj][m][0] *= rx; acc[ai][bj][m][1] *= rx; } }
#pragma unroll
        for (int ai = 0; ai < 2; ++ai) {
            const int chunk = 2 * ai + wr;
            if (fr == 0) { *(LAS f32x4*)(xl + (chunk * 2 + 0) * 128 + cl0) = acc[ai][0][0][0]; *(LAS f32x4*)(xl + (chunk * 2 + 0) * 128 + cl0 + 4) = acc[ai][0][0][1]; }
            if (fr == 15) { *(LAS f32x4*)(xl + (chunk * 2 + 1) * 128 + cl0) = acc[ai][0][3][0]; *(LAS f32x4*)(xl + (chunk * 2 + 1) * 128 + cl0 + 4) = acc[ai][0][3][1]; }
        }
        asm volatile("s_waitcnt lgkmcnt(0)" ::: "memory"); __builtin_amdgcn_s_barrier(); asm volatile("" ::: "memory");
        const int lup = (lane & ~15) | ((fr + 15) & 15), ldn = (lane & ~15) | ((fr + 1) & 15);
        const bool seq_first = (u.pm & 7) == 0, seq_last = (u.pm & 7) == 7;
#pragma unroll
        for (int ai = 0; ai < 2; ++ai) {
            const int chunk = 2 * ai + wr;
#pragma unroll
            for (int n = 0; n < 2; ++n) {
                const int ch = ch0 + 4 * n;
                const f32x4 w0 = *(const f32x4*)(cw + ch), w1 = *(const f32x4*)(cw + FF + ch), w2 = *(const f32x4*)(cw + 2 * FF + ch), bb = *(const f32x4*)(cb + ch);
                const f32x4 above = (chunk > 0) ? *(const LAS f32x4*)(xl + ((chunk - 1) * 2 + 1) * 128 + cl0 + 4 * n) : (f32x4){0.f, 0.f, 0.f, 0.f};
                const f32x4 below = (chunk < 3) ? *(const LAS f32x4*)(xl + ((chunk + 1) * 2 + 0) * 128 + cl0 + 4 * n) : (f32x4){0.f, 0.f, 0.f, 0.f};
                f32x4 Rprev = above, Lcur;
#pragma unroll
                for (int e = 0; e < 4; ++e) Lcur[e] = __shfl(acc[ai][0][0][n][e], ldn);
#pragma unroll
                for (int m = 0; m < 4; ++m) {
                    const int rt = ai * 128 + wr * 64 + m * 16 + fr;
                    const size_t row = (size_t)u.pm * 256 + rt;
                    const f32x4 cur = acc[ai][0][m][n], val = acc[ai][1][m][n];
                    f32x4 Rm, Lnext = below;
#pragma unroll
                    for (int e = 0; e < 4; ++e) { Rm[e] = __shfl(cur[e], lup); if (m < 3) Lnext[e] = __shfl(acc[ai][0][m < 3 ? m + 1 : 3][n][e], ldn); }
                    const f32x4 up = (fr == 0) ? Rprev : Rm, dn = (fr == 15) ? Lnext : Lcur;
                    Rprev = Rm; Lcur = Lnext;
                    const f32x4 pre = bb + w0 * up + w1 * cur + w2 * dn;
                    f32x4 res;
#pragma unroll
                    for (int e = 0; e < 4; ++e) res[e] = silu_f(pre[e]) * val[e];
                    if (rt == 0) {
                        *(f32x4*)(edge + ((size_t)u.pm * 2 + 0) * FF + ch) = cur;
                        if (!seq_first) { float* pp = part + (((size_t)u.pm * 2 + 0) * FF + ch) * 2;
                            *(f32x4*)pp = (f32x4){pre[0], val[0], pre[1], val[1]}; *(f32x4*)(pp + 4) = (f32x4){pre[2], val[2], pre[3], val[3]}; }
                    }
                    if (rt == 255) {
                        *(f32x4*)(edge + ((size_t)u.pm * 2 + 1) * FF + ch) = cur;
                        if (!seq_last) { float* pp = part + (((size_t)u.pm * 2 + 1) * FF + ch) * 2;
                            *(f32x4*)pp = (f32x4){pre[0], val[0], pre[1], val[1]}; *(f32x4*)(pp + 4) = (f32x4){pre[2], val[2], pre[3], val[3]}; }
                    }
                    u32x2 w; w.x = cvt_pk_bf16(res[0], res[1]); w.y = cvt_pk_bf16(res[2], res[3]);
                    *(u32x2*)(ACT + row * FF + ch) = w;
                }
            }
        }
    }
};
namespace att {
typedef __attribute__((ext_vector_type(16))) float f32x16;
typedef __attribute__((ext_vector_type(4))) short s16x4;
typedef short v4i16_t __attribute__((ext_vector_type(4)));
typedef LAS const char* lptr;
__device__ __forceinline__ s16x4 vtr(lptr p) { return __builtin_bit_cast(s16x4, __builtin_amdgcn_ds_read_tr16_b64_v4i16((LAS v4i16_t*)p)); }
typedef float f32x2_t __attribute__((ext_vector_type(2))); typedef __bf16 bf16x2_t __attribute__((ext_vector_type(2)));
__device__ __forceinline__ unsigned cvtpk_s(float lo, float hi) { f32x2_t v = {lo, hi}; bf16x2_t b = __builtin_convertvector(v, bf16x2_t); return __builtin_bit_cast(unsigned, b); }
__device__ __forceinline__ bf16x8 pack8(const f32x16& s, int b) {
    u32x4 w; w.x = cvtpk_s(s[b], s[b + 1]); w.y = cvtpk_s(s[b + 2], s[b + 3]); w.z = cvtpk_s(s[b + 4], s[b + 5]); w.w = cvtpk_s(s[b + 6], s[b + 7]);
    return __builtin_bit_cast(bf16x8, w);
}
#define MFMA32(a, b, c) __builtin_amdgcn_mfma_f32_32x32x16_bf16((a), (b), (c), 0, 0, 0)

#define LGKM_WAIT(n) asm volatile("s_waitcnt lgkmcnt(" #n ")" ::: "memory")
#define SCHED_FENCE() __builtin_amdgcn_sched_barrier(0)
__device__ __forceinline__ bf16x8 rd128(unsigned addr, int off) { bf16x8 r; asm volatile("ds_read_b128 %0, %1 offset:%c2" : "=&v"(r) : "v"(addr), "i"(off) : "memory"); return r; }
__device__ __forceinline__ s16x4 rdtr(unsigned addr, int off) { s16x4 r; asm volatile("ds_read_b64_tr_b16 %0, %1 offset:%c2" : "=&v"(r) : "v"(addr), "i"(off) : "memory"); return r; }
#define VFRAG(lo, hh) ((bf16x8){lo[0], lo[1], lo[2], lo[3], hh[0], hh[1], hh[2], hh[3]})
constexpr int KROW = 144, VROWD = 320, VROWA = 192;
constexpr int DSTG = 2 * 64 * KROW + 64 * VROWD;
constexpr int ASTG = 64 * KROW + 64 * VROWA;

constexpr int DST3 = 32768;
#define SGB(mask, n) __builtin_amdgcn_sched_group_barrier((mask), (n), 0)
__device__ __forceinline__ void diff_unit(LAS char* lds, const bf16* __restrict__ QKV, bf16* __restrict__ Y, int b, int h, int qb, float Mb, float lam, const float* __restrict__ subln, float outscale) {
    int tid = threadIdx.x; asm volatile("" : "+v"(tid)); const int lane = tid & 63, w = __builtin_amdgcn_readfirstlane(tid >> 6), q = lane & 31, hi = lane >> 5;
    const int rg = w >> 1, c = w & 1;
    const size_t rowQ = (size_t)b * S + qb * 128 + rg * 32 + q;
    const bf16* qp = QKV + rowQ * NIN + 768 + (2 * h + c) * 64 + hi * 8;
    bf16x8 qf[4];
#pragma unroll
    for (int ds = 0; ds < 4; ++ds) qf[ds] = *(const bf16x8*)(qp + ds * 16);
    const int krow = 8 * w + (lane >> 3), kch = (lane & 7) ^ ((krow >> 1) & 7);
    const int vrow = 4 * w + (lane >> 4), vch = (lane & 15) ^ ((vrow & 3) << 2);
    const bf16* kg = QKV + ((size_t)b * S + krow) * NIN + 1280 + 128 * h + kch * 8;
    const bf16* vg = QKV + ((size_t)b * S + vrow) * NIN + 1792 + 128 * h + vch * 8;
#define DDMA(t, so) do { const size_t o_ = (size_t)(t) * 64 * NIN; LAS unsigned char* d_ = (LAS unsigned char*)lds + (so) + w * 1024; \
        __builtin_amdgcn_global_load_lds((const unsigned*)(kg + o_), (LAS unsigned*)(d_), 16, 0, 0); \
        __builtin_amdgcn_global_load_lds((const unsigned*)(kg + o_ + 64), (LAS unsigned*)(d_ + 8192), 16, 0, 0); \
        __builtin_amdgcn_global_load_lds((const unsigned*)(vg + o_), (LAS unsigned*)(d_ + 16384), 16, 0, 0); \
        __builtin_amdgcn_global_load_lds((const unsigned*)(vg + o_ + 32 * NIN), (LAS unsigned*)(d_ + 16384 + 8192), 16, 0, 0); } while (0)
    f32x16 o[4];
#pragma unroll
    for (int i = 0; i < 4; ++i) o[i] = (f32x16){0.f};
    float l = 0.f;
    constexpr int NT = S / 64;
    DDMA(0, 0); DDMA(1, DST3); DDMA(2, 2 * DST3);
    const unsigned lbase = (unsigned)(size_t)lds;
    unsigned kofs[4], vofs[4];
    { const int sw = (q >> 1) & 7, vq = (lane & 15) >> 2;
#pragma unroll
      for (int ds = 0; ds < 4; ++ds) kofs[ds] = (unsigned)(c * 8192 + q * 128 + (((2 * ds + hi) ^ sw) << 4));
#pragma unroll
      for (int db = 0; db < 4; ++db) vofs[db] = (unsigned)(16384 + (4 * hi + vq) * 256 + ((db ^ vq) << 6) + ((lane >> 4) & 1) * 32 + (lane & 3) * 8); }
    f32x16 negm;
#pragma unroll
    for (int r = 0; r < 16; ++r) negm[r] = -Mb;
    f32x16 s0, s1;
    { asm volatile("s_waitcnt vmcnt(8)" ::: "memory"); __builtin_amdgcn_s_barrier(); asm volatile("" ::: "memory");
      bf16x8 kf[8];
#pragma unroll
      for (int ds = 0; ds < 4; ++ds) { kf[2 * ds] = rd128(lbase + kofs[ds], 0); kf[2 * ds + 1] = rd128(lbase + kofs[ds], 32 * 128); }
      LGKM_WAIT(0); SCHED_FENCE();
      s0 = negm; s1 = negm;
#pragma unroll
      for (int ds = 0; ds < 4; ++ds) { s0 = MFMA32(kf[2 * ds], qf[ds], s0); s1 = MFMA32(kf[2 * ds + 1], qf[ds], s1); }
      SCHED_FENCE(); }
    int so_cur = 0, so_n1 = DST3, so_n3 = 3 * DST3;
    for (int t = 0; t < NT; ++t) {
        asm volatile("s_waitcnt vmcnt(4)" ::: "memory");
        __builtin_amdgcn_s_barrier();
        asm volatile("" ::: "memory");
        { const int tn = (t + 3 < NT) ? t + 3 : NT - 1; DDMA(tn, so_n3); }
        const unsigned sb = lbase + so_cur, sn = lbase + so_n1;
        bf16x8 kf[8];
#pragma unroll
        for (int ds = 0; ds < 4; ++ds) { kf[2 * ds] = rd128(sn + kofs[ds], 0); kf[2 * ds + 1] = rd128(sn + kofs[ds], 32 * 128); }
        s16x4 vl[2][4], vh[2][4];
#pragma unroll
        for (int db = 0; db < 4; ++db) { vl[0][db] = rdtr(sb + vofs[db], 0); vh[0][db] = rdtr(sb + vofs[db], 8 * 256); }
        LGKM_WAIT(0); SCHED_FENCE();
        __builtin_amdgcn_s_setprio(1);
        f32x16 n0 = negm, n1 = negm;
#pragma unroll
        for (int ds = 0; ds < 4; ++ds) { n0 = MFMA32(kf[2 * ds], qf[ds], n0); n1 = MFMA32(kf[2 * ds + 1], qf[ds], n1); }
        float ls = 0.f;
#pragma unroll
        for (int r = 0; r < 16; ++r) { s0[r] = __builtin_amdgcn_exp2f(s0[r]); ls += s0[r]; }
        bf16x8 pf[4]; pf[0] = pack8(s0, 0); pf[1] = pack8(s0, 8);
#pragma unroll
        for (int i = 0; i < 8; ++i) { SGB(0x008, 1); SGB(0x400, 2); SGB(0x002, 3); }
        SCHED_FENCE();
        __builtin_amdgcn_s_setprio(0);
#pragma unroll
        for (int db = 0; db < 4; ++db) { vl[1][db] = rdtr(sb + vofs[db], 16 * 256); vh[1][db] = rdtr(sb + vofs[db], 16 * 256 + 8 * 256); }
        s16x4 wl[2][4], wh[2][4];
#pragma unroll
        for (int ks = 0; ks < 2; ++ks)
#pragma unroll
            for (int db = 0; db < 4; ++db) { wl[ks][db] = rdtr(sb + vofs[db], (ks + 2) * 16 * 256); wh[ks][db] = rdtr(sb + vofs[db], (ks + 2) * 16 * 256 + 8 * 256); }
        LGKM_WAIT(15); SCHED_FENCE();
        __builtin_amdgcn_s_setprio(1);
#pragma unroll
        for (int ks = 0; ks < 2; ++ks)
#pragma unroll
            for (int db = 0; db < 4; ++db) o[db] = MFMA32(VFRAG(vl[ks][db], vh[ks][db]), pf[ks], o[db]);
#pragma unroll
        for (int r = 0; r < 16; ++r) { s1[r] = __builtin_amdgcn_exp2f(s1[r]); ls += s1[r]; }
        l += ls;
        pf[2] = pack8(s1, 0); pf[3] = pack8(s1, 8);
#pragma unroll
        for (int i = 0; i < 8; ++i) { SGB(0x008, 1); SGB(0x400, 2); SGB(0x002, 3); }
        SCHED_FENCE();
        LGKM_WAIT(0); SCHED_FENCE();
#pragma unroll
        for (int ks = 0; ks < 2; ++ks)
#pragma unroll
            for (int db = 0; db < 4; ++db) o[db] = MFMA32(VFRAG(wl[ks][db], wh[ks][db]), pf[2 + ks], o[db]);
        SCHED_FENCE();
        __builtin_amdgcn_s_setprio(0);
        s0 = n0; s1 = n1;
        so_cur = so_n1; so_n1 = (so_n1 == 3 * DST3) ? 0 : so_n1 + DST3; so_n3 = (so_n3 == 3 * DST3) ? 0 : so_n3 + DST3;
    }
#undef DDMA
    asm volatile("s_waitcnt vmcnt(0)" ::: "memory");
    __syncthreads();
    l += __shfl_xor(l, 32);
    const float inv = 1.f / l;
    LAS f32x4* xb = (LAS f32x4*)lds + rg * (16 * 64) + lane;
    if (c == 1) {
#pragma unroll
        for (int db = 0; db < 4; ++db)
#pragma unroll
            for (int r4 = 0; r4 < 4; ++r4) xb[(db * 4 + r4) * 64] = (f32x4){o[db][4 * r4], o[db][4 * r4 + 1], o[db][4 * r4 + 2], o[db][4 * r4 + 3]} * inv;
    }
    __syncthreads();
    if (c == 0) {
        float ss = 0.f;
#pragma unroll
        for (int db = 0; db < 4; ++db)
#pragma unroll
            for (int r4 = 0; r4 < 4; ++r4) { const f32x4 ot = xb[(db * 4 + r4) * 64];
#pragma unroll
                for (int e = 0; e < 4; ++e) { const float d = o[db][4 * r4 + e] * inv - lam * ot[e]; o[db][4 * r4 + e] = d; ss += d * d; } }
        ss += __shfl_xor(ss, 32);
        const float rs = rsqrtf(ss * (1.f / 128.f) + EPS) * outscale;
        bf16* yp = Y + rowQ * D + 512 + 128 * h + 4 * hi;
#pragma unroll
        for (int db = 0; db < 4; ++db)
#pragma unroll
            for (int r4 = 0; r4 < 4; ++r4) { const f32x4 gw = *(const f32x4*)(subln + 32 * db + 8 * r4 + 4 * hi);
                u32x2 wv; wv.x = cvt_pk_bf16(o[db][4 * r4] * rs * gw[0], o[db][4 * r4 + 1] * rs * gw[1]); wv.y = cvt_pk_bf16(o[db][4 * r4 + 2] * rs * gw[2], o[db][4 * r4 + 3] * rs * gw[3]);
                *(u32x2*)(yp + 32 * db + 8 * r4) = wv; }
    }
    __syncthreads();
}

__device__ __forceinline__ void swa_unit(LAS char* lds, const bf16* __restrict__ QKV, bf16* __restrict__ Y, int b, int kvh, int n, float Mb, const float* __restrict__ sink) {
    int tid = threadIdx.x; asm volatile("" : "+v"(tid)); const int lane = tid & 63, w = __builtin_amdgcn_readfirstlane(tid >> 6), q = lane & 31, hi = lane >> 5;
    const int head = kvh * 4 + (w >> 1), rb = (w & 1) * 64;
    const size_t rowQ = (size_t)b * S + n * 128 + rb + q;
    bf16x8 qf[2][4];
#pragma unroll
    for (int rg = 0; rg < 2; ++rg)
#pragma unroll
        for (int ds = 0; ds < 4; ++ds) qf[rg][ds] = *(const bf16x8*)(QKV + (rowQ + 32 * rg) * NIN + head * 64 + hi * 8 + ds * 16);
    const int lrow = tid >> 3, lcc = tid & 7;
    const long kp0 = (long)b * S + (long)(n - 1) * 128 + lrow;
    const bf16* kg = QKV + kp0 * NIN + 512 + kvh * 64 + lcc * 8;
    const bf16* vg = QKV + kp0 * NIN + 640 + kvh * 64 + lcc * 8;
    const int kdst = lrow * KROW + lcc * 16, vdst = 64 * KROW + lrow * VROWA + lcc * 16;
    u32x4 st0, st1;
#define ALOAD(t) do { const long o_ = (long)(t) * 64 * NIN; st0 = *(const u32x4*)(kg + o_); st1 = *(const u32x4*)(vg + o_); } while (0)
#define ASTORE(bo) do { *(LAS u32x4*)(lds + (bo) + kdst) = st0; *(LAS u32x4*)(lds + (bo) + vdst) = st1; } while (0)
    f32x16 o[2][2];
#pragma unroll
    for (int i = 0; i < 2; ++i)
#pragma unroll
        for (int j = 0; j < 2; ++j) o[i][j] = (f32x16){0.f};
    float l[2] = {0.f, 0.f};
    const int t0 = (n == 0) ? 2 : 0, t1 = (n == S / 128 - 1) ? 4 : 6;
    ALOAD(t0); ASTORE((t0 & 1) * ASTG); __syncthreads();
    const int koff = q * KROW + hi * 16;
    const int voff = 64 * KROW + (4 * hi + ((lane & 15) >> 2)) * VROWA + ((lane >> 4) & 1) * 32 + (lane & 3) * 8;
    const unsigned lbase = (unsigned)(size_t)lds;
    for (int t = t0; t < t1; ++t) {
        const int cur = (t & 1) * ASTG, nxt = ASTG - cur;
        if (t + 1 < t1) ALOAD(t + 1);
        const unsigned ka = lbase + cur + koff, va = lbase + cur + voff;
        bf16x8 kf[8];
#pragma unroll
        for (int ds = 0; ds < 4; ++ds) { kf[2 * ds] = rd128(ka, ds * 32); kf[2 * ds + 1] = rd128(ka, 32 * KROW + ds * 32); }
        s16x4 vl[4][2], vh[4][2];
#pragma unroll
        for (int ks = 0; ks < 4; ++ks)
#pragma unroll
            for (int db = 0; db < 2; ++db) { vl[ks][db] = rdtr(va, ks * 16 * VROWA + db * 64); vh[ks][db] = rdtr(va, ks * 16 * VROWA + 8 * VROWA + db * 64); }
        LGKM_WAIT(0); SCHED_FENCE();
#pragma unroll
        for (int rg = 0; rg < 2; ++rg) {
            const int i0 = rb + 32 * rg;
            if (64 * t + 63 >= i0 && 64 * t <= i0 + 31 + 256) {
                f32x16 s0 = (f32x16){0.f}, s1 = (f32x16){0.f};
#pragma unroll
                for (int ds = 0; ds < 4; ++ds) { s0 = MFMA32(kf[2 * ds], qf[rg][ds], s0); s1 = MFMA32(kf[2 * ds + 1], qf[rg][ds], s1); }
                const int jb = 64 * t + 4 * hi - (i0 + q);
                float ls = 0.f;
#pragma unroll
                for (int r = 0; r < 16; ++r) {
                    const int d0 = jb + (r & 3) + 8 * (r >> 2), d1 = d0 + 32;
                    const float p0 = __builtin_amdgcn_exp2f(s0[r] - Mb), p1 = __builtin_amdgcn_exp2f(s1[r] - Mb);
                    s0[r] = ((unsigned)d0 <= 256u) ? p0 : 0.f; s1[r] = ((unsigned)d1 <= 256u) ? p1 : 0.f; ls += s0[r] + s1[r];
                }
                l[rg] += ls;
                bf16x8 pf[4]; pf[0] = pack8(s0, 0); pf[1] = pack8(s0, 8); pf[2] = pack8(s1, 0); pf[3] = pack8(s1, 8);
#pragma unroll
                for (int ks = 0; ks < 4; ++ks)
#pragma unroll
                    for (int db = 0; db < 2; ++db) o[rg][db] = MFMA32(VFRAG(vl[ks][db], vh[ks][db]), pf[ks], o[rg][db]);
            }
        }
        SCHED_FENCE();
        if (t + 1 < t1) ASTORE(nxt);
        __syncthreads();
    }
#undef ALOAD
#undef ASTORE
    const float sk = __builtin_amdgcn_exp2f(sink[head] * LOG2E - Mb);
#pragma unroll
    for (int rg = 0; rg < 2; ++rg) {
        float lt = l[rg]; lt += __shfl_xor(lt, 32);
        const float inv = 1.f / (lt + sk);
        bf16* yp = Y + (rowQ + 32 * rg) * D + head * 64 + 4 * hi;
#pragma unroll
        for (int db = 0; db < 2; ++db)
#pragma unroll
            for (int r4 = 0; r4 < 4; ++r4) { u32x2 wv; wv.x = cvt_pk_bf16(o[rg][db][4 * r4] * inv, o[rg][db][4 * r4 + 1] * inv); wv.y = cvt_pk_bf16(o[rg][db][4 * r4 + 2] * inv, o[rg][db][4 * r4 + 3] * inv);
                *(u32x2*)(yp + 32 * db + 8 * r4) = wv; }
    }
}
}
constexpr size_t MiB = 1u << 20;
constexpr size_t WS_CTL = 0, CTL_BYTES = 65536 + 4 * 65536;
constexpr size_t WS_ROWSQ = 65536;
constexpr int MISC_OFF = 131072 + 4096;
constexpr size_t WS_ROPE = 1 * MiB;
constexpr size_t WS_W = 2 * MiB, W_LAYER = 23 * MiB;
constexpr size_t W_IN = 0, W_OUT = (size_t)NIN * D * 2, W_UP = W_OUT + (size_t)D * D * 2, W_DOWN = W_UP + (size_t)NUP * D * 2;
static_assert(W_DOWN + (size_t)D * FF * 2 <= W_LAYER, "weights");
constexpr size_t WS_H = 48 * MiB;
constexpr size_t WS_QKV = 80 * MiB;
constexpr size_t WS_Y = 152 * MiB;
constexpr size_t WS_ACT = 80 * MiB;
constexpr size_t WS_EDGE = 184 * MiB;
constexpr size_t WS_PART = 186 * MiB;
constexpr size_t WS_END = 190 * MiB;
static_assert(WS_ACT + (size_t)M * FF * 2 <= WS_EDGE && WS_QKV + (size_t)M * NIN * 2 <= WS_Y && WS_Y + (size_t)M * D * 2 <= WS_EDGE, "ws map");

#ifndef REP_P0
#define REP_P0 1
#endif
#ifndef REP_P1
#define REP_P1 1
#endif
#ifndef REP_P3B
#define REP_P3B 1
#endif
#ifndef REP_P4
#define REP_P4 1
#endif
#ifndef ATT_REP
#define ATT_REP 1
#endif
#ifndef REP_P5
#define REP_P5 1
#endif
#ifndef REP_P3
#define REP_P3 1
#endif
#ifndef REP_SYNC
#define REP_SYNC 1
#endif
struct Args {
    const float *x, *g_attn, *w_in, *qn_a, *kn_a, *sink, *qn_b, *kn_b, *lq1, *lk1, *lq2, *lk2, *subln, *w_out, *g_ffn, *w_up, *conv_w, *conv_b, *w_down;
    float* out; unsigned char* ws;
};

__device__ __forceinline__ float wave_sum(float v) {
#pragma unroll
    for (int o = 1; o < 64; o <<= 1) v += __shfl_xor(v, o);
    return v;
}
__device__ __forceinline__ float uniform_f(float v) { return __uint_as_float(__builtin_amdgcn_readfirstlane(__float_as_uint(v))); }
__device__ __forceinline__ float wave_max(float v) {
#pragma unroll
    for (int o = 1; o < 64; o <<= 1) v = fmaxf(v, __shfl_xor(v, o));
    return v;
}
__device__ __forceinline__ unsigned f2bf(float f) { unsigned u = __builtin_bit_cast(unsigned, f); return (u + 0x7fffu + ((u >> 16) & 1u)) >> 16; }
__device__ __forceinline__ unsigned pk2(float lo, float hi) { return f2bf(lo) | (f2bf(hi) << 16); }

__device__ __forceinline__ void transpose_item(const float* __restrict__ W, int K, int N, bf16* __restrict__ WT, LAS float* scr, int kb, int nb, int dnb, int lane, const float* __restrict__ g) {
    const int k0 = 64 * kb, n0 = 32 * nb;
    float wv_[32];
#pragma unroll
    for (int i = 0; i < 32; ++i) { const int kk = 2 * i + (lane >> 5); wv_[i] = __builtin_nontemporal_load(&W[(size_t)(k0 + kk) * N + n0 + (lane & 31)]); }
#pragma unroll
    for (int i = 0; i < 32; ++i) { const int kk = 2 * i + (lane >> 5); scr[kk * 33 + (lane & 31)] = wv_[i] * (g ? g[k0 + kk] : 1.f); }
    asm volatile("s_waitcnt lgkmcnt(0)" ::: "memory");
    const int c = lane & 7;
#pragma unroll
    for (int j = 0; j < 4; ++j) { const int n = (lane >> 3) + 8 * j; const LAS float* s = scr + (8 * c) * 33 + n;
        u32x4 o; o.x = pk2(s[0 * 33], s[1 * 33]); o.y = pk2(s[2 * 33], s[3 * 33]); o.z = pk2(s[4 * 33], s[5 * 33]); o.w = pk2(s[6 * 33], s[7 * 33]);
        *(u32x4*)(WT + (size_t)(32 * dnb + n) * K + k0 + 8 * c) = o; }
    asm volatile("s_waitcnt lgkmcnt(0)" ::: "memory");
}

__device__ __forceinline__ void convert_rows(const float* __restrict__ x, bf16* __restrict__ out, float* __restrict__ rowsq, int gw, int ngw, int lane) {
    for (int m = gw; m < M; m += ngw) {
        const f32x4* xr = (const f32x4*)(x + (size_t)m * D) + lane; f32x4 v[4]; float s = 0.f;
#pragma unroll
        for (int j = 0; j < 4; ++j) { v[j] = __builtin_nontemporal_load(&xr[64 * j]); s += dot4(v[j]); }
        s = wave_sum(s);
        if (lane == 0) rowsq[m] = s;
        u32x2* o8 = (u32x2*)(out + (size_t)m * D) + lane;
#pragma unroll
        for (int j = 0; j < 4; ++j) { u32x2 wv; wv.x = pk2(v[j][0], v[j][1]); wv.y = pk2(v[j][2], v[j][3]); o8[64 * j] = wv; }
    }
}

#define XB_TMO      128
#define XB_XCNT(j)  (256  + 64 * (j))
#define XB_XSUB(j)  (1280 + 64 * (j))
#define XB_XGEN(j)  (2304 + 64 * (j))
#define XB_TOP      3328
#define XB_TOPGEN   3392
#define XCD_BAR_WORDS 3456
#define XB_SPIN_CAP (1u << 18)

__device__ __forceinline__ unsigned xb_ld(unsigned* p)              { return __hip_atomic_load(p, __ATOMIC_RELAXED, __HIP_MEMORY_SCOPE_AGENT); }
__device__ __forceinline__ unsigned xb_add(unsigned* p, unsigned v) { return __hip_atomic_fetch_add(p, v, __ATOMIC_RELAXED, __HIP_MEMORY_SCOPE_AGENT); }
__device__ __forceinline__ unsigned xb_xcc_id() { return (unsigned)__builtin_amdgcn_s_getreg((3 << 11) | 20) & 0xFu; }
#define XB_SPIN(cond, bar) do { unsigned _sp = 0; while (cond) { __builtin_amdgcn_s_sleep(0); \
    if ((++_sp & 255u) == 0u) { if (xb_ld(&(bar)[XB_TMO])) break; if (_sp > XB_SPIN_CAP) { atomicAdd(&(bar)[XB_TMO], 1u); break; } } } } while (0)

struct XcdBarrier {
    unsigned* bar; unsigned x;
    volatile LAS unsigned* st;
};

__device__ __forceinline__ XcdBarrier xcd_barrier_post(unsigned* bar, volatile LAS unsigned* st) {
    XcdBarrier b; b.bar = bar; b.x = xb_xcc_id(); b.st = st;
    if (threadIdx.x == 0) (void)xb_add(&bar[XB_XCNT(b.x)], 1u);
    return b;
}
__device__ __forceinline__ void xcd_barrier_complete(unsigned* bar, unsigned x, unsigned& nloc, unsigned& nx) {
    const unsigned G = gridDim.x * gridDim.y * gridDim.z;
    unsigned sum, cnt, mine, sp = 0u;
    for (;;) {
        sum = 0u; cnt = 0u; mine = 0u;
#pragma unroll
        for (unsigned j = 0; j < 16; ++j) { const unsigned c = xb_ld(&bar[XB_XCNT(j)]); sum += c; cnt += (c > 0u) ? 1u : 0u; mine = (j == x) ? c : mine; }
        if (sum == G) break;
        __builtin_amdgcn_s_sleep(1);
        if ((++sp & 255u) == 0u) { if (xb_ld(&bar[XB_TMO])) break; if (sp > XB_SPIN_CAP) { atomicAdd(&bar[XB_TMO], 1u); break; } }
    }
    nloc = mine > 0u ? mine : 1u; nx = cnt > 0u ? cnt : 1u;
}

__device__ __forceinline__ void xcd_barrier(const XcdBarrier& b) {
    asm volatile("s_waitcnt vmcnt(0)" ::: "memory");
    __syncthreads();
    if (threadIdx.x == 0) {
        unsigned* bar = b.bar;
        __builtin_amdgcn_s_waitcnt(0);
        unsigned nloc = b.st[0], nx = b.st[1];
        if (nloc == 0u) { xcd_barrier_complete(bar, b.x, nloc, nx); b.st[0] = nloc; b.st[1] = nx; }
        const unsigned old = xb_add(&bar[XB_XSUB(b.x)], 1u);
        const unsigned gen = old / nloc;
        if (old + 1u == (gen + 1u) * nloc) {
            __builtin_amdgcn_fence(__ATOMIC_RELEASE, "agent");
            asm volatile("s_waitcnt vmcnt(0)" ::: "memory");
            const unsigned og = xb_add(&bar[XB_TOP], 1u);
            const unsigned tg = og / nx;
            if (og + 1u == (tg + 1u) * nx) xb_add(&bar[XB_TOPGEN], 1u);
            else XB_SPIN(xb_ld(&bar[XB_TOPGEN]) == tg, bar);
            __builtin_amdgcn_fence(__ATOMIC_ACQUIRE, "agent");
            xb_add(&bar[XB_XGEN(b.x)], 1u);
            asm volatile("s_waitcnt vmcnt(0)" ::: "memory");
        } else {
            XB_SPIN(xb_ld(&bar[XB_XGEN(b.x)]) == gen, bar);
            __builtin_amdgcn_fence(__ATOMIC_ACQUIRE, "agent");
            asm volatile("s_waitcnt vmcnt(0)" ::: "memory");
        }
    }
    __syncthreads();
}

__global__ void __launch_bounds__(512, 2) mega_fwd(Args a) {
    extern __shared__ __attribute__((aligned(16))) unsigned char lds_raw[];
    LAS unsigned char* lds = (LAS unsigned char*)lds_raw;
    cg::grid_group grid = cg::this_grid();
    const int tid = threadIdx.x, lane = tid & 63, wave = __builtin_amdgcn_readfirstlane(tid >> 6);
    const int G = gridDim.x, bx = blockIdx.x;
    const int vcu = (G % 8 == 0) ? (bx % 8) * (G / 8) + bx / 8 : bx;
    const int gw = vcu * 8 + wave, ngw = G * 8;
    typedef const __attribute__((address_space(4))) Args* kargs_t;
    const kargs_t kap = (kargs_t)__builtin_amdgcn_kernarg_segment_ptr();
#define PHASE_ARGS() kargs_t ap = kap; asm volatile("" : "+s"(ap)); unsigned char* const ws = ap->ws; \
    float* const cosT = (float*)(ws + WS_ROPE); float* const sinT = cosT + S * 32; \
    bf16* const Hb = (bf16*)(ws + WS_H); bf16* const QKV = (bf16*)(ws + WS_QKV); bf16* const Yb = (bf16*)(ws + WS_Y); bf16* const ACT = (bf16*)(ws + WS_ACT); \
    float* const edge = (float*)(ws + WS_EDGE); float* const part = (float*)(ws + WS_PART); float* const rowsq = (float*)(ws + WS_ROWSQ); \
    (void)cosT; (void)sinT; (void)Hb; (void)QKV; (void)Yb; (void)ACT; (void)edge; (void)part; (void)rowsq
    volatile LAS unsigned* misc = (volatile LAS unsigned*)(lds + MISC_OFF);
    if (tid < 16) misc[tid] = 0u;
    __syncthreads();

#define CONVERT_WEIGHTS(L, wv, nwv) do { \
        int lane = threadIdx.x & 63; asm volatile("" : "+v"(lane)); \
        LAS float* scr = (LAS float*)(lds + wave * 16384); \
        constexpr int I_IN = 16 * 72, I_OUT = 16 * 32, I_UP = 16 * 176, I_DOWN = 44 * 32, I_L = I_IN + I_OUT + I_UP + I_DOWN; \
        unsigned char* wl_ = ws + WS_W + (size_t)(L) * W_LAYER; \
        for (int it = (wv); it < I_L; it += (nwv)) { \
            int r = it; \
            if (r < I_IN) { const int kb = r / 72, nb = r % 72; const int pn = nb >> 3, wc = (nb >> 1) & 3, bj = nb & 1; \
                transpose_item(ap->w_in + (size_t)(L) * D * NIN, D, NIN, (bf16*)(wl_ + W_IN), scr, kb, nb, 8 * pn + 4 * bj + wc, lane, ap->g_attn + (L) * D); continue; } \
            r -= I_IN; \
            if (r < I_OUT) { const int kb = r / 32, nb = r % 32; transpose_item(ap->w_out + (size_t)(L) * D * D, D, D, (bf16*)(wl_ + W_OUT), scr, kb, nb, nb, lane, nullptr); continue; } \
            r -= I_OUT; \
            if (r < I_UP) { const int kb = r / 176, nb = r % 176; const int isv = nb >= 88, nn = isv ? nb - 88 : nb; const int dnb = 8 * (nn >> 2) + 4 * isv + (nn & 3); \
                transpose_item(ap->w_up + (size_t)(L) * D * NUP, D, NUP, (bf16*)(wl_ + W_UP), scr, kb, nb, dnb, lane, ap->g_ffn + (L) * D); continue; } \
            r -= I_UP; \
            { const int kb = r / 32, nb = r % 32; transpose_item(ap->w_down + (size_t)(L) * FF * D, FF, D, (bf16*)(wl_ + W_DOWN), scr, kb, nb, nb, lane, nullptr); } \
        } } while (0)
    {
        PHASE_ARGS();
        CONVERT_WEIGHTS(0, gw, ngw);
        for (int i = vcu * 512 + tid; i < S * 32; i += G * 512) {
            const int pos = i >> 5, j = i & 31;
            double inv = 1.0; for (int k = 0; k < j; ++k) inv *= 0.74989420933245582730;
            const double ang = (double)pos * inv;
            const double kq = __builtin_rint(ang * 0.15915494309189533577);
            const double rr = (ang - kq * 6.283185307179586232) - kq * 2.4492935982947064e-16;
            const double r2 = rr * rr;
            double sn = 1.0, cs = 1.0;
#pragma unroll
            for (int k = 12; k >= 1; --k) { sn = 1.0 - sn * r2 * (1.0 / (double)((2 * k) * (2 * k + 1))); cs = 1.0 - cs * r2 * (1.0 / (double)((2 * k - 1) * (2 * k))); }
            cosT[i] = (float)cs; sinT[i] = (float)(sn * rr);
        }
        for (int i = vcu * 512 + tid; i < (int)(CTL_BYTES / 16); i += G * 512) { const size_t off = (size_t)i * 16;
            if (off < WS_ROWSQ || off >= WS_ROWSQ + (size_t)M * 4) *(u32x4*)(ws + WS_CTL + off) = (u32x4){0u, 0u, 0u, 0u}; }
        convert_rows(ap->x, Hb, rowsq, gw, ngw, lane);
    }
    asm volatile("s_waitcnt vmcnt(0)" ::: "memory");
    __syncthreads();
    if (tid == 0) { __builtin_amdgcn_fence(__ATOMIC_RELEASE, "agent"); asm volatile("s_waitcnt vmcnt(0)" ::: "memory"); }
    grid.sync();
    if (tid == 0) { __builtin_amdgcn_fence(__ATOMIC_ACQUIRE, "agent"); asm volatile("s_waitcnt vmcnt(0)" ::: "memory"); }
    __syncthreads();
    XcdBarrier xbar; { PHASE_ARGS(); xbar = xcd_barrier_post((unsigned*)(ws + WS_CTL) + 1024, misc); }

    for (int l = 0; l < DEPTH; ++l) {
        const float lambda_init = 0.8f - 0.6f * __expf(-0.3f * (float)l);
        {
            PHASE_ARGS(); unsigned char* const wl = ws + WS_W + (size_t)l * W_LAYER; (void)wl;
            pg8::Gemm g{Hb, (const bf16*)(wl + W_IN), M, NIN, D}; pg8::StaticOrder So; So.init(M, NIN, G, bx);
            EpiInProj E{QKV, ap->qn_a + l * 64, ap->kn_a + l * 64, ap->qn_b + l * 64, ap->kn_b + l * 64, cosT, sinT, rowsq + (size_t)(2 * l) * M};
            pg8::gemm_phase<EpiInProj, pg8::StaticOrder, true, true>(lds, g, So, E);
            if (l == 0 && DEPTH > 1) {
                const int nidle = G - 64;
                if (nidle >= 64) { if (bx >= 64) CONVERT_WEIGHTS(1, (bx - 64) * 8 + wave, nidle * 8); }
                else CONVERT_WEIGHTS(1, gw, ngw);
            }
        }
        xcd_barrier(xbar);
        {
            PHASE_ARGS(); unsigned char* const wl = ws + WS_W + (size_t)l * W_LAYER; (void)wl;
            int lane = threadIdx.x & 63; asm volatile("" : "+v"(lane));
            const float mqa = wave_max(fabsf(ap->qn_a[l * 64 + lane])), mka = wave_max(fabsf(ap->kn_a[l * 64 + lane]));
            const float mqb = wave_max(fabsf(ap->qn_b[l * 64 + lane])), mkb = wave_max(fabsf(ap->kn_b[l * 64 + lane]));
            const float MbA = uniform_f(8.f * mqa * mka * LOG2E * 1.02f), MbB = uniform_f(8.f * mqb * mkb * LOG2E * 1.02f);
            const float s1 = wave_sum(ap->lq1[l * 64 + lane] * ap->lk1[l * 64 + lane]), s2 = wave_sum(ap->lq2[l * 64 + lane] * ap->lk2[l * 64 + lane]);
            const float lam = uniform_f(__expf(s1) - __expf(s2) + lambda_init);
            {
            for (int uidx = vcu; uidx < NB * 4 * 16; uidx += G) {
                const int bh = uidx >> 4, qb = uidx & 15;
                att::diff_unit((LAS char*)lds, QKV, Yb, bh >> 2, bh & 3, qb, MbB, lam, ap->subln + l * 128, 1.f - lambda_init);
            }
            for (int uidx = vcu; uidx < NB * 2 * 16; uidx += G) {
                const int bk = uidx >> 4, n = uidx & 15;
                att::swa_unit((LAS char*)lds, QKV, Yb, bk >> 1, bk & 1, n, MbA, ap->sink + l * 8);
            }
            __syncthreads();
            }
        }
        xcd_barrier(xbar);
        {
            PHASE_ARGS(); unsigned char* const wl = ws + WS_W + (size_t)l * W_LAYER; (void)wl;
            pg8::Gemm g{Yb, (const bf16*)(wl + W_OUT), M, D, D}; pg8::StaticOrder So; So.init(M, D, G, bx);
            EpiResid E{Hb, rowsq + (size_t)(2 * l + 1) * M, nullptr};
            pg8::gemm_phase<EpiResid, pg8::StaticOrder, true, true>(lds, g, So, E);
        }
        xcd_barrier(xbar);
        {
            PHASE_ARGS(); unsigned char* const wl = ws + WS_W + (size_t)l * W_LAYER; (void)wl;
            pg8::Gemm g{Hb, (const bf16*)(wl + W_UP), M, NUP, D}; pg8::StaticOrder So; So.init(M, NUP, G, bx);
            EpiUpConv E{ACT, ap->conv_w + (size_t)l * 3 * FF, ap->conv_b + (size_t)l * FF, edge, part, (LAS float*)(lds + XL_OFF), rowsq + (size_t)(2 * l + 1) * M};
            pg8::gemm_phase<EpiUpConv, pg8::StaticOrder, true, true>(lds, g, So, E);
        }
        xcd_barrier(xbar);
        {
            PHASE_ARGS(); unsigned char* const wl = ws + WS_W + (size_t)l * W_LAYER; (void)wl;
            pg8::Gemm g{ACT, (const bf16*)(wl + W_DOWN), M, D, FF}; pg8::StaticOrder So; So.init(M, D, G, bx);
            { const float* cw = ap->conv_w + (size_t)l * 3 * FF; pg8::Unit uu; int tid = threadIdx.x; asm volatile("" : "+v"(tid));
              for (int ui = 0; So.next(ui, uu); ++ui) { const int pm = uu.pm;
                for (int i = tid; i < 2 * FF; i += 512) { const int which = i / FF, ch = i % FF;
                    if (which == 0 && (pm & 7) != 0) { const float* pp = part + (((size_t)pm * 2 + 0) * FF + ch) * 2;
                        const float pre = pp[0] + cw[ch] * edge[((size_t)(pm - 1) * 2 + 1) * FF + ch];
                        ACT[(size_t)(pm * 256) * FF + ch] = (bf16)f2bf(silu_f(pre) * pp[1]); }
                    if (which == 1 && (pm & 7) != 7) { const float* pp = part + (((size_t)pm * 2 + 1) * FF + ch) * 2;
                        const float pre = pp[0] + cw[2 * FF + ch] * edge[((size_t)(pm + 1) * 2 + 0) * FF + ch];
                        ACT[(size_t)(pm * 256 + 255) * FF + ch] = (bf16)f2bf(silu_f(pre) * pp[1]); } } }
              asm volatile("s_waitcnt vmcnt(0)" ::: "memory"); __syncthreads(); }
            const bool lastl = (l + 1 == DEPTH);
            EpiResid E{Hb, lastl ? nullptr : rowsq + (size_t)(2 * l + 2) * M, lastl ? ap->out : nullptr};
            pg8::gemm_phase<EpiResid, pg8::StaticOrder, true, true>(lds, g, So, E);
        }
        if (l + 1 < DEPTH) xcd_barrier(xbar);
    }
}

extern "C" void kernel_launch(void* const* d_in, const int* in_sizes, int n_in, void* d_out, int out_size, void* d_ws, size_t ws_size, hipStream_t stream) {
    static int grid = 0;
    if (grid == 0) {
        if (n_in != 19 || ws_size < WS_END) { fprintf(stderr, "kernel_launch: unexpected inputs (n_in %d, ws %zu)\n", n_in, ws_size); grid = -1; return; }
        int dev = 0, cus = 0, per_cu = 0;
        hipGetDevice(&dev);
        hipDeviceGetAttribute(&cus, hipDeviceAttributeMultiprocessorCount, dev);
        hipFuncSetAttribute((const void*)mega_fwd, hipFuncAttributeMaxDynamicSharedMemorySize, LDS_BYTES);
        hipOccupancyMaxActiveBlocksPerMultiprocessor(&per_cu, (const void*)mega_fwd, 512, LDS_BYTES);
        if (per_cu < 1) { fprintf(stderr, "kernel_launch: occupancy query reports %d blocks per CU\n", per_cu); per_cu = 1; }
        grid = cus;
        (void)hipGetLastError();
    }
    if (grid < 0) return;
    Args a{};
    const float** p = (const float**)&a;
    for (int i = 0; i < 19; ++i) p[i] = (const float*)d_in[i];
    a.out = (float*)d_out; a.ws = (unsigned char*)d_ws;
    void* args[] = {&a};
    hipError_t e = hipLaunchCooperativeKernel((const void*)mega_fwd, dim3(grid), dim3(512), args, LDS_BYTES, stream);
    if (e != hipSuccess) fprintf(stderr, "cooperative launch failed: %s (grid %d)\n", hipGetErrorString(e), grid);
}
```

```cpp
#include <hip/hip_runtime.h>
#include <hip/hip_cooperative_groups.h>
#include <cstdio>
#include <cstdint>
namespace cg = cooperative_groups;
namespace pg8 {
#define PG8_LAS __attribute__((address_space(3)))
typedef unsigned short bf16_t;
typedef short bf16x8 __attribute__((ext_vector_type(8)));
typedef float f32x4 __attribute__((ext_vector_type(4)));
typedef unsigned u32x4 __attribute__((ext_vector_type(4)));
constexpr int BM = 256, BK = 64, HALF = 128, HTB = HALF * BK * 2  , STAGE_BYTES = 8 * HTB, NXCD = 8, WGM = 4;

__host__ __device__ __forceinline__ int lds_byte(int r, int c) { const int st = (r >> 4) * 2 + (c >> 5), rr = r & 15, cc = c & 31, ob = rr * 64 + cc * 2; return st * 1024 + (ob ^ (((ob >> 9) & 1) << 5)); }
__host__ __device__ __forceinline__ void stage_rc(int b, int& R, int& C) { const int st = b / 1024, sb = b % 1024, swz = sb ^ (((sb >> 9) & 1) << 5); R = (st >> 1) * 16 + swz / 64; C = (st & 1) * 32 + (swz % 64) / 2; }
__host__ __device__ __forceinline__ int perm32(int rho) { const int n = rho >> 4, i = rho & 15; return 8 * (i >> 2) + 4 * n + (i & 3); }

struct Unit { int pm, pn; };
struct Gemm { const bf16_t* A; const bf16_t* Bt; int M, N, K; };

struct StaticOrder {
    int nM, nN, nwg, G, c;
    __host__ __device__ void init(int M, int N, int G_, int c_) { nM = M / BM; nN = N / BM; nwg = nM * nN; G = G_; c = c_; }
    __host__ __device__ bool next(int i, Unit& u) const {
        const long L = (long)i * G + c; if (L >= nwg) return false;
        int wgid = (int)L; { const int q = nwg / NXCD, r = nwg % NXCD, xcd = wgid % NXCD, off = wgid / NXCD; wgid = (xcd < r ? xcd * (q + 1) : r * (q + 1) + (xcd - r) * q) + off; }
        const int nig = WGM * nN, gid = wgid / nig, fm = gid * WGM, gsz = (nM - fm) < WGM ? (nM - fm) : WGM;
        u.pm = fm + ((wgid % nig) % gsz); u.pn = (wgid % nig) / gsz; return true;
    }
    __device__ __forceinline__ void a_ready(const Unit&) const {}
    __device__ __forceinline__ void done(const Unit&) const {}
};

__device__ __forceinline__ unsigned cvt_pk_bf16(float lo, float hi) { unsigned r; asm volatile("v_cvt_pk_bf16_f32 %0, %1, %2" : "=v"(r) : "v"(lo), "v"(hi)); return r; }
template <class Epi, class Sched, bool ALIGN_EPI = false, bool SP2 = false>
__device__ __forceinline__ void gemm_phase(PG8_LAS unsigned char* lds, const Gemm g, const Sched& S, const Epi& E) {
    int tid = threadIdx.x; asm volatile("" : "+v"(tid)); const int wid = __builtin_amdgcn_readfirstlane(tid >> 6), lane = tid & 63, wr = wid >> 2, wc = wid & 3, fr = lane & 15, fq = lane >> 4;
    const int K = g.K, nt = K / BK;
    unsigned voffA[2], voffB[2];
#pragma unroll
    for (int i = 0; i < 2; ++i) { int R, C; stage_rc(tid * 16 + i * 8192, R, C); const int Rb = Epi::PERM ? ((R & ~31) + perm32(R & 31)) : R;
        voffA[i] = (unsigned)(R * K + C) * 2u; voffB[i] = (unsigned)(Rb * K + C) * 2u; }
    const size_t kstep = (size_t)(BK * 2);
    const size_t hstep = (size_t)HALF * K * 2;
    const size_t tstep = 2 * hstep;
    const unsigned ldsw = (unsigned)wid * 1024u;
    const int aoff = lds_byte(wr * 64 + fr, fq * 8), boff = lds_byte(wc * 32 + fr, fq * 8);
#define PG8_SA(b, h) (((b) * 2 + (h)) * HTB)
#define PG8_SB(b, h) ((4 + (b) * 2 + (h)) * HTB)
#define PG8_STAGE(bufoff, gbase, voff) do { _Pragma("unroll") for (int _i = 0; _i < 2; ++_i) \
        __builtin_amdgcn_global_load_lds((const unsigned*)((const char*)(gbase) + (voff)[_i]), (PG8_LAS unsigned*)(lds + (bufoff) + ldsw + _i * 8192), 16, 0, 0); } while (0)
#define PG8_LDA(dst, b, h) do { _Pragma("unroll") for (int m = 0; m < 4; ++m) _Pragma("unroll") for (int k = 0; k < 2; ++k) dst[m][k] = *(const PG8_LAS bf16x8*)(lds + PG8_SA(b, h) + aoff + m * 2048 + k * 1024); } while (0)
#define PG8_LDB(dst, b, h) do { _Pragma("unroll") for (int n = 0; n < 2; ++n) _Pragma("unroll") for (int k = 0; k < 2; ++k) dst[n][k] = *(const PG8_LAS bf16x8*)(lds + PG8_SB(b, h) + boff + n * 2048 + k * 1024); } while (0)
#define PG8_MMA(ai, bj, At, Bt) do { __builtin_amdgcn_s_setprio(1); _Pragma("unroll") for (int m = 0; m < 4; ++m) _Pragma("unroll") for (int n = 0; n < 2; ++n) _Pragma("unroll") for (int k = 0; k < 2; ++k) \
        acc[ai][bj][m][n] = __builtin_amdgcn_mfma_f32_16x16x32_bf16(Bt[n][k], At[m][k], acc[ai][bj][m][n], 0, 0, 0); __builtin_amdgcn_s_setprio(0); } while (0)
#define PG8_WAIT_V(n) asm volatile("s_waitcnt vmcnt(" #n ")" ::: "memory")
#define PG8_WAIT_L(n) asm volatile("s_waitcnt lgkmcnt(" #n ")" ::: "memory")
#define PG8_BAR __builtin_amdgcn_s_barrier()
#define PG8_SCHED __builtin_amdgcn_sched_barrier(0)
    Unit cur, nxt; int ui = 0;
    if (!S.next(0, cur)) return;
    f32x4 acc[2][2][4][2];
#pragma unroll
    for (int a = 0; a < 2; ++a)
#pragma unroll
        for (int b = 0; b < 2; ++b)
#pragma unroll
            for (int m = 0; m < 4; ++m)
#pragma unroll
                for (int n = 0; n < 2; ++n) acc[a][b][m][n] = (f32x4){0.f, 0.f, 0.f, 0.f};
    bf16x8 At[4][2], B0[2][2], B1[2][2];
    const char* cA = (const char*)g.A + (size_t)cur.pm * tstep; const char* cB = (const char*)g.Bt + (size_t)cur.pn * tstep;
    S.a_ready(cur);
    if constexpr (SP2) {
        PG8_STAGE(PG8_SB(0, 0), cB, voffB); PG8_STAGE(PG8_SB(0, 1), cB + hstep, voffB); PG8_STAGE(PG8_SA(0, 0), cA, voffA); PG8_STAGE(PG8_SA(0, 1), cA + hstep, voffA);
        if (wr == 1) PG8_BAR;
        PG8_WAIT_V(2); PG8_BAR;
        PG8_STAGE(PG8_SB(1, 0), cB + kstep, voffB); PG8_STAGE(PG8_SA(1, 0), cA + kstep, voffA); PG8_STAGE(PG8_SB(1, 1), cB + hstep + kstep, voffB);
        PG8_WAIT_V(6); PG8_BAR;
    } else {
        PG8_STAGE(PG8_SB(0, 0), cB, voffB); PG8_STAGE(PG8_SA(0, 0), cA, voffA); PG8_STAGE(PG8_SB(0, 1), cB + hstep, voffB); PG8_STAGE(PG8_SA(0, 1), cA + hstep, voffA);
        if (wr == 1) PG8_BAR;
        PG8_WAIT_V(4); PG8_BAR;
        PG8_STAGE(PG8_SB(1, 0), cB + kstep, voffB); PG8_STAGE(PG8_SA(1, 0), cA + kstep, voffA); PG8_STAGE(PG8_SB(1, 1), cB + hstep + kstep, voffB);
        PG8_WAIT_V(6); PG8_BAR;
    }
    for (;;) {
        const bool has_next = S.next(ui + 1, nxt);
        const char* nA = has_next ? (const char*)g.A + (size_t)nxt.pm * tstep : cA; const char* nB = has_next ? (const char*)g.Bt + (size_t)nxt.pn * tstep : cB;
        for (int t = 0; t < nt; t += 2) {
            const bool last = (t == nt - 2);
            const char* a1 = cA + (size_t)(t + 1) * kstep;
            const char* a2 = last ? nA : cA + (size_t)(t + 2) * kstep; const char* b2 = last ? nB : cB + (size_t)(t + 2) * kstep;
            const char* a3 = a2 + kstep; const char* b3 = b2 + kstep;
            if (last && has_next) S.a_ready(nxt);
            if constexpr (SP2) {
            PG8_LDB(B0, 0, 0); PG8_LDB(B1, 0, 1); PG8_SCHED; PG8_LDA(At, 0, 0); PG8_STAGE(PG8_SA(1, 1), a1 + hstep, voffA);
            PG8_WAIT_V(8); PG8_WAIT_L(0); PG8_BAR; PG8_MMA(0, 0, At, B0); PG8_MMA(0, 1, At, B1); PG8_BAR; PG8_SCHED;
            PG8_LDA(At, 0, 1); PG8_STAGE(PG8_SB(0, 0), b2, voffB); PG8_STAGE(PG8_SB(0, 1), b2 + hstep, voffB); PG8_STAGE(PG8_SA(0, 0), a2, voffA);
            PG8_WAIT_V(8); PG8_WAIT_L(0); PG8_BAR; PG8_MMA(1, 0, At, B0); PG8_MMA(1, 1, At, B1); PG8_BAR; PG8_SCHED;
            PG8_LDB(B0, 1, 0); PG8_LDB(B1, 1, 1); PG8_SCHED; PG8_LDA(At, 1, 0); PG8_STAGE(PG8_SA(0, 1), a2 + hstep, voffA);
            PG8_WAIT_V(8); PG8_WAIT_L(0); PG8_BAR; PG8_MMA(0, 0, At, B0); PG8_MMA(0, 1, At, B1); PG8_BAR; PG8_SCHED;
            PG8_LDA(At, 1, 1); PG8_STAGE(PG8_SB(1, 0), b3, voffB); PG8_STAGE(PG8_SB(1, 1), b3 + hstep, voffB); PG8_STAGE(PG8_SA(1, 0), a3, voffA);
            PG8_WAIT_V(8); PG8_WAIT_L(0); PG8_BAR; PG8_MMA(1, 0, At, B0); PG8_MMA(1, 1, At, B1); PG8_BAR; PG8_SCHED;
            } else {
            PG8_LDB(B0, 0, 0); PG8_SCHED; PG8_LDA(At, 0, 0); PG8_STAGE(PG8_SA(1, 1), a1 + hstep, voffA);
            PG8_WAIT_L(8); PG8_BAR; PG8_WAIT_L(0); PG8_MMA(0, 0, At, B0); PG8_BAR; PG8_SCHED;
            PG8_LDB(B1, 0, 1); PG8_STAGE(PG8_SB(0, 0), b2, voffB);
            PG8_BAR; PG8_WAIT_L(0); PG8_MMA(0, 1, At, B1); PG8_BAR;
            PG8_LDA(At, 0, 1); PG8_STAGE(PG8_SA(0, 0), a2, voffA);
            PG8_BAR; PG8_WAIT_L(0); PG8_MMA(1, 0, At, B0); PG8_BAR; PG8_SCHED;
            PG8_STAGE(PG8_SB(0, 1), b2 + hstep, voffB);
            PG8_WAIT_V(6); PG8_BAR; PG8_MMA(1, 1, At, B1); PG8_BAR;
            PG8_LDB(B0, 1, 0); PG8_SCHED; PG8_LDA(At, 1, 0); PG8_STAGE(PG8_SA(0, 1), a2 + hstep, voffA);
            PG8_WAIT_L(8); PG8_BAR; PG8_WAIT_L(0); PG8_MMA(0, 0, At, B0); PG8_BAR; PG8_SCHED;
            PG8_LDB(B1, 1, 1); PG8_STAGE(PG8_SB(1, 0), b3, voffB);
            PG8_BAR; PG8_WAIT_L(0); PG8_MMA(0, 1, At, B1); PG8_BAR;
            PG8_LDA(At, 1, 1); PG8_STAGE(PG8_SA(1, 0), a3, voffA);
            PG8_BAR; PG8_WAIT_L(0); PG8_MMA(1, 0, At, B0); PG8_BAR; PG8_SCHED;
            PG8_STAGE(PG8_SB(1, 1), b3 + hstep, voffB);
            PG8_WAIT_V(6); PG8_BAR; PG8_MMA(1, 1, At, B1); PG8_BAR;
            }
        }
        if constexpr (ALIGN_EPI) { if (wr == 0) PG8_BAR; }
        if constexpr (!Epi::AFTER_DRAIN) { E(acc, cur, wr, wc, fr, fq); S.done(cur); }
        if (!has_next) break;
#pragma unroll
        for (int a = 0; a < 2; ++a)
#pragma unroll
            for (int b = 0; b < 2; ++b)
#pragma unroll
                for (int m = 0; m < 4; ++m)
#pragma unroll
                    for (int n = 0; n < 2; ++n) acc[a][b][m][n] = (f32x4){0.f, 0.f, 0.f, 0.f};
        cur = nxt; cA = nA; cB = nB; ++ui;
        if constexpr (ALIGN_EPI) { if (wr == 1) PG8_BAR; }
    }
    PG8_WAIT_V(0);
    if constexpr (!ALIGN_EPI) { if (wr == 0) PG8_BAR; }
    PG8_BAR;
    if constexpr (Epi::AFTER_DRAIN) { E.fused(acc, cur, wr, wc, fr, fq, lds, wid, lane); S.done(cur); }
#undef PG8_SA
#undef PG8_SB
#undef PG8_STAGE
#undef PG8_LDA
#undef PG8_LDB
#undef PG8_MMA
#undef PG8_WAIT_V
#undef PG8_WAIT_L
#undef PG8_BAR
#undef PG8_SCHED
}
}
#define LAS __attribute__((address_space(3)))
typedef unsigned short bf16;
using pg8::f32x4; using pg8::u32x4; using pg8::Unit; using pg8::cvt_pk_bf16; using pg8::bf16x8;
typedef unsigned u32x2 __attribute__((ext_vector_type(2)));

constexpr int NB = 8, S = 2048, D = 1024, M = NB * S, NIN = 2304, FF = 2816, NUP = 2 * FF, DEPTH = 2;
constexpr float EPS = 1e-6f;
constexpr float LOG2E = 1.4426950408889634f;
constexpr float QSCALE = 0.125f * LOG2E;
constexpr int XL_OFF = 131072;
constexpr int LDS_BYTES = 131072 + 8192;

__device__ __forceinline__ float dot4(f32x4 a) { return (a[0] * a[0] + a[1] * a[1]) + (a[2] * a[2] + a[3] * a[3]); }
__device__ __forceinline__ float silu_f(float v) { return v * __builtin_amdgcn_rcpf(1.f + __expf(-v)); }

struct EpiInProj {
    static constexpr bool PERM = true, AFTER_DRAIN = false;
    bf16* O; const float* qn_a; const float* kn_a; const float* qn_b; const float* kn_b; const float* cosT; const float* sinT; const float* rowsq;
    __device__ __forceinline__ void operator()(const f32x4 (&acc)[2][2][4][2], const Unit& u, int wr, int wc, int fr, int fq) const {
        asm volatile("" : "+v"(fr), "+v"(fq));
        const int pn = u.pn;
        const float* g = nullptr; float sc = 1.f;
        if (pn < 2) { g = qn_a; sc = QSCALE; }
        else if (pn == 2) { if (wc < 2) g = kn_a; }
        else if (pn < 5) { g = qn_b; sc = QSCALE; }
        else if (pn < 7) { g = kn_b; }
        const int colb = pn * 256 + wc * 64 + 8 * fq;
        const int row0 = u.pm * 256 + wr * 64 + fr;
        if (g) {
            f32x4 g1[2], g2[2];
#pragma unroll
            for (int n = 0; n < 2; ++n) { g1[n] = *(const f32x4*)(g + 8 * fq + 4 * n); g2[n] = *(const f32x4*)(g + 32 + 8 * fq + 4 * n); }
#pragma unroll
            for (int ai = 0; ai < 2; ++ai)
#pragma unroll
                for (int m = 0; m < 4; ++m) {
                    const int row = row0 + ai * 128 + m * 16;
                    const f32x4 a0 = acc[ai][0][m][0], a1 = acc[ai][0][m][1], b0 = acc[ai][1][m][0], b1 = acc[ai][1][m][1];
                    float ss = (dot4(a0) + dot4(a1)) + (dot4(b0) + dot4(b1));
                    ss += __shfl_xor(ss, 16); ss += __shfl_xor(ss, 32);
                    const float rx = rsqrtf(rowsq[row] * (1.f / D) + EPS);
                    const float rs = rsqrtf(ss * rx * rx * (1.f / 64.f) + EPS) * rx * sc;
                    const size_t ro = (size_t)(row & (S - 1)) * 32 + 8 * fq;
                    const f32x4 c0 = *(const f32x4*)(cosT + ro), c1 = *(const f32x4*)(cosT + ro + 4), s0 = *(const f32x4*)(sinT + ro), s1 = *(const f32x4*)(sinT + ro + 4);
                    const f32x4 y10 = a0 * rs * g1[0], y11 = a1 * rs * g1[1], y20 = b0 * rs * g2[0], y21 = b1 * rs * g2[1];
                    const f32x4 o10 = y10 * c0 - y20 * s0, o11 = y11 * c1 - y21 * s1, o20 = y20 * c0 + y10 * s0, o21 = y21 * c1 + y11 * s1;
                    u32x4 w1, w2;
                    w1.x = cvt_pk_bf16(o10[0], o10[1]); w1.y = cvt_pk_bf16(o10[2], o10[3]); w1.z = cvt_pk_bf16(o11[0], o11[1]); w1.w = cvt_pk_bf16(o11[2], o11[3]);
                    w2.x = cvt_pk_bf16(o20[0], o20[1]); w2.y = cvt_pk_bf16(o20[2], o20[3]); w2.z = cvt_pk_bf16(o21[0], o21[1]); w2.w = cvt_pk_bf16(o21[2], o21[3]);
                    bf16* op = O + (size_t)row * NIN + colb;
                    *(u32x4*)op = w1; *(u32x4*)(op + 32) = w2;
                }
        } else {
#pragma unroll
            for (int ai = 0; ai < 2; ++ai)
#pragma unroll
                for (int m = 0; m < 4; ++m) {
                    const int row = row0 + ai * 128 + m * 16;
                    bf16* op = O + (size_t)row * NIN + colb;
                    const float rx = rsqrtf(rowsq[row] * (1.f / D) + EPS);
#pragma unroll
                    for (int bj = 0; bj < 2; ++bj) { const f32x4 v0 = acc[ai][bj][m][0] * rx, v1 = acc[ai][bj][m][1] * rx; u32x4 w;
                        w.x = cvt_pk_bf16(v0[0], v0[1]); w.y = cvt_pk_bf16(v0[2], v0[3]); w.z = cvt_pk_bf16(v1[0], v1[1]); w.w = cvt_pk_bf16(v1[2], v1[3]);
                        *(u32x4*)(op + 32 * bj) = w; }
                }
        }
    }
};

__device__ __forceinline__ f32x4 bf2f_lo(unsigned a, unsigned b) { return (f32x4){__uint_as_float(a << 16), __uint_as_float(a & 0xffff0000u), __uint_as_float(b << 16), __uint_as_float(b & 0xffff0000u)}; }
struct EpiResid {
    static constexpr bool PERM = true, AFTER_DRAIN = false;
    bf16* XB; float* rowsq; float* outf;
    __device__ __forceinline__ void operator()(const f32x4 (&acc)[2][2][4][2], const Unit& u, int wr, int wc, int fr, int fq) const {
        asm volatile("" : "+v"(fr), "+v"(fq));
        const int col0 = u.pn * 256 + wc * 32 + 8 * fq, row0 = u.pm * 256 + wr * 64 + fr;
#pragma unroll
        for (int ai = 0; ai < 2; ++ai) {
            u32x4 xr[4][2];
#pragma unroll
            for (int m = 0; m < 4; ++m) { const size_t off = (size_t)(row0 + ai * 128 + m * 16) * D + col0;
#pragma unroll
                for (int bj = 0; bj < 2; ++bj) xr[m][bj] = *(const u32x4*)(XB + off + bj * 128); }
            asm volatile("" ::: "memory");
#pragma unroll
            for (int m = 0; m < 4; ++m) { const int row = row0 + ai * 128 + m * 16; const size_t off = (size_t)row * D + col0; float ss = 0.f;
#pragma unroll
                for (int bj = 0; bj < 2; ++bj) {
                    const f32x4 y0 = bf2f_lo(xr[m][bj].x, xr[m][bj].y) + acc[ai][bj][m][0], y1 = bf2f_lo(xr[m][bj].z, xr[m][bj].w) + acc[ai][bj][m][1];
                    ss += dot4(y0) + dot4(y1);
                    if (outf) { __builtin_nontemporal_store(y0, (f32x4*)(outf + off + bj * 128)); __builtin_nontemporal_store(y1, (f32x4*)(outf + off + bj * 128 + 4)); }
                    else { u32x4 w; w.x = cvt_pk_bf16(y0[0], y0[1]); w.y = cvt_pk_bf16(y0[2], y0[3]); w.z = cvt_pk_bf16(y1[0], y1[1]); w.w = cvt_pk_bf16(y1[2], y1[3]); *(u32x4*)(XB + off + bj * 128) = w; }
                }
                if (rowsq) { ss += __shfl_xor(ss, 16); ss += __shfl_xor(ss, 32); if (fq == 0) atomicAdd(rowsq + row, ss); }
            }
            asm volatile("" ::: "memory");
        }
    }
};

struct EpiUpConv {
    static constexpr bool PERM = true, AFTER_DRAIN = false;
    bf16* ACT; const float* cw; const float* cb; float* edge; float* part; LAS float* xl; const float* rowsq;
    __device__ __forceinline__ void operator()(f32x4 (&acc)[2][2][4][2], const Unit& u, int wr, int wc, int fr, int fq) const {
        asm volatile("" : "+v"(fr), "+v"(fq));
        const int lane = 16 * fq + fr;
        const int cl0 = 32 * wc + 8 * fq, ch0 = 128 * u.pn + cl0;
#pragma unroll
        for (int ai = 0; ai < 2; ++ai)
#pragma unroll
            for (int m = 0; m < 4; ++m) { const float rx = rsqrtf(rowsq[u.pm * 256 + ai * 128 + wr * 64 + m * 16 + fr] * (1.f / D) + EPS);
#pragma unroll
                for (int bj = 0; bj < 2; ++bj) { acc[ai][bj][m][0] *= rx; acc[ai][bj][m][1] *= rx; } }
#pragma unroll
        for (int ai = 0; ai < 2; ++ai) {
            const int chunk = 2 * ai + wr;
            if (fr == 0) { *(LAS f32x4*)(xl + (chunk * 2 + 0) * 128 + cl0) = acc[ai][0][0][0]; *(LAS f32x4*)(xl + (chunk * 2 + 0) * 128 + cl0 + 4) = acc[ai][0][0][1]; }
            if (fr == 15) { *(LAS f32x4*)(xl + (chunk * 2 + 1) * 128 + cl0) = acc[ai][0][3][0]; *(LAS f32x4*)(xl + (chunk * 2 + 1) * 128 + cl0 + 4) = acc[ai][0][3][1]; }
        }
        asm volatile("s_waitcnt lgkmcnt(0)" ::: "memory"); __builtin_amdgcn_s_barrier(); asm volatile("" ::: "memory");
        const int lup = (lane & ~15) | ((fr + 15) & 15), ldn = (lane & ~15) | ((fr + 1) & 15);
        const bool seq_first = (u.pm & 7) == 0, seq_last = (u.pm & 7) == 7;
#pragma unroll
        for (int ai = 0; ai < 2; ++ai) {
            const int chunk = 2 * ai + wr;
#pragma unroll
            for (int n = 0; n < 2; ++n) {
                const int ch = ch0 + 4 * n;
                const f32x4 w0 = *(const f32x4*)(cw + ch), w1 = *(const f32x4*)(cw + FF + ch), w2 = *(const f32x4*)(cw + 2 * FF + ch), bb = *(const f32x4*)(cb + ch);
                const f32x4 above = (chunk > 0) ? *(const LAS f32x4*)(xl + ((chunk - 1) * 2 + 1) * 128 + cl0 + 4 * n) : (f32x4){0.f, 0.f, 0.f, 0.f};
                const f32x4 below = (chunk < 3) ? *(const LAS f32x4*)(xl + ((chunk + 1) * 2 + 0) * 128 + cl0 + 4 * n) : (f32x4){0.f, 0.f, 0.f, 0.f};
                f32x4 Rprev = above, Lcur;
#pragma unroll
                for (int e = 0; e < 4; ++e) Lcur[e] = __shfl(acc[ai][0][0][n][e], ldn);
#pragma unroll
                for (int m = 0; m < 4; ++m) {
                    const int rt = ai * 128 + wr * 64 + m * 16 + fr;
                    const size_t row = (size_t)u.pm * 256 + rt;
                    const f32x4 cur = acc[ai][0][m][n], val = acc[ai][1][m][n];
                    f32x4 Rm, Lnext = below;
#pragma unroll
                    for (int e = 0; e < 4; ++e) { Rm[e] = __shfl(cur[e], lup); if (m < 3) Lnext[e] = __shfl(acc[ai][0][m < 3 ? m + 1 : 3][n][e], ldn); }
                    const f32x4 up = (fr == 0) ? Rprev : Rm, dn = (fr == 15) ? Lnext : Lcur;
                    Rprev = Rm; Lcur = Lnext;
                    const f32x4 pre = bb + w0 * up + w1 * cur + w2 * dn;
                    f32x4 res;
#pragma unroll
                    for (int e = 0; e < 4; ++e) res[e] = silu_f(pre[e]) * val[e];
                    if (rt == 0) {
                        *(f32x4*)(edge + ((size_t)u.pm * 2 + 0) * FF + ch) = cur;
                        if (!seq_first) { float* pp = part + (((size_t)u.pm * 2 + 0) * FF + ch) * 2;
                            *(f32x4*)pp = (f32x4){pre[0], val[0], pre[1], val[1]}; *(f32x4*)(pp + 4) = (f32x4){pre[2], val[2], pre[3], val[3]}; }
                    }
                    if (rt == 255) {
                        *(f32x4*)(edge + ((size_t)u.pm * 2 + 1) * FF + ch) = cur;
                        if (!seq_last) { float* pp = part + (((size_t)u.pm * 2 + 1) * FF + ch) * 2;
                            *(f32x4*)pp = (f32x4){pre[0], val[0], pre[1], val[1]}; *(f32x4*)(pp + 4) = (f32x4){pre[2], val[2], pre[3], val[3]}; }
                    }
                    u32x2 w; w.x = cvt_pk_bf16(res[0], res[1]); w.y = cvt_pk_bf16(res[2], res[3]);
                    *(u32x2*)(ACT + row * FF + ch) = w;
                }
            }
        }
    }
};
namespace att {
typedef __attribute__((ext_vector_type(16))) float f32x16;
typedef __attribute__((ext_vector_type(4))) short s16x4;
typedef short v4i16_t __attribute__((ext_vector_type(4)));
typedef LAS const char* lptr;
__device__ __forceinline__ s16x4 vtr(lptr p) { return __builtin_bit_cast(s16x4, __builtin_amdgcn_ds_read_tr16_b64_v4i16((LAS v4i16_t*)p)); }
typedef float f32x2_t __attribute__((ext_vector_type(2))); typedef __bf16 bf16x2_t __attribute__((ext_vector_type(2)));
__device__ __forceinline__ unsigned cvtpk_s(float lo, float hi) { f32x2_t v = {lo, hi}; bf16x2_t b = __builtin_convertvector(v, bf16x2_t); return __builtin_bit_cast(unsigned, b); }
__device__ __forceinline__ bf16x8 pack8(const f32x16& s, int b) {
    u32x4 w; w.x = cvtpk_s(s[b], s[b + 1]); w.y = cvtpk_s(s[b + 2], s[b + 3]); w.z = cvtpk_s(s[b + 4], s[b + 5]); w.w = cvtpk_s(s[b + 6], s[b + 7]);
    return __builtin_bit_cast(bf16x8, w);
}
#define MFMA32(a, b, c) __builtin_amdgcn_mfma_f32_32x32x16_bf16((a), (b), (c), 0, 0, 0)

#define LGKM_WAIT(n) asm volatile("s_waitcnt lgkmcnt(" #n ")" ::: "memory")
#define SCHED_FENCE() __builtin_amdgcn_sched_barrier(0)
__device__ __forceinline__ bf16x8 rd128(unsigned addr, int off) { bf16x8 r; asm volatile("ds_read_b128 %0, %1 offset:%c2" : "=&v"(r) : "v"(addr), "i"(off) : "memory"); return r; }
__device__ __forceinline__ s16x4 rdtr(unsigned addr, int off) { s16x4 r; asm volatile("ds_read_b64_tr_b16 %0, %1 offset:%c2" : "=&v"(r) : "v"(addr), "i"(off) : "memory"); return r; }
#define VFRAG(lo, hh) ((bf16x8){lo[0], lo[1], lo[2], lo[3], hh[0], hh[1], hh[2], hh[3]})
constexpr int KROW = 144, VROWD = 320, VROWA = 192;
constexpr int DSTG = 2 * 64 * KROW + 64 * VROWD;
constexpr int ASTG = 64 * KROW + 64 * VROWA;

constexpr int DST3 = 32768;
#define SGB(mask, n) __builtin_amdgcn_sched_group_barrier((mask), (n), 0)
__device__ __forceinline__ void diff_unit(LAS char* lds, const bf16* __restrict__ QKV, bf16* __restrict__ Y, int b, int h, int qb, float Mb, float lam, const float* __restrict__ subln, float outscale) {
    int tid = threadIdx.x; asm volatile("" : "+v"(tid)); const int lane = tid & 63, w = __builtin_amdgcn_readfirstlane(tid >> 6), q = lane & 31, hi = lane >> 5;
    const int rg = w >> 1, c = w & 1;
    const size_t rowQ = (size_t)b * S + qb * 128 + rg * 32 + q;
    const bf16* qp = QKV + rowQ * NIN + 768 + (2 * h + c) * 64 + hi * 8;
    bf16x8 qf[4];
#pragma unroll
    for (int ds = 0; ds < 4; ++ds) qf[ds] = *(const bf16x8*)(qp + ds * 16);
    const int krow = 8 * w + (lane >> 3), kch = (lane & 7) ^ ((krow >> 1) & 7);
    const int vrow = 4 * w + (lane >> 4), vch = (lane & 15) ^ ((vrow & 3) << 2);
    const bf16* kg = QKV + ((size_t)b * S + krow) * NIN + 1280 + 128 * h + kch * 8;
    const bf16* vg = QKV + ((size_t)b * S + vrow) * NIN + 1792 + 128 * h + vch * 8;
#define DDMA(t, so) do { const size_t o_ = (size_t)(t) * 64 * NIN; LAS unsigned char* d_ = (LAS unsigned char*)lds + (so) + w * 1024; \
        __builtin_amdgcn_global_load_lds((const unsigned*)(kg + o_), (LAS unsigned*)(d_), 16, 0, 0); \
        __builtin_amdgcn_global_load_lds((const unsigned*)(kg + o_ + 64), (LAS unsigned*)(d_ + 8192), 16, 0, 0); \
        __builtin_amdgcn_global_load_lds((const unsigned*)(vg + o_), (LAS unsigned*)(d_ + 16384), 16, 0, 0); \
        __builtin_amdgcn_global_load_lds((const unsigned*)(vg + o_ + 32 * NIN), (LAS unsigned*)(d_ + 16384 + 8192), 16, 0, 0); } while (0)
    f32x16 o[4];
#pragma unroll
    for (int i = 0; i < 4; ++i) o[i] = (f32x16){0.f};
    float l = 0.f;
    constexpr int NT = S / 64;
    DDMA(0, 0); DDMA(1, DST3); DDMA(2, 2 * DST3);
    const unsigned lbase = (unsigned)(size_t)lds;
    unsigned kofs[4], vofs[4];
    { const int sw = (q >> 1) & 7, vq = (lane & 15) >> 2;
#pragma unroll
      for (int ds = 0; ds < 4; ++ds) kofs[ds] = (unsigned)(c * 8192 + q * 128 + (((2 * ds + hi) ^ sw) << 4));
#pragma unroll
      for (int db = 0; db < 4; ++db) vofs[db] = (unsigned)(16384 + (4 * hi + vq) * 256 + ((db ^ vq) << 6) + ((lane >> 4) & 1) * 32 + (lane & 3) * 8); }
    f32x16 negm;
#pragma unroll
    for (int r = 0; r < 16; ++r) negm[r] = -Mb;
    f32x16 s0, s1;
    { asm volatile("s_waitcnt vmcnt(8)" ::: "memory"); __builtin_amdgcn_s_barrier(); asm volatile("" ::: "memory");
      bf16x8 kf[8];
#pragma unroll
      for (int ds = 0; ds < 4; ++ds) { kf[2 * ds] = rd128(lbase + kofs[ds], 0); kf[2 * ds + 1] = rd128(lbase + kofs[ds], 32 * 128); }
      LGKM_WAIT(0); SCHED_FENCE();
      s0 = negm; s1 = negm;
#pragma unroll
      for (int ds = 0; ds < 4; ++ds) { s0 = MFMA32(kf[2 * ds], qf[ds], s0); s1 = MFMA32(kf[2 * ds + 1], qf[ds], s1); }
      SCHED_FENCE(); }
    int so_cur = 0, so_n1 = DST3, so_n3 = 3 * DST3;
    for (int t = 0; t < NT; ++t) {
        asm volatile("s_waitcnt vmcnt(4)" ::: "memory");
        __builtin_amdgcn_s_barrier();
        asm volatile("" ::: "memory");
        { const int tn = (t + 3 < NT) ? t + 3 : NT - 1; DDMA(tn, so_n3); }
        const unsigned sb = lbase + so_cur, sn = lbase + so_n1;
        bf16x8 kf[8];
#pragma unroll
        for (int ds = 0; ds < 4; ++ds) { kf[2 * ds] = rd128(sn + kofs[ds], 0); kf[2 * ds + 1] = rd128(sn + kofs[ds], 32 * 128); }
        s16x4 vl[2][4], vh[2][4];
#pragma unroll
        for (int db = 0; db < 4; ++db) { vl[0][db] = rdtr(sb + vofs[db], 0); vh[0][db] = rdtr(sb + vofs[db], 8 * 256); }
        LGKM_WAIT(0); SCHED_FENCE();
        __builtin_amdgcn_s_setprio(1);
        f32x16 n0 = negm, n1 = negm;
#pragma unroll
        for (int ds = 0; ds < 4; ++ds) { n0 = MFMA32(kf[2 * ds], qf[ds], n0); n1 = MFMA32(kf[2 * ds + 1], qf[ds], n1); }
        float ls = 0.f;
#pragma unroll
        for (int r = 0; r < 16; ++r) { s0[r] = __builtin_amdgcn_exp2f(s0[r]); ls += s0[r]; }
        bf16x8 pf[4]; pf[0] = pack8(s0, 0); pf[1] = pack8(s0, 8);
#pragma unroll
        for (int i = 0; i < 8; ++i) { SGB(0x008, 1); SGB(0x400, 2); SGB(0x002, 3); }
        SCHED_FENCE();
        __builtin_amdgcn_s_setprio(0);
#pragma unroll
        for (int db = 0; db < 4; ++db) { vl[1][db] = rdtr(sb + vofs[db], 16 * 256); vh[1][db] = rdtr(sb + vofs[db], 16 * 256 + 8 * 256); }
        s16x4 wl[2][4], wh[2][4];
#pragma unroll
        for (int ks = 0; ks < 2; ++ks)
#pragma unroll
            for (int db = 0; db < 4; ++db) { wl[ks][db] = rdtr(sb + vofs[db], (ks + 2) * 16 * 256); wh[ks][db] = rdtr(sb + vofs[db], (ks + 2) * 16 * 256 + 8 * 256); }
        LGKM_WAIT(15); SCHED_FENCE();
        __builtin_amdgcn_s_setprio(1);
#pragma unroll
        for (int ks = 0; ks < 2; ++ks)
#pragma unroll
            for (int db = 0; db < 4; ++db) o[db] = MFMA32(VFRAG(vl[ks][db], vh[ks][db]), pf[ks], o[db]);
#pragma unroll
        for (int r = 0; r < 16; ++r) { s1[r] = __builtin_amdgcn_exp2f(s1[r]); ls += s1[r]; }
        l += ls;
        pf[2] = pack8(s1, 0); pf[3] = pack8(s1, 8);
#pragma unroll
        for (int i = 0; i < 8; ++i) { SGB(0x008, 1); SGB(0x400, 2); SGB(0x002, 3); }
        SCHED_FENCE();
        LGKM_WAIT(0); SCHED_FENCE();
#pragma unroll
        for (int ks = 0; ks < 2; ++ks)
#pragma unroll
            for (int db = 0; db < 4; ++db) o[db] = MFMA32(VFRAG(wl[ks][db], wh[ks][db]), pf[2 + ks], o[db]);
        SCHED_FENCE();
        __builtin_amdgcn_s_setprio(0);
        s0 = n0; s1 = n1;
        so_cur = so_n1; so_n1 = (so_n1 == 3 * DST3) ? 0 : so_n1 + DST3; so_n3 = (so_n3 == 3 * DST3) ? 0 : so_n3 + DST3;
    }
#undef DDMA
    asm volatile("s_waitcnt vmcnt(0)" ::: "memory");
    __syncthreads();
    l += __shfl_xor(l, 32);
    const float inv = 1.f / l;
    LAS f32x4* xb = (LAS f32x4*)lds + rg * (16 * 64) + lane;
    if (c == 1) {
#pragma unroll
        for (int db = 0; db < 4; ++db)
#pragma unroll
            for (int r4 = 0; r4 < 4; ++r4) xb[(db * 4 + r4) * 64] = (f32x4){o[db][4 * r4], o[db][4 * r4 + 1], o[db][4 * r4 + 2], o[db][4 * r4 + 3]} * inv;
    }
    __syncthreads();
    if (c == 0) {
        float ss = 0.f;
#pragma unroll
        for (int db = 0; db < 4; ++db)
#pragma unroll
            for (int r4 = 0; r4 < 4; ++r4) { const f32x4 ot = xb[(db * 4 + r4) * 64];
#pragma unroll
                for (int e = 0; e < 4; ++e) { const float d = o[db][4 * r4 + e] * inv - lam * ot[e]; o[db][4 * r4 + e] = d; ss += d * d; } }
        ss += __shfl_xor(ss, 32);
        const float rs = rsqrtf(ss * (1.f / 128.f) + EPS) * outscale;
        bf16* yp = Y + rowQ * D + 512 + 128 * h + 4 * hi;
#pragma unroll
        for (int db = 0; db < 4; ++db)
#pragma unroll
            for (int r4 = 0; r4 < 4; ++r4) { const f32x4 gw = *(const f32x4*)(subln + 32 * db + 8 * r4 + 4 * hi);
                u32x2 wv; wv.x = cvt_pk_bf16(o[db][4 * r4] * rs * gw[0], o[db][4 * r4 + 1] * rs * gw[1]); wv.y = cvt_pk_bf16(o[db][4 * r4 + 2] * rs * gw[2], o[db][4 * r4 + 3] * rs * gw[3]);
                *(u32x2*)(yp + 32 * db + 8 * r4) = wv; }
    }
    __syncthreads();
}

__device__ __forceinline__ void swa_unit(LAS char* lds, const bf16* __restrict__ QKV, bf16* __restrict__ Y, int b, int kvh, int n, float Mb, const float* __restrict__ sink) {
    int tid = threadIdx.x; asm volatile("" : "+v"(tid)); const int lane = tid & 63, w = __builtin_amdgcn_readfirstlane(tid >> 6), q = lane & 31, hi = lane >> 5;
    const int head = kvh * 4 + (w >> 1), rb = (w & 1) * 64;
    const size_t rowQ = (size_t)b * S + n * 128 + rb + q;
    bf16x8 qf[2][4];
#pragma unroll
    for (int rg = 0; rg < 2; ++rg)
#pragma unroll
        for (int ds = 0; ds < 4; ++ds) qf[rg][ds] = *(const bf16x8*)(QKV + (rowQ + 32 * rg) * NIN + head * 64 + hi * 8 + ds * 16);
    const int lrow = tid >> 3, lcc = tid & 7;
    const long kp0 = (long)b * S + (long)(n - 1) * 128 + lrow;
    const bf16* kg = QKV + kp0 * NIN + 512 + kvh * 64 + lcc * 8;
    const bf16* vg = QKV + kp0 * NIN + 640 + kvh * 64 + lcc * 8;
    const int kdst = lrow * KROW + lcc * 16, vdst = 64 * KROW + lrow * VROWA + lcc * 16;
    u32x4 st0, st1;
#define ALOAD(t) do { const long o_ = (long)(t) * 64 * NIN; st0 = *(const u32x4*)(kg + o_); st1 = *(const u32x4*)(vg + o_); } while (0)
#define ASTORE(bo) do { *(LAS u32x4*)(lds + (bo) + kdst) = st0; *(LAS u32x4*)(lds + (bo) + vdst) = st1; } while (0)
    f32x16 o[2][2];
#pragma unroll
    for (int i = 0; i < 2; ++i)
#pragma unroll
        for (int j = 0; j < 2; ++j) o[i][j] = (f32x16){0.f};
    float l[2] = {0.f, 0.f};
    const int t0 = (n == 0) ? 2 : 0, t1 = (n == S / 128 - 1) ? 4 : 6;
    ALOAD(t0); ASTORE((t0 & 1) * ASTG); __syncthreads();
    const int koff = q * KROW + hi * 16;
    const int voff = 64 * KROW + (4 * hi + ((lane & 15) >> 2)) * VROWA + ((lane >> 4) & 1) * 32 + (lane & 3) * 8;
    const unsigned lbase = (unsigned)(size_t)lds;
    for (int t = t0; t < t1; ++t) {
        const int cur = (t & 1) * ASTG, nxt = ASTG - cur;
        if (t + 1 < t1) ALOAD(t + 1);
        const unsigned ka = lbase + cur + koff, va = lbase + cur + voff;
        bf16x8 kf[8];
#pragma unroll
        for (int ds = 0; ds < 4; ++ds) { kf[2 * ds] = rd128(ka, ds * 32); kf[2 * ds + 1] = rd128(ka, 32 * KROW + ds * 32); }
        s16x4 vl[4][2], vh[4][2];
#pragma unroll
        for (int ks = 0; ks < 4; ++ks)
#pragma unroll
            for (int db = 0; db < 2; ++db) { vl[ks][db] = rdtr(va, ks * 16 * VROWA + db * 64); vh[ks][db] = rdtr(va, ks * 16 * VROWA + 8 * VROWA + db * 64); }
        LGKM_WAIT(0); SCHED_FENCE();
#pragma unroll
        for (int rg = 0; rg < 2; ++rg) {
            const int i0 = rb + 32 * rg;
            if (64 * t + 63 >= i0 && 64 * t <= i0 + 31 + 256) {
                f32x16 s0 = (f32x16){0.f}, s1 = (f32x16){0.f};
#pragma unroll
                for (int ds = 0; ds < 4; ++ds) { s0 = MFMA32(kf[2 * ds], qf[rg][ds], s0); s1 = MFMA32(kf[2 * ds + 1], qf[rg][ds], s1); }
                const int jb = 64 * t + 4 * hi - (i0 + q);
                float ls = 0.f;
#pragma unroll
                for (int r = 0; r < 16; ++r) {
                    const int d0 = jb + (r & 3) + 8 * (r >> 2), d1 = d0 + 32;
                    const float p0 = __builtin_amdgcn_exp2f(s0[r] - Mb), p1 = __builtin_amdgcn_exp2f(s1[r] - Mb);
                    s0[r] = ((unsigned)d0 <= 256u) ? p0 : 0.f; s1[r] = ((unsigned)d1 <= 256u) ? p1 : 0.f; ls += s0[r] + s1[r];
                }
                l[rg] += ls;
                bf16x8 pf[4]; pf[0] = pack8(s0, 0); pf[1] = pack8(s0, 8); pf[2] = pack8(s1, 0); pf[3] = pack8(s1, 8);
#pragma unroll
                for (int ks = 0; ks < 4; ++ks)
#pragma unroll
                    for (int db = 0; db < 2; ++db) o[rg][db] = MFMA32(VFRAG(vl[ks][db], vh[ks][db]), pf[ks], o[rg][db]);
            }
        }
        SCHED_FENCE();
        if (t + 1 < t1) ASTORE(nxt);
        __syncthreads();
    }
#undef ALOAD
#undef ASTORE
    const float sk = __builtin_amdgcn_exp2f(sink[head] * LOG2E - Mb);
#pragma unroll
    for (int rg = 0; rg < 2; ++rg) {
        float lt = l[rg]; lt += __shfl_xor(lt, 32);
        const float inv = 1.f / (lt + sk);
        bf16* yp = Y + (rowQ + 32 * rg) * D + head * 64 + 4 * hi;
#pragma unroll
        for (int db = 0; db < 2; ++db)
#pragma unroll
            for (int r4 = 0; r4 < 4; ++r4) { u32x2 wv; wv.x = cvt_pk_bf16(o[rg][db][4 * r4] * inv, o[rg][db][4 * r4 + 1] * inv); wv.y = cvt_pk_bf16(o[rg][db][4 * r4 + 2] * inv, o[rg][db][4 * r4 + 3] * inv);
                *(u32x2*)(yp + 32 * db + 8 * r4) = wv; }
    }
}
}
constexpr size_t MiB = 1u << 20;
constexpr size_t WS_CTL = 0, CTL_BYTES = 65536 + 4 * 65536;
constexpr size_t WS_ROWSQ = 65536;
constexpr int MISC_OFF = 131072 + 4096;
constexpr size_t WS_ROPE = 1 * MiB;
constexpr size_t WS_W = 2 * MiB, W_LAYER = 23 * MiB;
constexpr size_t W_IN = 0, W_OUT = (size_t)NIN * D * 2, W_UP = W_OUT + (size_t)D * D * 2, W_DOWN = W_UP + (size_t)NUP * D * 2;
static_assert(W_DOWN + (size_t)D * FF * 2 <= W_LAYER, "weights");
constexpr size_t WS_H = 48 * MiB;
constexpr size_t WS_QKV = 80 * MiB;
constexpr size_t WS_Y = 152 * MiB;
constexpr size_t WS_ACT = 80 * MiB;
constexpr size_t WS_EDGE = 184 * MiB;
constexpr size_t WS_PART = 186 * MiB;
constexpr size_t WS_END = 190 * MiB;
static_assert(WS_ACT + (size_t)M * FF * 2 <= WS_EDGE && WS_QKV + (size_t)M * NIN * 2 <= WS_Y && WS_Y + (size_t)M * D * 2 <= WS_EDGE, "ws map");

#ifndef REP_P0
#define REP_P0 1
#endif
#ifndef REP_P1
#define REP_P1 1
#endif
#ifndef REP_P3B
#define REP_P3B 1
#endif
#ifndef REP_P4
#define REP_P4 1
#endif
#ifndef ATT_REP
#define ATT_REP 1
#endif
#ifndef REP_P5
#define REP_P5 1
#endif
#ifndef REP_P3
#define REP_P3 1
#endif
#ifndef REP_SYNC
#define REP_SYNC 1
#endif
struct Args {
    const float *x, *g_attn, *w_in, *qn_a, *kn_a, *sink, *qn_b, *kn_b, *lq1, *lk1, *lq2, *lk2, *subln, *w_out, *g_ffn, *w_up, *conv_w, *conv_b, *w_down;
    float* out; unsigned char* ws;
};

__device__ __forceinline__ float wave_sum(float v) {
#pragma unroll
    for (int o = 1; o < 64; o <<= 1) v += __shfl_xor(v, o);
    return v;
}
__device__ __forceinline__ float uniform_f(float v) { return __uint_as_float(__builtin_amdgcn_readfirstlane(__float_as_uint(v))); }
__device__ __forceinline__ float wave_max(float v) {
#pragma unroll
    for (int o = 1; o < 64; o <<= 1) v = fmaxf(v, __shfl_xor(v, o));
    return v;
}
__device__ __forceinline__ unsigned f2bf(float f) { unsigned u = __builtin_bit_cast(unsigned, f); return (u + 0x7fffu + ((u >> 16) & 1u)) >> 16; }
__device__ __forceinline__ unsigned pk2(float lo, float hi) { return f2bf(lo) | (f2bf(hi) << 16); }

__device__ __forceinline__ void transpose_item(const float* __restrict__ W, int K, int N, bf16* __restrict__ WT, LAS float* scr, int kb, int nb, int dnb, int lane, const float* __restrict__ g) {
    const int k0 = 64 * kb, n0 = 32 * nb;
    float wv_[32];
#pragma unroll
    for (int i = 0; i < 32; ++i) { const int kk = 2 * i + (lane >> 5); wv_[i] = __builtin_nontemporal_load(&W[(size_t)(k0 + kk) * N + n0 + (lane & 31)]); }
#pragma unroll
    for (int i = 0; i < 32; ++i) { const int kk = 2 * i + (lane >> 5); scr[kk * 33 + (lane & 31)] = wv_[i] * (g ? g[k0 + kk] : 1.f); }
    asm volatile("s_waitcnt lgkmcnt(0)" ::: "memory");
    const int c = lane & 7;
#pragma unroll
    for (int j = 0; j < 4; ++j) { const int n = (lane >> 3) + 8 * j; const LAS float* s = scr + (8 * c) * 33 + n;
        u32x4 o; o.x = pk2(s[0 * 33], s[1 * 33]); o.y = pk2(s[2 * 33], s[3 * 33]); o.z = pk2(s[4 * 33], s[5 * 33]); o.w = pk2(s[6 * 33], s[7 * 33]);
        *(u32x4*)(WT + (size_t)(32 * dnb + n) * K + k0 + 8 * c) = o; }
    asm volatile("s_waitcnt lgkmcnt(0)" ::: "memory");
}

__device__ __forceinline__ void convert_rows(const float* __restrict__ x, bf16* __restrict__ out, float* __restrict__ rowsq, int gw, int ngw, int lane) {
    for (int m0 = gw; m0 < M; m0 += 4 * ngw) {
        f32x4 v[4][4];
#pragma unroll
        for (int r = 0; r < 4; ++r) { const int m = m0 + r * ngw; if (m < M) { const f32x4* xr = (const f32x4*)(x + (size_t)m * D) + lane;
#pragma unroll
            for (int j = 0; j < 4; ++j) v[r][j] = __builtin_nontemporal_load(&xr[64 * j]); } }
#pragma unroll
        for (int r = 0; r < 4; ++r) { const int m = m0 + r * ngw; if (m < M) {
            float s = 0.f;
#pragma unroll
            for (int j = 0; j < 4; ++j) s += dot4(v[r][j]);
            s = wave_sum(s);
            if (lane == 0) rowsq[m] = s;
            u32x2* o8 = (u32x2*)(out + (size_t)m * D) + lane;
#pragma unroll
            for (int j = 0; j < 4; ++j) { u32x2 wv; wv.x = pk2(v[r][j][0], v[r][j][1]); wv.y = pk2(v[r][j][2], v[r][j][3]); o8[64 * j] = wv; } } }
    }
}

#define XB_TMO      128
#define XB_XCNT(j)  (256  + 64 * (j))
#define XB_XSUB(j)  (1280 + 64 * (j))
#define XB_XGEN(j)  (2304 + 64 * (j))
#define XB_TOP      3328
#define XB_TOPGEN   3392
#define XCD_BAR_WORDS 3456
#define XB_SPIN_CAP (1u << 18)

__device__ __forceinline__ unsigned xb_ld(unsigned* p)              { return __hip_atomic_load(p, __ATOMIC_RELAXED, __HIP_MEMORY_SCOPE_AGENT); }
__device__ __forceinline__ unsigned xb_add(unsigned* p, unsigned v) { return __hip_atomic_fetch_add(p, v, __ATOMIC_RELAXED, __HIP_MEMORY_SCOPE_AGENT); }
__device__ __forceinline__ unsigned xb_xcc_id() { return (unsigned)__builtin_amdgcn_s_getreg((3 << 11) | 20) & 0xFu; }
#define XB_SPIN(cond, bar) do { unsigned _sp = 0; while (cond) { __builtin_amdgcn_s_sleep(0); \
    if ((++_sp & 255u) == 0u) { if (xb_ld(&(bar)[XB_TMO])) break; if (_sp > XB_SPIN_CAP) { atomicAdd(&(bar)[XB_TMO], 1u); break; } } } } while (0)

struct XcdBarrier {
    unsigned* bar; unsigned x;
    volatile LAS unsigned* st;
};

__device__ __forceinline__ XcdBarrier xcd_barrier_post(unsigned* bar, volatile LAS unsigned* st) {
    XcdBarrier b; b.bar = bar; b.x = xb_xcc_id(); b.st = st;
    if (threadIdx.x == 0) (void)xb_add(&bar[XB_XCNT(b.x)], 1u);
    return b;
}
__device__ __forceinline__ void xcd_barrier_complete(unsigned* bar, unsigned x, unsigned& nloc, unsigned& nx) {
    const unsigned G = gridDim.x * gridDim.y * gridDim.z;
    unsigned sum, cnt, mine, sp = 0u;
    for (;;) {
        sum = 0u; cnt = 0u; mine = 0u;
#pragma unroll
        for (unsigned j = 0; j < 16; ++j) { const unsigned c = xb_ld(&bar[XB_XCNT(j)]); sum += c; cnt += (c > 0u) ? 1u : 0u; mine = (j == x) ? c : mine; }
        if (sum == G) break;
        __builtin_amdgcn_s_sleep(1);
        if ((++sp & 255u) == 0u) { if (xb_ld(&bar[XB_TMO])) break; if (sp > XB_SPIN_CAP) { atomicAdd(&bar[XB_TMO], 1u); break; } }
    }
    nloc = mine > 0u ? mine : 1u; nx = cnt > 0u ? cnt : 1u;
}

__device__ __forceinline__ void xcd_barrier(const XcdBarrier& b) {
    asm volatile("s_waitcnt vmcnt(0)" ::: "memory");
    __syncthreads();
    if (threadIdx.x == 0) {
        unsigned* bar = b.bar;
        __builtin_amdgcn_s_waitcnt(0);
        unsigned nloc = b.st[0], nx = b.st[1];
        if (nloc == 0u) { xcd_barrier_complete(bar, b.x, nloc, nx); b.st[0] = nloc; b.st[1] = nx; }
        const unsigned old = xb_add(&bar[XB_XSUB(b.x)], 1u);
        const unsigned gen = old / nloc;
        if (old + 1u == (gen + 1u) * nloc) {
            __builtin_amdgcn_fence(__ATOMIC_RELEASE, "agent");
            asm volatile("s_waitcnt vmcnt(0)" ::: "memory");
            const unsigned og = xb_add(&bar[XB_TOP], 1u);
            const unsigned tg = og / nx;
            if (og + 1u == (tg + 1u) * nx) xb_add(&bar[XB_TOPGEN], 1u);
            else XB_SPIN(xb_ld(&bar[XB_TOPGEN]) == tg, bar);
            __builtin_amdgcn_fence(__ATOMIC_ACQUIRE, "agent");
            xb_add(&bar[XB_XGEN(b.x)], 1u);
            asm volatile("s_waitcnt vmcnt(0)" ::: "memory");
        } else {
            XB_SPIN(xb_ld(&bar[XB_XGEN(b.x)]) == gen, bar);
            __builtin_amdgcn_fence(__ATOMIC_ACQUIRE, "agent");
            asm volatile("s_waitcnt vmcnt(0)" ::: "memory");
        }
    }
    __syncthreads();
}

__global__ void __launch_bounds__(512, 2) mega_fwd(Args a) {
    extern __shared__ __attribute__((aligned(16))) unsigned char lds_raw[];
    LAS unsigned char* lds = (LAS unsigned char*)lds_raw;
    cg::grid_group grid = cg::this_grid();
    const int tid = threadIdx.x, lane = tid & 63, wave = __builtin_amdgcn_readfirstlane(tid >> 6);
    const int G = gridDim.x, bx = blockIdx.x;
    const int vcu = (G % 8 == 0) ? (bx % 8) * (G / 8) + bx / 8 : bx;
    const int gw = vcu * 8 + wave, ngw = G * 8;
    typedef const __attribute__((address_space(4))) Args* kargs_t;
    const kargs_t kap = (kargs_t)__builtin_amdgcn_kernarg_segment_ptr();
#define PHASE_ARGS() kargs_t ap = kap; asm volatile("" : "+s"(ap)); unsigned char* const ws = ap->ws; \
    float* const cosT = (float*)(ws + WS_ROPE); float* const sinT = cosT + S * 32; \
    bf16* const Hb = (bf16*)(ws + WS_H); bf16* const QKV = (bf16*)(ws + WS_QKV); bf16* const Yb = (bf16*)(ws + WS_Y); bf16* const ACT = (bf16*)(ws + WS_ACT); \
    float* const edge = (float*)(ws + WS_EDGE); float* const part = (float*)(ws + WS_PART); float* const rowsq = (float*)(ws + WS_ROWSQ); \
    (void)cosT; (void)sinT; (void)Hb; (void)QKV; (void)Yb; (void)ACT; (void)edge; (void)part; (void)rowsq
    volatile LAS unsigned* misc = (volatile LAS unsigned*)(lds + MISC_OFF);
    if (tid < 16) misc[tid] = 0u;
    __syncthreads();

    constexpr int I_IN = 16 * 72, I_OUT = 16 * 32, I_UP = 16 * 176, I_DOWN = 44 * 32, I_L = I_IN + I_OUT + I_UP + I_DOWN;
#define CONVERT_WEIGHTS(L, wv, nwv, i0, i1) do { \
        int lane = threadIdx.x & 63; asm volatile("" : "+v"(lane)); \
        LAS float* scr = (LAS float*)(lds + wave * 16384); \
        unsigned char* wl_ = ws + WS_W + (size_t)(L) * W_LAYER; \
        for (int it = (i0) + (wv); it < (i1); it += (nwv)) { \
            int r = it; \
            if (r < I_IN) { const int kb = r / 72, nb = r % 72; const int pn = nb >> 3, wc = (nb >> 1) & 3, bj = nb & 1; \
                transpose_item(ap->w_in + (size_t)(L) * D * NIN, D, NIN, (bf16*)(wl_ + W_IN), scr, kb, nb, 8 * pn + 4 * bj + wc, lane, ap->g_attn + (L) * D); continue; } \
            r -= I_IN; \
            if (r < I_OUT) { const int kb = r / 32, nb = r % 32; transpose_item(ap->w_out + (size_t)(L) * D * D, D, D, (bf16*)(wl_ + W_OUT), scr, kb, nb, nb, lane, nullptr); continue; } \
            r -= I_OUT; \
            if (r < I_UP) { const int kb = r / 176, nb = r % 176; const int isv = nb >= 88, nn = isv ? nb - 88 : nb; const int dnb = 8 * (nn >> 2) + 4 * isv + (nn & 3); \
                transpose_item(ap->w_up + (size_t)(L) * D * NUP, D, NUP, (bf16*)(wl_ + W_UP), scr, kb, nb, dnb, lane, ap->g_ffn + (L) * D); continue; } \
            r -= I_UP; \
            { const int kb = r / 32, nb = r % 32; transpose_item(ap->w_down + (size_t)(L) * FF * D, FF, D, (bf16*)(wl_ + W_DOWN), scr, kb, nb, nb, lane, nullptr); } \
        } } while (0)
    {
        PHASE_ARGS();
        CONVERT_WEIGHTS(0, gw, ngw, 0, I_IN);
        for (int i = vcu * 512 + tid; i < S * 32; i += G * 512) {
            const int pos = i >> 5, j = i & 31;
            double inv = 1.0; for (int k = 0; k < j; ++k) inv *= 0.74989420933245582730;
            const double ang = (double)pos * inv;
            const double kq = __builtin_rint(ang * 0.15915494309189533577);
            const double rr = (ang - kq * 6.283185307179586232) - kq * 2.4492935982947064e-16;
            const double r2 = rr * rr;
            double sn = 1.0, cs = 1.0;
#pragma unroll
            for (int k = 12; k >= 1; --k) { sn = 1.0 - sn * r2 * (1.0 / (double)((2 * k) * (2 * k + 1))); cs = 1.0 - cs * r2 * (1.0 / (double)((2 * k - 1) * (2 * k))); }
            cosT[i] = (float)cs; sinT[i] = (float)(sn * rr);
        }
        for (int i = vcu * 512 + tid; i < (int)(CTL_BYTES / 16); i += G * 512) { const size_t off = (size_t)i * 16;
            if (off < WS_ROWSQ || off >= WS_ROWSQ + (size_t)M * 4) *(u32x4*)(ws + WS_CTL + off) = (u32x4){0u, 0u, 0u, 0u}; }
        convert_rows(ap->x, Hb, rowsq, gw, ngw, lane);
    }
    asm volatile("s_waitcnt vmcnt(0)" ::: "memory");
    __syncthreads();
    if (tid == 0) { __builtin_amdgcn_fence(__ATOMIC_RELEASE, "agent"); asm volatile("s_waitcnt vmcnt(0)" ::: "memory"); }
    grid.sync();
    if (tid == 0) { __builtin_amdgcn_fence(__ATOMIC_ACQUIRE, "agent"); asm volatile("s_waitcnt vmcnt(0)" ::: "memory"); }
    __syncthreads();
    XcdBarrier xbar; { PHASE_ARGS(); xbar = xcd_barrier_post((unsigned*)(ws + WS_CTL) + 1024, misc); }

    for (int l = 0; l < DEPTH; ++l) {
        const float lambda_init = 0.8f - 0.6f * __expf(-0.3f * (float)l);
        {
            PHASE_ARGS(); unsigned char* const wl = ws + WS_W + (size_t)l * W_LAYER; (void)wl;
            pg8::Gemm g{Hb, (const bf16*)(wl + W_IN), M, NIN, D}; pg8::StaticOrder So; So.init(M, NIN, G, bx);
            EpiInProj E{QKV, ap->qn_a + l * 64, ap->kn_a + l * 64, ap->qn_b + l * 64, ap->kn_b + l * 64, cosT, sinT, rowsq + (size_t)(2 * l) * M};
            pg8::gemm_phase<EpiInProj, pg8::StaticOrder, true, true>(lds, g, So, E);
            if (l == 0) {
                const int nidle = G - 64;
                if (nidle >= 64) { if (bx >= 64) { CONVERT_WEIGHTS(0, (bx - 64) * 8 + wave, nidle * 8, I_IN, I_L); CONVERT_WEIGHTS(1, (bx - 64) * 8 + wave, nidle * 8, 0, I_L); } }
                else { CONVERT_WEIGHTS(0, gw, ngw, I_IN, I_L); CONVERT_WEIGHTS(1, gw, ngw, 0, I_L); }
            }
        }
        xcd_barrier(xbar);
        {
            PHASE_ARGS(); unsigned char* const wl = ws + WS_W + (size_t)l * W_LAYER; (void)wl;
            int lane = threadIdx.x & 63; asm volatile("" : "+v"(lane));
            const float mqa = wave_max(fabsf(ap->qn_a[l * 64 + lane])), mka = wave_max(fabsf(ap->kn_a[l * 64 + lane]));
            const float mqb = wave_max(fabsf(ap->qn_b[l * 64 + lane])), mkb = wave_max(fabsf(ap->kn_b[l * 64 + lane]));
            const float MbA = uniform_f(8.f * mqa * mka * LOG2E * 1.02f), MbB = uniform_f(8.f * mqb * mkb * LOG2E * 1.02f);
            const float s1 = wave_sum(ap->lq1[l * 64 + lane] * ap->lk1[l * 64 + lane]), s2 = wave_sum(ap->lq2[l * 64 + lane] * ap->lk2[l * 64 + lane]);
            const float lam = uniform_f(__expf(s1) - __expf(s2) + lambda_init);
            {
            for (int uidx = vcu; uidx < NB * 4 * 16; uidx += G) {
                const int bh = uidx >> 4, qb = uidx & 15;
                att::diff_unit((LAS char*)lds, QKV, Yb, bh >> 2, bh & 3, qb, MbB, lam, ap->subln + l * 128, 1.f - lambda_init);
            }
            for (int uidx = vcu; uidx < NB * 2 * 16; uidx += G) {
                const int bk = uidx >> 4, n = uidx & 15;
                att::swa_unit((LAS char*)lds, QKV, Yb, bk >> 1, bk & 1, n, MbA, ap->sink + l * 8);
            }
            __syncthreads();
            }
        }
        xcd_barrier(xbar);
        {
            PHASE_ARGS(); unsigned char* const wl = ws + WS_W + (size_t)l * W_LAYER; (void)wl;
            pg8::Gemm g{Yb, (const bf16*)(wl + W_OUT), M, D, D}; pg8::StaticOrder So; So.init(M, D, G, bx);
            EpiResid E{Hb, rowsq + (size_t)(2 * l + 1) * M, nullptr};
            pg8::gemm_phase<EpiResid, pg8::StaticOrder, true, true>(lds, g, So, E);
        }
        xcd_barrier(xbar);
        {
            PHASE_ARGS(); unsigned char* const wl = ws + WS_W + (size_t)l * W_LAYER; (void)wl;
            pg8::Gemm g{Hb, (const bf16*)(wl + W_UP), M, NUP, D}; pg8::StaticOrder So; So.init(M, NUP, G, bx);
            EpiUpConv E{ACT, ap->conv_w + (size_t)l * 3 * FF, ap->conv_b + (size_t)l * FF, edge, part, (LAS float*)(lds + XL_OFF), rowsq + (size_t)(2 * l + 1) * M};
            pg8::gemm_phase<EpiUpConv, pg8::StaticOrder, true, true>(lds, g, So, E);
        }
        xcd_barrier(xbar);
        {
            PHASE_ARGS(); unsigned char* const wl = ws + WS_W + (size_t)l * W_LAYER; (void)wl;
            pg8::Gemm g{ACT, (const bf16*)(wl + W_DOWN), M, D, FF}; pg8::StaticOrder So; So.init(M, D, G, bx);
            { const float* cw = ap->conv_w + (size_t)l * 3 * FF; pg8::Unit uu; int tid = threadIdx.x; asm volatile("" : "+v"(tid));
              for (int ui = 0; So.next(ui, uu); ++ui) { const int pm = uu.pm;
                for (int i = tid; i < 2 * FF; i += 512) { const int which = i / FF, ch = i % FF;
                    if (which == 0 && (pm & 7) != 0) { const float* pp = part + (((size_t)pm * 2 + 0) * FF + ch) * 2;
                        const float pre = pp[0] + cw[ch] * edge[((size_t)(pm - 1) * 2 + 1) * FF + ch];
                        ACT[(size_t)(pm * 256) * FF + ch] = (bf16)f2bf(silu_f(pre) * pp[1]); }
                    if (which == 1 && (pm & 7) != 7) { const float* pp = part + (((size_t)pm * 2 + 1) * FF + ch) * 2;
                        const float pre = pp[0] + cw[2 * FF + ch] * edge[((size_t)(pm + 1) * 2 + 0) * FF + ch];
                        ACT[(size_t)(pm * 256 + 255) * FF + ch] = (bf16)f2bf(silu_f(pre) * pp[1]); } } }
              asm volatile("s_waitcnt vmcnt(0)" ::: "memory"); __syncthreads(); }
            const bool lastl = (l + 1 == DEPTH);
            EpiResid E{Hb, lastl ? nullptr : rowsq + (size_t)(2 * l + 2) * M, lastl ? ap->out : nullptr};
            pg8::gemm_phase<EpiResid, pg8::StaticOrder, true, true>(lds, g, So, E);
        }
        if (l + 1 < DEPTH) xcd_barrier(xbar);
    }
}

extern "C" void kernel_launch(void* const* d_in, const int* in_sizes, int n_in, void* d_out, int out_size, void* d_ws, size_t ws_size, hipStream_t stream) {
    static int grid = 0;
    if (grid == 0) {
        if (n_in != 19 || ws_size < WS_END) { fprintf(stderr, "kernel_launch: unexpected inputs (n_in %d, ws %zu)\n", n_in, ws_size); grid = -1; return; }
        int dev = 0, cus = 0, per_cu = 0;
        hipGetDevice(&dev);
        hipDeviceGetAttribute(&cus, hipDeviceAttributeMultiprocessorCount, dev);
        hipFuncSetAttribute((const void*)mega_fwd, hipFuncAttributeMaxDynamicSharedMemorySize, LDS_BYTES);
        hipOccupancyMaxActiveBlocksPerMultiprocessor(&per_cu, (const void*)mega_fwd, 512, LDS_BYTES);
        if (per_cu < 1) { fprintf(stderr, "kernel_launch: occupancy query reports %d blocks per CU\n", per_cu); per_cu = 1; }
        grid = cus;
        (void)hipGetLastError();
    }
    if (grid < 0) return;
    Args a{};
    const float** p = (const float**)&a;
    for (int i = 0; i < 19; ++i) p[i] = (const float*)d_in[i];
    a.out = (float*)d_out; a.ws = (unsigned char*)d_ws;
    void* args[] = {&a};
    hipError_t e = hipLaunchCooperativeKernel((const void*)mega_fwd, dim3(grid), dim3(512), args, LDS_BYTES, stream);
    if (e != hipSuccess) fprintf(stderr, "cooperative launch failed: %s (grid %d)\n", hipGetErrorString(e), grid);
}
```

```cpp
#include <hip/hip_runtime.h>
#include <hip/hip_cooperative_groups.h>
#include <cstdio>
#include <cstdint>
namespace cg = cooperative_groups;
namespace pg8 {
#define PG8_LAS __attribute__((address_space(3)))
typedef unsigned short bf16_t;
typedef short bf16x8 __attribute__((ext_vector_type(8)));
typedef float f32x4 __attribute__((ext_vector_type(4)));
typedef unsigned u32x4 __attribute__((ext_vector_type(4)));
constexpr int BM = 256, BK = 64, HALF = 128, HTB = HALF * BK * 2  , STAGE_BYTES = 8 * HTB, NXCD = 8, WGM = 4;

__host__ __device__ __forceinline__ int lds_byte(int r, int c) { const int st = (r >> 4) * 2 + (c >> 5), rr = r & 15, cc = c & 31, ob = rr * 64 + cc * 2; return st * 1024 + (ob ^ (((ob >> 9) & 1) << 5)); }
__host__ __device__ __forceinline__ void stage_rc(int b, int& R, int& C) { const int st = b / 1024, sb = b % 1024, swz = sb ^ (((sb >> 9) & 1) << 5); R = (st >> 1) * 16 + swz / 64; C = (st & 1) * 32 + (swz % 64) / 2; }
__host__ __device__ __forceinline__ int perm32(int rho) { const int n = rho >> 4, i = rho & 15; return 8 * (i >> 2) + 4 * n + (i & 3); }

struct Unit { int pm, pn; };
struct Gemm { const bf16_t* A; const bf16_t* Bt; int M, N, K; };

struct StaticOrder {
    int nM, nN, nwg, G, c;
    __host__ __device__ void init(int M, int N, int G_, int c_) { nM = M / BM; nN = N / BM; nwg = nM * nN; G = G_; c = c_; }
    __host__ __device__ bool next(int i, Unit& u) const {
        const long L = (long)i * G + c; if (L >= nwg) return false;
        int wgid = (int)L; { const int q = nwg / NXCD, r = nwg % NXCD, xcd = wgid % NXCD, off = wgid / NXCD; wgid = (xcd < r ? xcd * (q + 1) : r * (q + 1) + (xcd - r) * q) + off; }
        const int nig = WGM * nN, gid = wgid / nig, fm = gid * WGM, gsz = (nM - fm) < WGM ? (nM - fm) : WGM;
        u.pm = fm + ((wgid % nig) % gsz); u.pn = (wgid % nig) / gsz; return true;
    }
    __device__ __forceinline__ void a_ready(const Unit&) const {}
    __device__ __forceinline__ void done(const Unit&) const {}
};

__device__ __forceinline__ unsigned cvt_pk_bf16(float lo, float hi) { unsigned r; asm volatile("v_cvt_pk_bf16_f32 %0, %1, %2" : "=v"(r) : "v"(lo), "v"(hi)); return r; }
template <class Epi, class Sched, bool ALIGN_EPI = false, bool SP2 = false>
__device__ __forceinline__ void gemm_phase(PG8_LAS unsigned char* lds, const Gemm g, const Sched& S, const Epi& E) {
    int tid = threadIdx.x; asm volatile("" : "+v"(tid)); const int wid = __builtin_amdgcn_readfirstlane(tid >> 6), lane = tid & 63, wr = wid >> 2, wc = wid & 3, fr = lane & 15, fq = lane >> 4;
    const int K = g.K, nt = K / BK;
    unsigned voffA[2], voffB[2];
#pragma unroll
    for (int i = 0; i < 2; ++i) { int R, C; stage_rc(tid * 16 + i * 8192, R, C); const int Rb = Epi::PERM ? ((R & ~31) + perm32(R & 31)) : R;
        voffA[i] = (unsigned)(R * K + C) * 2u; voffB[i] = (unsigned)(Rb * K + C) * 2u; }
    const size_t kstep = (size_t)(BK * 2);
    const size_t hstep = (size_t)HALF * K * 2;
    const size_t tstep = 2 * hstep;
    const unsigned ldsw = (unsigned)wid * 1024u;
    const int aoff = lds_byte(wr * 64 + fr, fq * 8), boff = lds_byte(wc * 32 + fr, fq * 8);
#define PG8_SA(b, h) (((b) * 2 + (h)) * HTB)
#define PG8_SB(b, h) ((4 + (b) * 2 + (h)) * HTB)
#define PG8_STAGE(bufoff, gbase, voff) do { _Pragma("unroll") for (int _i = 0; _i < 2; ++_i) \
        __builtin_amdgcn_global_load_lds((const unsigned*)((const char*)(gbase) + (voff)[_i]), (PG8_LAS unsigned*)(lds + (bufoff) + ldsw + _i * 8192), 16, 0, 0); } while (0)
#define PG8_LDA(dst, b, h) do { _Pragma("unroll") for (int m = 0; m < 4; ++m) _Pragma("unroll") for (int k = 0; k < 2; ++k) dst[m][k] = *(const PG8_LAS bf16x8*)(lds + PG8_SA(b, h) + aoff + m * 2048 + k * 1024); } while (0)
#define PG8_LDB(dst, b, h) do { _Pragma("unroll") for (int n = 0; n < 2; ++n) _Pragma("unroll") for (int k = 0; k < 2; ++k) dst[n][k] = *(const PG8_LAS bf16x8*)(lds + PG8_SB(b, h) + boff + n * 2048 + k * 1024); } while (0)
#define PG8_MMA(ai, bj, At, Bt) do { __builtin_amdgcn_s_setprio(1); _Pragma("unroll") for (int m = 0; m < 4; ++m) _Pragma("unroll") for (int n = 0; n < 2; ++n) _Pragma("unroll") for (int k = 0; k < 2; ++k) \
        acc[ai][bj][m][n] = __builtin_amdgcn_mfma_f32_16x16x32_bf16(Bt[n][k], At[m][k], acc[ai][bj][m][n], 0, 0, 0); __builtin_amdgcn_s_setprio(0); } while (0)
#define PG8_WAIT_V(n) asm volatile("s_waitcnt vmcnt(" #n ")" ::: "memory")
#define PG8_WAIT_L(n) asm volatile("s_waitcnt lgkmcnt(" #n ")" ::: "memory")
#define PG8_BAR __builtin_amdgcn_s_barrier()
#define PG8_SCHED __builtin_amdgcn_sched_barrier(0)
    Unit cur, nxt; int ui = 0;
    if (!S.next(0, cur)) return;
    f32x4 acc[2][2][4][2];
#pragma unroll
    for (int a = 0; a < 2; ++a)
#pragma unroll
        for (int b = 0; b < 2; ++b)
#pragma unroll
            for (int m = 0; m < 4; ++m)
#pragma unroll
                for (int n = 0; n < 2; ++n) acc[a][b][m][n] = (f32x4){0.f, 0.f, 0.f, 0.f};
    bf16x8 At[4][2], B0[2][2], B1[2][2];
    const char* cA = (const char*)g.A + (size_t)cur.pm * tstep; const char* cB = (const char*)g.Bt + (size_t)cur.pn * tstep;
    S.a_ready(cur);
    if constexpr (SP2) {
        PG8_STAGE(PG8_SB(0, 0), cB, voffB); PG8_STAGE(PG8_SB(0, 1), cB + hstep, voffB); PG8_STAGE(PG8_SA(0, 0), cA, voffA); PG8_STAGE(PG8_SA(0, 1), cA + hstep, voffA);
        if (wr == 1) PG8_BAR;
        PG8_WAIT_V(2); PG8_BAR;
        PG8_STAGE(PG8_SB(1, 0), cB + kstep, voffB); PG8_STAGE(PG8_SA(1, 0), cA + kstep, voffA); PG8_STAGE(PG8_SB(1, 1), cB + hstep + kstep, voffB);
        PG8_WAIT_V(6); PG8_BAR;
    } else {
        PG8_STAGE(PG8_SB(0, 0), cB, voffB); PG8_STAGE(PG8_SA(0, 0), cA, voffA); PG8_STAGE(PG8_SB(0, 1), cB + hstep, voffB); PG8_STAGE(PG8_SA(0, 1), cA + hstep, voffA);
        if (wr == 1) PG8_BAR;
        PG8_WAIT_V(4); PG8_BAR;
        PG8_STAGE(PG8_SB(1, 0), cB + kstep, voffB); PG8_STAGE(PG8_SA(1, 0), cA + kstep, voffA); PG8_STAGE(PG8_SB(1, 1), cB + hstep + kstep, voffB);
        PG8_WAIT_V(6); PG8_BAR;
    }
    for (;;) {
        const bool has_next = S.next(ui + 1, nxt);
        const char* nA = has_next ? (const char*)g.A + (size_t)nxt.pm * tstep : cA; const char* nB = has_next ? (const char*)g.Bt + (size_t)nxt.pn * tstep : cB;
        for (int t = 0; t < nt; t += 2) {
            const bool last = (t == nt - 2);
            const char* a1 = cA + (size_t)(t + 1) * kstep;
            const char* a2 = last ? nA : cA + (size_t)(t + 2) * kstep; const char* b2 = last ? nB : cB + (size_t)(t + 2) * kstep;
            const char* a3 = a2 + kstep; const char* b3 = b2 + kstep;
            if (last && has_next) S.a_ready(nxt);
            if constexpr (SP2) {
            PG8_LDB(B0, 0, 0); PG8_LDB(B1, 0, 1); PG8_SCHED; PG8_LDA(At, 0, 0); PG8_STAGE(PG8_SA(1, 1), a1 + hstep, voffA);
            PG8_WAIT_V(8); PG8_WAIT_L(0); PG8_BAR; PG8_MMA(0, 0, At, B0); PG8_MMA(0, 1, At, B1); PG8_BAR; PG8_SCHED;
            PG8_LDA(At, 0, 1); PG8_STAGE(PG8_SB(0, 0), b2, voffB); PG8_STAGE(PG8_SB(0, 1), b2 + hstep, voffB); PG8_STAGE(PG8_SA(0, 0), a2, voffA);
            PG8_WAIT_V(8); PG8_WAIT_L(0); PG8_BAR; PG8_MMA(1, 0, At, B0); PG8_MMA(1, 1, At, B1); PG8_BAR; PG8_SCHED;
            PG8_LDB(B0, 1, 0); PG8_LDB(B1, 1, 1); PG8_SCHED; PG8_LDA(At, 1, 0); PG8_STAGE(PG8_SA(0, 1), a2 + hstep, voffA);
            PG8_WAIT_V(8); PG8_WAIT_L(0); PG8_BAR; PG8_MMA(0, 0, At, B0); PG8_MMA(0, 1, At, B1); PG8_BAR; PG8_SCHED;
            PG8_LDA(At, 1, 1); PG8_STAGE(PG8_SB(1, 0), b3, voffB); PG8_STAGE(PG8_SB(1, 1), b3 + hstep, voffB); PG8_STAGE(PG8_SA(1, 0), a3, voffA);
            PG8_WAIT_V(8); PG8_WAIT_L(0); PG8_BAR; PG8_MMA(1, 0, At, B0); PG8_MMA(1, 1, At, B1); PG8_BAR; PG8_SCHED;
            } else {
            PG8_LDB(B0, 0, 0); PG8_SCHED; PG8_LDA(At, 0, 0); PG8_STAGE(PG8_SA(1, 1), a1 + hstep, voffA);
            PG8_WAIT_L(8); PG8_BAR; PG8_WAIT_L(0); PG8_MMA(0, 0, At, B0); PG8_BAR; PG8_SCHED;
            PG8_LDB(B1, 0, 1); PG8_STAGE(PG8_SB(0, 0), b2, voffB);
            PG8_BAR; PG8_WAIT_L(0); PG8_MMA(0, 1, At, B1); PG8_BAR;
            PG8_LDA(At, 0, 1); PG8_STAGE(PG8_SA(0, 0), a2, voffA);
            PG8_BAR; PG8_WAIT_L(0); PG8_MMA(1, 0, At, B0); PG8_BAR; PG8_SCHED;
            PG8_STAGE(PG8_SB(0, 1), b2 + hstep, voffB);
            PG8_WAIT_V(6); PG8_BAR; PG8_MMA(1, 1, At, B1); PG8_BAR;
            PG8_LDB(B0, 1, 0); PG8_SCHED; PG8_LDA(At, 1, 0); PG8_STAGE(PG8_SA(0, 1), a2 + hstep, voffA);
            PG8_WAIT_L(8); PG8_BAR; PG8_WAIT_L(0); PG8_MMA(0, 0, At, B0); PG8_BAR; PG8_SCHED;
            PG8_LDB(B1, 1, 1); PG8_STAGE(PG8_SB(1, 0), b3, voffB);
            PG8_BAR; PG8_WAIT_L(0); PG8_MMA(0, 1, At, B1); PG8_BAR;
            PG8_LDA(At, 1, 1); PG8_STAGE(PG8_SA(1, 0), a3, voffA);
            PG8_BAR; PG8_WAIT_L(0); PG8_MMA(1, 0, At, B0); PG8_BAR; PG8_SCHED;
            PG8_STAGE(PG8_SB(1, 1), b3 + hstep, voffB);
            PG8_WAIT_V(6); PG8_BAR; PG8_MMA(1, 1, At, B1); PG8_BAR;
            }
        }
        if constexpr (ALIGN_EPI) { if (wr == 0) PG8_BAR; }
        if constexpr (!Epi::AFTER_DRAIN) { E(acc, cur, wr, wc, fr, fq); S.done(cur); }
        if (!has_next) break;
#pragma unroll
        for (int a = 0; a < 2; ++a)
#pragma unroll
            for (int b = 0; b < 2; ++b)
#pragma unroll
                for (int m = 0; m < 4; ++m)
#pragma unroll
                    for (int n = 0; n < 2; ++n) acc[a][b][m][n] = (f32x4){0.f, 0.f, 0.f, 0.f};
        cur = nxt; cA = nA; cB = nB; ++ui;
        if constexpr (ALIGN_EPI) { if (wr == 1) PG8_BAR; }
    }
    PG8_WAIT_V(0);
    if constexpr (!ALIGN_EPI) { if (wr == 0) PG8_BAR; }
    PG8_BAR;
    if constexpr (Epi::AFTER_DRAIN) { E.fused(acc, cur, wr, wc, fr, fq, lds, wid, lane); S.done(cur); }
#undef PG8_SA
#undef PG8_SB
#undef PG8_STAGE
#undef PG8_LDA
#undef PG8_LDB
#undef PG8_MMA
#undef PG8_WAIT_V
#undef PG8_WAIT_L
#undef PG8_BAR
#undef PG8_SCHED
}
}
#define LAS __attribute__((address_space(3)))
typedef unsigned short bf16;
using pg8::f32x4; using pg8::u32x4; using pg8::Unit; using pg8::cvt_pk_bf16; using pg8::bf16x8;
typedef unsigned u32x2 __attribute__((ext_vector_type(2)));

constexpr int NB = 8, S = 2048, D = 1024, M = NB * S, NIN = 2304, FF = 2816, NUP = 2 * FF, DEPTH = 2;
constexpr float EPS = 1e-6f;
constexpr float LOG2E = 1.4426950408889634f;
constexpr float QSCALE = 0.125f * LOG2E;
constexpr int XL_OFF = 131072;
constexpr int LDS_BYTES = 131072 + 8192;

__device__ __forceinline__ float dot4(f32x4 a) { return (a[0] * a[0] + a[1] * a[1]) + (a[2] * a[2] + a[3] * a[3]); }
__device__ __forceinline__ float silu_f(float v) { return v * __builtin_amdgcn_rcpf(1.f + __expf(-v)); }

struct EpiInProj {
    static constexpr bool PERM = true, AFTER_DRAIN = false;
    bf16* O; const float* qn_a; const float* kn_a; const float* qn_b; const float* kn_b; const float* cosT; const float* sinT; const float* rowsq;
    __device__ __forceinline__ void operator()(const f32x4 (&acc)[2][2][4][2], const Unit& u, int wr, int wc, int fr, int fq) const {
        asm volatile("" : "+v"(fr), "+v"(fq));
        const int pn = u.pn;
        const float* g = nullptr; float sc = 1.f;
        if (pn < 2) { g = qn_a; sc = QSCALE; }
        else if (pn == 2) { if (wc < 2) g = kn_a; }
        else if (pn < 5) { g = qn_b; sc = QSCALE; }
        else if (pn < 7) { g = kn_b; }
        const int colb = pn * 256 + wc * 64 + 8 * fq;
        const int row0 = u.pm * 256 + wr * 64 + fr;
        if (g) {
            f32x4 g1[2], g2[2];
#pragma unroll
            for (int n = 0; n < 2; ++n) { g1[n] = *(const f32x4*)(g + 8 * fq + 4 * n); g2[n] = *(const f32x4*)(g + 32 + 8 * fq + 4 * n); }
#pragma unroll
            for (int ai = 0; ai < 2; ++ai)
#pragma unroll
                for (int m = 0; m < 4; ++m) {
                    const int row = row0 + ai * 128 + m * 16;
                    const f32x4 a0 = acc[ai][0][m][0], a1 = acc[ai][0][m][1], b0 = acc[ai][1][m][0], b1 = acc[ai][1][m][1];
                    float ss = (dot4(a0) + dot4(a1)) + (dot4(b0) + dot4(b1));
                    ss += __shfl_xor(ss, 16); ss += __shfl_xor(ss, 32);
                    const float rx = rsqrtf(rowsq[row] * (1.f / D) + EPS);
                    const float rs = rsqrtf(ss * rx * rx * (1.f / 64.f) + EPS) * rx * sc;
                    const size_t ro = (size_t)(row & (S - 1)) * 32 + 8 * fq;
                    const f32x4 c0 = *(const f32x4*)(cosT + ro), c1 = *(const f32x4*)(cosT + ro + 4), s0 = *(const f32x4*)(sinT + ro), s1 = *(const f32x4*)(sinT + ro + 4);
                    const f32x4 y10 = a0 * rs * g1[0], y11 = a1 * rs * g1[1], y20 = b0 * rs * g2[0], y21 = b1 * rs * g2[1];
                    const f32x4 o10 = y10 * c0 - y20 * s0, o11 = y11 * c1 - y21 * s1, o20 = y20 * c0 + y10 * s0, o21 = y21 * c1 + y11 * s1;
                    u32x4 w1, w2;
                    w1.x = cvt_pk_bf16(o10[0], o10[1]); w1.y = cvt_pk_bf16(o10[2], o10[3]); w1.z = cvt_pk_bf16(o11[0], o11[1]); w1.w = cvt_pk_bf16(o11[2], o11[3]);
                    w2.x = cvt_pk_bf16(o20[0], o20[1]); w2.y = cvt_pk_bf16(o20[2], o20[3]); w2.z = cvt_pk_bf16(o21[0], o21[1]); w2.w = cvt_pk_bf16(o21[2], o21[3]);
                    bf16* op = O + (size_t)row * NIN + colb;
                    *(u32x4*)op = w1; *(u32x4*)(op + 32) = w2;
                }
        } else {
#pragma unroll
            for (int ai = 0; ai < 2; ++ai)
#pragma unroll
                for (int m = 0; m < 4; ++m) {
                    const int row = row0 + ai * 128 + m * 16;
                    bf16* op = O + (size_t)row * NIN + colb;
                    const float rx = rsqrtf(rowsq[row] * (1.f / D) + EPS);
#pragma unroll
                    for (int bj = 0; bj < 2; ++bj) { const f32x4 v0 = acc[ai][bj][m][0] * rx, v1 = acc[ai][bj][m][1] * rx; u32x4 w;
                        w.x = cvt_pk_bf16(v0[0], v0[1]); w.y = cvt_pk_bf16(v0[2], v0[3]); w.z = cvt_pk_bf16(v1[0], v1[1]); w.w = cvt_pk_bf16(v1[2], v1[3]);
                        *(u32x4*)(op + 32 * bj) = w; }
                }
        }
    }
};

__device__ __forceinline__ f32x4 bf2f_lo(unsigned a, unsigned b) { return (f32x4){__uint_as_float(a << 16), __uint_as_float(a & 0xffff0000u), __uint_as_float(b << 16), __uint_as_float(b & 0xffff0000u)}; }
struct EpiResid {
    static constexpr bool PERM = true, AFTER_DRAIN = false;
    bf16* XB; float* rowsq; float* outf;
    __device__ __forceinline__ void operator()(const f32x4 (&acc)[2][2][4][2], const Unit& u, int wr, int wc, int fr, int fq) const {
        asm volatile("" : "+v"(fr), "+v"(fq));
        const int col0 = u.pn * 256 + wc * 32 + 8 * fq, row0 = u.pm * 256 + wr * 64 + fr;
#pragma unroll
        for (int ai = 0; ai < 2; ++ai) {
            u32x4 xr[4][2];
#pragma unroll
            for (int m = 0; m < 4; ++m) { const size_t off = (size_t)(row0 + ai * 128 + m * 16) * D + col0;
#pragma unroll
                for (int bj = 0; bj < 2; ++bj) xr[m][bj] = *(const u32x4*)(XB + off + bj * 128); }
            asm volatile("" ::: "memory");
#pragma unroll
            for (int m = 0; m < 4; ++m) { const int row = row0 + ai * 128 + m * 16; const size_t off = (size_t)row * D + col0; float ss = 0.f;
#pragma unroll
                for (int bj = 0; bj < 2; ++bj) {
                    const f32x4 y0 = bf2f_lo(xr[m][bj].x, xr[m][bj].y) + acc[ai][bj][m][0], y1 = bf2f_lo(xr[m][bj].z, xr[m][bj].w) + acc[ai][bj][m][1];
                    ss += dot4(y0) + dot4(y1);
                    if (outf) { __builtin_nontemporal_store(y0, (f32x4*)(outf + off + bj * 128)); __builtin_nontemporal_store(y1, (f32x4*)(outf + off + bj * 128 + 4)); }
                    else { u32x4 w; w.x = cvt_pk_bf16(y0[0], y0[1]); w.y = cvt_pk_bf16(y0[2], y0[3]); w.z = cvt_pk_bf16(y1[0], y1[1]); w.w = cvt_pk_bf16(y1[2], y1[3]); *(u32x4*)(XB + off + bj * 128) = w; }
                }
                if (rowsq) { ss += __shfl_xor(ss, 16); ss += __shfl_xor(ss, 32); if (fq == 0) atomicAdd(rowsq + row, ss); }
            }
            asm volatile("" ::: "memory");
        }
    }
};

struct EpiUpConv {
    static constexpr bool PERM = true, AFTER_DRAIN = false;
    bf16* ACT; const float* cw; const float* cb; float* edge; float* part; LAS float* xl; const float* rowsq;
    __device__ __forceinline__ void operator()(f32x4 (&acc)[2][2][4][2], const Unit& u, int wr, int wc, int fr, int fq) const {
        asm volatile("" : "+v"(fr), "+v"(fq));
        const int lane = 16 * fq + fr;
        const int cl0 = 32 * wc + 8 * fq, ch0 = 128 * u.pn + cl0;
#pragma unroll
        for (int ai = 0; ai < 2; ++ai)
#pragma unroll
            for (int m = 0; m < 4; ++m) { const float rx = rsqrtf(rowsq[u.pm * 256 + ai * 128 + wr * 64 + m * 16 + fr] * (1.f / D) + EPS);
#pragma unroll
                for (int bj = 0; bj < 2; ++bj) { acc[ai][bj][m][0] *= rx; acc[ai][bj][m][1] *= rx; } }
#pragma unroll
        for (int ai = 0; ai < 2; ++ai) {
            const int chunk = 2 * ai + wr;
            if (fr == 0) { *(LAS f32x4*)(xl + (chunk * 2 + 0) * 128 + cl0) = acc[ai][0][0][0]; *(LAS f32x4*)(xl + (chunk * 2 + 0) * 128 + cl0 + 4) = acc[ai][0][0][1]; }
            if (fr == 15) { *(LAS f32x4*)(xl + (chunk * 2 + 1) * 128 + cl0) = acc[ai][0][3][0]; *(LAS f32x4*)(xl + (chunk * 2 + 1) * 128 + cl0 + 4) = acc[ai][0][3][1]; }
        }
        asm volatile("s_waitcnt lgkmcnt(0)" ::: "memory"); __builtin_amdgcn_s_barrier(); asm volatile("" ::: "memory");
        const int lup = (lane & ~15) | ((fr + 15) & 15), ldn = (lane & ~15) | ((fr + 1) & 15);
        const bool seq_first = (u.pm & 7) == 0, seq_last = (u.pm & 7) == 7;
#pragma unroll
        for (int ai = 0; ai < 2; ++ai) {
            const int chunk = 2 * ai + wr;
#pragma unroll
            for (int n = 0; n < 2; ++n) {
                const int ch = ch0 + 4 * n;
                const f32x4 w0 = *(const f32x4*)(cw + ch), w1 = *(const f32x4*)(cw + FF + ch), w2 = *(const f32x4*)(cw + 2 * FF + ch), bb = *(const f32x4*)(cb + ch);
                const f32x4 above = (chunk > 0) ? *(const LAS f32x4*)(xl + ((chunk - 1) * 2 + 1) * 128 + cl0 + 4 * n) : (f32x4){0.f, 0.f, 0.f, 0.f};
                const f32x4 below = (chunk < 3) ? *(const LAS f32x4*)(xl + ((chunk + 1) * 2 + 0) * 128 + cl0 + 4 * n) : (f32x4){0.f, 0.f, 0.f, 0.f};
                f32x4 Rprev = above, Lcur;
#pragma unroll
                for (int e = 0; e < 4; ++e) Lcur[e] = __shfl(acc[ai][0][0][n][e], ldn);
#pragma unroll
                for (int m = 0; m < 4; ++m) {
                    const int rt = ai * 128 + wr * 64 + m * 16 + fr;
                    const size_t row = (size_t)u.pm * 256 + rt;
                    const f32x4 cur = acc[ai][0][m][n], val = acc[ai][1][m][n];
                    f32x4 Rm, Lnext = below;
#pragma unroll
                    for (int e = 0; e < 4; ++e) { Rm[e] = __shfl(cur[e], lup); if (m < 3) Lnext[e] = __shfl(acc[ai][0][m < 3 ? m + 1 : 3][n][e], ldn); }
                    const f32x4 up = (fr == 0) ? Rprev : Rm, dn = (fr == 15) ? Lnext : Lcur;
                    Rprev = Rm; Lcur = Lnext;
                    const f32x4 pre = bb + w0 * up + w1 * cur + w2 * dn;
                    f32x4 res;
#pragma unroll
                    for (int e = 0; e < 4; ++e) res[e] = silu_f(pre[e]) * val[e];
                    if (rt == 0) {
                        *(f32x4*)(edge + ((size_t)u.pm * 2 + 0) * FF + ch) = cur;
                        if (!seq_first) { float* pp = part + (((size_t)u.pm * 2 + 0) * FF + ch) * 2;
                            *(f32x4*)pp = (f32x4){pre[0], val[0], pre[1], val[1]}; *(f32x4*)(pp + 4) = (f32x4){pre[2], val[2], pre[3], val[3]}; }
                    }
                    if (rt == 255) {
                        *(f32x4*)(edge + ((size_t)u.pm * 2 + 1) * FF + ch) = cur;
                        if (!seq_last) { float* pp = part + (((size_t)u.pm * 2 + 1) * FF + ch) * 2;
                            *(f32x4*)pp = (f32x4){pre[0], val[0], pre[1], val[1]}; *(f32x4*)(pp + 4) = (f32x4){pre[2], val[2], pre[3], val[3]}; }
                    }
                    u32x2 w; w.x = cvt_pk_bf16(res[0], res[1]); w.y = cvt_pk_bf16(res[2], res[3]);
                    *(u32x2*)(ACT + row * FF + ch) = w;
                }
            }
        }
    }
};
namespace att {
typedef __attribute__((ext_vector_type(16))) float f32x16;
typedef __attribute__((ext_vector_type(4))) short s16x4;
typedef short v4i16_t __attribute__((ext_vector_type(4)));
typedef LAS const char* lptr;
__device__ __forceinline__ s16x4 vtr(lptr p) { return __builtin_bit_cast(s16x4, __builtin_amdgcn_ds_read_tr16_b64_v4i16((LAS v4i16_t*)p)); }
typedef float f32x2_t __attribute__((ext_vector_type(2))); typedef __bf16 bf16x2_t __attribute__((ext_vector_type(2)));
__device__ __forceinline__ unsigned cvtpk_s(float lo, float hi) { f32x2_t v = {lo, hi}; bf16x2_t b = __builtin_convertvector(v, bf16x2_t); return __builtin_bit_cast(unsigned, b); }
__device__ __forceinline__ bf16x8 pack8(const f32x16& s, int b) {
    u32x4 w; w.x = cvtpk_s(s[b], s[b + 1]); w.y = cvtpk_s(s[b + 2], s[b + 3]); w.z = cvtpk_s(s[b + 4], s[b + 5]); w.w = cvtpk_s(s[b + 6], s[b + 7]);
    return __builtin_bit_cast(bf16x8, w);
}
#define MFMA32(a, b, c) __builtin_amdgcn_mfma_f32_32x32x16_bf16((a), (b), (c), 0, 0, 0)

#define LGKM_WAIT(n) asm volatile("s_waitcnt lgkmcnt(" #n ")" ::: "memory")
#define SCHED_FENCE() __builtin_amdgcn_sched_barrier(0)
__device__ __forceinline__ bf16x8 rd128(unsigned addr, int off) { bf16x8 r; asm volatile("ds_read_b128 %0, %1 offset:%c2" : "=&v"(r) : "v"(addr), "i"(off) : "memory"); return r; }
__device__ __forceinline__ s16x4 rdtr(unsigned addr, int off) { s16x4 r; asm volatile("ds_read_b64_tr_b16 %0, %1 offset:%c2" : "=&v"(r) : "v"(addr), "i"(off) : "memory"); return r; }
#define VFRAG(lo, hh) ((bf16x8){lo[0], lo[1], lo[2], lo[3], hh[0], hh[1], hh[2], hh[3]})
constexpr int KROW = 144, VROWD = 320, VROWA = 192;
constexpr int DSTG = 2 * 64 * KROW + 64 * VROWD;
constexpr int ASTG = 64 * KROW + 64 * VROWA;

constexpr int DST3 = 32768;
#define SGB(mask, n) __builtin_amdgcn_sched_group_barrier((mask), (n), 0)
__device__ __forceinline__ void diff_unit(LAS char* lds, const bf16* __restrict__ QKV, bf16* __restrict__ Y, int b, int h, int qb, float Mb, float lam, const float* __restrict__ subln, float outscale) {
    int tid = threadIdx.x; asm volatile("" : "+v"(tid)); const int lane = tid & 63, w = __builtin_amdgcn_readfirstlane(tid >> 6), q = lane & 31, hi = lane >> 5;
    const int rg = w >> 1, c = w & 1;
    const size_t rowQ = (size_t)b * S + qb * 128 + rg * 32 + q;
    const bf16* qp = QKV + rowQ * NIN + 768 + (2 * h + c) * 64 + hi * 8;
    bf16x8 qf[4];
#pragma unroll
    for (int ds = 0; ds < 4; ++ds) qf[ds] = *(const bf16x8*)(qp + ds * 16);
    const int krow = 8 * w + (lane >> 3), kch = (lane & 7) ^ ((krow >> 1) & 7);
    const int vrow = 4 * w + (lane >> 4), vch = (lane & 15) ^ ((vrow & 3) << 2);
    const bf16* kg = QKV + ((size_t)b * S + krow) * NIN + 1280 + 128 * h + kch * 8;
    const bf16* vg = QKV + ((size_t)b * S + vrow) * NIN + 1792 + 128 * h + vch * 8;
#define DDMA(t, so) do { const size_t o_ = (size_t)(t) * 64 * NIN; LAS unsigned char* d_ = (LAS unsigned char*)lds + (so) + w * 1024; \
        __builtin_amdgcn_global_load_lds((const unsigned*)(kg + o_), (LAS unsigned*)(d_), 16, 0, 0); \
        __builtin_amdgcn_global_load_lds((const unsigned*)(kg + o_ + 64), (LAS unsigned*)(d_ + 8192), 16, 0, 0); \
        __builtin_amdgcn_global_load_lds((const unsigned*)(vg + o_), (LAS unsigned*)(d_ + 16384), 16, 0, 0); \
        __builtin_amdgcn_global_load_lds((const unsigned*)(vg + o_ + 32 * NIN), (LAS unsigned*)(d_ + 16384 + 8192), 16, 0, 0); } while (0)
    f32x16 o[4];
#pragma unroll
    for (int i = 0; i < 4; ++i) o[i] = (f32x16){0.f};
    float l = 0.f;
    constexpr int NT = S / 64;
    DDMA(0, 0); DDMA(1, DST3); DDMA(2, 2 * DST3);
    const unsigned lbase = (unsigned)(size_t)lds;
    unsigned kofs[4], vofs[4];
    { const int sw = (q >> 1) & 7, vq = (lane & 15) >> 2;
#pragma unroll
      for (int ds = 0; ds < 4; ++ds) kofs[ds] = (unsigned)(c * 8192 + q * 128 + (((2 * ds + hi) ^ sw) << 4));
#pragma unroll
      for (int db = 0; db < 4; ++db) vofs[db] = (unsigned)(16384 + (4 * hi + vq) * 256 + ((db ^ vq) << 6) + ((lane >> 4) & 1) * 32 + (lane & 3) * 8); }
    f32x16 negm;
#pragma unroll
    for (int r = 0; r < 16; ++r) negm[r] = -Mb;
    f32x16 s0, s1;
    { asm volatile("s_waitcnt vmcnt(8)" ::: "memory"); __builtin_amdgcn_s_barrier(); asm volatile("" ::: "memory");
      bf16x8 kf[8];
#pragma unroll
      for (int ds = 0; ds < 4; ++ds) { kf[2 * ds] = rd128(lbase + kofs[ds], 0); kf[2 * ds + 1] = rd128(lbase + kofs[ds], 32 * 128); }
      LGKM_WAIT(0); SCHED_FENCE();
      s0 = negm; s1 = negm;
#pragma unroll
      for (int ds = 0; ds < 4; ++ds) { s0 = MFMA32(kf[2 * ds], qf[ds], s0); s1 = MFMA32(kf[2 * ds + 1], qf[ds], s1); }
      SCHED_FENCE(); }
    int so_cur = 0, so_n1 = DST3, so_n3 = 3 * DST3;
    for (int t = 0; t < NT; ++t) {
        asm volatile("s_waitcnt vmcnt(4)" ::: "memory");
        __builtin_amdgcn_s_barrier();
        asm volatile("" ::: "memory");
        { const int tn = (t + 3 < NT) ? t + 3 : NT - 1; DDMA(tn, so_n3); }
        const unsigned sb = lbase + so_cur, sn = lbase + so_n1;
        bf16x8 kf[8];
#pragma unroll
        for (int ds = 0; ds < 4; ++ds) { kf[2 * ds] = rd128(sn + kofs[ds], 0); kf[2 * ds + 1] = rd128(sn + kofs[ds], 32 * 128); }
        s16x4 vl[2][4], vh[2][4];
#pragma unroll
        for (int db = 0; db < 4; ++db) { vl[0][db] = rdtr(sb + vofs[db], 0); vh[0][db] = rdtr(sb + vofs[db], 8 * 256); }
        LGKM_WAIT(0); SCHED_FENCE();
        __builtin_amdgcn_s_setprio(1);
        f32x16 n0 = negm, n1 = negm;
#pragma unroll
        for (int ds = 0; ds < 4; ++ds) { n0 = MFMA32(kf[2 * ds], qf[ds], n0); n1 = MFMA32(kf[2 * ds + 1], qf[ds], n1); }
        float ls = 0.f;
#pragma unroll
        for (int r = 0; r < 16; ++r) { s0[r] = __builtin_amdgcn_exp2f(s0[r]); ls += s0[r]; }
        bf16x8 pf[4]; pf[0] = pack8(s0, 0); pf[1] = pack8(s0, 8);
#pragma unroll
        for (int i = 0; i < 8; ++i) { SGB(0x008, 1); SGB(0x400, 2); SGB(0x002, 3); }
        SCHED_FENCE();
        __builtin_amdgcn_s_setprio(0);
#pragma unroll
        for (int db = 0; db < 4; ++db) { vl[1][db] = rdtr(sb + vofs[db], 16 * 256); vh[1][db] = rdtr(sb + vofs[db], 16 * 256 + 8 * 256); }
        s16x4 wl[2][4], wh[2][4];
#pragma unroll
        for (int ks = 0; ks < 2; ++ks)
#pragma unroll
            for (int db = 0; db < 4; ++db) { wl[ks][db] = rdtr(sb + vofs[db], (ks + 2) * 16 * 256); wh[ks][db] = rdtr(sb + vofs[db], (ks + 2) * 16 * 256 + 8 * 256); }
        LGKM_WAIT(15); SCHED_FENCE();
        __builtin_amdgcn_s_setprio(1);
#pragma unroll
        for (int ks = 0; ks < 2; ++ks)
#pragma unroll
            for (int db = 0; db < 4; ++db) o[db] = MFMA32(VFRAG(vl[ks][db], vh[ks][db]), pf[ks], o[db]);
#pragma unroll
        for (int r = 0; r < 16; ++r) { s1[r] = __builtin_amdgcn_exp2f(s1[r]); ls += s1[r]; }
        l += ls;
        pf[2] = pack8(s1, 0); pf[3] = pack8(s1, 8);
#pragma unroll
        for (int i = 0; i < 8; ++i) { SGB(0x008, 1); SGB(0x400, 2); SGB(0x002, 3); }
        SCHED_FENCE();
        LGKM_WAIT(0); SCHED_FENCE();
#pragma unroll
        for (int ks = 0; ks < 2; ++ks)
#pragma unroll
            for (int db = 0; db < 4; ++db) o[db] = MFMA32(VFRAG(wl[ks][db], wh[ks][db]), pf[2 + ks], o[db]);
        SCHED_FENCE();
        __builtin_amdgcn_s_setprio(0);
        s0 = n0; s1 = n1;
        so_cur = so_n1; so_n1 = (so_n1 == 3 * DST3) ? 0 : so_n1 + DST3; so_n3 = (so_n3 == 3 * DST3) ? 0 : so_n3 + DST3;
    }
#undef DDMA
    asm volatile("s_waitcnt vmcnt(0)" ::: "memory");
    __syncthreads();
    l += __shfl_xor(l, 32);
    const float inv = 1.f / l;
    LAS f32x4* xb = (LAS f32x4*)lds + rg * (16 * 64) + lane;
    if (c == 1) {
#pragma unroll
        for (int db = 0; db < 4; ++db)
#pragma unroll
            for (int r4 = 0; r4 < 4; ++r4) xb[(db * 4 + r4) * 64] = (f32x4){o[db][4 * r4], o[db][4 * r4 + 1], o[db][4 * r4 + 2], o[db][4 * r4 + 3]} * inv;
    }
    __syncthreads();
    if (c == 0) {
        float ss = 0.f;
#pragma unroll
        for (int db = 0; db < 4; ++db)
#pragma unroll
            for (int r4 = 0; r4 < 4; ++r4) { const f32x4 ot = xb[(db * 4 + r4) * 64];
#pragma unroll
                for (int e = 0; e < 4; ++e) { const float d = o[db][4 * r4 + e] * inv - lam * ot[e]; o[db][4 * r4 + e] = d; ss += d * d; } }
        ss += __shfl_xor(ss, 32);
        const float rs = rsqrtf(ss * (1.f / 128.f) + EPS) * outscale;
        LAS char* stg = lds + 65536 + rg * 8704;
#pragma unroll
        for (int db = 0; db < 4; ++db)
#pragma unroll
            for (int r4 = 0; r4 < 4; ++r4) { const f32x4 gw = *(const f32x4*)(subln + 32 * db + 8 * r4 + 4 * hi);
                u32x2 wv; wv.x = cvt_pk_bf16(o[db][4 * r4] * rs * gw[0], o[db][4 * r4 + 1] * rs * gw[1]); wv.y = cvt_pk_bf16(o[db][4 * r4 + 2] * rs * gw[2], o[db][4 * r4 + 3] * rs * gw[3]);
                *(LAS u32x2*)(stg + q * 272 + (32 * db + 8 * r4 + 4 * hi) * 2) = wv; }
        asm volatile("s_waitcnt lgkmcnt(0)" ::: "memory");
        bf16* yrow = Y + ((size_t)b * S + qb * 128 + rg * 32) * D + 512 + 128 * h;
#pragma unroll
        for (int i = 0; i < 8; ++i) { const int row = i * 4 + (lane >> 4), chn = lane & 15;
            const u32x4 v = *(const LAS u32x4*)(stg + row * 272 + chn * 16); *(u32x4*)(yrow + (size_t)row * D + chn * 8) = v; }
    }
    __syncthreads();
}

__device__ __forceinline__ void swa_unit(LAS char* lds, const bf16* __restrict__ QKV, bf16* __restrict__ Y, int b, int kvh, int n, float Mb, const float* __restrict__ sink) {
    int tid = threadIdx.x; asm volatile("" : "+v"(tid)); const int lane = tid & 63, w = __builtin_amdgcn_readfirstlane(tid >> 6), q = lane & 31, hi = lane >> 5;
    const int head = kvh * 4 + (w >> 1), rb = (w & 1) * 64;
    const size_t rowQ = (size_t)b * S + n * 128 + rb + q;
    bf16x8 qf[2][4];
#pragma unroll
    for (int rg = 0; rg < 2; ++rg)
#pragma unroll
        for (int ds = 0; ds < 4; ++ds) qf[rg][ds] = *(const bf16x8*)(QKV + (rowQ + 32 * rg) * NIN + head * 64 + hi * 8 + ds * 16);
    const int lrow = tid >> 3, lcc = tid & 7;
    const long kp0 = (long)b * S + (long)(n - 1) * 128 + lrow;
    const bf16* kg = QKV + kp0 * NIN + 512 + kvh * 64 + lcc * 8;
    const bf16* vg = QKV + kp0 * NIN + 640 + kvh * 64 + lcc * 8;
    const int kdst = lrow * KROW + lcc * 16, vdst = 64 * KROW + lrow * VROWA + lcc * 16;
    u32x4 st0, st1;
#define ALOAD(t) do { const long o_ = (long)(t) * 64 * NIN; st0 = *(const u32x4*)(kg + o_); st1 = *(const u32x4*)(vg + o_); } while (0)
#define ASTORE(bo) do { *(LAS u32x4*)(lds + (bo) + kdst) = st0; *(LAS u32x4*)(lds + (bo) + vdst) = st1; } while (0)
    f32x16 o[2][2];
#pragma unroll
    for (int i = 0; i < 2; ++i)
#pragma unroll
        for (int j = 0; j < 2; ++j) o[i][j] = (f32x16){0.f};
    float l[2] = {0.f, 0.f};
    const int t0 = (n == 0) ? 2 : 0, t1 = (n == S / 128 - 1) ? 4 : 6;
    ALOAD(t0); ASTORE((t0 & 1) * ASTG); __syncthreads();
    const int koff = q * KROW + hi * 16;
    const int voff = 64 * KROW + (4 * hi + ((lane & 15) >> 2)) * VROWA + ((lane >> 4) & 1) * 32 + (lane & 3) * 8;
    const unsigned lbase = (unsigned)(size_t)lds;
    for (int t = t0; t < t1; ++t) {
        const int cur = (t & 1) * ASTG, nxt = ASTG - cur;
        if (t + 1 < t1) ALOAD(t + 1);
        const unsigned ka = lbase + cur + koff, va = lbase + cur + voff;
        bf16x8 kf[8];
#pragma unroll
        for (int ds = 0; ds < 4; ++ds) { kf[2 * ds] = rd128(ka, ds * 32); kf[2 * ds + 1] = rd128(ka, 32 * KROW + ds * 32); }
        s16x4 vl[4][2], vh[4][2];
#pragma unroll
        for (int ks = 0; ks < 4; ++ks)
#pragma unroll
            for (int db = 0; db < 2; ++db) { vl[ks][db] = rdtr(va, ks * 16 * VROWA + db * 64); vh[ks][db] = rdtr(va, ks * 16 * VROWA + 8 * VROWA + db * 64); }
        LGKM_WAIT(0); SCHED_FENCE();
#pragma unroll
        for (int rg = 0; rg < 2; ++rg) {
            const int i0 = rb + 32 * rg;
            if (64 * t + 63 >= i0 && 64 * t <= i0 + 31 + 256) {
                f32x16 s0 = (f32x16){0.f}, s1 = (f32x16){0.f};
#pragma unroll
                for (int ds = 0; ds < 4; ++ds) { s0 = MFMA32(kf[2 * ds], qf[rg][ds], s0); s1 = MFMA32(kf[2 * ds + 1], qf[rg][ds], s1); }
                const int jb = 64 * t + 4 * hi - (i0 + q);
                float ls = 0.f;
#pragma unroll
                for (int r = 0; r < 16; ++r) {
                    const int d0 = jb + (r & 3) + 8 * (r >> 2), d1 = d0 + 32;
                    const float p0 = __builtin_amdgcn_exp2f(s0[r] - Mb), p1 = __builtin_amdgcn_exp2f(s1[r] - Mb);
                    s0[r] = ((unsigned)d0 <= 256u) ? p0 : 0.f; s1[r] = ((unsigned)d1 <= 256u) ? p1 : 0.f; ls += s0[r] + s1[r];
                }
                l[rg] += ls;
                bf16x8 pf[4]; pf[0] = pack8(s0, 0); pf[1] = pack8(s0, 8); pf[2] = pack8(s1, 0); pf[3] = pack8(s1, 8);
#pragma unroll
                for (int ks = 0; ks < 4; ++ks)
#pragma unroll
                    for (int db = 0; db < 2; ++db) o[rg][db] = MFMA32(VFRAG(vl[ks][db], vh[ks][db]), pf[ks], o[rg][db]);
            }
        }
        SCHED_FENCE();
        if (t + 1 < t1) ASTORE(nxt);
        __syncthreads();
    }
#undef ALOAD
#undef ASTORE
    const float sk = __builtin_amdgcn_exp2f(sink[head] * LOG2E - Mb);
#pragma unroll
    for (int rg = 0; rg < 2; ++rg) {
        float lt = l[rg]; lt += __shfl_xor(lt, 32);
        const float inv = 1.f / (lt + sk);
        bf16* yp = Y + (rowQ + 32 * rg) * D + head * 64 + 4 * hi;
#pragma unroll
        for (int db = 0; db < 2; ++db)
#pragma unroll
            for (int r4 = 0; r4 < 4; ++r4) { u32x2 wv; wv.x = cvt_pk_bf16(o[rg][db][4 * r4] * inv, o[rg][db][4 * r4 + 1] * inv); wv.y = cvt_pk_bf16(o[rg][db][4 * r4 + 2] * inv, o[rg][db][4 * r4 + 3] * inv);
                *(u32x2*)(yp + 32 * db + 8 * r4) = wv; }
    }
}
}
constexpr size_t MiB = 1u << 20;
constexpr size_t WS_CTL = 0, CTL_BYTES = 65536 + 4 * 65536;
constexpr size_t WS_ROWSQ = 65536;
constexpr int MISC_OFF = 131072 + 4096;
constexpr size_t WS_ROPE = 1 * MiB;
constexpr size_t WS_W = 2 * MiB, W_LAYER = 23 * MiB;
constexpr size_t W_IN = 0, W_OUT = (size_t)NIN * D * 2, W_UP = W_OUT + (size_t)D * D * 2, W_DOWN = W_UP + (size_t)NUP * D * 2;
static_assert(W_DOWN + (size_t)D * FF * 2 <= W_LAYER, "weights");
constexpr size_t WS_H = 48 * MiB;
constexpr size_t WS_QKV = 80 * MiB;
constexpr size_t WS_Y = 152 * MiB;
constexpr size_t WS_ACT = 80 * MiB;
constexpr size_t WS_EDGE = 184 * MiB;
constexpr size_t WS_PART = 186 * MiB;
constexpr size_t WS_END = 190 * MiB;
static_assert(WS_ACT + (size_t)M * FF * 2 <= WS_EDGE && WS_QKV + (size_t)M * NIN * 2 <= WS_Y && WS_Y + (size_t)M * D * 2 <= WS_EDGE, "ws map");

#ifndef REP_P0
#define REP_P0 1
#endif
#ifndef REP_P1
#define REP_P1 1
#endif
#ifndef REP_P3B
#define REP_P3B 1
#endif
#ifndef REP_P4
#define REP_P4 1
#endif
#ifndef ATT_REP
#define ATT_REP 1
#endif
#ifndef REP_P5
#define REP_P5 1
#endif
#ifndef REP_P3
#define REP_P3 1
#endif
#ifndef REP_SYNC
#define REP_SYNC 1
#endif
struct Args {
    const float *x, *g_attn, *w_in, *qn_a, *kn_a, *sink, *qn_b, *kn_b, *lq1, *lk1, *lq2, *lk2, *subln, *w_out, *g_ffn, *w_up, *conv_w, *conv_b, *w_down;
    float* out; unsigned char* ws;
};

__device__ __forceinline__ float wave_sum(float v) {
#pragma unroll
    for (int o = 1; o < 64; o <<= 1) v += __shfl_xor(v, o);
    return v;
}
__device__ __forceinline__ float uniform_f(float v) { return __uint_as_float(__builtin_amdgcn_readfirstlane(__float_as_uint(v))); }
__device__ __forceinline__ float wave_max(float v) {
#pragma unroll
    for (int o = 1; o < 64; o <<= 1) v = fmaxf(v, __shfl_xor(v, o));
    return v;
}
__device__ __forceinline__ unsigned f2bf(float f) { unsigned u = __builtin_bit_cast(unsigned, f); return (u + 0x7fffu + ((u >> 16) & 1u)) >> 16; }
__device__ __forceinline__ unsigned pk2(float lo, float hi) { return f2bf(lo) | (f2bf(hi) << 16); }

__device__ __forceinline__ void transpose_item(const float* __restrict__ W, int K, int N, bf16* __restrict__ WT, LAS float* scr, int kb, int nb, int dnb, int lane, const float* __restrict__ g) {
    const int k0 = 64 * kb, n0 = 32 * nb;
    float wv_[32];
#pragma unroll
    for (int i = 0; i < 32; ++i) { const int kk = 2 * i + (lane >> 5); wv_[i] = __builtin_nontemporal_load(&W[(size_t)(k0 + kk) * N + n0 + (lane & 31)]); }
#pragma unroll
    for (int i = 0; i < 32; ++i) { const int kk = 2 * i + (lane >> 5); scr[kk * 33 + (lane & 31)] = wv_[i] * (g ? g[k0 + kk] : 1.f); }
    asm volatile("s_waitcnt lgkmcnt(0)" ::: "memory");
    const int c = lane & 7;
#pragma unroll
    for (int j = 0; j < 4; ++j) { const int n = (lane >> 3) + 8 * j; const LAS float* s = scr + (8 * c) * 33 + n;
        u32x4 o; o.x = pk2(s[0 * 33], s[1 * 33]); o.y = pk2(s[2 * 33], s[3 * 33]); o.z = pk2(s[4 * 33], s[5 * 33]); o.w = pk2(s[6 * 33], s[7 * 33]);
        *(u32x4*)(WT + (size_t)(32 * dnb + n) * K + k0 + 8 * c) = o; }
    asm volatile("s_waitcnt lgkmcnt(0)" ::: "memory");
}

__device__ __forceinline__ void convert_rows(const float* __restrict__ x, bf16* __restrict__ out, float* __restrict__ rowsq, int gw, int ngw, int lane) {
    for (int m0 = gw; m0 < M; m0 += 4 * ngw) {
        f32x4 v[4][4];
#pragma unroll
        for (int r = 0; r < 4; ++r) { const int m = m0 + r * ngw; if (m < M) { const f32x4* xr = (const f32x4*)(x + (size_t)m * D) + lane;
#pragma unroll
            for (int j = 0; j < 4; ++j) v[r][j] = __builtin_nontemporal_load(&xr[64 * j]); } }
#pragma unroll
        for (int r = 0; r < 4; ++r) { const int m = m0 + r * ngw; if (m < M) {
            float s = 0.f;
#pragma unroll
            for (int j = 0; j < 4; ++j) s += dot4(v[r][j]);
            s = wave_sum(s);
            if (lane == 0) rowsq[m] = s;
            u32x2* o8 = (u32x2*)(out + (size_t)m * D) + lane;
#pragma unroll
            for (int j = 0; j < 4; ++j) { u32x2 wv; wv.x = pk2(v[r][j][0], v[r][j][1]); wv.y = pk2(v[r][j][2], v[r][j][3]); o8[64 * j] = wv; } } }
    }
}

#define XB_TMO      128
#define XB_XCNT(j)  (256  + 64 * (j))
#define XB_XSUB(j)  (1280 + 64 * (j))
#define XB_XGEN(j)  (2304 + 64 * (j))
#define XB_TOP      3328
#define XB_TOPGEN   3392
#define XCD_BAR_WORDS 3456
#define XB_SPIN_CAP (1u << 18)

__device__ __forceinline__ unsigned xb_ld(unsigned* p)              { return __hip_atomic_load(p, __ATOMIC_RELAXED, __HIP_MEMORY_SCOPE_AGENT); }
__device__ __forceinline__ unsigned xb_add(unsigned* p, unsigned v) { return __hip_atomic_fetch_add(p, v, __ATOMIC_RELAXED, __HIP_MEMORY_SCOPE_AGENT); }
__device__ __forceinline__ unsigned xb_xcc_id() { return (unsigned)__builtin_amdgcn_s_getreg((3 << 11) | 20) & 0xFu; }
#define XB_SPIN(cond, bar) do { unsigned _sp = 0; while (cond) { __builtin_amdgcn_s_sleep(0); \
    if ((++_sp & 255u) == 0u) { if (xb_ld(&(bar)[XB_TMO])) break; if (_sp > XB_SPIN_CAP) { atomicAdd(&(bar)[XB_TMO], 1u); break; } } } } while (0)

struct XcdBarrier {
    unsigned* bar; unsigned x;
    volatile LAS unsigned* st;
};

__device__ __forceinline__ XcdBarrier xcd_barrier_post(unsigned* bar, volatile LAS unsigned* st) {
    XcdBarrier b; b.bar = bar; b.x = xb_xcc_id(); b.st = st;
    if (threadIdx.x == 0) (void)xb_add(&bar[XB_XCNT(b.x)], 1u);
    return b;
}
__device__ __forceinline__ void xcd_barrier_complete(unsigned* bar, unsigned x, unsigned& nloc, unsigned& nx) {
    const unsigned G = gridDim.x * gridDim.y * gridDim.z;
    unsigned sum, cnt, mine, sp = 0u;
    for (;;) {
        sum = 0u; cnt = 0u; mine = 0u;
#pragma unroll
        for (unsigned j = 0; j < 16; ++j) { const unsigned c = xb_ld(&bar[XB_XCNT(j)]); sum += c; cnt += (c > 0u) ? 1u : 0u; mine = (j == x) ? c : mine; }
        if (sum == G) break;
        __builtin_amdgcn_s_sleep(1);
        if ((++sp & 255u) == 0u) { if (xb_ld(&bar[XB_TMO])) break; if (sp > XB_SPIN_CAP) { atomicAdd(&bar[XB_TMO], 1u); break; } }
    }
    nloc = mine > 0u ? mine : 1u; nx = cnt > 0u ? cnt : 1u;
}

__device__ __forceinline__ void xcd_barrier(const XcdBarrier& b) {
    asm volatile("s_waitcnt vmcnt(0)" ::: "memory");
    __syncthreads();
    if (threadIdx.x == 0) {
        unsigned* bar = b.bar;
        __builtin_amdgcn_s_waitcnt(0);
        unsigned nloc = b.st[0], nx = b.st[1];
        if (nloc == 0u) { xcd_barrier_complete(bar, b.x, nloc, nx); b.st[0] = nloc; b.st[1] = nx; }
        const unsigned old = xb_add(&bar[XB_XSUB(b.x)], 1u);
        const unsigned gen = old / nloc;
        if (old + 1u == (gen + 1u) * nloc) {
            __builtin_amdgcn_fence(__ATOMIC_RELEASE, "agent");
            asm volatile("s_waitcnt vmcnt(0)" ::: "memory");
            const unsigned og = xb_add(&bar[XB_TOP], 1u);
            const unsigned tg = og / nx;
            if (og + 1u == (tg + 1u) * nx) xb_add(&bar[XB_TOPGEN], 1u);
            else XB_SPIN(xb_ld(&bar[XB_TOPGEN]) == tg, bar);
            __builtin_amdgcn_fence(__ATOMIC_ACQUIRE, "agent");
            xb_add(&bar[XB_XGEN(b.x)], 1u);
            asm volatile("s_waitcnt vmcnt(0)" ::: "memory");
        } else {
            XB_SPIN(xb_ld(&bar[XB_XGEN(b.x)]) == gen, bar);
            __builtin_amdgcn_fence(__ATOMIC_ACQUIRE, "agent");
            asm volatile("s_waitcnt vmcnt(0)" ::: "memory");
        }
    }
    __syncthreads();
}

__global__ void __launch_bounds__(512, 2) mega_fwd(Args a) {
    extern __shared__ __attribute__((aligned(16))) unsigned char lds_raw[];
    LAS unsigned char* lds = (LAS unsigned char*)lds_raw;
    cg::grid_group grid = cg::this_grid();
    const int tid = threadIdx.x, lane = tid & 63, wave = __builtin_amdgcn_readfirstlane(tid >> 6);
    const int G = gridDim.x, bx = blockIdx.x;
    const int vcu = (G % 8 == 0) ? (bx % 8) * (G / 8) + bx / 8 : bx;
    const int gw = vcu * 8 + wave, ngw = G * 8;
    typedef const __attribute__((address_space(4))) Args* kargs_t;
    const kargs_t kap = (kargs_t)__builtin_amdgcn_kernarg_segment_ptr();
#define PHASE_ARGS() kargs_t ap = kap; asm volatile("" : "+s"(ap)); unsigned char* const ws = ap->ws; \
    float* const cosT = (float*)(ws + WS_ROPE); float* const sinT = cosT + S * 32; \
    bf16* const Hb = (bf16*)(ws + WS_H); bf16* const QKV = (bf16*)(ws + WS_QKV); bf16* const Yb = (bf16*)(ws + WS_Y); bf16* const ACT = (bf16*)(ws + WS_ACT); \
    float* const edge = (float*)(ws + WS_EDGE); float* const part = (float*)(ws + WS_PART); float* const rowsq = (float*)(ws + WS_ROWSQ); \
    (void)cosT; (void)sinT; (void)Hb; (void)QKV; (void)Yb; (void)ACT; (void)edge; (void)part; (void)rowsq
    volatile LAS unsigned* misc = (volatile LAS unsigned*)(lds + MISC_OFF);
    if (tid < 16) misc[tid] = 0u;
    __syncthreads();

    constexpr int I_IN = 16 * 72, I_OUT = 16 * 32, I_UP = 16 * 176, I_DOWN = 44 * 32, I_L = I_IN + I_OUT + I_UP + I_DOWN;
#define CONVERT_WEIGHTS(L, wv, nwv, i0, i1) do { \
        int lane = threadIdx.x & 63; asm volatile("" : "+v"(lane)); \
        LAS float* scr = (LAS float*)(lds + wave * 16384); \
        unsigned char* wl_ = ws + WS_W + (size_t)(L) * W_LAYER; \
        for (int it = (i0) + (wv); it < (i1); it += (nwv)) { \
            int r = it; \
            if (r < I_IN) { const int kb = r / 72, nb = r % 72; const int pn = nb >> 3, wc = (nb >> 1) & 3, bj = nb & 1; \
                transpose_item(ap->w_in + (size_t)(L) * D * NIN, D, NIN, (bf16*)(wl_ + W_IN), scr, kb, nb, 8 * pn + 4 * bj + wc, lane, ap->g_attn + (L) * D); continue; } \
            r -= I_IN; \
            if (r < I_OUT) { const int kb = r / 32, nb = r % 32; transpose_item(ap->w_out + (size_t)(L) * D * D, D, D, (bf16*)(wl_ + W_OUT), scr, kb, nb, nb, lane, nullptr); continue; } \
            r -= I_OUT; \
            if (r < I_UP) { const int kb = r / 176, nb = r % 176; const int isv = nb >= 88, nn = isv ? nb - 88 : nb; const int dnb = 8 * (nn >> 2) + 4 * isv + (nn & 3); \
                transpose_item(ap->w_up + (size_t)(L) * D * NUP, D, NUP, (bf16*)(wl_ + W_UP), scr, kb, nb, dnb, lane, ap->g_ffn + (L) * D); continue; } \
            r -= I_UP; \
            { const int kb = r / 32, nb = r % 32; transpose_item(ap->w_down + (size_t)(L) * FF * D, FF, D, (bf16*)(wl_ + W_DOWN), scr, kb, nb, nb, lane, nullptr); } \
        } } while (0)
    {
        PHASE_ARGS();
        CONVERT_WEIGHTS(0, gw, ngw, 0, I_IN);
        for (int i = vcu * 512 + tid; i < S * 32; i += G * 512) {
            const int pos = i >> 5, j = i & 31;
            double inv = 1.0; for (int k = 0; k < j; ++k) inv *= 0.74989420933245582730;
            const double ang = (double)pos * inv;
            const double kq = __builtin_rint(ang * 0.15915494309189533577);
            const double rr = (ang - kq * 6.283185307179586232) - kq * 2.4492935982947064e-16;
            const double r2 = rr * rr;
            double sn = 1.0, cs = 1.0;
#pragma unroll
            for (int k = 12; k >= 1; --k) { sn = 1.0 - sn * r2 * (1.0 / (double)((2 * k) * (2 * k + 1))); cs = 1.0 - cs * r2 * (1.0 / (double)((2 * k - 1) * (2 * k))); }
            cosT[i] = (float)cs; sinT[i] = (float)(sn * rr);
        }
        for (int i = vcu * 512 + tid; i < (int)(CTL_BYTES / 16); i += G * 512) { const size_t off = (size_t)i * 16;
            if (off < WS_ROWSQ || off >= WS_ROWSQ + (size_t)M * 4) *(u32x4*)(ws + WS_CTL + off) = (u32x4){0u, 0u, 0u, 0u}; }
        convert_rows(ap->x, Hb, rowsq, gw, ngw, lane);
    }
    asm volatile("s_waitcnt vmcnt(0)" ::: "memory");
    __syncthreads();
    if (tid == 0) { __builtin_amdgcn_fence(__ATOMIC_RELEASE, "agent"); asm volatile("s_waitcnt vmcnt(0)" ::: "memory"); }
    grid.sync();
    if (tid == 0) { __builtin_amdgcn_fence(__ATOMIC_ACQUIRE, "agent"); asm volatile("s_waitcnt vmcnt(0)" ::: "memory"); }
    __syncthreads();
    XcdBarrier xbar; { PHASE_ARGS(); xbar = xcd_barrier_post((unsigned*)(ws + WS_CTL) + 1024, misc); }

    for (int l = 0; l < DEPTH; ++l) {
        const float lambda_init = 0.8f - 0.6f * __expf(-0.3f * (float)l);
        {
            PHASE_ARGS(); unsigned char* const wl = ws + WS_W + (size_t)l * W_LAYER; (void)wl;
            pg8::Gemm g{Hb, (const bf16*)(wl + W_IN), M, NIN, D}; pg8::StaticOrder So; So.init(M, NIN, G, bx);
            EpiInProj E{QKV, ap->qn_a + l * 64, ap->kn_a + l * 64, ap->qn_b + l * 64, ap->kn_b + l * 64, cosT, sinT, rowsq + (size_t)(2 * l) * M};
            pg8::gemm_phase<EpiInProj, pg8::StaticOrder, true, true>(lds, g, So, E);
            if (l == 0) {
                const int nidle = G - 64;
                if (nidle >= 64) { if (bx >= 64) { CONVERT_WEIGHTS(0, (bx - 64) * 8 + wave, nidle * 8, I_IN, I_L); CONVERT_WEIGHTS(1, (bx - 64) * 8 + wave, nidle * 8, 0, I_L); } }
                else { CONVERT_WEIGHTS(0, gw, ngw, I_IN, I_L); CONVERT_WEIGHTS(1, gw, ngw, 0, I_L); }
            }
        }
        xcd_barrier(xbar);
        {
            PHASE_ARGS(); unsigned char* const wl = ws + WS_W + (size_t)l * W_LAYER; (void)wl;
            int lane = threadIdx.x & 63; asm volatile("" : "+v"(lane));
            const float mqa = wave_max(fabsf(ap->qn_a[l * 64 + lane])), mka = wave_max(fabsf(ap->kn_a[l * 64 + lane]));
            const float mqb = wave_max(fabsf(ap->qn_b[l * 64 + lane])), mkb = wave_max(fabsf(ap->kn_b[l * 64 + lane]));
            const float MbA = uniform_f(8.f * mqa * mka * LOG2E * 1.02f), MbB = uniform_f(8.f * mqb * mkb * LOG2E * 1.02f);
            const float s1 = wave_sum(ap->lq1[l * 64 + lane] * ap->lk1[l * 64 + lane]), s2 = wave_sum(ap->lq2[l * 64 + lane] * ap->lk2[l * 64 + lane]);
            const float lam = uniform_f(__expf(s1) - __expf(s2) + lambda_init);
            {
            for (int uidx = vcu; uidx < NB * 4 * 16; uidx += G) {
                const int bh = uidx >> 4, qb = uidx & 15;
                att::diff_unit((LAS char*)lds, QKV, Yb, bh >> 2, bh & 3, qb, MbB, lam, ap->subln + l * 128, 1.f - lambda_init);
            }
            for (int uidx = vcu; uidx < NB * 2 * 16; uidx += G) {
                const int bk = uidx >> 4, n = uidx & 15;
                att::swa_unit((LAS char*)lds, QKV, Yb, bk >> 1, bk & 1, n, MbA, ap->sink + l * 8);
            }
            __syncthreads();
            }
        }
        xcd_barrier(xbar);
        {
            PHASE_ARGS(); unsigned char* const wl = ws + WS_W + (size_t)l * W_LAYER; (void)wl;
            pg8::Gemm g{Yb, (const bf16*)(wl + W_OUT), M, D, D}; pg8::StaticOrder So; So.init(M, D, G, bx);
            EpiResid E{Hb, rowsq + (size_t)(2 * l + 1) * M, nullptr};
            pg8::gemm_phase<EpiResid, pg8::StaticOrder, true, true>(lds, g, So, E);
        }
        xcd_barrier(xbar);
        {
            PHASE_ARGS(); unsigned char* const wl = ws + WS_W + (size_t)l * W_LAYER; (void)wl;
            pg8::Gemm g{Hb, (const bf16*)(wl + W_UP), M, NUP, D}; pg8::StaticOrder So; So.init(M, NUP, G, bx);
            EpiUpConv E{ACT, ap->conv_w + (size_t)l * 3 * FF, ap->conv_b + (size_t)l * FF, edge, part, (LAS float*)(lds + XL_OFF), rowsq + (size_t)(2 * l + 1) * M};
            pg8::gemm_phase<EpiUpConv, pg8::StaticOrder, true, true>(lds, g, So, E);
        }
        xcd_barrier(xbar);
        {
            PHASE_ARGS(); unsigned char* const wl = ws + WS_W + (size_t)l * W_LAYER; (void)wl;
            pg8::Gemm g{ACT, (const bf16*)(wl + W_DOWN), M, D, FF}; pg8::StaticOrder So; So.init(M, D, G, bx);
            { const float* cw = ap->conv_w + (size_t)l * 3 * FF; pg8::Unit uu; int tid = threadIdx.x; asm volatile("" : "+v"(tid));
              for (int ui = 0; So.next(ui, uu); ++ui) { const int pm = uu.pm;
                for (int i = tid; i < 2 * FF; i += 512) { const int which = i / FF, ch = i % FF;
                    if (which == 0 && (pm & 7) != 0) { const float* pp = part + (((size_t)pm * 2 + 0) * FF + ch) * 2;
                        const float pre = pp[0] + cw[ch] * edge[((size_t)(pm - 1) * 2 + 1) * FF + ch];
                        ACT[(size_t)(pm * 256) * FF + ch] = (bf16)f2bf(silu_f(pre) * pp[1]); }
                    if (which == 1 && (pm & 7) != 7) { const float* pp = part + (((size_t)pm * 2 + 1) * FF + ch) * 2;
                        const float pre = pp[0] + cw[2 * FF + ch] * edge[((size_t)(pm + 1) * 2 + 0) * FF + ch];
                        ACT[(size_t)(pm * 256 + 255) * FF + ch] = (bf16)f2bf(silu_f(pre) * pp[1]); } } }
              asm volatile("s_waitcnt vmcnt(0)" ::: "memory"); __syncthreads(); }
            const bool lastl = (l + 1 == DEPTH);
            EpiResid E{Hb, lastl ? nullptr : rowsq + (size_t)(2 * l + 2) * M, lastl ? ap->out : nullptr};
            pg8::gemm_phase<EpiResid, pg8::StaticOrder, true, true>(lds, g, So, E);
        }
        if (l + 1 < DEPTH) xcd_barrier(xbar);
    }
}

extern "C" void kernel_launch(void* const* d_in, const int* in_sizes, int n_in, void* d_out, int out_size, void* d_ws, size_t ws_size, hipStream_t stream) {
    static int grid = 0;
    if (grid == 0) {
        if (n_in != 19 || ws_size < WS_END) { fprintf(stderr, "kernel_launch: unexpected inputs (n_in %d, ws %zu)\n", n_in, ws_size); grid = -1; return; }
        int dev = 0, cus = 0, per_cu = 0;
        hipGetDevice(&dev);
        hipDeviceGetAttribute(&cus, hipDeviceAttributeMultiprocessorCount, dev);
        hipFuncSetAttribute((const void*)mega_fwd, hipFuncAttributeMaxDynamicSharedMemorySize, LDS_BYTES);
        hipOccupancyMaxActiveBlocksPerMultiprocessor(&per_cu, (const void*)mega_fwd, 512, LDS_BYTES);
        if (per_cu < 1) { fprintf(stderr, "kernel_launch: occupancy query reports %d blocks per CU\n", per_cu); per_cu = 1; }
        grid = cus;
        (void)hipGetLastError();
    }
    if (grid < 0) return;
    Args a{};
    const float** p = (const float**)&a;
    for (int i = 0; i < 19; ++i) p[i] = (const float*)d_in[i];
    a.out = (float*)d_out; a.ws = (unsigned char*)d_ws;
    void* args[] = {&a};
    hipError_t e = hipLaunchCooperativeKernel((const void*)mega_fwd, dim3(grid), dim3(512), args, LDS_BYTES, stream);
    if (e != hipSuccess) fprintf(stderr, "cooperative launch failed: %s (grid %d)\n", hipGetErrorString(e), grid);
}
```
